# Optimizing an MI355X kernel written in HIP

```python
import math
import jax, jax.numpy as jnp
from jax import lax
import numpy as np

D_MODEL = 1024
BATCH = 8
SEQ = 2048
DEPTH = 1

MEM_LEN = 256
CHUNK = 128
A_GROUPS = 8
A_WIDTH = D_MODEL
A_GROUP_DIM = A_WIDTH // A_GROUPS
SB_HEADS = 8
SB_HEAD_DIM = D_MODEL // SB_HEADS
SB_WIDTH = SB_HEADS * SB_HEAD_DIM
Q_BLOCK = 128
MEM_HEADS = 4
MEM_HEAD_DIM = 128
MEM_WIDTH = MEM_HEADS * MEM_HEAD_DIM
N_EXPERTS = 64
TOP_K = 8
N_GROUPS = 8
TOPK_GROUPS = 4
EXPERT_HIDDEN = 256
SHARED_HIDDEN = 256
ROUTED_SCALE = 2.5
MOE_BLOCK = 256
LN_EPS = 1e-5
ALPHA = (2 * DEPTH) ** 0.25
BETA = (8 * DEPTH) ** -0.25
IN_WIDTH = 2 * A_WIDTH + 3 * SB_WIDTH + 2 * D_MODEL

kernel_name = "hybrid_gmlp_stickbreak_mem_moe_deepnorm"


def layer_norm(x, g, b):
    xf = x.astype(jnp.float32)
    mu = jnp.mean(xf, axis=-1, keepdims=True)
    var = jnp.mean(jnp.square(xf - mu), axis=-1, keepdims=True)
    y = (xf - mu) * lax.rsqrt(var + LN_EPS) * g.astype(jnp.float32) + b.astype(jnp.float32)
    return y.astype(x.dtype)


def chunk_gmlp(u, v, ln_g, ln_b, w_s, b_s):
    bsz, seq, _ = u.shape
    n_chunks = seq // CHUNK
    v = layer_norm(v, ln_g, ln_b).reshape(bsz, n_chunks, CHUNK, A_GROUPS, A_GROUP_DIM)
    w = jnp.tril(w_s)
    mixed = jnp.einsum('gts,bcsgd->bctgd', w, v) + b_s.T[None, None, :, :, None]
    return u * mixed.reshape(bsz, seq, A_WIDTH)


def stick_breaking_attention(q, k, v):
    seq = q.shape[1]
    scale = SB_HEAD_DIM ** -0.5
    outs = []
    for i in range(seq // Q_BLOCK):
        q0 = i * Q_BLOCK
        kend = q0 + Q_BLOCK
        qb = q[:, q0:kend]
        kb = k[:, :kend]
        vb = v[:, :kend]
        z = jnp.einsum('bqhd,bkhd->bhqk', qb, kb,
                       preferred_element_type=jnp.float32) * scale
        t_pos = q0 + jnp.arange(Q_BLOCK)
        s_pos = jnp.arange(kend)
        mask = s_pos[None, :] < t_pos[:, None]
        log_stay = jnp.where(mask, jax.nn.log_sigmoid(-z), 0.0)
        log_w = jax.nn.log_sigmoid(z) + lax.cumsum(log_stay, axis=3, reverse=True) - log_stay
        a = jnp.where(mask, jnp.exp(log_w), 0.0)
        outs.append(jnp.einsum('bhqk,bkhd->bqhd', a.astype(v.dtype), vb))
    return jnp.concatenate(outs, axis=1)


def memory_attention(x, mem, w_q, w_kv, w_o):
    bsz, seq, _ = x.shape
    q = (x @ w_q).reshape(bsz, seq, MEM_HEADS, MEM_HEAD_DIM)
    k, v = jnp.split(mem @ w_kv, 2, axis=-1)
    k = k.reshape(bsz, MEM_LEN, MEM_HEADS, MEM_HEAD_DIM)
    v = v.reshape(bsz, MEM_LEN, MEM_HEADS, MEM_HEAD_DIM)
    logits = jnp.einsum('bqhd,bmhd->bhqm', q, k,
                        preferred_element_type=jnp.float32) * (MEM_HEAD_DIM ** -0.5)
    p = jax.nn.softmax(logits, axis=-1).astype(v.dtype)
    o = jnp.einsum('bhqm,bmhd->bqhd', p, v).reshape(bsz, seq, MEM_WIDTH)
    return o @ w_o


def swiglu(x, w_gate, w_up, w_down):
    return (jax.nn.silu(x @ w_gate) * (x @ w_up)) @ w_down


def route(xf, w_router, e_bias):
    n_tok = xf.shape[0]
    scores = jax.nn.sigmoid(xf.astype(jnp.float32) @ w_router.astype(jnp.float32))
    sel = scores + e_bias.astype(jnp.float32)[None, :]
    grouped = sel.reshape(n_tok, N_GROUPS, N_EXPERTS // N_GROUPS)
    group_score = jnp.sum(lax.top_k(grouped, 2)[0], axis=-1)
    _, gidx = lax.top_k(group_score, TOPK_GROUPS)
    gmask = jnp.any(gidx[:, :, None] == jnp.arange(N_GROUPS)[None, None, :], axis=1)
    emask = jnp.repeat(gmask, N_EXPERTS // N_GROUPS, axis=1)
    sel = jnp.where(emask, sel, -jnp.inf)
    _, idx = lax.top_k(sel, TOP_K)
    w = jnp.take_along_axis(scores, idx, axis=1)
    w = w / jnp.sum(w, axis=-1, keepdims=True) * ROUTED_SCALE
    return idx, w


def routed_experts(xf, idx, gate_w, w_gate, w_up, w_down):
    n_tok, d = xf.shape
    n_assign = n_tok * TOP_K
    flat_e = idx.reshape(-1).astype(jnp.int32)
    flat_tok = jnp.repeat(jnp.arange(n_tok, dtype=jnp.int32), TOP_K)
    flat_w = gate_w.reshape(-1)
    order = jnp.argsort(flat_e)
    e_sorted = flat_e[order]
    tok_sorted = flat_tok[order]
    w_sorted = flat_w[order]
    counts = jnp.bincount(flat_e, length=N_EXPERTS).astype(jnp.int32)
    start = jnp.cumsum(counts) - counts
    padded = (counts + MOE_BLOCK - 1) // MOE_BLOCK * MOE_BLOCK
    pad_end = jnp.cumsum(padded)
    pad_start = pad_end - padded
    dest = pad_start[e_sorted] + (jnp.arange(n_assign, dtype=jnp.int32) - start[e_sorted])
    n_blocks = -(-n_assign // MOE_BLOCK) + N_EXPERTS
    n_rows = n_blocks * MOE_BLOCK
    row_tok = jnp.full((n_rows,), n_tok, jnp.int32).at[dest].set(tok_sorted)
    row_w = jnp.zeros((n_rows,), xf.dtype).at[dest].set(w_sorted.astype(xf.dtype))
    block_start = jnp.arange(n_blocks, dtype=jnp.int32) * MOE_BLOCK
    block_e = jnp.minimum(jnp.searchsorted(pad_end, block_start, side='right'),
                          N_EXPERTS - 1).astype(jnp.int32)
    x_pad = jnp.concatenate([xf, jnp.zeros((1, d), xf.dtype)], axis=0)

    def block_fn(args):
        toks, e = args
        xb = x_pad[toks]
        return swiglu(xb, w_gate[e], w_up[e], w_down[e])

    yb = lax.map(block_fn, (row_tok.reshape(n_blocks, MOE_BLOCK), block_e))
    y = yb.reshape(n_rows, d) * row_w[:, None]
    return jax.ops.segment_sum(y, row_tok, num_segments=n_tok + 1)[:n_tok]


def setup_inputs(seed: int = 0) -> dict:
    key = jax.random.key(seed)
    ks = jax.random.split(key, 32)
    f32 = jnp.float32

    def nrm(k, shape, scale):
        return jax.random.normal(k, shape, f32) * scale

    return {
        "x": nrm(ks[0], (BATCH, SEQ, D_MODEL), 1.0),
        "mem": nrm(ks[1], (BATCH, MEM_LEN, D_MODEL), 1.0),
        "ln_in_g": 1.0 + nrm(ks[2], (D_MODEL,), 0.02),
        "ln_in_b": nrm(ks[3], (D_MODEL,), 0.02),
        "w_in": nrm(ks[4], (DEPTH, D_MODEL, IN_WIDTH), D_MODEL ** -0.5),
        "b_in": nrm(ks[5], (DEPTH, IN_WIDTH), 0.02),
        "ln_v_g": 1.0 + nrm(ks[6], (DEPTH, A_WIDTH), 0.02),
        "ln_v_b": nrm(ks[7], (DEPTH, A_WIDTH), 0.02),
        "w_spatial": nrm(ks[8], (DEPTH, A_GROUPS, CHUNK, CHUNK), CHUNK ** -0.5),
        "b_spatial": 1.0 + nrm(ks[9], (DEPTH, A_GROUPS, CHUNK), 0.02),
        "w_out": nrm(ks[10], (DEPTH, D_MODEL, D_MODEL), BETA * D_MODEL ** -0.5),
        "ln1_g": 1.0 + nrm(ks[11], (DEPTH, D_MODEL), 0.02),
        "ln1_b": nrm(ks[12], (DEPTH, D_MODEL), 0.02),
        "w_mem_q": nrm(ks[13], (DEPTH, D_MODEL, MEM_WIDTH), D_MODEL ** -0.5),
        "w_mem_kv": nrm(ks[14], (DEPTH, D_MODEL, 2 * MEM_WIDTH), D_MODEL ** -0.5),
        "w_mem_o": nrm(ks[15], (DEPTH, MEM_WIDTH, D_MODEL), BETA * MEM_WIDTH ** -0.5),
        "ln2_g": 1.0 + nrm(ks[16], (DEPTH, D_MODEL), 0.02),
        "ln2_b": nrm(ks[17], (DEPTH, D_MODEL), 0.02),
        "w_router": nrm(ks[18], (DEPTH, D_MODEL, N_EXPERTS), D_MODEL ** -0.5),
        "router_bias": nrm(ks[19], (DEPTH, N_EXPERTS), 0.01),
        "w_exp_gate": nrm(ks[20], (DEPTH, N_EXPERTS, D_MODEL, EXPERT_HIDDEN), D_MODEL ** -0.5),
        "w_exp_up": nrm(ks[21], (DEPTH, N_EXPERTS, D_MODEL, EXPERT_HIDDEN), D_MODEL ** -0.5),
        "w_exp_down": nrm(ks[22], (DEPTH, N_EXPERTS, EXPERT_HIDDEN, D_MODEL), BETA * EXPERT_HIDDEN ** -0.5),
        "w_sh_gate": nrm(ks[23], (DEPTH, D_MODEL, SHARED_HIDDEN), D_MODEL ** -0.5),
        "w_sh_up": nrm(ks[24], (DEPTH, D_MODEL, SHARED_HIDDEN), D_MODEL ** -0.5),
        "w_sh_down": nrm(ks[25], (DEPTH, SHARED_HIDDEN, D_MODEL), BETA * SHARED_HIDDEN ** -0.5),
        "ln3_g": 1.0 + nrm(ks[26], (DEPTH, D_MODEL), 0.02),
        "ln3_b": nrm(ks[27], (DEPTH, D_MODEL), 0.02),
    }


def reference(x, mem, ln_in_g, ln_in_b, w_in, b_in, ln_v_g, ln_v_b, w_spatial, b_spatial,
              w_out, ln1_g, ln1_b, w_mem_q, w_mem_kv, w_mem_o, ln2_g, ln2_b,
              w_router, router_bias, w_exp_gate, w_exp_up, w_exp_down,
              w_sh_gate, w_sh_up, w_sh_down, ln3_g, ln3_b):
    bsz, seq, d = x.shape
    split_at = [A_WIDTH, 2 * A_WIDTH,
                2 * A_WIDTH + SB_WIDTH,
                2 * A_WIDTH + 2 * SB_WIDTH,
                2 * A_WIDTH + 3 * SB_WIDTH,
                2 * A_WIDTH + 3 * SB_WIDTH + D_MODEL]
    x = layer_norm(x, ln_in_g, ln_in_b)
    for l in range(DEPTH):
        proj = x @ w_in[l] + b_in[l]
        u_a, v_a, q_b, k_b, v_b, g_a, g_b = jnp.split(proj, split_at, axis=-1)
        y_a = chunk_gmlp(jax.nn.gelu(u_a, approximate=False), jax.nn.gelu(v_a, approximate=False),
                         ln_v_g[l], ln_v_b[l], w_spatial[l], b_spatial[l])
        heads = (bsz, seq, SB_HEADS, SB_HEAD_DIM)
        y_b = stick_breaking_attention(q_b.reshape(heads), k_b.reshape(heads),
                                       v_b.reshape(heads)).reshape(bsz, seq, SB_WIDTH)
        merged = jax.nn.sigmoid(g_a) * y_a + jax.nn.sigmoid(g_b) * y_b
        x = layer_norm(ALPHA * x + merged @ w_out[l], ln1_g[l], ln1_b[l])
        m = memory_attention(x, mem, w_mem_q[l], w_mem_kv[l], w_mem_o[l])
        x = layer_norm(ALPHA * x + m, ln2_g[l], ln2_b[l])
        xf = x.reshape(bsz * seq, d)
        idx, gate_w = route(xf, w_router[l], router_bias[l])
        moe = swiglu(xf, w_sh_gate[l], w_sh_up[l], w_sh_down[l]) + \
            routed_experts(xf, idx, gate_w, w_exp_gate[l], w_exp_up[l], w_exp_down[l])
        x = layer_norm(ALPHA * x + moe.reshape(bsz, seq, d), ln3_g[l], ln3_b[l])
    return x
```

```cpp
#include <hip/hip_runtime.h>
#include <cstdio>
#include <cstdint>

#ifndef MK_N_LAUNCHES
#define MK_N_LAUNCHES 1
#endif

#define GAS __attribute__((address_space(1)))
#define LAS __attribute__((address_space(3)))
typedef unsigned short bf16;
typedef short bf16x8 __attribute__((ext_vector_type(8)));
typedef short s16x4 __attribute__((ext_vector_type(4)));
typedef float f32x4 __attribute__((ext_vector_type(4)));
typedef float f32x2 __attribute__((ext_vector_type(2)));
typedef unsigned u32x4 __attribute__((ext_vector_type(4)));
typedef unsigned u32x2 __attribute__((ext_vector_type(2)));
#define RLX_AGENT __ATOMIC_RELAXED, __HIP_MEMORY_SCOPE_AGENT
#define DI __device__ __forceinline__

constexpr int T = 16384, D = 1024, NBATCH = 8, SEQ = 2048, MEMLEN = 256, INW = 7168;
constexpr int NEXP = 64, TOPK = 8, EH = 256, MEMW = 512;
constexpr float LN_EPS = 1e-5f;
constexpr float ALPHA = 1.189207115002721f;
constexpr float QSCALE = 0.08838834764831845f;
constexpr float ROUTED_SCALE = 2.5f;
constexpr float LOG2E = 1.4426950408889634f, LN2 = 0.6931471805599453f;
constexpr float SB_EXIT = -30.0f;
constexpr int NWAVES = 8, NTHREADS = 512;
constexpr int MAXBLK = 576;
constexpr int SH_ROW0 = MAXBLK * 256;

constexpr size_t MiB = 1u << 20;
constexpr size_t WS_CTL = 0, CTL_ZERO_BYTES = 1 * MiB;
constexpr size_t WS_WRHI = 1 * MiB, WS_WRLO = WS_WRHI + 128 * 1024, WS_WSP = WS_WRLO + 128 * 1024, WS_BPERM = WS_WSP + 256 * 1024, WS_XSTAT = WS_BPERM + 32 * 1024;
constexpr size_t WS_ROWTOK = 2 * MiB, WS_ROWW = WS_ROWTOK + 576 * 1024, WS_SLOT = WS_ROWW + 576 * 1024;
constexpr size_t WS_WIN = 4 * MiB, WS_WOUT = 18 * MiB, WS_WQ = 20 * MiB, WS_WKV = 21 * MiB, WS_WO = 23 * MiB, WS_MEMB = 24 * MiB;
constexpr size_t WS_P1 = 29 * MiB;
constexpr size_t WS_UG = WS_P1, WS_VA = WS_P1 + 32 * MiB, WS_Q = WS_P1 + 64 * MiB, WS_K = WS_P1 + 96 * MiB, WS_V = WS_P1 + 128 * MiB, WS_GB = WS_P1 + 160 * MiB;
constexpr size_t WS_VSTAT = 221 * MiB;
constexpr size_t WS_MERGED = 228 * MiB;
constexpr size_t WS_Y1 = 29 * MiB;
constexpr size_t WS_X1F = 93 * MiB, WS_X1B = 157 * MiB;
constexpr size_t WS_QM = 189 * MiB, WS_KVM = 205 * MiB, WS_OM = 209 * MiB;
constexpr size_t WS_WGU = 29 * MiB;
constexpr size_t WS_H = 148 * MiB;
constexpr size_t WS_X2B = 228 * MiB;
constexpr size_t WS_WD = 260 * MiB;
constexpr size_t WS_WGUS = 293 * MiB, WS_WDS = 294 * MiB;
constexpr size_t WS_TK = 295 * MiB, WS_TKW = WS_TK + 512 * 1024, WS_WGBASE = WS_TKW + 512 * 1024;
constexpr size_t WS_YH = 4 * MiB;
constexpr size_t WS_END = 297 * MiB;
static_assert(WS_XSTAT + (size_t)T * 8 <= WS_ROWTOK && WS_SLOT + (size_t)T * 8 * 4 <= WS_WIN && WS_MEMB + 4 * MiB <= WS_P1, "ws map 1");
static_assert(WS_GB + 32 * MiB <= WS_VSTAT && WS_VSTAT + 2 * MiB <= WS_MERGED && WS_H + (size_t)(SH_ROW0 + T) * 512 <= WS_X2B && WS_X2B + 32 * MiB <= WS_WD, "ws map 2");
static_assert(WS_WD + (size_t)64 * 1024 * 256 * 2 <= WS_WGUS && WS_YH + (size_t)288 * 256 * 2048 <= WS_H && WS_WGBASE + 256 * 64 * 4 <= WS_END, "ws map 3");
constexpr int CW_TMO = 0, CW_CODE = 1;
constexpr int CW_GCOUNT = 64;
constexpr int CW_HDR = 192;
constexpr int CW_BLKE = 256;
constexpr int CW_BAR = 4096;

constexpr int SCR_BYTES = 140 * 1024;
constexpr int MISC_OFF = SCR_BYTES;
constexpr int LDS_BYTES = 144 * 1024;

DI unsigned cvt_pk_bf16(float lo, float hi) { unsigned r; asm volatile("v_cvt_pk_bf16_f32 %0, %1, %2" : "=v"(r) : "v"(lo), "v"(hi)); return r; }
DI float bf2f(unsigned short h) { return __uint_as_float((unsigned)h << 16); }
DI float bflo(unsigned w) { return __uint_as_float(w << 16); }
DI float bfhi(unsigned w) { return __uint_as_float(w & 0xffff0000u); }
DI float fast_exp2(float x) { return __builtin_amdgcn_exp2f(x); }
DI float fast_log2(float x) { return __builtin_amdgcn_logf(x); }
DI float fast_rcp(float x) { return __builtin_amdgcn_rcpf(x); }
DI float sigmoidf_(float x) { return fast_rcp(1.0f + fast_exp2(-x * LOG2E)); }
DI float wave_sum(float v) {
#pragma unroll
    for (int o = 1; o < 64; o <<= 1) v += __shfl_xor(v, o);
    return v;
}
DI float wave_max(float v) {
#pragma unroll
    for (int o = 1; o < 64; o <<= 1) v = fmaxf(v, __shfl_xor(v, o));
    return v;
}
#define LDS_WAIT() asm volatile("s_waitcnt lgkmcnt(0)" ::: "memory")
#define VM_WAIT() asm volatile("s_waitcnt vmcnt(0)" ::: "memory")

namespace pg8 {
constexpr int BM = 256, BK = 64, HALF = 128, HTB = HALF * BK * 2, STAGE_BYTES = 8 * HTB, NXCD = 8, WGM = 8;
__host__ __device__ __forceinline__ int lds_byte(int r, int c) { const int st = (r >> 4) * 2 + (c >> 5), rr = r & 15, cc = c & 31, ob = rr * 64 + cc * 2; return st * 1024 + (ob ^ (((ob >> 9) & 1) << 5)); }
__host__ __device__ __forceinline__ void stage_rc(int b, int& R, int& C) { const int st = b / 1024, sb = b % 1024, swz = sb ^ (((sb >> 9) & 1) << 5); R = (st >> 1) * 16 + swz / 64; C = (st & 1) * 32 + (swz % 64) / 2; }
__host__ __device__ __forceinline__ int perm32(int rho) { const int n = rho >> 4, i = rho & 15; return 8 * (i >> 2) + 4 * n + (i & 3); }

struct Unit { int pm, pn, e; const char* A; const char* B; };

typedef float f32x2v __attribute__((ext_vector_type(2)));
DI f32x2v gelu_pk(f32x2v v) {
    const f32x2v av = __builtin_elementwise_abs(v), d = av * 0.2316418882f + 1.0f;
    f32x2v t; t.x = __builtin_amdgcn_rcpf(d.x); t.y = __builtin_amdgcn_rcpf(d.y);
    f32x2v q = t * 0.5307027145f + (-0.7265760135f); q = q * t + 0.7107068705f; q = q * t + (-0.142248368f); q = q * t + 0.127414796f; q = q * t;
    const f32x2v s = (v * v) * (-0.72134752044f);
    f32x2v e; e.x = __builtin_amdgcn_exp2f(s.x); e.y = __builtin_amdgcn_exp2f(s.y);
    const f32x2v m = v * (q * e), r = v - m;
    f32x2v o; o.x = v.x < 0.f ? m.x : r.x; o.y = v.y < 0.f ? m.y : r.y; return o;
}
DI f32x4 gelu4(f32x4 v) { const f32x2v a = gelu_pk((f32x2v){v[0], v[1]}), b = gelu_pk((f32x2v){v[2], v[3]}); return (f32x4){a.x, a.y, b.x, b.y}; }
DI f32x4 sigmoid4(f32x4 v) { return (f32x4){sigmoidf_(v[0]), sigmoidf_(v[1]), sigmoidf_(v[2]), sigmoidf_(v[3])}; }
DI u32x4 pack8(f32x4 v0, f32x4 v1) { u32x4 w; w.x = cvt_pk_bf16(v0[0], v0[1]); w.y = cvt_pk_bf16(v0[2], v0[3]); w.z = cvt_pk_bf16(v1[0], v1[1]); w.w = cvt_pk_bf16(v1[2], v1[3]); return w; }

template <class Epi, class Sched, bool ALIGN_EPI>
DI void gemm_phase(LAS unsigned char* lds, const int K, const Sched& S, const Epi& E) {
    const int tid = threadIdx.x, wid = __builtin_amdgcn_readfirstlane(tid >> 6), lane = tid & 63, wr = wid >> 2, wc = wid & 3, fr = lane & 15, fq = lane >> 4;
    const int nt = K / BK;
    int Rr[2], Cc[2]; unsigned voffB[2];
#pragma unroll
    for (int i = 0; i < 2; ++i) { int R, C; stage_rc(tid * 16 + i * 8192, R, C); const int Rb = Epi::PERM ? ((R & ~31) + perm32(R & 31)) : R; Rr[i] = R; Cc[i] = C; voffB[i] = (unsigned)(Rb * K + C) * 2u; }
    const size_t kstep = (size_t)(BK * 2);
    const size_t hstep = (size_t)HALF * K * 2;
    const unsigned ldsw = (unsigned)wid * 1024u;
    const int aoff = lds_byte(wr * 64 + fr, fq * 8), boff = lds_byte(wc * 32 + fr, fq * 8);
#define PG8_SA(b, h) (((b) * 2 + (h)) * HTB)
#define PG8_SB(b, h) ((4 + (b) * 2 + (h)) * HTB)
#define PG8_STAGE_B(bufoff, gbase) do { _Pragma("unroll") for (int _i = 0; _i < 2; ++_i) \
        __builtin_amdgcn_global_load_lds((const unsigned*)((const char*)(gbase) + voffB[_i]), (LAS unsigned*)(lds + (bufoff) + ldsw + _i * 8192), 16, 0, 0); } while (0)
#define PG8_STAGE_A(bufoff, gbase, o0, o1) do { \
        __builtin_amdgcn_global_load_lds((const unsigned*)((const char*)(gbase) + (o0)), (LAS unsigned*)(lds + (bufoff) + ldsw), 16, 0, 0); \
        __builtin_amdgcn_global_load_lds((const unsigned*)((const char*)(gbase) + (o1)), (LAS unsigned*)(lds + (bufoff) + ldsw + 8192), 16, 0, 0); } while (0)
#define PG8_LDA(dst, b, h) do { _Pragma("unroll") for (int m = 0; m < 4; ++m) _Pragma("unroll") for (int k = 0; k < 2; ++k) dst[m][k] = *(const LAS bf16x8*)(lds + PG8_SA(b, h) + aoff + m * 2048 + k * 1024); } while (0)
#define PG8_LDB(dst, b, h) do { _Pragma("unroll") for (int n = 0; n < 2; ++n) _Pragma("unroll") for (int k = 0; k < 2; ++k) dst[n][k] = *(const LAS bf16x8*)(lds + PG8_SB(b, h) + boff + n * 2048 + k * 1024); } while (0)
#define PG8_MMA(ai, bj, At, Bt) do { __builtin_amdgcn_s_setprio(1); _Pragma("unroll") for (int m = 0; m < 4; ++m) _Pragma("unroll") for (int n = 0; n < 2; ++n) _Pragma("unroll") for (int k = 0; k < 2; ++k) \
        acc[ai][bj][m][n] = __builtin_amdgcn_mfma_f32_16x16x32_bf16(Bt[n][k], At[m][k], acc[ai][bj][m][n], 0, 0, 0); __builtin_amdgcn_s_setprio(0); } while (0)
#define PG8_WAIT_V(n) asm volatile("s_waitcnt vmcnt(" #n ")" ::: "memory")
#define PG8_WAIT_L(n) asm volatile("s_waitcnt lgkmcnt(" #n ")" ::: "memory")
#define PG8_BAR __builtin_amdgcn_s_barrier()
#define PG8_SCHED __builtin_amdgcn_sched_barrier(0)
    Unit cur, nxt; int ui = 0;
    if (!S.next(0, cur)) return;
    unsigned oc[2][2], on[2][2];
    S.a_offs(cur, Rr, Cc, K, oc);
    f32x4 acc[2][2][4][2];
#pragma unroll
    for (int a = 0; a < 2; ++a)
#pragma unroll
        for (int b = 0; b < 2; ++b)
#pragma unroll
            for (int m = 0; m < 4; ++m)
#pragma unroll
                for (int n = 0; n < 2; ++n) acc[a][b][m][n] = (f32x4){0.f, 0.f, 0.f, 0.f};
    bf16x8 At[4][2], B0[2][2], B1[2][2];
    const char* cA = cur.A; const char* cB = cur.B;
    PG8_STAGE_B(PG8_SB(0, 0), cB); PG8_STAGE_B(PG8_SB(0, 1), cB + hstep); PG8_STAGE_A(PG8_SA(0, 0), cA, oc[0][0], oc[0][1]); PG8_STAGE_A(PG8_SA(0, 1), cA, oc[1][0], oc[1][1]);
    if (wr == 1) PG8_BAR;
    PG8_WAIT_V(2); PG8_BAR;
    PG8_STAGE_B(PG8_SB(1, 0), cB + kstep); PG8_STAGE_A(PG8_SA(1, 0), cA + kstep, oc[0][0], oc[0][1]); PG8_STAGE_B(PG8_SB(1, 1), cB + hstep + kstep);
    PG8_WAIT_V(6); PG8_BAR;
    for (;;) {
        const bool has_next = S.next(ui + 1, nxt);
        const char* nA = has_next ? nxt.A : cA; const char* nB = has_next ? nxt.B : cB;
        if (has_next) S.a_offs(nxt, Rr, Cc, K, on);
        else {
#pragma unroll
            for (int h = 0; h < 2; ++h)
#pragma unroll
                for (int i = 0; i < 2; ++i) on[h][i] = oc[h][i]; }
#pragma unroll 1
        for (int t = 0; t < nt; t += 2) {
            const bool last = (t == nt - 2);
            const char* a1 = cA + (size_t)(t + 1) * kstep;
            const char* a2 = last ? nA : cA + (size_t)(t + 2) * kstep; const char* b2 = last ? nB : cB + (size_t)(t + 2) * kstep;
            const char* a3 = a2 + kstep; const char* b3 = b2 + kstep;
            const unsigned x00 = last ? on[0][0] : oc[0][0], x01 = last ? on[0][1] : oc[0][1], x10 = last ? on[1][0] : oc[1][0], x11 = last ? on[1][1] : oc[1][1];
            PG8_LDB(B0, 0, 0); PG8_LDB(B1, 0, 1); PG8_SCHED; PG8_LDA(At, 0, 0); PG8_STAGE_A(PG8_SA(1, 1), a1, oc[1][0], oc[1][1]);
            PG8_WAIT_V(8); PG8_WAIT_L(0); PG8_BAR; PG8_MMA(0, 0, At, B0); PG8_MMA(0, 1, At, B1); PG8_BAR; PG8_SCHED;
            PG8_LDA(At, 0, 1); PG8_STAGE_B(PG8_SB(0, 0), b2); PG8_STAGE_B(PG8_SB(0, 1), b2 + hstep); PG8_STAGE_A(PG8_SA(0, 0), a2, x00, x01);
            PG8_WAIT_V(8); PG8_WAIT_L(0); PG8_BAR; PG8_MMA(1, 0, At, B0); PG8_MMA(1, 1, At, B1); PG8_BAR; PG8_SCHED;
            PG8_LDB(B0, 1, 0); PG8_LDB(B1, 1, 1); PG8_SCHED; PG8_LDA(At, 1, 0); PG8_STAGE_A(PG8_SA(0, 1), a2, x10, x11);
            PG8_WAIT_V(8); PG8_WAIT_L(0); PG8_BAR; PG8_MMA(0, 0, At, B0); PG8_MMA(0, 1, At, B1); PG8_BAR; PG8_SCHED;
            PG8_LDA(At, 1, 1); PG8_STAGE_B(PG8_SB(1, 0), b3); PG8_STAGE_B(PG8_SB(1, 1), b3 + hstep); PG8_STAGE_A(PG8_SA(1, 0), a3, x00, x01);
            PG8_WAIT_V(8); PG8_WAIT_L(0); PG8_BAR; PG8_MMA(1, 0, At, B0); PG8_MMA(1, 1, At, B1); PG8_BAR; PG8_SCHED;
        }
        if constexpr (ALIGN_EPI) { if (wr == 0) PG8_BAR; }
        E(acc, cur, wr, wc, fr, fq);
        if (!has_next) break;
#pragma unroll
        for (int a = 0; a < 2; ++a)
#pragma unroll
            for (int b = 0; b < 2; ++b)
#pragma unroll
                for (int m = 0; m < 4; ++m)
#pragma unroll
                    for (int n = 0; n < 2; ++n) acc[a][b][m][n] = (f32x4){0.f, 0.f, 0.f, 0.f};
        cur = nxt; cA = nA; cB = nB; ++ui;
#pragma unroll
        for (int h = 0; h < 2; ++h)
#pragma unroll
            for (int i = 0; i < 2; ++i) oc[h][i] = on[h][i];
        if constexpr (ALIGN_EPI) { if (wr == 1) PG8_BAR; }
    }
    PG8_WAIT_V(0);
    if constexpr (!ALIGN_EPI) { if (wr == 0) PG8_BAR; }
    PG8_BAR;
#undef PG8_SA
#undef PG8_SB
#undef PG8_STAGE_A
#undef PG8_STAGE_B
#undef PG8_LDA
#undef PG8_LDB
#undef PG8_MMA
#undef PG8_WAIT_V
#undef PG8_WAIT_L
#undef PG8_BAR
#undef PG8_SCHED
}

struct DenseOrder {
    const char* A; const char* Bt; int K, nM, nN, nwg, G, c;
    DI void init(const bf16* A_, const bf16* Bt_, int M, int N, int K_, int G_, int c_) { A = (const char*)A_; Bt = (const char*)Bt_; K = K_; nM = M / BM; nN = N / BM; nwg = nM * nN; G = G_; c = c_; }
    DI bool next(int i, Unit& u) const {
        const long L = (long)i * G + c; if (L >= nwg) return false;
        int wgid = (int)L; { const int q = nwg / NXCD, r = nwg % NXCD, xcd = wgid % NXCD, off = wgid / NXCD; wgid = (xcd < r ? xcd * (q + 1) : r * (q + 1) + (xcd - r) * q) + off; }
        const int nig = WGM * nN, gid = wgid / nig, fm = gid * WGM, gsz = (nM - fm) < WGM ? (nM - fm) : WGM;
        u.pm = fm + ((wgid % nig) % gsz); u.pn = (wgid % nig) / gsz; u.e = 0;
        u.A = A + (size_t)u.pm * BM * K * 2; u.B = Bt + (size_t)u.pn * BM * K * 2; return true;
    }
    DI void a_offs(const Unit&, const int (&R)[2], const int (&C)[2], int K_, unsigned (&off)[2][2]) const {
#pragma unroll
        for (int h = 0; h < 2; ++h)
#pragma unroll
            for (int i = 0; i < 2; ++i) off[h][i] = (unsigned)((h * HALF + R[i]) * K_ + C[i]) * 2u;
    }
};
}

#define XB_TMO      128
#define XB_XCNT(j)  (256  + 64 * (j))
#define XB_XSUB(j)  (1280 + 64 * (j))
#define XB_XGEN(j)  (2304 + 64 * (j))
#define XB_TOP      3328
#define XB_TOPGEN   3392
#define XCD_BAR_WORDS 3456
#define XB_SPIN_CAP (1u << 18)
DI unsigned xb_ld(unsigned* p)              { return __hip_atomic_load(p, __ATOMIC_RELAXED, __HIP_MEMORY_SCOPE_AGENT); }
DI unsigned xb_add(unsigned* p, unsigned v) { return __hip_atomic_fetch_add(p, v, __ATOMIC_RELAXED, __HIP_MEMORY_SCOPE_AGENT); }
DI unsigned xb_xcc_id() { return (unsigned)__builtin_amdgcn_s_getreg((3 << 11) | 20) & 0xFu; }
#define XB_SPIN(cond, bar) do { unsigned _sp = 0; while (cond) { __builtin_amdgcn_s_sleep(1); \
    if ((++_sp & 255u) == 0u) { if (xb_ld(&(bar)[XB_TMO])) break; if (_sp > XB_SPIN_CAP) { atomicAdd(&(bar)[XB_TMO], 1u); break; } } } } while (0)
struct XcdBarrier { unsigned* bar; unsigned x; volatile LAS unsigned* st; };
DI XcdBarrier xcd_barrier_post(unsigned* bar, volatile LAS unsigned* st) {
    XcdBarrier b; b.bar = bar; b.x = xb_xcc_id(); b.st = st;
    if (threadIdx.x == 0) (void)xb_add(&bar[XB_XCNT(b.x)], 1u);
    return b;
}
DI void xcd_barrier_complete(unsigned* bar, unsigned x, unsigned& nloc, unsigned& nx) {
    const unsigned G = gridDim.x * gridDim.y * gridDim.z;
    unsigned sum, cnt, mine, sp = 0u;
    for (;;) {
        sum = 0u; cnt = 0u; mine = 0u;
#pragma unroll
        for (unsigned j = 0; j < 16; ++j) { const unsigned c = xb_ld(&bar[XB_XCNT(j)]); sum += c; cnt += (c > 0u) ? 1u : 0u; mine = (j == x) ? c : mine; }
        if (sum == G) break;
        __builtin_amdgcn_s_sleep(1);
        if ((++sp & 255u) == 0u) { if (xb_ld(&bar[XB_TMO])) break; if (sp > XB_SPIN_CAP) { atomicAdd(&bar[XB_TMO], 1u); break; } }
    }
    nloc = mine > 0u ? mine : 1u; nx = cnt > 0u ? cnt : 1u;
}
DI void xcd_barrier(const XcdBarrier& b) {
    asm volatile("s_waitcnt vmcnt(0)" ::: "memory");
    __syncthreads();
    if (threadIdx.x == 0) {
        unsigned* bar = b.bar;
        __builtin_amdgcn_s_waitcnt(0);
        unsigned nloc = b.st[0], nx = b.st[1];
        if (nloc == 0u) { xcd_barrier_complete(bar, b.x, nloc, nx); b.st[0] = nloc; b.st[1] = nx; }
        const unsigned old = xb_add(&bar[XB_XSUB(b.x)], 1u);
        const unsigned gen = old / nloc;
        if (old + 1u == (gen + 1u) * nloc) {
            __builtin_amdgcn_fence(__ATOMIC_RELEASE, "agent");
            asm volatile("s_waitcnt vmcnt(0)" ::: "memory");
            const unsigned og = xb_add(&bar[XB_TOP], 1u);
            const unsigned tg = og / nx;
            if (og + 1u == (tg + 1u) * nx) xb_add(&bar[XB_TOPGEN], 1u);
            else XB_SPIN(xb_ld(&bar[XB_TOPGEN]) == tg, bar);
            __builtin_amdgcn_fence(__ATOMIC_ACQUIRE, "agent");
            xb_add(&bar[XB_XGEN(b.x)], 1u);
            asm volatile("s_waitcnt vmcnt(0)" ::: "memory");
        } else {
            XB_SPIN(xb_ld(&bar[XB_XGEN(b.x)]) == gen, bar);
            __builtin_amdgcn_fence(__ATOMIC_ACQUIRE, "agent");
            asm volatile("s_waitcnt vmcnt(0)" ::: "memory");
        }
    }
    __syncthreads();
}

namespace pg8 {
typedef __bf16 bf16x2_t __attribute__((ext_vector_type(2)));
DI unsigned pk2(float lo, float hi) { f32x2v v = {lo, hi}; bf16x2_t b = __builtin_convertvector(v, bf16x2_t); return __builtin_bit_cast(unsigned, b); }
DI u32x4 pk8(f32x4 v0, f32x4 v1) { u32x4 w; w.x = pk2(v0[0], v0[1]); w.y = pk2(v0[2], v0[3]); w.z = pk2(v1[0], v1[1]); w.w = pk2(v1[2], v1[3]); return w; }

struct EpiInProj {
    static constexpr bool PERM = true;
    bf16* P1; float* vstat; const float* bias;
    DI void operator()(const f32x4 (&acc)[2][2][4][2], const Unit& u, int wr, int wc, int fr, int fq) const {
        const int row0 = u.pm * BM + wr * 64 + fr;
        const int bcol0 = u.pn * BM + wc * 32 + 8 * fq;
        f32x4 bv[2][2];
#pragma unroll
        for (int bj = 0; bj < 2; ++bj)
#pragma unroll
            for (int n = 0; n < 2; ++n) bv[bj][n] = *(const f32x4*)(bias + bcol0 + bj * HALF + 4 * n);
        if (u.pn < 8) {
            bf16* base = P1 + u.pn * 128 + wc * 32 + 8 * fq;
#pragma unroll
            for (int ai = 0; ai < 2; ++ai)
#pragma unroll
                for (int m = 0; m < 4; ++m) {
                    f32x4 u0 = gelu4(acc[ai][0][m][0] + bv[0][0]), u1 = gelu4(acc[ai][0][m][1] + bv[0][1]);
                    const f32x4 g0 = sigmoid4(acc[ai][1][m][0] + bv[1][0]), g1 = sigmoid4(acc[ai][1][m][1] + bv[1][1]);
                    u0 = u0 * g0; u1 = u1 * g1;
                    *(u32x4*)(base + (size_t)(row0 + ai * HALF + m * 16) * D) = pk8(u0, u1);
                }
        } else {
            const int t = (u.pn - 8) >> 2, colt = ((u.pn - 8) & 3) * BM;
            bf16* base = P1 + (size_t)(t + 1) * T * D + colt + wc * 32 + 8 * fq;
#pragma unroll
            for (int ai = 0; ai < 2; ++ai)
#pragma unroll
                for (int m = 0; m < 4; ++m) {
                    float s1 = 0.f, s2 = 0.f;
#pragma unroll
                    for (int bj = 0; bj < 2; ++bj) {
                        f32x4 v0 = acc[ai][bj][m][0] + bv[bj][0], v1 = acc[ai][bj][m][1] + bv[bj][1];
                        if (t == 0) { v0 = gelu4(v0); v1 = gelu4(v1);
                            s1 += (v0[0] + v0[1]) + (v0[2] + v0[3]) + (v1[0] + v1[1]) + (v1[2] + v1[3]);
                            s2 += (v0[0] * v0[0] + v0[1] * v0[1]) + (v0[2] * v0[2] + v0[3] * v0[3]) + (v1[0] * v1[0] + v1[1] * v1[1]) + (v1[2] * v1[2] + v1[3] * v1[3]); }
                        else if (t == 1) { v0 = v0 * QSCALE; v1 = v1 * QSCALE; }
                        else if (t == 4) { v0 = sigmoid4(v0); v1 = sigmoid4(v1); }
                        *(u32x4*)(base + (size_t)(row0 + ai * HALF + m * 16) * D + bj * HALF) = pk8(v0, v1);
                    }
                    if (t == 0) {
                        s1 += __shfl_xor(s1, 16); s1 += __shfl_xor(s1, 32); s2 += __shfl_xor(s2, 16); s2 += __shfl_xor(s2, 32);
                        if (fq == 0) *(f32x2v*)(vstat + ((size_t)(row0 + ai * HALF + m * 16) * 16 + (u.pn - 8) * 4 + wc) * 2) = (f32x2v){s1, s2};
                    }
                }
        }
    }
};
struct EpiBf16S {
    static constexpr bool PERM = true;
    bf16* O; int ldc; float scale;
    DI void operator()(const f32x4 (&acc)[2][2][4][2], const Unit& u, int wr, int wc, int fr, int fq) const {
        const int row0 = u.pm * BM + wr * 64 + fr, col0 = u.pn * BM + wc * 32 + 8 * fq;
#pragma unroll
        for (int ai = 0; ai < 2; ++ai)
#pragma unroll
            for (int m = 0; m < 4; ++m)
#pragma unroll
                for (int bj = 0; bj < 2; ++bj)
                    *(u32x4*)(O + (size_t)(row0 + ai * HALF + m * 16) * ldc + col0 + bj * HALF) = pk8(acc[ai][bj][m][0] * scale, acc[ai][bj][m][1] * scale);
    }
};
template <bool LNIN> struct EpiResF32 {
    static constexpr bool PERM = false;
    float* out; const float* res; const float* xstat; const float* g; const float* b;
    DI void operator()(const f32x4 (&acc)[2][2][4][2], const Unit& u, int wr, int wc, int fr, int fq) const {
        const int col0 = u.pn * BM + wc * 32 + 4 * fq;
        f32x4 gv[2][2], bv[2][2];
        if (LNIN) {
#pragma unroll
            for (int bj = 0; bj < 2; ++bj)
#pragma unroll
                for (int n = 0; n < 2; ++n) { gv[bj][n] = *(const f32x4*)(g + col0 + bj * HALF + n * 16); bv[bj][n] = *(const f32x4*)(b + col0 + bj * HALF + n * 16); }
        }
#pragma unroll
        for (int ai = 0; ai < 2; ++ai)
#pragma unroll
            for (int m = 0; m < 4; ++m) {
                const int row = u.pm * BM + ai * HALF + wr * 64 + m * 16 + fr; const size_t off = (size_t)row * D + col0;
                f32x2v st = (f32x2v){0.f, 1.f}; if (LNIN) st = *(const f32x2v*)(xstat + 2 * (size_t)row);
#pragma unroll
                for (int bj = 0; bj < 2; ++bj)
#pragma unroll
                    for (int n = 0; n < 2; ++n) { f32x4 r = *(const f32x4*)(res + off + bj * HALF + n * 16);
                        if (LNIN) r = (r - st.x) * st.y * gv[bj][n] + bv[bj][n];
                        *(f32x4*)(out + off + bj * HALF + n * 16) = r * ALPHA + acc[ai][bj][m][n]; }
                if (m & 1) asm volatile("" ::: "memory");
            }
    }
};
struct EpiGateUp {
    static constexpr bool PERM = true;
    bf16* H;
    DI void operator()(const f32x4 (&acc)[2][2][4][2], const Unit& u, int wr, int wc, int fr, int fq) const {
        const int row0 = u.pm * BM + wr * 64 + fr, col0 = u.pn * 128 + wc * 32 + 8 * fq;
#pragma unroll
        for (int ai = 0; ai < 2; ++ai)
#pragma unroll
            for (int m = 0; m < 4; ++m) {
                const f32x4 g0 = acc[ai][0][m][0], g1 = acc[ai][0][m][1];
                const f32x4 h0 = g0 * sigmoid4(g0) * acc[ai][1][m][0], h1 = g1 * sigmoid4(g1) * acc[ai][1][m][1];
                *(u32x4*)(H + (size_t)(row0 + ai * HALF + m * 16) * EH + col0) = pk8(h0, h1);
            }
    }
};
struct EpiDown {
    static constexpr bool PERM = true;
    bf16* Y; const float* roww; int lo; float* base; const bf16* x2b;
    DI void operator()(const f32x4 (&acc)[2][2][4][2], const Unit& u, int wr, int wc, int fr, int fq) const {
        const int rl = wr * 64 + fr, col0 = u.pn * BM + wc * 32 + 8 * fq;
        if (u.e < 64) {
#pragma unroll
            for (int ai = 0; ai < 2; ++ai)
#pragma unroll
                for (int m = 0; m < 4; ++m) { const int r = rl + ai * HALF + m * 16;
                    const float w = __hip_atomic_load(roww + (size_t)u.pm * BM + r, RLX_AGENT);
#pragma unroll
                    for (int bj = 0; bj < 2; ++bj)
                        *(u32x4*)(Y + ((size_t)(u.pm - lo) * BM + r) * D + col0 + bj * HALF) = pk8(acc[ai][bj][m][0] * w, acc[ai][bj][m][1] * w);
                    if (m & 1) asm volatile("" ::: "memory"); }
        } else {
#pragma unroll
            for (int ai = 0; ai < 2; ++ai)
#pragma unroll
                for (int m = 0; m < 4; ++m) { const size_t off = ((size_t)(u.pm - SH_ROW0 / BM) * BM + rl + ai * HALF + m * 16) * D + col0;
#pragma unroll
                    for (int bj = 0; bj < 2; ++bj) { const u32x4 xr = *(const u32x4*)(x2b + off + bj * HALF);
                        const f32x4 x0 = (f32x4){bflo(xr.x), bfhi(xr.x), bflo(xr.y), bfhi(xr.y)}, x1 = (f32x4){bflo(xr.z), bfhi(xr.z), bflo(xr.w), bfhi(xr.w)};
                        *(f32x4*)(base + off + bj * HALF) = x0 * ALPHA + acc[ai][bj][m][0]; *(f32x4*)(base + off + bj * HALF + 4) = x1 * ALPHA + acc[ai][bj][m][1]; }
                    asm volatile("" ::: "memory"); }
        }
    }
};
struct GateUpOrder {
    const char* X; const char* Wgu; const char* Wgus; const int* rowtok; const unsigned* blke; int nblk, G, c;
    DI bool next(int i, Unit& u) const {
        const int L = i * G + c; if (L >= (nblk + 64) * 2) return false;
        const int bl = L >> 1; u.pn = L & 1;
        if (bl < nblk) { u.e = (int)__builtin_amdgcn_readfirstlane(__hip_atomic_load(blke + bl, RLX_AGENT)); u.pm = bl; u.A = X; u.B = Wgu + ((size_t)u.e * 512 + u.pn * 256) * D * 2; }
        else { u.e = 64; u.pm = SH_ROW0 / BM + (bl - nblk); u.A = X + (size_t)(bl - nblk) * BM * D * 2; u.B = Wgus + (size_t)u.pn * 256 * D * 2; }
        return true;
    }
    DI void a_offs(const Unit& u, const int (&R)[2], const int (&C)[2], int K_, unsigned (&off)[2][2]) const {
        if (u.e < 64) {
#pragma unroll
            for (int h = 0; h < 2; ++h)
#pragma unroll
                for (int i = 0; i < 2; ++i) { const int tok = __hip_atomic_load(rowtok + (size_t)u.pm * BM + h * HALF + R[i], RLX_AGENT); off[h][i] = (unsigned)(tok * K_ + C[i]) * 2u; }
        } else {
#pragma unroll
            for (int h = 0; h < 2; ++h)
#pragma unroll
                for (int i = 0; i < 2; ++i) off[h][i] = (unsigned)((h * HALF + R[i]) * K_ + C[i]) * 2u;
        }
    }
};
struct DownOrder {
    const char* H; const char* Wd; const char* Wds; const unsigned* blke; int lo, hi, nsh, G, c;
    DI bool next(int i, Unit& u) const {
        const int L = i * G + c; if (L >= (hi - lo + nsh) * 4) return false;
        const int bl = lo + (L >> 2); u.pn = L & 3;
        if (bl < hi) { u.e = (int)__builtin_amdgcn_readfirstlane(__hip_atomic_load(blke + bl, RLX_AGENT)); u.pm = bl; u.B = Wd + ((size_t)u.e * D + u.pn * 256) * EH * 2; }
        else { u.e = 64; u.pm = SH_ROW0 / BM + (bl - hi); u.B = Wds + (size_t)u.pn * 256 * EH * 2; }
        u.A = H + (size_t)u.pm * BM * EH * 2;
        return true;
    }
    DI void a_offs(const Unit&, const int (&R)[2], const int (&C)[2], int K_, unsigned (&off)[2][2]) const {
#pragma unroll
        for (int h = 0; h < 2; ++h)
#pragma unroll
            for (int i = 0; i < 2; ++i) off[h][i] = (unsigned)((h * HALF + R[i]) * K_ + C[i]) * 2u;
    }
};
}

struct Frame {
    LAS unsigned char* lds;
    unsigned* ctl;
    unsigned char* ws; float* out;
    int tid, lane, wave, vcu, G;
};
DI unsigned short f2bf1(float x) { return (unsigned short)(pg8::pk2(x, x) & 0xffffu); }

template <class RowMap>
DI void transpose_item(const float* W, int N, bf16* WT, int Kd, RowMap rm, LAS float* scr, int kb, int nb, int lane) {
    const int k0 = 64 * kb, n0 = 32 * nb;
#pragma unroll 8
    for (int i = 0; i < 32; ++i) { const int kk = 2 * i + (lane >> 5); scr[kk * 33 + (lane & 31)] = W[(size_t)(k0 + kk) * N + n0 + (lane & 31)]; }
    LDS_WAIT(); asm volatile("" ::: "memory");
    const int c = lane & 7; const int drow0 = rm(n0);
#pragma unroll
    for (int j = 0; j < 4; ++j) { const int n = (lane >> 3) + 8 * j; const LAS float* s = scr + (8 * c) * 33 + n;
        u32x4 o; o.x = pg8::pk2(s[0 * 33], s[1 * 33]); o.y = pg8::pk2(s[2 * 33], s[3 * 33]); o.z = pg8::pk2(s[4 * 33], s[5 * 33]); o.w = pg8::pk2(s[6 * 33], s[7 * 33]);
        *(u32x4*)(WT + (size_t)(drow0 + n) * Kd + k0 + 8 * c) = o; }
    LDS_WAIT(); asm volatile("" ::: "memory");
}
struct RmIdent { int off; DI int operator()(int n0) const { return off + n0; } };
struct RmInProj { DI int operator()(int n0) const { const int seg = n0 >> 10, w = n0 & 1023;
    return seg == 0 ? ((w >> 7) * 256 + (w & 127)) : seg == 5 ? ((w >> 7) * 256 + 128 + (w & 127)) : seg == 6 ? 6144 + w : 1024 + n0; } };
struct RmGateUp { int up; DI int operator()(int n0) const { return (n0 >> 7) * 256 + up * 128 + (n0 & 127); } };
DI int inproj_dest(int n) { return RmInProj()(n & ~31) + (n & 31); }

DI void row_stats(const float* xrow, int lane, f32x4 (&v)[4], float& mean, float& rstd) {
    const f32x4* xr = (const f32x4*)xrow + lane; float s = 0.f;
#pragma unroll
    for (int j = 0; j < 4; ++j) { v[j] = xr[64 * j]; s += (v[j][0] + v[j][1]) + (v[j][2] + v[j][3]); }
    mean = wave_sum(s) * (1.f / D); float s2 = 0.f;
#pragma unroll
    for (int j = 0; j < 4; ++j) { const f32x4 d = v[j] - mean; s2 += (d[0] * d[0] + d[1] * d[1]) + (d[2] * d[2] + d[3] * d[3]); }
    rstd = 1.f / sqrtf(wave_sum(s2) * (1.f / D) + LN_EPS);
}

DI void p0_prologue(Frame& F, const float* const* in) {
    LAS float* scr = (LAS float*)(F.lds + F.wave * 16384);
    const int gw = F.vcu * NWAVES + F.wave, NGW = F.G * NWAVES, lane = F.lane;
    unsigned char* ws = F.ws;
    constexpr int I_IN = 16 * (INW / 32), I_OUT = 16 * 32, I_Q = 16 * 16, I_KV = 16 * 32, I_O = 8 * 32, I_SG = 16 * 8, I_SD = 4 * 32;
    constexpr int NITEMS = I_IN + I_OUT + I_Q + I_KV + I_O + 2 * I_SG + I_SD;
    for (int it = gw; it < NITEMS; it += NGW) {
        int r = it;
        if (r < I_IN) { transpose_item(in[4], INW, (bf16*)(ws + WS_WIN), D, RmInProj(), scr, r / (INW / 32), r % (INW / 32), lane); continue; } r -= I_IN;
        if (r < I_OUT) { transpose_item(in[10], D, (bf16*)(ws + WS_WOUT), D, RmIdent{0}, scr, r / 32, r % 32, lane); continue; } r -= I_OUT;
        if (r < I_Q) { transpose_item(in[13], MEMW, (bf16*)(ws + WS_WQ), D, RmIdent{0}, scr, r / 16, r % 16, lane); continue; } r -= I_Q;
        if (r < I_KV) { transpose_item(in[14], 2 * MEMW, (bf16*)(ws + WS_WKV), D, RmIdent{0}, scr, r / 32, r % 32, lane); continue; } r -= I_KV;
        if (r < I_O) { transpose_item(in[15], D, (bf16*)(ws + WS_WO), MEMW, RmIdent{0}, scr, r / 32, r % 32, lane); continue; } r -= I_O;
        if (r < I_SG) { transpose_item(in[23], EH, (bf16*)(ws + WS_WGUS), D, RmGateUp{0}, scr, r / 8, r % 8, lane); continue; } r -= I_SG;
        if (r < I_SG) { transpose_item(in[24], EH, (bf16*)(ws + WS_WGUS), D, RmGateUp{1}, scr, r / 8, r % 8, lane); continue; } r -= I_SG;
        transpose_item(in[25], D, (bf16*)(ws + WS_WDS), EH, RmIdent{0}, scr, r / 32, r % 32, lane);
    }
    const int gt = F.vcu * NTHREADS + F.tid, NGT = F.G * NTHREADS;
    { const float* wr = in[18]; bf16* hi = (bf16*)(ws + WS_WRHI); bf16* lo = (bf16*)(ws + WS_WRLO);
      for (int idx = gt; idx < D * NEXP; idx += NGT) { const int k = idx >> 6, e = idx & 63; const float w = wr[idx]; const unsigned short h = f2bf1(w); hi[e * D + k] = h; lo[e * D + k] = f2bf1(w - bf2f(h)); } }
    { const float* wsp = in[8]; bf16* o = (bf16*)(ws + WS_WSP);
      for (int idx = gt; idx < 8 * 128 * 128; idx += NGT) { const int s = idx & 127, t = (idx >> 7) & 127; o[idx] = (s <= t) ? f2bf1(wsp[idx]) : (unsigned short)0; } }
    { const float* bi = in[5]; float* o = (float*)(ws + WS_BPERM);
      for (int idx = gt; idx < INW; idx += NGT) o[inproj_dest(idx)] = bi[idx]; }
    { const f32x4* m4 = (const f32x4*)in[1]; u32x2* o = (u32x2*)(ws + WS_MEMB);
      for (int idx = gt; idx < NBATCH * MEMLEN * D / 4; idx += NGT) { const f32x4 v = m4[idx]; o[idx] = (u32x2){pg8::pk2(v[0], v[1]), pg8::pk2(v[2], v[3])}; } }
    { const float* x = in[0]; const float* g = in[2]; const float* b = in[3]; bf16* X0b = (bf16*)F.out; float* xstat = (float*)(ws + WS_XSTAT);
      f32x4 gv[4], bv[4];
#pragma unroll
      for (int j = 0; j < 4; ++j) { gv[j] = ((const f32x4*)g)[lane + 64 * j]; bv[j] = ((const f32x4*)b)[lane + 64 * j]; }
      for (int m = gw; m < T; m += NGW) { f32x4 v[4]; float mean, rstd; row_stats(x + (size_t)m * D, lane, v, mean, rstd);
          u32x2* o8 = (u32x2*)(X0b + (size_t)m * D) + lane;
#pragma unroll
          for (int j = 0; j < 4; ++j) { const f32x4 y = (v[j] - mean) * rstd * gv[j] + bv[j]; o8[64 * j] = (u32x2){pg8::pk2(y[0], y[1]), pg8::pk2(y[2], y[3])}; }
          if (lane == 0) *(f32x2*)(xstat + 2 * (size_t)m) = (f32x2){mean, rstd}; } }
}
DI void expert_convert(Frame& F, const float* const* in) {
    LAS float* scr = (LAS float*)(F.lds + F.wave * 16384);
    const int gw = F.vcu * NWAVES + F.wave, NGW = F.G * NWAVES, lane = F.lane;
    for (int it = gw; it < NEXP * 384; it += NGW) {
        const int e = it / 384; int r = it % 384;
        if (r < 128) { transpose_item(in[20] + (size_t)e * D * EH, EH, (bf16*)(F.ws + WS_WGU) + (size_t)e * 512 * D, D, RmGateUp{0}, scr, r / 8, r % 8, lane); continue; } r -= 128;
        if (r < 128) { transpose_item(in[21] + (size_t)e * D * EH, EH, (bf16*)(F.ws + WS_WGU) + (size_t)e * 512 * D, D, RmGateUp{1}, scr, r / 8, r % 8, lane); continue; } r -= 128;
        transpose_item(in[22] + (size_t)e * EH * D, D, (bf16*)(F.ws + WS_WD) + (size_t)e * D * EH, EH, RmIdent{0}, scr, r / 32, r % 32, lane);
    }
}

constexpr int MX_RS = 272;
constexpr int MX_KT = 0, MX_VT = 128 * MX_RS, MX_NT = 2 * 128 * MX_RS, MX_STAT = 3 * 128 * MX_RS, MX_FLG = MX_STAT + 1024, MX_END = MX_FLG + 64;
static_assert(MX_END <= SCR_BYTES, "mixer LDS");
DI bf16x8 mk_frag(f32x4 e0, f32x4 e1) { const u32x4 w = pg8::pk8(e0, e1); return __builtin_bit_cast(bf16x8, w); }
DI bf16x8 ld_split8(const LAS unsigned char* p) {
    const s16x4 lo = *(const LAS s16x4*)p, hi = *(const LAS s16x4*)(p + 32);
    return (bf16x8){lo[0], lo[1], lo[2], lo[3], hi[0], hi[1], hi[2], hi[3]};
}
DI void mix_phase(Frame& F, const float* const* in) {
    LAS unsigned char* lds = F.lds; unsigned char* ws = F.ws;
    const int tid = F.tid, lane = F.lane, w = F.wave, r = lane & 15, q = lane >> 4;
    const bf16* UG = (const bf16*)(ws + WS_UG); const bf16* VA = (const bf16*)(ws + WS_VA); const bf16* Qg = (const bf16*)(ws + WS_Q);
    const bf16* Kg = (const bf16*)(ws + WS_K); const bf16* Vg = (const bf16*)(ws + WS_V); const bf16* GB = (const bf16*)(ws + WS_GB);
    const float* vstat = (const float*)(ws + WS_VSTAT); const bf16* WSP = (const bf16*)(ws + WS_WSP); bf16* MG = (bf16*)(ws + WS_MERGED);
    const float* lnvg = in[6]; const float* lnvb = in[7]; const float* bsp = in[9];
    bf16x8 UE, UO, ONES;
#pragma unroll
    for (int jj = 0; jj < 8; ++jj) { ONES[jj] = (short)0x3F80;
        UE[jj] = (jj < 4) ? ((4 * q + jj > r) ? (short)0x3F80 : (short)0) : (short)0x3F80;
        UO[jj] = (jj < 4) ? (short)0 : ((4 * q + jj - 4 > r) ? (short)0x3F80 : (short)0); }
    for (int un = F.vcu; un < NBATCH * 16 * 8; un += F.G) {
        const int j = un & 7, i = (un >> 3) & 15, b = un >> 7;
        const int t0 = b * SEQ + 128 * i, c0 = 128 * j;
        if (tid < 128) { const f32x2* p = (const f32x2*)vstat + (size_t)(t0 + tid) * 16; float s1 = 0.f, s2 = 0.f;
#pragma unroll
            for (int k = 0; k < 16; ++k) { const f32x2 v = p[k]; s1 += v[0]; s2 += v[1]; }
            const float mean = s1 * (1.f / D), var = s2 * (1.f / D) - mean * mean;
            *(LAS f32x2*)(lds + MX_STAT + tid * 8) = (f32x2){mean, 1.f / sqrtf(fmaxf(var, 0.f) + LN_EPS)}; }
        __syncthreads();
#pragma unroll
        for (int it = 0; it < 4; ++it) { const int id = tid + 512 * it, ch = id >> 7, s = id & 127;
            const u32x4 raw = *(const u32x4*)(VA + (size_t)(t0 + s) * D + c0 + 8 * ch);
            const f32x2 st = *(const LAS f32x2*)(lds + MX_STAT + s * 8);
            const f32x4 g0 = *(const f32x4*)(lnvg + c0 + 8 * ch), g1 = *(const f32x4*)(lnvg + c0 + 8 * ch + 4), b0 = *(const f32x4*)(lnvb + c0 + 8 * ch), b1 = *(const f32x4*)(lnvb + c0 + 8 * ch + 4);
            const f32x4 x0 = (f32x4){bflo(raw.x), bfhi(raw.x), bflo(raw.y), bfhi(raw.y)}, x1 = (f32x4){bflo(raw.z), bfhi(raw.z), bflo(raw.w), bfhi(raw.w)};
            const f32x4 y0 = (x0 - st[0]) * st[1] * g0 + b0, y1 = (x1 - st[0]) * st[1] * g1 + b1;
            LAS unsigned short* nt = (LAS unsigned short*)(lds + MX_NT + (8 * ch) * MX_RS + s * 2);
#pragma unroll
            for (int e = 0; e < 4; ++e) { nt[e * (MX_RS / 2)] = f2bf1(y0[e]); nt[(4 + e) * (MX_RS / 2)] = f2bf1(y1[e]); } }
        bf16x8 qf[4];
#pragma unroll
        for (int kk = 0; kk < 4; ++kk) qf[kk] = *(const bf16x8*)(Qg + (size_t)(t0 + 16 * w + r) * D + c0 + 32 * kk + 8 * q);
        f32x4 ya[8], yb[8];
#pragma unroll
        for (int dt = 0; dt < 8; ++dt) { ya[dt] = (f32x4){0.f, 0.f, 0.f, 0.f}; yb[dt] = (f32x4){0.f, 0.f, 0.f, 0.f}; }
        float carry = 0.f;
        for (int kb = i; kb >= 0; --kb) {
            const int kv0 = b * SEQ + 128 * kb;
#pragma unroll
            for (int it = 0; it < 4; ++it) { const int id = tid + 512 * it;
                { const int s = id >> 4, ch = id & 15; *(LAS u32x4*)(lds + MX_KT + s * MX_RS + ch * 16) = *(const u32x4*)(Kg + (size_t)(kv0 + s) * D + c0 + 8 * ch); }
                { const int ch = id >> 7, s = id & 127; const u32x4 raw = *(const u32x4*)(Vg + (size_t)(kv0 + s) * D + c0 + 8 * ch);
                  LAS unsigned short* vt = (LAS unsigned short*)(lds + MX_VT + (8 * ch) * MX_RS + s * 2);
                  vt[0 * (MX_RS / 2)] = (unsigned short)(raw.x & 0xffffu); vt[1 * (MX_RS / 2)] = (unsigned short)(raw.x >> 16); vt[2 * (MX_RS / 2)] = (unsigned short)(raw.y & 0xffffu); vt[3 * (MX_RS / 2)] = (unsigned short)(raw.y >> 16);
                  vt[4 * (MX_RS / 2)] = (unsigned short)(raw.z & 0xffffu); vt[5 * (MX_RS / 2)] = (unsigned short)(raw.z >> 16); vt[6 * (MX_RS / 2)] = (unsigned short)(raw.w & 0xffffu); vt[7 * (MX_RS / 2)] = (unsigned short)(raw.w >> 16); } }
            __syncthreads();
            if (kb == i) {
                const int nks = (w >> 1) + 1;
                for (int ks = 0; ks < nks; ++ks) {
                    const bf16x8 wf = *(const bf16x8*)(WSP + ((size_t)j * 128 + 16 * w + r) * 128 + 32 * ks + 8 * q);
#pragma unroll
                    for (int dt = 0; dt < 8; ++dt) { const bf16x8 af = *(const LAS bf16x8*)(lds + MX_NT + (16 * dt + r) * MX_RS + (32 * ks + 8 * q) * 2);
                        ya[dt] = __builtin_amdgcn_mfma_f32_16x16x32_bf16(af, wf, ya[dt], 0, 0, 0); }
                }
            }
            f32x4 z[8];
#pragma unroll
            for (int st = 0; st < 8; ++st) { z[st] = (f32x4){0.f, 0.f, 0.f, 0.f};
#pragma unroll
                for (int kk = 0; kk < 4; ++kk) { const bf16x8 kf = *(const LAS bf16x8*)(lds + MX_KT + (16 * st + r) * MX_RS + (32 * kk + 8 * q) * 2);
                    z[st] = __builtin_amdgcn_mfma_f32_16x16x32_bf16(kf, qf[kk], z[st], 0, 0, 0); } }
            f32x4 ls[8]; const bool diag = (kb == i); const int tq = 16 * w + r;
#pragma unroll
            for (int st = 0; st < 8; ++st)
#pragma unroll
                for (int e = 0; e < 4; ++e) { const float zz = z[st][e]; const float sp = fmaxf(zz, 0.f) + LN2 * fast_log2(1.0f + fast_exp2(-fabsf(zz) * LOG2E));
                    const bool msk = diag && (16 * st + 4 * q + e >= tq);
                    ls[st][e] = msk ? 0.f : -sp; z[st][e] = msk ? -1e30f : zz - sp; }
            bf16x8 lf[4];
#pragma unroll
            for (int p = 0; p < 4; ++p) lf[p] = mk_frag(ls[2 * p], ls[2 * p + 1]);
            f32x4 tot = (f32x4){0.f, 0.f, 0.f, 0.f};
#pragma unroll
            for (int p = 0; p < 4; ++p) tot = __builtin_amdgcn_mfma_f32_16x16x32_bf16(ONES, lf[p], tot, 0, 0, 0);
            bf16x8 af[4];
#pragma unroll
            for (int p = 0; p < 4; ++p) {
                f32x4 s0 = (f32x4){0.f, 0.f, 0.f, 0.f}, s1 = (f32x4){0.f, 0.f, 0.f, 0.f};
                s0 = __builtin_amdgcn_mfma_f32_16x16x32_bf16(UE, lf[p], s0, 0, 0, 0);
                s1 = __builtin_amdgcn_mfma_f32_16x16x32_bf16(UO, lf[p], s1, 0, 0, 0);
#pragma unroll
                for (int p2 = p + 1; p2 < 4; ++p2) { s0 = __builtin_amdgcn_mfma_f32_16x16x32_bf16(ONES, lf[p2], s0, 0, 0, 0); s1 = __builtin_amdgcn_mfma_f32_16x16x32_bf16(ONES, lf[p2], s1, 0, 0, 0); }
                f32x4 a0, a1;
#pragma unroll
                for (int e = 0; e < 4; ++e) { a0[e] = fast_exp2((z[2 * p][e] + s0[e] + carry) * LOG2E); a1[e] = fast_exp2((z[2 * p + 1][e] + s1[e] + carry) * LOG2E); }
                af[p] = mk_frag(a0, a1);
            }
#pragma unroll
            for (int dt = 0; dt < 8; ++dt)
#pragma unroll
                for (int p = 0; p < 4; ++p) { const bf16x8 vf = ld_split8(lds + MX_VT + (16 * dt + r) * MX_RS + (32 * p + 4 * q) * 2);
                    yb[dt] = __builtin_amdgcn_mfma_f32_16x16x32_bf16(vf, af[p], yb[dt], 0, 0, 0); }
            carry += tot[0];
            const float wm = wave_max(carry);
            if (lane == 0) *(LAS float*)(lds + MX_FLG + ((kb & 1) * 8 + w) * 4) = wm;
            __syncthreads();
            float gm = -1e30f;
#pragma unroll
            for (int k = 0; k < 8; ++k) gm = fmaxf(gm, *(const LAS float*)(lds + MX_FLG + ((kb & 1) * 8 + k) * 4));
            if (gm < SB_EXIT) break;
        }
        { const float bs = bsp[j * 128 + 16 * w + r]; const size_t rowoff = (size_t)(t0 + 16 * w + r) * D + c0 + 4 * q;
#pragma unroll
          for (int dt = 0; dt < 8; ++dt) { const u32x2 ug = *(const u32x2*)(UG + rowoff + 16 * dt), gb = *(const u32x2*)(GB + rowoff + 16 * dt);
              const f32x4 u4 = (f32x4){bflo(ug.x), bfhi(ug.x), bflo(ug.y), bfhi(ug.y)}, g4 = (f32x4){bflo(gb.x), bfhi(gb.x), bflo(gb.y), bfhi(gb.y)};
              const f32x4 o = u4 * (ya[dt] + bs) + g4 * yb[dt];
              *(u32x2*)(MG + rowoff + 16 * dt) = (u32x2){pg8::pk2(o[0], o[1]), pg8::pk2(o[2], o[3])}; } }
        __syncthreads();
    }
}

DI void ln1_phase(Frame& F, const float* const* in) {
    const int gw = F.vcu * NWAVES + F.wave, NGW = F.G * NWAVES, lane = F.lane;
    const float* Y1 = (const float*)(F.ws + WS_Y1); float* X1f = (float*)(F.ws + WS_X1F); bf16* X1b = (bf16*)(F.ws + WS_X1B);
    f32x4 gv[4], bv[4];
#pragma unroll
    for (int j = 0; j < 4; ++j) { gv[j] = ((const f32x4*)in[11])[lane + 64 * j]; bv[j] = ((const f32x4*)in[12])[lane + 64 * j]; }
    for (int m = gw; m < T; m += NGW) { f32x4 v[4]; float mean, rstd; row_stats(Y1 + (size_t)m * D, lane, v, mean, rstd);
        f32x4* of = (f32x4*)(X1f + (size_t)m * D) + lane; u32x2* ob = (u32x2*)(X1b + (size_t)m * D) + lane;
#pragma unroll
        for (int j = 0; j < 4; ++j) { const f32x4 y = (v[j] - mean) * rstd * gv[j] + bv[j]; of[64 * j] = y; ob[64 * j] = (u32x2){pg8::pk2(y[0], y[1]), pg8::pk2(y[2], y[3])}; } }
}

constexpr int MA_KRS = 272, MA_VRS = 528;
constexpr int MA_K = 0, MA_V = 256 * MA_KRS, MA_END = MA_V + 128 * MA_VRS;
static_assert(MA_END <= SCR_BYTES, "mem-attn LDS");
DI void memattn_phase(Frame& F) {
    LAS unsigned char* lds = F.lds; unsigned char* ws = F.ws;
    const int tid = F.tid, lane = F.lane, w = F.wave, r = lane & 15, q = lane >> 4;
    const bf16* Qm = (const bf16*)(ws + WS_QM); const bf16* KV = (const bf16*)(ws + WS_KVM); bf16* Om = (bf16*)(ws + WS_OM);
    for (int su = F.vcu; su < NBATCH * 4 * 8; su += F.G) {
        const int qc = su & 7, h = (su >> 3) & 3, b = su >> 5;
#pragma unroll
        for (int it = 0; it < 8; ++it) { const int id = tid + 512 * it;
            { const int s = id >> 4, ch = id & 15; *(LAS u32x4*)(lds + MA_K + s * MA_KRS + ch * 16) = *(const u32x4*)(KV + (size_t)(b * MEMLEN + s) * D + h * 128 + 8 * ch); }
            { const int ch = id >> 8, s = id & 255; const u32x4 raw = *(const u32x4*)(KV + (size_t)(b * MEMLEN + s) * D + MEMW + h * 128 + 8 * ch);
              LAS unsigned short* vt = (LAS unsigned short*)(lds + MA_V + (8 * ch) * MA_VRS + s * 2);
              vt[0 * (MA_VRS / 2)] = (unsigned short)(raw.x & 0xffffu); vt[1 * (MA_VRS / 2)] = (unsigned short)(raw.x >> 16); vt[2 * (MA_VRS / 2)] = (unsigned short)(raw.y & 0xffffu); vt[3 * (MA_VRS / 2)] = (unsigned short)(raw.y >> 16);
              vt[4 * (MA_VRS / 2)] = (unsigned short)(raw.z & 0xffffu); vt[5 * (MA_VRS / 2)] = (unsigned short)(raw.z >> 16); vt[6 * (MA_VRS / 2)] = (unsigned short)(raw.w & 0xffffu); vt[7 * (MA_VRS / 2)] = (unsigned short)(raw.w >> 16); } }
        __syncthreads();
        for (int c = 0; c < 2; ++c) {
            const size_t trow = (size_t)b * SEQ + 256 * qc + 128 * c + 16 * w + r;
            bf16x8 qf[4];
#pragma unroll
            for (int kk = 0; kk < 4; ++kk) qf[kk] = *(const bf16x8*)(Qm + trow * MEMW + h * 128 + 32 * kk + 8 * q);
            f32x4 z[16];
#pragma unroll
            for (int st = 0; st < 16; ++st) { z[st] = (f32x4){0.f, 0.f, 0.f, 0.f};
#pragma unroll
                for (int kk = 0; kk < 4; ++kk) { const bf16x8 kf = *(const LAS bf16x8*)(lds + MA_K + (16 * st + r) * MA_KRS + (32 * kk + 8 * q) * 2);
                    z[st] = __builtin_amdgcn_mfma_f32_16x16x32_bf16(kf, qf[kk], z[st], 0, 0, 0); }
                if (st & 1) __builtin_amdgcn_sched_barrier(0); }
            float mx = -1e30f;
#pragma unroll
            for (int st = 0; st < 16; ++st) mx = fmaxf(mx, fmaxf(fmaxf(z[st][0], z[st][1]), fmaxf(z[st][2], z[st][3])));
            mx = fmaxf(mx, __shfl_xor(mx, 16)); mx = fmaxf(mx, __shfl_xor(mx, 32));
            float sum = 0.f;
#pragma unroll
            for (int st = 0; st < 16; ++st)
#pragma unroll
                for (int e = 0; e < 4; ++e) { const float pp = fast_exp2((z[st][e] - mx) * LOG2E); z[st][e] = pp; sum += pp; }
            sum += __shfl_xor(sum, 16); sum += __shfl_xor(sum, 32);
            const float inv = 1.0f / sum;
            f32x4 o[8];
#pragma unroll
            for (int dt = 0; dt < 8; ++dt) o[dt] = (f32x4){0.f, 0.f, 0.f, 0.f};
#pragma unroll
            for (int p = 0; p < 8; ++p) { const bf16x8 pf = mk_frag(z[2 * p], z[2 * p + 1]);
#pragma unroll
                for (int dt = 0; dt < 8; ++dt) { const bf16x8 vf = ld_split8(lds + MA_V + (16 * dt + r) * MA_VRS + (32 * p + 4 * q) * 2);
                    o[dt] = __builtin_amdgcn_mfma_f32_16x16x32_bf16(vf, pf, o[dt], 0, 0, 0); }
                __builtin_amdgcn_sched_barrier(0); }
#pragma unroll
            for (int dt = 0; dt < 8; ++dt) { const f32x4 v = o[dt] * inv;
                *(u32x2*)(Om + trow * MEMW + h * 128 + 16 * dt + 4 * q) = (u32x2){pg8::pk2(v[0], v[1]), pg8::pk2(v[2], v[3])}; }
        }
        __syncthreads();
    }
}

constexpr int RT_XRS = 2064;
constexpr int RT_XH = 0, RT_XL = 16 * RT_XRS, RT_PART = 2 * 16 * RT_XRS, RT_SC = RT_PART + 8 * 16 * 64 * 4, RT_SEL = RT_SC + 16 * 64 * 4, RT_HIST = RT_SEL + 16 * 64 * 4, RT_END = RT_HIST + 256;
static_assert(RT_END <= SCR_BYTES, "router LDS");
DI void route_phase(Frame& F, const float* const* in) {
    LAS unsigned char* lds = F.lds; unsigned char* ws = F.ws;
    const int tid = F.tid, lane = F.lane, w = F.wave, r = lane & 15, q = lane >> 4;
    const float* Y2 = F.out; bf16* X2b = (bf16*)(ws + WS_X2B);
    const bf16* WRH = (const bf16*)(ws + WS_WRHI); const bf16* WRL = (const bf16*)(ws + WS_WRLO);
    unsigned* TK = (unsigned*)(ws + WS_TK); float* TKW = (float*)(ws + WS_TKW); unsigned* WGB = (unsigned*)(ws + WS_WGBASE);
    const float* rbias = in[19];
    LAS unsigned* HIST = (LAS unsigned*)(lds + RT_HIST);
    if (tid < 64) HIST[tid] = 0u;
    f32x4 gv[4], bv[4];
#pragma unroll
    for (int j = 0; j < 4; ++j) { gv[j] = ((const f32x4*)in[16])[lane + 64 * j]; bv[j] = ((const f32x4*)in[17])[lane + 64 * j]; }
    __syncthreads();
    for (int tl = F.vcu; tl < T / 16; tl += F.G) {
#pragma unroll
        for (int rr = 0; rr < 2; ++rr) { const int lr = 2 * w + rr; const size_t m = (size_t)16 * tl + lr;
            f32x4 v[4]; float mean, rstd; row_stats(Y2 + m * D, lane, v, mean, rstd);
            u32x2* ob = (u32x2*)(X2b + m * D) + lane;
#pragma unroll
            for (int j = 0; j < 4; ++j) { const f32x4 y = (v[j] - mean) * rstd * gv[j] + bv[j];
                const u32x2 hi = (u32x2){pg8::pk2(y[0], y[1]), pg8::pk2(y[2], y[3])}; ob[64 * j] = hi;
                const f32x4 rs = (f32x4){y[0] - bflo(hi.x), y[1] - bfhi(hi.x), y[2] - bflo(hi.y), y[3] - bfhi(hi.y)};
                *(LAS u32x2*)(lds + RT_XH + lr * RT_XRS + (4 * lane + 256 * j) * 2) = hi;
                *(LAS u32x2*)(lds + RT_XL + lr * RT_XRS + (4 * lane + 256 * j) * 2) = (u32x2){pg8::pk2(rs[0], rs[1]), pg8::pk2(rs[2], rs[3])}; } }
        __syncthreads();
        { f32x4 acc[4];
#pragma unroll
          for (int nt = 0; nt < 4; ++nt) acc[nt] = (f32x4){0.f, 0.f, 0.f, 0.f};
#pragma unroll
          for (int kk = 0; kk < 4; ++kk) { const int k0 = 128 * w + 32 * kk + 8 * q;
              const bf16x8 ah = *(const LAS bf16x8*)(lds + RT_XH + r * RT_XRS + k0 * 2), al = *(const LAS bf16x8*)(lds + RT_XL + r * RT_XRS + k0 * 2);
#pragma unroll
              for (int nt = 0; nt < 4; ++nt) { const bf16x8 bh = *(const bf16x8*)(WRH + (size_t)(16 * nt + r) * D + k0), bl = *(const bf16x8*)(WRL + (size_t)(16 * nt + r) * D + k0);
                  acc[nt] = __builtin_amdgcn_mfma_f32_16x16x32_bf16(ah, bh, acc[nt], 0, 0, 0);
                  acc[nt] = __builtin_amdgcn_mfma_f32_16x16x32_bf16(al, bh, acc[nt], 0, 0, 0);
                  acc[nt] = __builtin_amdgcn_mfma_f32_16x16x32_bf16(ah, bl, acc[nt], 0, 0, 0); } }
#pragma unroll
          for (int nt = 0; nt < 4; ++nt)
#pragma unroll
              for (int e = 0; e < 4; ++e) *(LAS float*)(lds + RT_PART + ((w * 16 + 4 * q + e) * 64 + 16 * nt + r) * 4) = acc[nt][e]; }
        __syncthreads();
#pragma unroll
        for (int h2 = 0; h2 < 2; ++h2) { const int idx = tid + 512 * h2; float lg = 0.f;
#pragma unroll
            for (int k = 0; k < 8; ++k) lg += *(const LAS float*)(lds + RT_PART + (k * 1024 + idx) * 4);
            const float sc = 1.0f / (1.0f + __expf(-lg));
            *(LAS float*)(lds + RT_SC + idx * 4) = sc; *(LAS float*)(lds + RT_SEL + idx * 4) = sc + rbias[idx & 63]; }
        __syncthreads();
        if (tid < 16) {
            const LAS float* SEL = (const LAS float*)(lds + RT_SEL + tid * 256); const LAS float* SC = (const LAS float*)(lds + RT_SC + tid * 256);
            float gs[8];
#pragma unroll
            for (int g = 0; g < 8; ++g) { float m1 = -1e30f, m2 = -1e30f;
#pragma unroll
                for (int k = 0; k < 8; ++k) { const float v = SEL[8 * g + k]; if (v > m1) { m2 = m1; m1 = v; } else if (v > m2) m2 = v; }
                gs[g] = m1 + m2; }
            unsigned gmask = 0u;
#pragma unroll
            for (int it = 0; it < 4; ++it) { float best = -1e30f; int bi = 0;
#pragma unroll
                for (int g = 0; g < 8; ++g) { const bool ok = !((gmask >> g) & 1u) && gs[g] > best; best = ok ? gs[g] : best; bi = ok ? g : bi; }
                gmask |= 1u << bi; }
            unsigned long long taken = 0ull; float wsum = 0.f; const size_t tok = (size_t)16 * tl + tid;
            unsigned ch[8]; float cw[8];
#pragma unroll
            for (int it = 0; it < 8; ++it) { float best = -1e30f; int bi = 0;
                for (int e = 0; e < 64; ++e) { const float v = SEL[e]; const bool ok = ((gmask >> (e >> 3)) & 1u) && !((taken >> e) & 1ull) && v > best; best = ok ? v : best; bi = ok ? e : bi; }
                taken |= 1ull << bi; const float s = SC[bi]; wsum += s; ch[it] = (unsigned)bi; cw[it] = s; }
            const float sc = ROUTED_SCALE / wsum;
#pragma unroll
            for (int it = 0; it < 8; ++it) { const unsigned lrk = __hip_atomic_fetch_add(&HIST[ch[it]], 1u, __ATOMIC_RELAXED, __HIP_MEMORY_SCOPE_WORKGROUP); TK[tok * 8 + it] = ch[it] | (lrk << 8); TKW[tok * 8 + it] = cw[it] * sc; }
        }
        __syncthreads();
    }
    if (tid < 64) { const unsigned cnt = HIST[tid]; const unsigned base = __hip_atomic_fetch_add(F.ctl + CW_GCOUNT + tid, cnt, RLX_AGENT); WGB[F.vcu * 64 + tid] = base; }
}

DI void slots_phase(Frame& F) {
    LAS unsigned char* lds = F.lds; unsigned char* ws = F.ws; const int tid = F.tid;
    LAS unsigned* CNT = (LAS unsigned*)lds; LAS unsigned* PS = CNT + 64;
    int* ROWTOK = (int*)(ws + WS_ROWTOK); float* ROWW = (float*)(ws + WS_ROWW); unsigned* SLOT = (unsigned*)(ws + WS_SLOT);
    const unsigned* TK = (const unsigned*)(ws + WS_TK); const float* TKW = (const float*)(ws + WS_TKW); const unsigned* WGB = (const unsigned*)(ws + WS_WGBASE);
    if (tid < 64) CNT[tid] = __hip_atomic_load(F.ctl + CW_GCOUNT + tid, RLX_AGENT);
    __syncthreads();
    if (tid == 0) { unsigned run = 0u; for (int e = 0; e < 64; ++e) { PS[e] = run; run += (CNT[e] + 255u) & ~255u; } PS[64] = run; }
    __syncthreads();
    const unsigned nblk = PS[64] >> 8;
    if (F.vcu == 0) {
        if (tid == 0) { __hip_atomic_store(F.ctl + CW_HDR, nblk, RLX_AGENT); __hip_atomic_store(F.ctl + CW_HDR + 1, (nblk + 1u) >> 1, RLX_AGENT); }
        for (unsigned bl = tid; bl < nblk; bl += NTHREADS) { unsigned e = 0; for (int k = 1; k < 64; ++k) e += (PS[k] <= bl * 256u) ? 1u : 0u; __hip_atomic_store(F.ctl + CW_BLKE + bl, e, RLX_AGENT); }
    }
    for (int e = F.vcu; e < 64; e += F.G) { const unsigned lo = PS[e] + CNT[e], hi = PS[e + 1]; for (unsigned s = lo + tid; s < hi; s += NTHREADS) { ROWTOK[s] = 0; ROWW[s] = 0.f; } }
    for (int tl = F.vcu; tl < T / 16; tl += F.G) {
        if (tid < 128) { const size_t a = (size_t)16 * 8 * tl + tid; const unsigned pk = TK[a], e = pk & 0xffu, lrk = pk >> 8;
            const unsigned slot = PS[e] + WGB[F.vcu * 64 + e] + lrk; ROWTOK[slot] = (int)(a >> 3); ROWW[slot] = TKW[a]; SLOT[a] = slot; }
    }
}

template <bool FINAL> DI void combine_phase(Frame& F, const float* const* in) {
    const int gw = F.vcu * NWAVES + F.wave, NGW = F.G * NWAVES, lane = F.lane;
    const unsigned split = __builtin_amdgcn_readfirstlane(__hip_atomic_load(F.ctl + CW_HDR + 1, RLX_AGENT)) * 256u;
    const unsigned* SLOT = (const unsigned*)(F.ws + WS_SLOT); const bf16* Y = (const bf16*)(F.ws + WS_YH); float* base = F.out;
    f32x4 gv[4], bv[4];
    if (FINAL) {
#pragma unroll
        for (int j = 0; j < 4; ++j) { gv[j] = ((const f32x4*)in[26])[lane + 64 * j]; bv[j] = ((const f32x4*)in[27])[lane + 64 * j]; } }
    for (int m = gw; m < T; m += NGW) {
        f32x4* br = (f32x4*)(base + (size_t)m * D) + lane; f32x4 v[4];
#pragma unroll
        for (int j = 0; j < 4; ++j) v[j] = br[64 * j];
#pragma unroll
        for (int k = 0; k < 8; ++k) { const unsigned slot = __builtin_amdgcn_readfirstlane(__hip_atomic_load(SLOT + (size_t)m * 8 + k, RLX_AGENT));
            const bool mine = FINAL ? (slot >= split) : (slot < split);
            if (mine) { const u32x2* yr = (const u32x2*)(Y + (size_t)(FINAL ? slot - split : slot) * D) + lane;
#pragma unroll
                for (int j = 0; j < 4; ++j) { const u32x2 y = yr[64 * j]; v[j] += (f32x4){bflo(y.x), bfhi(y.x), bflo(y.y), bfhi(y.y)}; } } }
        if (FINAL) { float s = 0.f;
#pragma unroll
            for (int j = 0; j < 4; ++j) s += (v[j][0] + v[j][1]) + (v[j][2] + v[j][3]);
            const float mean = wave_sum(s) * (1.f / D); float s2 = 0.f;
#pragma unroll
            for (int j = 0; j < 4; ++j) { const f32x4 d = v[j] - mean; s2 += (d[0] * d[0] + d[1] * d[1]) + (d[2] * d[2] + d[3] * d[3]); }
            const float rstd = 1.f / sqrtf(wave_sum(s2) * (1.f / D) + LN_EPS);
#pragma unroll
            for (int j = 0; j < 4; ++j) br[64 * j] = (v[j] - mean) * rstd * gv[j] + bv[j];
        } else {
#pragma unroll
            for (int j = 0; j < 4; ++j) br[64 * j] = v[j]; }
    }
}

constexpr int NPHASE = 15;
constexpr int N_LAUNCHES = MK_N_LAUNCHES;
static_assert(N_LAUNCHES == 1 || N_LAUNCHES == NPHASE, "MK_N_LAUNCHES: 1 (one dispatch) or 15 (one dispatch per phase)");
struct Args { const float* in[28]; float* out; unsigned char* ws; int ph_lo, ph_hi; };
static_assert(sizeof(Args) == 28 * 8 + 8 + 8 + 8, "Args has no padding");

__global__ void __launch_bounds__(NTHREADS, 2) fwd_kernel(Args args) {
    extern __shared__ __attribute__((aligned(16))) unsigned char lds_raw[];
    Frame F;
    F.lds = (LAS unsigned char*)lds_raw;
    volatile LAS unsigned* MISC = (volatile LAS unsigned*)(F.lds + MISC_OFF);
    F.tid = threadIdx.x; F.lane = F.tid & 63; F.wave = __builtin_amdgcn_readfirstlane(F.tid >> 6);
    F.G = gridDim.x; { const int bx = blockIdx.x; F.vcu = (F.G % 8 == 0) ? (bx % 8) * (F.G / 8) + bx / 8 : bx; }
    F.ws = args.ws; F.ctl = (unsigned*)(args.ws + WS_CTL); F.out = args.out;
    unsigned char* ws = args.ws;
    for (int u = F.tid; u < (LDS_BYTES - MISC_OFF) / 4; u += NTHREADS) ((LAS unsigned*)(F.lds + MISC_OFF))[u] = 0u;
    __syncthreads();
    XcdBarrier bar; bar.bar = F.ctl + CW_BAR; bar.x = 0; bar.st = nullptr;
    if (N_LAUNCHES == 1) bar = xcd_barrier_post(F.ctl + CW_BAR, MISC + 8);
#define GRID_BAR() do { if (N_LAUNCHES == 1) xcd_barrier(bar); } while (0)
    const int lo = args.ph_lo, hi = args.ph_hi;
#ifndef PHASE_MASK
#define PHASE_MASK 0x7fff
#endif
#define IN(k) (((PHASE_MASK >> (k)) & 1) && lo <= (k) && (k) < hi)
#define SEAM(k) do { if (IN(k) && IN((k) + 1)) GRID_BAR(); } while (0)
    const float* const* in = args.in;

    if (IN(0)) { p0_prologue(F, in); SEAM(0); }
    if (IN(1)) {
        pg8::DenseOrder S; S.init((const bf16*)F.out, (const bf16*)(ws + WS_WIN), T, INW, D, F.G, (int)blockIdx.x);
        pg8::EpiInProj E{(bf16*)(ws + WS_P1), (float*)(ws + WS_VSTAT), (const float*)(ws + WS_BPERM)};
        pg8::gemm_phase<pg8::EpiInProj, pg8::DenseOrder, true>(F.lds, D, S, E);
        SEAM(1);
    }
    if (IN(2)) { mix_phase(F, in); SEAM(2); }
    if (IN(3)) {
        pg8::DenseOrder S; S.init((const bf16*)(ws + WS_MERGED), (const bf16*)(ws + WS_WOUT), T, D, D, F.G, (int)blockIdx.x);
        pg8::EpiResF32<true> E{(float*)(ws + WS_Y1), in[0], (const float*)(ws + WS_XSTAT), in[2], in[3]};
        pg8::gemm_phase<pg8::EpiResF32<true>, pg8::DenseOrder, false>(F.lds, D, S, E);
        SEAM(3);
    }
    if (IN(4)) { ln1_phase(F, in); SEAM(4); }
    if (IN(5)) {
        expert_convert(F, in);
        __syncthreads();
        { pg8::DenseOrder S; S.init((const bf16*)(ws + WS_X1B), (const bf16*)(ws + WS_WQ), T, MEMW, D, F.G, (int)blockIdx.x);
          pg8::EpiBf16S E{(bf16*)(ws + WS_QM), MEMW, QSCALE};
          pg8::gemm_phase<pg8::EpiBf16S, pg8::DenseOrder, false>(F.lds, D, S, E); }
        { const int c2 = ((int)blockIdx.x + F.G - 128 % F.G) % F.G;
          pg8::DenseOrder S; S.init((const bf16*)(ws + WS_MEMB), (const bf16*)(ws + WS_WKV), NBATCH * MEMLEN, 2 * MEMW, D, F.G, c2);
          pg8::EpiBf16S E{(bf16*)(ws + WS_KVM), 2 * MEMW, 1.0f};
          pg8::gemm_phase<pg8::EpiBf16S, pg8::DenseOrder, false>(F.lds, D, S, E); }
        SEAM(5);
    }
    if (IN(6)) { memattn_phase(F); SEAM(6); }
    if (IN(7)) {
        pg8::DenseOrder S; S.init((const bf16*)(ws + WS_OM), (const bf16*)(ws + WS_WO), T, D, MEMW, F.G, (int)blockIdx.x);
        pg8::EpiResF32<false> E{F.out, (const float*)(ws + WS_X1F), nullptr, nullptr, nullptr};
        pg8::gemm_phase<pg8::EpiResF32<false>, pg8::DenseOrder, false>(F.lds, MEMW, S, E);
        SEAM(7);
    }
    if (IN(8)) { route_phase(F, in); SEAM(8); }
    if (IN(9)) { slots_phase(F); SEAM(9); }
    if (IN(10)) {
        const int nblk = (int)__builtin_amdgcn_readfirstlane(__hip_atomic_load(F.ctl + CW_HDR, RLX_AGENT));
        pg8::GateUpOrder S{(const char*)(ws + WS_X2B), (const char*)(ws + WS_WGU), (const char*)(ws + WS_WGUS), (const int*)(ws + WS_ROWTOK), F.ctl + CW_BLKE, nblk, F.G, F.vcu};
        pg8::EpiGateUp E{(bf16*)(ws + WS_H)};
        pg8::gemm_phase<pg8::EpiGateUp, pg8::GateUpOrder, true>(F.lds, D, S, E);
        SEAM(10);
    }
    if (IN(11)) {
        const int split = (int)__builtin_amdgcn_readfirstlane(__hip_atomic_load(F.ctl + CW_HDR + 1, RLX_AGENT));
        pg8::DownOrder S{(const char*)(ws + WS_H), (const char*)(ws + WS_WD), (const char*)(ws + WS_WDS), F.ctl + CW_BLKE, 0, split, 64, F.G, F.vcu};
        pg8::EpiDown E{(bf16*)(ws + WS_YH), (const float*)(ws + WS_ROWW), 0, F.out, (const bf16*)(ws + WS_X2B)};
        pg8::gemm_phase<pg8::EpiDown, pg8::DownOrder, true>(F.lds, EH, S, E);
        SEAM(11);
    }
    if (IN(12)) { combine_phase<false>(F, in); SEAM(12); }
    if (IN(13)) {
        const int nblk = (int)__builtin_amdgcn_readfirstlane(__hip_atomic_load(F.ctl + CW_HDR, RLX_AGENT));
        const int split = (int)__builtin_amdgcn_readfirstlane(__hip_atomic_load(F.ctl + CW_HDR + 1, RLX_AGENT));
        pg8::DownOrder S{(const char*)(ws + WS_H), (const char*)(ws + WS_WD), (const char*)(ws + WS_WDS), F.ctl + CW_BLKE, split, nblk, 0, F.G, F.vcu};
        pg8::EpiDown E{(bf16*)(ws + WS_YH), (const float*)(ws + WS_ROWW), split, F.out, (const bf16*)(ws + WS_X2B)};
        pg8::gemm_phase<pg8::EpiDown, pg8::DownOrder, true>(F.lds, EH, S, E);
        SEAM(13);
    }
    if (IN(14)) { combine_phase<true>(F, in); }
#undef IN
#undef SEAM
#undef GRID_BAR
}

extern "C" void kernel_launch(void* const* d_in, const int* in_sizes, int n_in, void* d_out, int out_size, void* d_ws, size_t ws_size, hipStream_t stream) {
    static int grid = 0;
    if (grid == 0) {
        if (n_in != 28 || in_sizes[0] != T * D || out_size != T * D || ws_size < WS_END) { fprintf(stderr, "kernel_launch: unexpected shapes / workspace (n_in %d, ws %zu < %zu)\n", n_in, ws_size, (size_t)WS_END); grid = -1; return; }
        int dev = 0, cus = 0, per_cu = 0;
        if (hipGetDevice(&dev) != hipSuccess || hipDeviceGetAttribute(&cus, hipDeviceAttributeMultiprocessorCount, dev) != hipSuccess) { grid = -1; return; }
        if (hipFuncSetAttribute((const void*)fwd_kernel, hipFuncAttributeMaxDynamicSharedMemorySize, LDS_BYTES) != hipSuccess) { fprintf(stderr, "kernel_launch: hipFuncSetAttribute failed\n"); grid = -1; return; }
        if (hipOccupancyMaxActiveBlocksPerMultiprocessor(&per_cu, (const void*)fwd_kernel, NTHREADS, LDS_BYTES) != hipSuccess || per_cu < 1) { fprintf(stderr, "kernel_launch: occupancy query reports %d\n", per_cu); }
        (void)hipGetLastError();
        grid = cus;
    }
    if (grid < 0) return;
    if (hipMemsetAsync((char*)d_ws + WS_CTL, 0, CTL_ZERO_BYTES, stream) != hipSuccess) return;
    Args a{};
    for (int i = 0; i < 28; ++i) a.in[i] = (const float*)d_in[i];
    a.out = (float*)d_out; a.ws = (unsigned char*)d_ws;
    for (int li = 0; li < N_LAUNCHES; ++li) {
        a.ph_lo = (N_LAUNCHES == 1) ? 0 : li; a.ph_hi = (N_LAUNCHES == 1) ? NPHASE : li + 1;
        hipLaunchKernelGGL(fwd_kernel, dim3(grid), dim3(NTHREADS), LDS_BYTES, stream, a);
        if (hipPeekAtLastError() != hipSuccess) { fprintf(stderr, "kernel_launch: launch %d failed\n", li); break; }
    }
}
```

```cpp
#include <hip/hip_runtime.h>
#include <cstdio>
#include <cstdint>

#ifndef MK_N_LAUNCHES
#define MK_N_LAUNCHES 1
#endif

#define GAS __attribute__((address_space(1)))
#define LAS __attribute__((address_space(3)))
typedef unsigned short bf16;
typedef short bf16x8 __attribute__((ext_vector_type(8)));
typedef short s16x4 __attribute__((ext_vector_type(4)));
typedef float f32x4 __attribute__((ext_vector_type(4)));
typedef float f32x2 __attribute__((ext_vector_type(2)));
typedef unsigned u32x4 __attribute__((ext_vector_type(4)));
typedef unsigned u32x2 __attribute__((ext_vector_type(2)));
#define RLX_AGENT __ATOMIC_RELAXED, __HIP_MEMORY_SCOPE_AGENT
#define DI __device__ __forceinline__

constexpr int T = 16384, D = 1024, NBATCH = 8, SEQ = 2048, MEMLEN = 256, INW = 7168;
constexpr int NEXP = 64, TOPK = 8, EH = 256, MEMW = 512;
constexpr float LN_EPS = 1e-5f;
constexpr float ALPHA = 1.189207115002721f;
constexpr float QSCALE = 0.08838834764831845f;
constexpr float ROUTED_SCALE = 2.5f;
constexpr float LOG2E = 1.4426950408889634f, LN2 = 0.6931471805599453f;
constexpr float SB_EXIT = -30.0f;
constexpr int NWAVES = 8, NTHREADS = 512;
constexpr int MAXBLK = 576;
constexpr int SH_ROW0 = MAXBLK * 256;

constexpr size_t MiB = 1u << 20;
constexpr size_t WS_CTL = 0, CTL_ZERO_BYTES = 1 * MiB;
constexpr size_t WS_WRHI = 1 * MiB, WS_WRLO = WS_WRHI + 128 * 1024, WS_WSP = WS_WRLO + 128 * 1024, WS_BPERM = WS_WSP + 256 * 1024, WS_XSTAT = WS_BPERM + 32 * 1024;
constexpr size_t WS_ROWTOK = 2 * MiB, WS_ROWW = WS_ROWTOK + 576 * 1024, WS_SLOT = WS_ROWW + 576 * 1024;
constexpr size_t WS_WIN = 4 * MiB, WS_WOUT = 18 * MiB, WS_WQ = 20 * MiB, WS_WKV = 21 * MiB, WS_WO = 23 * MiB, WS_MEMB = 24 * MiB;
constexpr size_t WS_P1 = 29 * MiB;
constexpr size_t WS_UG = WS_P1, WS_VA = WS_P1 + 32 * MiB, WS_Q = WS_P1 + 64 * MiB, WS_K = WS_P1 + 96 * MiB, WS_V = WS_P1 + 128 * MiB, WS_GB = WS_P1 + 160 * MiB;
constexpr size_t WS_VSTAT = 221 * MiB;
constexpr size_t WS_MERGED = 228 * MiB;
constexpr size_t WS_Y1 = 29 * MiB;
constexpr size_t WS_X1F = 93 * MiB, WS_X1B = 157 * MiB;
constexpr size_t WS_QM = 189 * MiB, WS_KVM = 205 * MiB, WS_OM = 209 * MiB;
constexpr size_t WS_WGU = 29 * MiB;
constexpr size_t WS_H = 148 * MiB;
constexpr size_t WS_X2B = 228 * MiB;
constexpr size_t WS_WD = 260 * MiB;
constexpr size_t WS_WGUS = 293 * MiB, WS_WDS = 294 * MiB;
constexpr size_t WS_TK = 295 * MiB, WS_TKW = WS_TK + 512 * 1024, WS_WGBASE = WS_TKW + 512 * 1024;
constexpr size_t WS_YH = 4 * MiB;
constexpr size_t WS_END = 297 * MiB;
static_assert(WS_XSTAT + (size_t)T * 8 <= WS_ROWTOK && WS_SLOT + (size_t)T * 8 * 4 <= WS_WIN && WS_MEMB + 4 * MiB <= WS_P1, "ws map 1");
static_assert(WS_GB + 32 * MiB <= WS_VSTAT && WS_VSTAT + 2 * MiB <= WS_MERGED && WS_H + (size_t)(SH_ROW0 + T) * 512 <= WS_X2B && WS_X2B + 32 * MiB <= WS_WD, "ws map 2");
static_assert(WS_WD + (size_t)64 * 1024 * 256 * 2 <= WS_WGUS && WS_YH + (size_t)288 * 256 * 2048 <= WS_H && WS_WGBASE + 256 * 64 * 4 <= WS_END, "ws map 3");
constexpr int CW_TMO = 0, CW_CODE = 1;
constexpr int CW_GCOUNT = 64;
constexpr int CW_HDR = 192;
constexpr int CW_BLKE = 256;
constexpr int CW_BAR = 4096;

constexpr int SCR_BYTES = 140 * 1024;
constexpr int MISC_OFF = SCR_BYTES;
constexpr int LDS_BYTES = 144 * 1024;

DI unsigned cvt_pk_bf16(float lo, float hi) { unsigned r; asm volatile("v_cvt_pk_bf16_f32 %0, %1, %2" : "=v"(r) : "v"(lo), "v"(hi)); return r; }
DI float bf2f(unsigned short h) { return __uint_as_float((unsigned)h << 16); }
DI float bflo(unsigned w) { return __uint_as_float(w << 16); }
DI float bfhi(unsigned w) { return __uint_as_float(w & 0xffff0000u); }
DI float fast_exp2(float x) { return __builtin_amdgcn_exp2f(x); }
DI float fast_log2(float x) { return __builtin_amdgcn_logf(x); }
DI float fast_rcp(float x) { return __builtin_amdgcn_rcpf(x); }
DI float sigmoidf_(float x) { return fast_rcp(1.0f + fast_exp2(-x * LOG2E)); }
DI float wave_sum(float v) {
#pragma unroll
    for (int o = 1; o < 64; o <<= 1) v += __shfl_xor(v, o);
    return v;
}
DI float wave_max(float v) {
#pragma unroll
    for (int o = 1; o < 64; o <<= 1) v = fmaxf(v, __shfl_xor(v, o));
    return v;
}
#define LDS_WAIT() asm volatile("s_waitcnt lgkmcnt(0)" ::: "memory")
#define VM_WAIT() asm volatile("s_waitcnt vmcnt(0)" ::: "memory")

namespace pg8 {
constexpr int BM = 256, BK = 64, HALF = 128, HTB = HALF * BK * 2, STAGE_BYTES = 8 * HTB, NXCD = 8, WGM = 8;
__host__ __device__ __forceinline__ int lds_byte(int r, int c) { const int st = (r >> 4) * 2 + (c >> 5), rr = r & 15, cc = c & 31, ob = rr * 64 + cc * 2; return st * 1024 + (ob ^ (((ob >> 9) & 1) << 5)); }
__host__ __device__ __forceinline__ void stage_rc(int b, int& R, int& C) { const int st = b / 1024, sb = b % 1024, swz = sb ^ (((sb >> 9) & 1) << 5); R = (st >> 1) * 16 + swz / 64; C = (st & 1) * 32 + (swz % 64) / 2; }
__host__ __device__ __forceinline__ int perm32(int rho) { const int n = rho >> 4, i = rho & 15; return 8 * (i >> 2) + 4 * n + (i & 3); }

struct Unit { int pm, pn, e; const char* A; const char* B; };

typedef float f32x2v __attribute__((ext_vector_type(2)));
DI f32x2v gelu_pk(f32x2v v) {
    const f32x2v av = __builtin_elementwise_abs(v), d = av * 0.2316418882f + 1.0f;
    f32x2v t; t.x = __builtin_amdgcn_rcpf(d.x); t.y = __builtin_amdgcn_rcpf(d.y);
    f32x2v q = t * 0.5307027145f + (-0.7265760135f); q = q * t + 0.7107068705f; q = q * t + (-0.142248368f); q = q * t + 0.127414796f; q = q * t;
    const f32x2v s = (v * v) * (-0.72134752044f);
    f32x2v e; e.x = __builtin_amdgcn_exp2f(s.x); e.y = __builtin_amdgcn_exp2f(s.y);
    const f32x2v m = v * (q * e), r = v - m;
    f32x2v o; o.x = v.x < 0.f ? m.x : r.x; o.y = v.y < 0.f ? m.y : r.y; return o;
}
DI f32x4 gelu4(f32x4 v) { const f32x2v a = gelu_pk((f32x2v){v[0], v[1]}), b = gelu_pk((f32x2v){v[2], v[3]}); return (f32x4){a.x, a.y, b.x, b.y}; }
DI f32x4 sigmoid4(f32x4 v) { return (f32x4){sigmoidf_(v[0]), sigmoidf_(v[1]), sigmoidf_(v[2]), sigmoidf_(v[3])}; }
DI u32x4 pack8(f32x4 v0, f32x4 v1) { u32x4 w; w.x = cvt_pk_bf16(v0[0], v0[1]); w.y = cvt_pk_bf16(v0[2], v0[3]); w.z = cvt_pk_bf16(v1[0], v1[1]); w.w = cvt_pk_bf16(v1[2], v1[3]); return w; }

template <class Epi, class Sched, bool ALIGN_EPI>
DI void gemm_phase(LAS unsigned char* lds, const int K, const Sched& S, const Epi& E) {
    const int tid = threadIdx.x, wid = __builtin_amdgcn_readfirstlane(tid >> 6), lane = tid & 63, wr = wid >> 2, wc = wid & 3, fr = lane & 15, fq = lane >> 4;
    const int nt = K / BK;
    int Rr[2], Cc[2]; unsigned voffB[2];
#pragma unroll
    for (int i = 0; i < 2; ++i) { int R, C; stage_rc(tid * 16 + i * 8192, R, C); const int Rb = Epi::PERM ? ((R & ~31) + perm32(R & 31)) : R; Rr[i] = R; Cc[i] = C; voffB[i] = (unsigned)(Rb * K + C) * 2u; }
    const size_t kstep = (size_t)(BK * 2);
    const size_t hstep = (size_t)HALF * K * 2;
    const unsigned ldsw = (unsigned)wid * 1024u;
    const int aoff = lds_byte(wr * 64 + fr, fq * 8), boff = lds_byte(wc * 32 + fr, fq * 8);
#define PG8_SA(b, h) (((b) * 2 + (h)) * HTB)
#define PG8_SB(b, h) ((4 + (b) * 2 + (h)) * HTB)
#define PG8_STAGE_B(bufoff, gbase) do { _Pragma("unroll") for (int _i = 0; _i < 2; ++_i) \
        __builtin_amdgcn_global_load_lds((const unsigned*)((const char*)(gbase) + voffB[_i]), (LAS unsigned*)(lds + (bufoff) + ldsw + _i * 8192), 16, 0, 0); } while (0)
#define PG8_STAGE_A(bufoff, gbase, o0, o1) do { \
        __builtin_amdgcn_global_load_lds((const unsigned*)((const char*)(gbase) + (o0)), (LAS unsigned*)(lds + (bufoff) + ldsw), 16, 0, 0); \
        __builtin_amdgcn_global_load_lds((const unsigned*)((const char*)(gbase) + (o1)), (LAS unsigned*)(lds + (bufoff) + ldsw + 8192), 16, 0, 0); } while (0)
#define PG8_LDA(dst, b, h) do { _Pragma("unroll") for (int m = 0; m < 4; ++m) _Pragma("unroll") for (int k = 0; k < 2; ++k) dst[m][k] = *(const LAS bf16x8*)(lds + PG8_SA(b, h) + aoff + m * 2048 + k * 1024); } while (0)
#define PG8_LDB(dst, b, h) do { _Pragma("unroll") for (int n = 0; n < 2; ++n) _Pragma("unroll") for (int k = 0; k < 2; ++k) dst[n][k] = *(const LAS bf16x8*)(lds + PG8_SB(b, h) + boff + n * 2048 + k * 1024); } while (0)
#define PG8_MMA(ai, bj, At, Bt) do { __builtin_amdgcn_s_setprio(1); _Pragma("unroll") for (int m = 0; m < 4; ++m) _Pragma("unroll") for (int n = 0; n < 2; ++n) _Pragma("unroll") for (int k = 0; k < 2; ++k) \
        acc[ai][bj][m][n] = __builtin_amdgcn_mfma_f32_16x16x32_bf16(Bt[n][k], At[m][k], acc[ai][bj][m][n], 0, 0, 0); __builtin_amdgcn_s_setprio(0); } while (0)
#define PG8_WAIT_V(n) asm volatile("s_waitcnt vmcnt(" #n ")" ::: "memory")
#define PG8_WAIT_L(n) asm volatile("s_waitcnt lgkmcnt(" #n ")" ::: "memory")
#define PG8_BAR __builtin_amdgcn_s_barrier()
#define PG8_SCHED __builtin_amdgcn_sched_barrier(0)
    Unit cur, nxt; int ui = 0;
    if (!S.next(0, cur)) return;
    unsigned oc[2][2], on[2][2];
    S.a_offs(cur, Rr, Cc, K, oc);
    f32x4 acc[2][2][4][2];
#pragma unroll
    for (int a = 0; a < 2; ++a)
#pragma unroll
        for (int b = 0; b < 2; ++b)
#pragma unroll
            for (int m = 0; m < 4; ++m)
#pragma unroll
                for (int n = 0; n < 2; ++n) acc[a][b][m][n] = (f32x4){0.f, 0.f, 0.f, 0.f};
    bf16x8 At[4][2], B0[2][2], B1[2][2];
    const char* cA = cur.A; const char* cB = cur.B;
    PG8_STAGE_B(PG8_SB(0, 0), cB); PG8_STAGE_B(PG8_SB(0, 1), cB + hstep); PG8_STAGE_A(PG8_SA(0, 0), cA, oc[0][0], oc[0][1]); PG8_STAGE_A(PG8_SA(0, 1), cA, oc[1][0], oc[1][1]);
    if (wr == 1) PG8_BAR;
    PG8_WAIT_V(2); PG8_BAR;
    PG8_STAGE_B(PG8_SB(1, 0), cB + kstep); PG8_STAGE_A(PG8_SA(1, 0), cA + kstep, oc[0][0], oc[0][1]); PG8_STAGE_B(PG8_SB(1, 1), cB + hstep + kstep);
    PG8_WAIT_V(6); PG8_BAR;
    for (;;) {
        const bool has_next = S.next(ui + 1, nxt);
        const char* nA = has_next ? nxt.A : cA; const char* nB = has_next ? nxt.B : cB;
        if (has_next) S.a_offs(nxt, Rr, Cc, K, on);
        else {
#pragma unroll
            for (int h = 0; h < 2; ++h)
#pragma unroll
                for (int i = 0; i < 2; ++i) on[h][i] = oc[h][i]; }
#pragma unroll 1
        for (int t = 0; t < nt; t += 2) {
            const bool last = (t == nt - 2);
            const char* a1 = cA + (size_t)(t + 1) * kstep;
            const char* a2 = last ? nA : cA + (size_t)(t + 2) * kstep; const char* b2 = last ? nB : cB + (size_t)(t + 2) * kstep;
            const char* a3 = a2 + kstep; const char* b3 = b2 + kstep;
            const unsigned x00 = last ? on[0][0] : oc[0][0], x01 = last ? on[0][1] : oc[0][1], x10 = last ? on[1][0] : oc[1][0], x11 = last ? on[1][1] : oc[1][1];
            PG8_LDB(B0, 0, 0); PG8_LDB(B1, 0, 1); PG8_SCHED; PG8_LDA(At, 0, 0); PG8_STAGE_A(PG8_SA(1, 1), a1, oc[1][0], oc[1][1]);
            PG8_WAIT_V(8); PG8_WAIT_L(0); PG8_BAR; PG8_MMA(0, 0, At, B0); PG8_MMA(0, 1, At, B1); PG8_BAR; PG8_SCHED;
            PG8_LDA(At, 0, 1); PG8_STAGE_B(PG8_SB(0, 0), b2); PG8_STAGE_B(PG8_SB(0, 1), b2 + hstep); PG8_STAGE_A(PG8_SA(0, 0), a2, x00, x01);
            PG8_WAIT_V(8); PG8_WAIT_L(0); PG8_BAR; PG8_MMA(1, 0, At, B0); PG8_MMA(1, 1, At, B1); PG8_BAR; PG8_SCHED;
            PG8_LDB(B0, 1, 0); PG8_LDB(B1, 1, 1); PG8_SCHED; PG8_LDA(At, 1, 0); PG8_STAGE_A(PG8_SA(0, 1), a2, x10, x11);
            PG8_WAIT_V(8); PG8_WAIT_L(0); PG8_BAR; PG8_MMA(0, 0, At, B0); PG8_MMA(0, 1, At, B1); PG8_BAR; PG8_SCHED;
            PG8_LDA(At, 1, 1); PG8_STAGE_B(PG8_SB(1, 0), b3); PG8_STAGE_B(PG8_SB(1, 1), b3 + hstep); PG8_STAGE_A(PG8_SA(1, 0), a3, x00, x01);
            PG8_WAIT_V(8); PG8_WAIT_L(0); PG8_BAR; PG8_MMA(1, 0, At, B0); PG8_MMA(1, 1, At, B1); PG8_BAR; PG8_SCHED;
        }
        if constexpr (ALIGN_EPI) { if (wr == 0) PG8_BAR; }
        E(acc, cur, wr, wc, fr, fq);
        if (!has_next) break;
#pragma unroll
        for (int a = 0; a < 2; ++a)
#pragma unroll
            for (int b = 0; b < 2; ++b)
#pragma unroll
                for (int m = 0; m < 4; ++m)
#pragma unroll
                    for (int n = 0; n < 2; ++n) acc[a][b][m][n] = (f32x4){0.f, 0.f, 0.f, 0.f};
        cur = nxt; cA = nA; cB = nB; ++ui;
#pragma unroll
        for (int h = 0; h < 2; ++h)
#pragma unroll
            for (int i = 0; i < 2; ++i) oc[h][i] = on[h][i];
        if constexpr (ALIGN_EPI) { if (wr == 1) PG8_BAR; }
    }
    PG8_WAIT_V(0);
    if constexpr (!ALIGN_EPI) { if (wr == 0) PG8_BAR; }
    PG8_BAR;
#undef PG8_SA
#undef PG8_SB
#undef PG8_STAGE_A
#undef PG8_STAGE_B
#undef PG8_LDA
#undef PG8_LDB
#undef PG8_MMA
#undef PG8_WAIT_V
#undef PG8_WAIT_L
#undef PG8_BAR
#undef PG8_SCHED
}

struct DenseOrder {
    const char* A; const char* Bt; int K, nM, nN, nwg, G, c;
    DI void init(const bf16* A_, const bf16* Bt_, int M, int N, int K_, int G_, int c_) { A = (const char*)A_; Bt = (const char*)Bt_; K = K_; nM = M / BM; nN = N / BM; nwg = nM * nN; G = G_; c = c_; }
    DI bool next(int i, Unit& u) const {
        const long L = (long)i * G + c; if (L >= nwg) return false;
        int wgid = (int)L; { const int q = nwg / NXCD, r = nwg % NXCD, xcd = wgid % NXCD, off = wgid / NXCD; wgid = (xcd < r ? xcd * (q + 1) : r * (q + 1) + (xcd - r) * q) + off; }
        const int nig = WGM * nN, gid = wgid / nig, fm = gid * WGM, gsz = (nM - fm) < WGM ? (nM - fm) : WGM;
        u.pm = fm + ((wgid % nig) % gsz); u.pn = (wgid % nig) / gsz; u.e = 0;
        u.A = A + (size_t)u.pm * BM * K * 2; u.B = Bt + (size_t)u.pn * BM * K * 2; return true;
    }
    DI void a_offs(const Unit&, const int (&R)[2], const int (&C)[2], int K_, unsigned (&off)[2][2]) const {
#pragma unroll
        for (int h = 0; h < 2; ++h)
#pragma unroll
            for (int i = 0; i < 2; ++i) off[h][i] = (unsigned)((h * HALF + R[i]) * K_ + C[i]) * 2u;
    }
};
}

#define XB_TMO      128
#define XB_XCNT(j)  (256  + 64 * (j))
#define XB_XSUB(j)  (1280 + 64 * (j))
#define XB_XGEN(j)  (2304 + 64 * (j))
#define XB_TOP      3328
#define XB_TOPGEN   3392
#define XCD_BAR_WORDS 3456
#define XB_SPIN_CAP (1u << 18)
DI unsigned xb_ld(unsigned* p)              { return __hip_atomic_load(p, __ATOMIC_RELAXED, __HIP_MEMORY_SCOPE_AGENT); }
DI unsigned xb_add(unsigned* p, unsigned v) { return __hip_atomic_fetch_add(p, v, __ATOMIC_RELAXED, __HIP_MEMORY_SCOPE_AGENT); }
DI unsigned xb_xcc_id() { return (unsigned)__builtin_amdgcn_s_getreg((3 << 11) | 20) & 0xFu; }
#define XB_SPIN(cond, bar) do { unsigned _sp = 0; while (cond) { __builtin_amdgcn_s_sleep(1); \
    if ((++_sp & 255u) == 0u) { if (xb_ld(&(bar)[XB_TMO])) break; if (_sp > XB_SPIN_CAP) { atomicAdd(&(bar)[XB_TMO], 1u); break; } } } } while (0)
struct XcdBarrier { unsigned* bar; unsigned x; volatile LAS unsigned* st; };
DI XcdBarrier xcd_barrier_post(unsigned* bar, volatile LAS unsigned* st) {
    XcdBarrier b; b.bar = bar; b.x = xb_xcc_id(); b.st = st;
    if (threadIdx.x == 0) (void)xb_add(&bar[XB_XCNT(b.x)], 1u);
    return b;
}
DI void xcd_barrier_complete(unsigned* bar, unsigned x, unsigned& nloc, unsigned& nx) {
    const unsigned G = gridDim.x * gridDim.y * gridDim.z;
    unsigned sum, cnt, mine, sp = 0u;
    for (;;) {
        sum = 0u; cnt = 0u; mine = 0u;
#pragma unroll
        for (unsigned j = 0; j < 16; ++j) { const unsigned c = xb_ld(&bar[XB_XCNT(j)]); sum += c; cnt += (c > 0u) ? 1u : 0u; mine = (j == x) ? c : mine; }
        if (sum == G) break;
        __builtin_amdgcn_s_sleep(1);
        if ((++sp & 255u) == 0u) { if (xb_ld(&bar[XB_TMO])) break; if (sp > XB_SPIN_CAP) { atomicAdd(&bar[XB_TMO], 1u); break; } }
    }
    nloc = mine > 0u ? mine : 1u; nx = cnt > 0u ? cnt : 1u;
}
DI void xcd_barrier(const XcdBarrier& b) {
    asm volatile("s_waitcnt vmcnt(0)" ::: "memory");
    __syncthreads();
    if (threadIdx.x == 0) {
        unsigned* bar = b.bar;
        __builtin_amdgcn_s_waitcnt(0);
        unsigned nloc = b.st[0], nx = b.st[1];
        if (nloc == 0u) { xcd_barrier_complete(bar, b.x, nloc, nx); b.st[0] = nloc; b.st[1] = nx; }
        const unsigned old = xb_add(&bar[XB_XSUB(b.x)], 1u);
        const unsigned gen = old / nloc;
        if (old + 1u == (gen + 1u) * nloc) {
            __builtin_amdgcn_fence(__ATOMIC_RELEASE, "agent");
            asm volatile("s_waitcnt vmcnt(0)" ::: "memory");
            const unsigned og = xb_add(&bar[XB_TOP], 1u);
            const unsigned tg = og / nx;
            if (og + 1u == (tg + 1u) * nx) xb_add(&bar[XB_TOPGEN], 1u);
            else XB_SPIN(xb_ld(&bar[XB_TOPGEN]) == tg, bar);
            __builtin_amdgcn_fence(__ATOMIC_ACQUIRE, "agent");
            xb_add(&bar[XB_XGEN(b.x)], 1u);
            asm volatile("s_waitcnt vmcnt(0)" ::: "memory");
        } else {
            XB_SPIN(xb_ld(&bar[XB_XGEN(b.x)]) == gen, bar);
            __builtin_amdgcn_fence(__ATOMIC_ACQUIRE, "agent");
            asm volatile("s_waitcnt vmcnt(0)" ::: "memory");
        }
    }
    __syncthreads();
}

namespace pg8 {
typedef __bf16 bf16x2_t __attribute__((ext_vector_type(2)));
DI unsigned pk2(float lo, float hi) { f32x2v v = {lo, hi}; bf16x2_t b = __builtin_convertvector(v, bf16x2_t); return __builtin_bit_cast(unsigned, b); }
DI u32x4 pk8(f32x4 v0, f32x4 v1) { u32x4 w; w.x = pk2(v0[0], v0[1]); w.y = pk2(v0[2], v0[3]); w.z = pk2(v1[0], v1[1]); w.w = pk2(v1[2], v1[3]); return w; }

struct EpiInProj {
    static constexpr bool PERM = true;
    bf16* P1; float* vstat; const float* bias;
    DI void operator()(const f32x4 (&acc)[2][2][4][2], const Unit& u, int wr, int wc, int fr, int fq) const {
        const int row0 = u.pm * BM + wr * 64 + fr;
        const int bcol0 = u.pn * BM + wc * 32 + 8 * fq;
        f32x4 bv[2][2];
#pragma unroll
        for (int bj = 0; bj < 2; ++bj)
#pragma unroll
            for (int n = 0; n < 2; ++n) bv[bj][n] = *(const f32x4*)(bias + bcol0 + bj * HALF + 4 * n);
        if (u.pn < 8) {
            bf16* base = P1 + u.pn * 128 + wc * 32 + 8 * fq;
#pragma unroll
            for (int ai = 0; ai < 2; ++ai)
#pragma unroll
                for (int m = 0; m < 4; ++m) {
                    f32x4 u0 = gelu4(acc[ai][0][m][0] + bv[0][0]), u1 = gelu4(acc[ai][0][m][1] + bv[0][1]);
                    const f32x4 g0 = sigmoid4(acc[ai][1][m][0] + bv[1][0]), g1 = sigmoid4(acc[ai][1][m][1] + bv[1][1]);
                    u0 = u0 * g0; u1 = u1 * g1;
                    *(u32x4*)(base + (size_t)(row0 + ai * HALF + m * 16) * D) = pk8(u0, u1);
                }
        } else {
            const int t = (u.pn - 8) >> 2, colt = ((u.pn - 8) & 3) * BM;
            bf16* base = P1 + (size_t)(t + 1) * T * D + colt + wc * 32 + 8 * fq;
#pragma unroll
            for (int ai = 0; ai < 2; ++ai)
#pragma unroll
                for (int m = 0; m < 4; ++m) {
                    float s1 = 0.f, s2 = 0.f;
#pragma unroll
                    for (int bj = 0; bj < 2; ++bj) {
                        f32x4 v0 = acc[ai][bj][m][0] + bv[bj][0], v1 = acc[ai][bj][m][1] + bv[bj][1];
                        if (t == 0) { v0 = gelu4(v0); v1 = gelu4(v1);
                            s1 += (v0[0] + v0[1]) + (v0[2] + v0[3]) + (v1[0] + v1[1]) + (v1[2] + v1[3]);
                            s2 += (v0[0] * v0[0] + v0[1] * v0[1]) + (v0[2] * v0[2] + v0[3] * v0[3]) + (v1[0] * v1[0] + v1[1] * v1[1]) + (v1[2] * v1[2] + v1[3] * v1[3]); }
                        else if (t == 1) { v0 = v0 * QSCALE; v1 = v1 * QSCALE; }
                        else if (t == 4) { v0 = sigmoid4(v0); v1 = sigmoid4(v1); }
                        *(u32x4*)(base + (size_t)(row0 + ai * HALF + m * 16) * D + bj * HALF) = pk8(v0, v1);
                    }
                    if (t == 0) {
                        s1 += __shfl_xor(s1, 16); s1 += __shfl_xor(s1, 32); s2 += __shfl_xor(s2, 16); s2 += __shfl_xor(s2, 32);
                        if (fq == 0) *(f32x2v*)(vstat + ((size_t)(row0 + ai * HALF + m * 16) * 16 + (u.pn - 8) * 4 + wc) * 2) = (f32x2v){s1, s2};
                    }
                }
        }
    }
};
struct EpiBf16S {
    static constexpr bool PERM = true;
    bf16* O; int ldc; float scale;
    DI void operator()(const f32x4 (&acc)[2][2][4][2], const Unit& u, int wr, int wc, int fr, int fq) const {
        const int row0 = u.pm * BM + wr * 64 + fr, col0 = u.pn * BM + wc * 32 + 8 * fq;
#pragma unroll
        for (int ai = 0; ai < 2; ++ai)
#pragma unroll
            for (int m = 0; m < 4; ++m)
#pragma unroll
                for (int bj = 0; bj < 2; ++bj)
                    *(u32x4*)(O + (size_t)(row0 + ai * HALF + m * 16) * ldc + col0 + bj * HALF) = pk8(acc[ai][bj][m][0] * scale, acc[ai][bj][m][1] * scale);
    }
};
template <bool LNIN> struct EpiResF32 {
    static constexpr bool PERM = false;
    float* out; const float* res; const float* xstat; const float* g; const float* b;
    DI void operator()(const f32x4 (&acc)[2][2][4][2], const Unit& u, int wr, int wc, int fr, int fq) const {
        const int col0 = u.pn * BM + wc * 32 + 4 * fq;
        f32x4 gv[2][2], bv[2][2];
        if (LNIN) {
#pragma unroll
            for (int bj = 0; bj < 2; ++bj)
#pragma unroll
                for (int n = 0; n < 2; ++n) { gv[bj][n] = *(const f32x4*)(g + col0 + bj * HALF + n * 16); bv[bj][n] = *(const f32x4*)(b + col0 + bj * HALF + n * 16); }
        }
#pragma unroll
        for (int ai = 0; ai < 2; ++ai)
#pragma unroll
            for (int m = 0; m < 4; ++m) {
                const int row = u.pm * BM + ai * HALF + wr * 64 + m * 16 + fr; const size_t off = (size_t)row * D + col0;
                f32x2v st = (f32x2v){0.f, 1.f}; if (LNIN) st = *(const f32x2v*)(xstat + 2 * (size_t)row);
#pragma unroll
                for (int bj = 0; bj < 2; ++bj)
#pragma unroll
                    for (int n = 0; n < 2; ++n) { f32x4 r = *(const f32x4*)(res + off + bj * HALF + n * 16);
                        if (LNIN) r = (r - st.x) * st.y * gv[bj][n] + bv[bj][n];
                        *(f32x4*)(out + off + bj * HALF + n * 16) = r * ALPHA + acc[ai][bj][m][n]; }
                if (m & 1) asm volatile("" ::: "memory");
            }
    }
};
struct EpiGateUp {
    static constexpr bool PERM = true;
    bf16* H;
    DI void operator()(const f32x4 (&acc)[2][2][4][2], const Unit& u, int wr, int wc, int fr, int fq) const {
        const int row0 = u.pm * BM + wr * 64 + fr, col0 = u.pn * 128 + wc * 32 + 8 * fq;
#pragma unroll
        for (int ai = 0; ai < 2; ++ai)
#pragma unroll
            for (int m = 0; m < 4; ++m) {
                const f32x4 g0 = acc[ai][0][m][0], g1 = acc[ai][0][m][1];
                const f32x4 h0 = g0 * sigmoid4(g0) * acc[ai][1][m][0], h1 = g1 * sigmoid4(g1) * acc[ai][1][m][1];
                *(u32x4*)(H + (size_t)(row0 + ai * HALF + m * 16) * EH + col0) = pk8(h0, h1);
            }
    }
};
struct EpiDown {
    static constexpr bool PERM = true;
    bf16* Y; const float* roww; int lo; float* base; const bf16* x2b;
    DI void operator()(const f32x4 (&acc)[2][2][4][2], const Unit& u, int wr, int wc, int fr, int fq) const {
        const int rl = wr * 64 + fr, col0 = u.pn * BM + wc * 32 + 8 * fq;
        if (u.e < 64) {
#pragma unroll
            for (int ai = 0; ai < 2; ++ai)
#pragma unroll
                for (int m = 0; m < 4; ++m) { const int r = rl + ai * HALF + m * 16;
                    const float w = __hip_atomic_load(roww + (size_t)u.pm * BM + r, RLX_AGENT);
#pragma unroll
                    for (int bj = 0; bj < 2; ++bj)
                        *(u32x4*)(Y + ((size_t)(u.pm - lo) * BM + r) * D + col0 + bj * HALF) = pk8(acc[ai][bj][m][0] * w, acc[ai][bj][m][1] * w);
                    if (m & 1) asm volatile("" ::: "memory"); }
        } else {
#pragma unroll
            for (int ai = 0; ai < 2; ++ai)
#pragma unroll
                for (int m = 0; m < 4; ++m) { const size_t off = ((size_t)(u.pm - SH_ROW0 / BM) * BM + rl + ai * HALF + m * 16) * D + col0;
#pragma unroll
                    for (int bj = 0; bj < 2; ++bj) { const u32x4 xr = *(const u32x4*)(x2b + off + bj * HALF);
                        const f32x4 x0 = (f32x4){bflo(xr.x), bfhi(xr.x), bflo(xr.y), bfhi(xr.y)}, x1 = (f32x4){bflo(xr.z), bfhi(xr.z), bflo(xr.w), bfhi(xr.w)};
                        *(f32x4*)(base + off + bj * HALF) = x0 * ALPHA + acc[ai][bj][m][0]; *(f32x4*)(base + off + bj * HALF + 4) = x1 * ALPHA + acc[ai][bj][m][1]; }
                    asm volatile("" ::: "memory"); }
        }
    }
};
struct GateUpOrder {
    const char* X; const char* Wgu; const char* Wgus; const int* rowtok; const unsigned* blke; int nblk, G, c;
    DI bool next(int i, Unit& u) const {
        const int L = i * G + c; if (L >= (nblk + 64) * 2) return false;
        const int bl = L >> 1; u.pn = L & 1;
        if (bl < nblk) { u.e = (int)__builtin_amdgcn_readfirstlane(__hip_atomic_load(blke + bl, RLX_AGENT)); u.pm = bl; u.A = X; u.B = Wgu + ((size_t)u.e * 512 + u.pn * 256) * D * 2; }
        else { u.e = 64; u.pm = SH_ROW0 / BM + (bl - nblk); u.A = X + (size_t)(bl - nblk) * BM * D * 2; u.B = Wgus + (size_t)u.pn * 256 * D * 2; }
        return true;
    }
    DI void a_offs(const Unit& u, const int (&R)[2], const int (&C)[2], int K_, unsigned (&off)[2][2]) const {
        if (u.e < 64) {
#pragma unroll
            for (int h = 0; h < 2; ++h)
#pragma unroll
                for (int i = 0; i < 2; ++i) { const int tok = __hip_atomic_load(rowtok + (size_t)u.pm * BM + h * HALF + R[i], RLX_AGENT); off[h][i] = (unsigned)(tok * K_ + C[i]) * 2u; }
        } else {
#pragma unroll
            for (int h = 0; h < 2; ++h)
#pragma unroll
                for (int i = 0; i < 2; ++i) off[h][i] = (unsigned)((h * HALF + R[i]) * K_ + C[i]) * 2u;
        }
    }
};
struct DownOrder {
    const char* H; const char* Wd; const char* Wds; const unsigned* blke; int lo, hi, nsh, G, c;
    DI bool next(int i, Unit& u) const {
        const int L = i * G + c; if (L >= (hi - lo + nsh) * 4) return false;
        const int bl = lo + (L >> 2); u.pn = L & 3;
        if (bl < hi) { u.e = (int)__builtin_amdgcn_readfirstlane(__hip_atomic_load(blke + bl, RLX_AGENT)); u.pm = bl; u.B = Wd + ((size_t)u.e * D + u.pn * 256) * EH * 2; }
        else { u.e = 64; u.pm = SH_ROW0 / BM + (bl - hi); u.B = Wds + (size_t)u.pn * 256 * EH * 2; }
        u.A = H + (size_t)u.pm * BM * EH * 2;
        return true;
    }
    DI void a_offs(const Unit&, const int (&R)[2], const int (&C)[2], int K_, unsigned (&off)[2][2]) const {
#pragma unroll
        for (int h = 0; h < 2; ++h)
#pragma unroll
            for (int i = 0; i < 2; ++i) off[h][i] = (unsigned)((h * HALF + R[i]) * K_ + C[i]) * 2u;
    }
};
}

struct Frame {
    LAS unsigned char* lds;
    unsigned* ctl;
    unsigned char* ws; float* out;
    int tid, lane, wave, vcu, G;
};
DI unsigned short f2bf1(float x) { return (unsigned short)(pg8::pk2(x, x) & 0xffffu); }

template <class RowMap>
DI void transpose_item(const float* W, int N, bf16* WT, int Kd, RowMap rm, LAS float* scr, int kb, int nb, int lane) {
    const int k0 = 64 * kb, n0 = 32 * nb;
#pragma unroll 8
    for (int i = 0; i < 32; ++i) { const int kk = 2 * i + (lane >> 5); scr[kk * 33 + (lane & 31)] = W[(size_t)(k0 + kk) * N + n0 + (lane & 31)]; }
    LDS_WAIT(); asm volatile("" ::: "memory");
    const int c = lane & 7; const int drow0 = rm(n0);
#pragma unroll
    for (int j = 0; j < 4; ++j) { const int n = (lane >> 3) + 8 * j; const LAS float* s = scr + (8 * c) * 33 + n;
        u32x4 o; o.x = pg8::pk2(s[0 * 33], s[1 * 33]); o.y = pg8::pk2(s[2 * 33], s[3 * 33]); o.z = pg8::pk2(s[4 * 33], s[5 * 33]); o.w = pg8::pk2(s[6 * 33], s[7 * 33]);
        *(u32x4*)(WT + (size_t)(drow0 + n) * Kd + k0 + 8 * c) = o; }
    LDS_WAIT(); asm volatile("" ::: "memory");
}
struct RmIdent { int off; DI int operator()(int n0) const { return off + n0; } };
struct RmInProj { DI int operator()(int n0) const { const int seg = n0 >> 10, w = n0 & 1023;
    return seg == 0 ? ((w >> 7) * 256 + (w & 127)) : seg == 5 ? ((w >> 7) * 256 + 128 + (w & 127)) : seg == 6 ? 6144 + w : 1024 + n0; } };
struct RmGateUp { int up; DI int operator()(int n0) const { return (n0 >> 7) * 256 + up * 128 + (n0 & 127); } };
DI int inproj_dest(int n) { return RmInProj()(n & ~31) + (n & 31); }

DI void row_stats(const float* xrow, int lane, f32x4 (&v)[4], float& mean, float& rstd) {
    const f32x4* xr = (const f32x4*)xrow + lane; float s = 0.f;
#pragma unroll
    for (int j = 0; j < 4; ++j) { v[j] = xr[64 * j]; s += (v[j][0] + v[j][1]) + (v[j][2] + v[j][3]); }
    mean = wave_sum(s) * (1.f / D); float s2 = 0.f;
#pragma unroll
    for (int j = 0; j < 4; ++j) { const f32x4 d = v[j] - mean; s2 += (d[0] * d[0] + d[1] * d[1]) + (d[2] * d[2] + d[3] * d[3]); }
    rstd = 1.f / sqrtf(wave_sum(s2) * (1.f / D) + LN_EPS);
}

DI void p0_prologue(Frame& F, const float* const* in) {
    LAS float* scr = (LAS float*)(F.lds + F.wave * 16384);
    const int gw = F.vcu * NWAVES + F.wave, NGW = F.G * NWAVES, lane = F.lane;
    unsigned char* ws = F.ws;
    constexpr int I_IN = 16 * (INW / 32), I_OUT = 16 * 32, I_Q = 16 * 16, I_KV = 16 * 32, I_O = 8 * 32, I_SG = 16 * 8, I_SD = 4 * 32;
    constexpr int NITEMS = I_IN + I_OUT + I_Q + I_KV + I_O + 2 * I_SG + I_SD;
    for (int it = gw; it < NITEMS; it += NGW) {
        int r = it;
        if (r < I_IN) { transpose_item(in[4], INW, (bf16*)(ws + WS_WIN), D, RmInProj(), scr, r / (INW / 32), r % (INW / 32), lane); continue; } r -= I_IN;
        if (r < I_OUT) { transpose_item(in[10], D, (bf16*)(ws + WS_WOUT), D, RmIdent{0}, scr, r / 32, r % 32, lane); continue; } r -= I_OUT;
        if (r < I_Q) { transpose_item(in[13], MEMW, (bf16*)(ws + WS_WQ), D, RmIdent{0}, scr, r / 16, r % 16, lane); continue; } r -= I_Q;
        if (r < I_KV) { transpose_item(in[14], 2 * MEMW, (bf16*)(ws + WS_WKV), D, RmIdent{0}, scr, r / 32, r % 32, lane); continue; } r -= I_KV;
        if (r < I_O) { transpose_item(in[15], D, (bf16*)(ws + WS_WO), MEMW, RmIdent{0}, scr, r / 32, r % 32, lane); continue; } r -= I_O;
        if (r < I_SG) { transpose_item(in[23], EH, (bf16*)(ws + WS_WGUS), D, RmGateUp{0}, scr, r / 8, r % 8, lane); continue; } r -= I_SG;
        if (r < I_SG) { transpose_item(in[24], EH, (bf16*)(ws + WS_WGUS), D, RmGateUp{1}, scr, r / 8, r % 8, lane); continue; } r -= I_SG;
        transpose_item(in[25], D, (bf16*)(ws + WS_WDS), EH, RmIdent{0}, scr, r / 32, r % 32, lane);
    }
    const int gt = F.vcu * NTHREADS + F.tid, NGT = F.G * NTHREADS;
    { const float* wr = in[18]; bf16* hi = (bf16*)(ws + WS_WRHI); bf16* lo = (bf16*)(ws + WS_WRLO);
      for (int idx = gt; idx < D * NEXP; idx += NGT) { const int k = idx >> 6, e = idx & 63; const float w = wr[idx]; const unsigned short h = f2bf1(w); hi[e * D + k] = h; lo[e * D + k] = f2bf1(w - bf2f(h)); } }
    { const float* wsp = in[8]; bf16* o = (bf16*)(ws + WS_WSP);
      for (int idx = gt; idx < 8 * 128 * 128; idx += NGT) { const int s = idx & 127, t = (idx >> 7) & 127; o[idx] = (s <= t) ? f2bf1(wsp[idx]) : (unsigned short)0; } }
    { const float* bi = in[5]; float* o = (float*)(ws + WS_BPERM);
      for (int idx = gt; idx < INW; idx += NGT) o[inproj_dest(idx)] = bi[idx]; }
    { const f32x4* m4 = (const f32x4*)in[1]; u32x2* o = (u32x2*)(ws + WS_MEMB);
      for (int idx = gt; idx < NBATCH * MEMLEN * D / 4; idx += NGT) { const f32x4 v = m4[idx]; o[idx] = (u32x2){pg8::pk2(v[0], v[1]), pg8::pk2(v[2], v[3])}; } }
    { const float* x = in[0]; const float* g = in[2]; const float* b = in[3]; bf16* X0b = (bf16*)F.out; float* xstat = (float*)(ws + WS_XSTAT);
      f32x4 gv[4], bv[4];
#pragma unroll
      for (int j = 0; j < 4; ++j) { gv[j] = ((const f32x4*)g)[lane + 64 * j]; bv[j] = ((const f32x4*)b)[lane + 64 * j]; }
      for (int m = gw; m < T; m += NGW) { f32x4 v[4]; float mean, rstd; row_stats(x + (size_t)m * D, lane, v, mean, rstd);
          u32x2* o8 = (u32x2*)(X0b + (size_t)m * D) + lane;
#pragma unroll
          for (int j = 0; j < 4; ++j) { const f32x4 y = (v[j] - mean) * rstd * gv[j] + bv[j]; o8[64 * j] = (u32x2){pg8::pk2(y[0], y[1]), pg8::pk2(y[2], y[3])}; }
          if (lane == 0) *(f32x2*)(xstat + 2 * (size_t)m) = (f32x2){mean, rstd}; } }
}
DI void expert_convert(Frame& F, const float* const* in) {
    LAS float* scr = (LAS float*)(F.lds + F.wave * 16384);
    const int gw = F.vcu * NWAVES + F.wave, NGW = F.G * NWAVES, lane = F.lane;
    for (int it = gw; it < NEXP * 384; it += NGW) {
        const int e = it / 384; int r = it % 384;
        if (r < 128) { transpose_item(in[20] + (size_t)e * D * EH, EH, (bf16*)(F.ws + WS_WGU) + (size_t)e * 512 * D, D, RmGateUp{0}, scr, r / 8, r % 8, lane); continue; } r -= 128;
        if (r < 128) { transpose_item(in[21] + (size_t)e * D * EH, EH, (bf16*)(F.ws + WS_WGU) + (size_t)e * 512 * D, D, RmGateUp{1}, scr, r / 8, r % 8, lane); continue; } r -= 128;
        transpose_item(in[22] + (size_t)e * EH * D, D, (bf16*)(F.ws + WS_WD) + (size_t)e * D * EH, EH, RmIdent{0}, scr, r / 32, r % 32, lane);
    }
}

constexpr int MX_RS = 272;
constexpr int MX_KT = 0, MX_VT = 128 * MX_RS, MX_NT = 2 * 128 * MX_RS, MX_STAT = 3 * 128 * MX_RS, MX_FLG = MX_STAT + 1024, MX_END = MX_FLG + 64;
static_assert(MX_END <= SCR_BYTES, "mixer LDS");
DI bf16x8 mk_frag(f32x4 e0, f32x4 e1) { const u32x4 w = pg8::pk8(e0, e1); return __builtin_bit_cast(bf16x8, w); }
DI bf16x8 ld_split8(const LAS unsigned char* p) {
    const s16x4 lo = *(const LAS s16x4*)p, hi = *(const LAS s16x4*)(p + 32);
    return (bf16x8){lo[0], lo[1], lo[2], lo[3], hi[0], hi[1], hi[2], hi[3]};
}
DI void mix_phase(Frame& F, const float* const* in) {
    LAS unsigned char* lds = F.lds; unsigned char* ws = F.ws;
    const int tid = F.tid, lane = F.lane, w = F.wave, r = lane & 15, q = lane >> 4;
    const bf16* UG = (const bf16*)(ws + WS_UG); const bf16* VA = (const bf16*)(ws + WS_VA); const bf16* Qg = (const bf16*)(ws + WS_Q);
    const bf16* Kg = (const bf16*)(ws + WS_K); const bf16* Vg = (const bf16*)(ws + WS_V); const bf16* GB = (const bf16*)(ws + WS_GB);
    const float* vstat = (const float*)(ws + WS_VSTAT); const bf16* WSP = (const bf16*)(ws + WS_WSP); bf16* MG = (bf16*)(ws + WS_MERGED);
    const float* lnvg = in[6]; const float* lnvb = in[7]; const float* bsp = in[9];
    bf16x8 UE, UO, ONES;
#pragma unroll
    for (int jj = 0; jj < 8; ++jj) { ONES[jj] = (short)0x3F80;
        UE[jj] = (jj < 4) ? ((4 * q + jj > r) ? (short)0x3F80 : (short)0) : (short)0x3F80;
        UO[jj] = (jj < 4) ? (short)0 : ((4 * q + jj - 4 > r) ? (short)0x3F80 : (short)0); }
    for (int un = F.vcu; un < NBATCH * 16 * 8; un += F.G) {
        const int j = un & 7, i = (un >> 3) & 15, b = un >> 7;
        const int t0 = b * SEQ + 128 * i, c0 = 128 * j;
        if (tid < 128) { const f32x2* p = (const f32x2*)vstat + (size_t)(t0 + tid) * 16; float s1 = 0.f, s2 = 0.f;
#pragma unroll
            for (int k = 0; k < 16; ++k) { const f32x2 v = p[k]; s1 += v[0]; s2 += v[1]; }
            const float mean = s1 * (1.f / D), var = s2 * (1.f / D) - mean * mean;
            *(LAS f32x2*)(lds + MX_STAT + tid * 8) = (f32x2){mean, 1.f / sqrtf(fmaxf(var, 0.f) + LN_EPS)}; }
        __syncthreads();
#pragma unroll
        for (int it = 0; it < 4; ++it) { const int id = tid + 512 * it, ch = id >> 7, s = id & 127;
            const u32x4 raw = *(const u32x4*)(VA + (size_t)(t0 + s) * D + c0 + 8 * ch);
            const f32x2 st = *(const LAS f32x2*)(lds + MX_STAT + s * 8);
            const f32x4 g0 = *(const f32x4*)(lnvg + c0 + 8 * ch), g1 = *(const f32x4*)(lnvg + c0 + 8 * ch + 4), b0 = *(const f32x4*)(lnvb + c0 + 8 * ch), b1 = *(const f32x4*)(lnvb + c0 + 8 * ch + 4);
            const f32x4 x0 = (f32x4){bflo(raw.x), bfhi(raw.x), bflo(raw.y), bfhi(raw.y)}, x1 = (f32x4){bflo(raw.z), bfhi(raw.z), bflo(raw.w), bfhi(raw.w)};
            const f32x4 y0 = (x0 - st[0]) * st[1] * g0 + b0, y1 = (x1 - st[0]) * st[1] * g1 + b1;
            LAS unsigned short* nt = (LAS unsigned short*)(lds + MX_NT + (8 * ch) * MX_RS + s * 2);
#pragma unroll
            for (int e = 0; e < 4; ++e) { nt[e * (MX_RS / 2)] = f2bf1(y0[e]); nt[(4 + e) * (MX_RS / 2)] = f2bf1(y1[e]); } }
        bf16x8 qf[4];
#pragma unroll
        for (int kk = 0; kk < 4; ++kk) qf[kk] = *(const bf16x8*)(Qg + (size_t)(t0 + 16 * w + r) * D + c0 + 32 * kk + 8 * q);
        f32x4 ya[8], yb[8];
#pragma unroll
        for (int dt = 0; dt < 8; ++dt) { ya[dt] = (f32x4){0.f, 0.f, 0.f, 0.f}; yb[dt] = (f32x4){0.f, 0.f, 0.f, 0.f}; }
        float carry = 0.f;
        for (int kb = i; kb >= 0; --kb) {
            const int kv0 = b * SEQ + 128 * kb;
#pragma unroll
            for (int it = 0; it < 4; ++it) { const int id = tid + 512 * it;
                { const int s = id >> 4, ch = id & 15; *(LAS u32x4*)(lds + MX_KT + s * MX_RS + ch * 16) = *(const u32x4*)(Kg + (size_t)(kv0 + s) * D + c0 + 8 * ch); }
                { const int ch = id >> 7, s = id & 127; const u32x4 raw = *(const u32x4*)(Vg + (size_t)(kv0 + s) * D + c0 + 8 * ch);
                  LAS unsigned short* vt = (LAS unsigned short*)(lds + MX_VT + (8 * ch) * MX_RS + s * 2);
                  vt[0 * (MX_RS / 2)] = (unsigned short)(raw.x & 0xffffu); vt[1 * (MX_RS / 2)] = (unsigned short)(raw.x >> 16); vt[2 * (MX_RS / 2)] = (unsigned short)(raw.y & 0xffffu); vt[3 * (MX_RS / 2)] = (unsigned short)(raw.y >> 16);
                  vt[4 * (MX_RS / 2)] = (unsigned short)(raw.z & 0xffffu); vt[5 * (MX_RS / 2)] = (unsigned short)(raw.z >> 16); vt[6 * (MX_RS / 2)] = (unsigned short)(raw.w & 0xffffu); vt[7 * (MX_RS / 2)] = (unsigned short)(raw.w >> 16); } }
            __syncthreads();
            if (kb == i) {
                const int nks = (w >> 1) + 1;
                for (int ks = 0; ks < nks; ++ks) {
                    const bf16x8 wf = *(const bf16x8*)(WSP + ((size_t)j * 128 + 16 * w + r) * 128 + 32 * ks + 8 * q);
#pragma unroll
                    for (int dt = 0; dt < 8; ++dt) { const bf16x8 af = *(const LAS bf16x8*)(lds + MX_NT + (16 * dt + r) * MX_RS + (32 * ks + 8 * q) * 2);
                        ya[dt] = __builtin_amdgcn_mfma_f32_16x16x32_bf16(af, wf, ya[dt], 0, 0, 0); }
                }
            }
            f32x4 z[8];
#pragma unroll
            for (int st = 0; st < 8; ++st) { z[st] = (f32x4){0.f, 0.f, 0.f, 0.f};
#pragma unroll
                for (int kk = 0; kk < 4; ++kk) { const bf16x8 kf = *(const LAS bf16x8*)(lds + MX_KT + (16 * st + r) * MX_RS + (32 * kk + 8 * q) * 2);
                    z[st] = __builtin_amdgcn_mfma_f32_16x16x32_bf16(kf, qf[kk], z[st], 0, 0, 0); } }
            f32x4 ls[8]; const bool diag = (kb == i); const int tq = 16 * w + r;
#pragma unroll
            for (int st = 0; st < 8; ++st)
#pragma unroll
                for (int e = 0; e < 4; ++e) { const float zz = z[st][e]; const float sp = fmaxf(zz, 0.f) + LN2 * fast_log2(1.0f + fast_exp2(-fabsf(zz) * LOG2E));
                    const bool msk = diag && (16 * st + 4 * q + e >= tq);
                    ls[st][e] = msk ? 0.f : -sp; z[st][e] = msk ? -1e30f : zz - sp; }
            bf16x8 lf[4];
#pragma unroll
            for (int p = 0; p < 4; ++p) lf[p] = mk_frag(ls[2 * p], ls[2 * p + 1]);
            f32x4 tot = (f32x4){0.f, 0.f, 0.f, 0.f};
#pragma unroll
            for (int p = 0; p < 4; ++p) tot = __builtin_amdgcn_mfma_f32_16x16x32_bf16(ONES, lf[p], tot, 0, 0, 0);
            bf16x8 af[4];
#pragma unroll
            for (int p = 0; p < 4; ++p) {
                f32x4 s0 = (f32x4){0.f, 0.f, 0.f, 0.f}, s1 = (f32x4){0.f, 0.f, 0.f, 0.f};
                s0 = __builtin_amdgcn_mfma_f32_16x16x32_bf16(UE, lf[p], s0, 0, 0, 0);
                s1 = __builtin_amdgcn_mfma_f32_16x16x32_bf16(UO, lf[p], s1, 0, 0, 0);
#pragma unroll
                for (int p2 = p + 1; p2 < 4; ++p2) { s0 = __builtin_amdgcn_mfma_f32_16x16x32_bf16(ONES, lf[p2], s0, 0, 0, 0); s1 = __builtin_amdgcn_mfma_f32_16x16x32_bf16(ONES, lf[p2], s1, 0, 0, 0); }
                f32x4 a0, a1;
#pragma unroll
                for (int e = 0; e < 4; ++e) { a0[e] = fast_exp2((z[2 * p][e] + s0[e] + carry) * LOG2E); a1[e] = fast_exp2((z[2 * p + 1][e] + s1[e] + carry) * LOG2E); }
                af[p] = mk_frag(a0, a1);
            }
#pragma unroll
            for (int dt = 0; dt < 8; ++dt)
#pragma unroll
                for (int p = 0; p < 4; ++p) { const bf16x8 vf = ld_split8(lds + MX_VT + (16 * dt + r) * MX_RS + (32 * p + 4 * q) * 2);
                    yb[dt] = __builtin_amdgcn_mfma_f32_16x16x32_bf16(vf, af[p], yb[dt], 0, 0, 0); }
            carry += tot[0];
            const float wm = wave_max(carry);
            if (lane == 0) *(LAS float*)(lds + MX_FLG + ((kb & 1) * 8 + w) * 4) = wm;
            __syncthreads();
            float gm = -1e30f;
#pragma unroll
            for (int k = 0; k < 8; ++k) gm = fmaxf(gm, *(const LAS float*)(lds + MX_FLG + ((kb & 1) * 8 + k) * 4));
            if (gm < SB_EXIT) break;
        }
        { const float bs = bsp[j * 128 + 16 * w + r]; const size_t rowoff = (size_t)(t0 + 16 * w + r) * D + c0 + 4 * q;
#pragma unroll
          for (int dt = 0; dt < 8; ++dt) { const u32x2 ug = *(const u32x2*)(UG + rowoff + 16 * dt), gb = *(const u32x2*)(GB + rowoff + 16 * dt);
              const f32x4 u4 = (f32x4){bflo(ug.x), bfhi(ug.x), bflo(ug.y), bfhi(ug.y)}, g4 = (f32x4){bflo(gb.x), bfhi(gb.x), bflo(gb.y), bfhi(gb.y)};
              const f32x4 o = u4 * (ya[dt] + bs) + g4 * yb[dt];
              *(u32x2*)(MG + rowoff + 16 * dt) = (u32x2){pg8::pk2(o[0], o[1]), pg8::pk2(o[2], o[3])}; } }
        __syncthreads();
    }
}

DI void ln1_phase(Frame& F, const float* const* in) {
    const int gw = F.vcu * NWAVES + F.wave, NGW = F.G * NWAVES, lane = F.lane;
    const float* Y1 = (const float*)(F.ws + WS_Y1); float* X1f = (float*)(F.ws + WS_X1F); bf16* X1b = (bf16*)(F.ws + WS_X1B);
    f32x4 gv[4], bv[4];
#pragma unroll
    for (int j = 0; j < 4; ++j) { gv[j] = ((const f32x4*)in[11])[lane + 64 * j]; bv[j] = ((const f32x4*)in[12])[lane + 64 * j]; }
    for (int m = gw; m < T; m += NGW) { f32x4 v[4]; float mean, rstd; row_stats(Y1 + (size_t)m * D, lane, v, mean, rstd);
        f32x4* of = (f32x4*)(X1f + (size_t)m * D) + lane; u32x2* ob = (u32x2*)(X1b + (size_t)m * D) + lane;
#pragma unroll
        for (int j = 0; j < 4; ++j) { const f32x4 y = (v[j] - mean) * rstd * gv[j] + bv[j]; of[64 * j] = y; ob[64 * j] = (u32x2){pg8::pk2(y[0], y[1]), pg8::pk2(y[2], y[3])}; } }
}

constexpr int MA_KRS = 272, MA_VRS = 528;
constexpr int MA_K = 0, MA_V = 256 * MA_KRS, MA_END = MA_V + 128 * MA_VRS;
static_assert(MA_END <= SCR_BYTES, "mem-attn LDS");
DI void memattn_phase(Frame& F) {
    LAS unsigned char* lds = F.lds; unsigned char* ws = F.ws;
    const int tid = F.tid, lane = F.lane, w = F.wave, r = lane & 15, q = lane >> 4;
    const bf16* Qm = (const bf16*)(ws + WS_QM); const bf16* KV = (const bf16*)(ws + WS_KVM); bf16* Om = (bf16*)(ws + WS_OM);
    for (int su = F.vcu; su < NBATCH * 4 * 8; su += F.G) {
        const int qc = su & 7, h = (su >> 3) & 3, b = su >> 5;
#pragma unroll
        for (int it = 0; it < 8; ++it) { const int id = tid + 512 * it;
            { const int s = id >> 4, ch = id & 15; *(LAS u32x4*)(lds + MA_K + s * MA_KRS + ch * 16) = *(const u32x4*)(KV + (size_t)(b * MEMLEN + s) * D + h * 128 + 8 * ch); }
            { const int ch = id >> 8, s = id & 255; const u32x4 raw = *(const u32x4*)(KV + (size_t)(b * MEMLEN + s) * D + MEMW + h * 128 + 8 * ch);
              LAS unsigned short* vt = (LAS unsigned short*)(lds + MA_V + (8 * ch) * MA_VRS + s * 2);
              vt[0 * (MA_VRS / 2)] = (unsigned short)(raw.x & 0xffffu); vt[1 * (MA_VRS / 2)] = (unsigned short)(raw.x >> 16); vt[2 * (MA_VRS / 2)] = (unsigned short)(raw.y & 0xffffu); vt[3 * (MA_VRS / 2)] = (unsigned short)(raw.y >> 16);
              vt[4 * (MA_VRS / 2)] = (unsigned short)(raw.z & 0xffffu); vt[5 * (MA_VRS / 2)] = (unsigned short)(raw.z >> 16); vt[6 * (MA_VRS / 2)] = (unsigned short)(raw.w & 0xffffu); vt[7 * (MA_VRS / 2)] = (unsigned short)(raw.w >> 16); } }
        __syncthreads();
        for (int c = 0; c < 2; ++c) {
            const size_t trow = (size_t)b * SEQ + 256 * qc + 128 * c + 16 * w + r;
            bf16x8 qf[4];
#pragma unroll
            for (int kk = 0; kk < 4; ++kk) qf[kk] = *(const bf16x8*)(Qm + trow * MEMW + h * 128 + 32 * kk + 8 * q);
            f32x4 z[16];
#pragma unroll
            for (int st = 0; st < 16; ++st) { z[st] = (f32x4){0.f, 0.f, 0.f, 0.f};
#pragma unroll
                for (int kk = 0; kk < 4; ++kk) { const bf16x8 kf = *(const LAS bf16x8*)(lds + MA_K + (16 * st + r) * MA_KRS + (32 * kk + 8 * q) * 2);
                    z[st] = __builtin_amdgcn_mfma_f32_16x16x32_bf16(kf, qf[kk], z[st], 0, 0, 0); }
                if (st & 1) __builtin_amdgcn_sched_barrier(0); }
            float mx = -1e30f;
#pragma unroll
            for (int st = 0; st < 16; ++st) mx = fmaxf(mx, fmaxf(fmaxf(z[st][0], z[st][1]), fmaxf(z[st][2], z[st][3])));
            mx = fmaxf(mx, __shfl_xor(mx, 16)); mx = fmaxf(mx, __shfl_xor(mx, 32));
            float sum = 0.f;
#pragma unroll
            for (int st = 0; st < 16; ++st)
#pragma unroll
                for (int e = 0; e < 4; ++e) { const float pp = fast_exp2((z[st][e] - mx) * LOG2E); z[st][e] = pp; sum += pp; }
            sum += __shfl_xor(sum, 16); sum += __shfl_xor(sum, 32);
            const float inv = 1.0f / sum;
            f32x4 o[8];
#pragma unroll
            for (int dt = 0; dt < 8; ++dt) o[dt] = (f32x4){0.f, 0.f, 0.f, 0.f};
#pragma unroll
            for (int p = 0; p < 8; ++p) { const bf16x8 pf = mk_frag(z[2 * p], z[2 * p + 1]);
#pragma unroll
                for (int dt = 0; dt < 8; ++dt) { const bf16x8 vf = ld_split8(lds + MA_V + (16 * dt + r) * MA_VRS + (32 * p + 4 * q) * 2);
                    o[dt] = __builtin_amdgcn_mfma_f32_16x16x32_bf16(vf, pf, o[dt], 0, 0, 0); }
                __builtin_amdgcn_sched_barrier(0); }
#pragma unroll
            for (int dt = 0; dt < 8; ++dt) { const f32x4 v = o[dt] * inv;
                *(u32x2*)(Om + trow * MEMW + h * 128 + 16 * dt + 4 * q) = (u32x2){pg8::pk2(v[0], v[1]), pg8::pk2(v[2], v[3])}; }
        }
        __syncthreads();
    }
}

constexpr int RT_XRS = 2064;
constexpr int RT_XH = 0, RT_XL = 16 * RT_XRS, RT_PART = 2 * 16 * RT_XRS, RT_SC = RT_PART + 8 * 16 * 64 * 4, RT_SEL = RT_SC + 16 * 64 * 4, RT_HIST = RT_SEL + 16 * 64 * 4, RT_END = RT_HIST + 256;
static_assert(RT_END <= SCR_BYTES, "router LDS");
DI float grp8_max(float v) { v = fmaxf(v, __shfl_xor(v, 1)); v = fmaxf(v, __shfl_xor(v, 2)); v = fmaxf(v, __shfl_xor(v, 4)); return v; }
DI float rdlane(float v, int l) { return __uint_as_float(__builtin_amdgcn_readlane(__float_as_uint(v), l)); }
DI void route_phase(Frame& F, const float* const* in, unsigned* gcount) {
    LAS unsigned char* lds = F.lds; unsigned char* ws = F.ws;
    const int tid = F.tid, lane = F.lane, w = F.wave, r = lane & 15, q = lane >> 4;
    const float* Y2 = F.out; bf16* X2b = (bf16*)(ws + WS_X2B);
    const bf16* WRH = (const bf16*)(ws + WS_WRHI); const bf16* WRL = (const bf16*)(ws + WS_WRLO);
    unsigned* TK = (unsigned*)(ws + WS_TK); float* TKW = (float*)(ws + WS_TKW); unsigned* WGB = (unsigned*)(ws + WS_WGBASE);
    LAS unsigned* HIST = (LAS unsigned*)(lds + RT_HIST);
    if (tid < 64) HIST[tid] = 0u;
    const float rb = in[19][lane];
    f32x4 gv[4], bv[4];
#pragma unroll
    for (int j = 0; j < 4; ++j) { gv[j] = ((const f32x4*)in[16])[lane + 64 * j]; bv[j] = ((const f32x4*)in[17])[lane + 64 * j]; }
    bf16x8 bh[4][4], bl[4][4];
#pragma unroll
    for (int kk = 0; kk < 4; ++kk)
#pragma unroll
        for (int nt = 0; nt < 4; ++nt) { const size_t o = (size_t)(16 * nt + r) * D + 128 * w + 32 * kk + 8 * q; bh[kk][nt] = *(const bf16x8*)(WRH + o); bl[kk][nt] = *(const bf16x8*)(WRL + o); }
    f32x4 va[4], vb[4];
    { const int tl0 = F.vcu; if (tl0 < T / 16) {
#pragma unroll
        for (int j = 0; j < 4; ++j) { va[j] = ((const f32x4*)(Y2 + ((size_t)16 * tl0 + 2 * w) * D))[lane + 64 * j]; vb[j] = ((const f32x4*)(Y2 + ((size_t)16 * tl0 + 2 * w + 1) * D))[lane + 64 * j]; } } }
    __syncthreads();
    for (int tl = F.vcu; tl < T / 16; tl += F.G) {
#pragma unroll
        for (int rr = 0; rr < 2; ++rr) { const int lr = 2 * w + rr; const size_t m = (size_t)16 * tl + lr;
            f32x4 v[4]; float s = 0.f;
#pragma unroll
            for (int j = 0; j < 4; ++j) { v[j] = rr ? vb[j] : va[j]; s += (v[j][0] + v[j][1]) + (v[j][2] + v[j][3]); }
            const float mean = wave_sum(s) * (1.f / D); float s2 = 0.f;
#pragma unroll
            for (int j = 0; j < 4; ++j) { const f32x4 d = v[j] - mean; s2 += (d[0] * d[0] + d[1] * d[1]) + (d[2] * d[2] + d[3] * d[3]); }
            const float rstd = 1.f / sqrtf(wave_sum(s2) * (1.f / D) + LN_EPS);
            u32x2* ob = (u32x2*)(X2b + m * D) + lane;
#pragma unroll
            for (int j = 0; j < 4; ++j) { const f32x4 y = (v[j] - mean) * rstd * gv[j] + bv[j];
                const u32x2 hi = (u32x2){pg8::pk2(y[0], y[1]), pg8::pk2(y[2], y[3])}; ob[64 * j] = hi;
                const f32x4 rs = (f32x4){y[0] - bflo(hi.x), y[1] - bfhi(hi.x), y[2] - bflo(hi.y), y[3] - bfhi(hi.y)};
                *(LAS u32x2*)(lds + RT_XH + lr * RT_XRS + (4 * lane + 256 * j) * 2) = hi;
                *(LAS u32x2*)(lds + RT_XL + lr * RT_XRS + (4 * lane + 256 * j) * 2) = (u32x2){pg8::pk2(rs[0], rs[1]), pg8::pk2(rs[2], rs[3])}; } }
        { const int tn = tl + F.G; if (tn < T / 16) {
#pragma unroll
            for (int j = 0; j < 4; ++j) { va[j] = ((const f32x4*)(Y2 + ((size_t)16 * tn + 2 * w) * D))[lane + 64 * j]; vb[j] = ((const f32x4*)(Y2 + ((size_t)16 * tn + 2 * w + 1) * D))[lane + 64 * j]; } } }
        __syncthreads();
        { f32x4 acc[4];
#pragma unroll
          for (int nt = 0; nt < 4; ++nt) acc[nt] = (f32x4){0.f, 0.f, 0.f, 0.f};
#pragma unroll
          for (int kk = 0; kk < 4; ++kk) { const int k0 = 128 * w + 32 * kk + 8 * q;
              const bf16x8 ah = *(const LAS bf16x8*)(lds + RT_XH + r * RT_XRS + k0 * 2), al = *(const LAS bf16x8*)(lds + RT_XL + r * RT_XRS + k0 * 2);
#pragma unroll
              for (int nt = 0; nt < 4; ++nt) {
                  acc[nt] = __builtin_amdgcn_mfma_f32_16x16x32_bf16(ah, bh[kk][nt], acc[nt], 0, 0, 0);
                  acc[nt] = __builtin_amdgcn_mfma_f32_16x16x32_bf16(al, bh[kk][nt], acc[nt], 0, 0, 0);
                  acc[nt] = __builtin_amdgcn_mfma_f32_16x16x32_bf16(ah, bl[kk][nt], acc[nt], 0, 0, 0); } }
#pragma unroll
          for (int nt = 0; nt < 4; ++nt)
#pragma unroll
              for (int e = 0; e < 4; ++e) *(LAS float*)(lds + RT_PART + ((w * 16 + 4 * q + e) * 64 + 16 * nt + r) * 4) = acc[nt][e]; }
        __syncthreads();
#pragma unroll
        for (int rr = 0; rr < 2; ++rr) { const int lt = 2 * w + rr; const size_t tok = (size_t)16 * tl + lt;
            float lg = 0.f;
#pragma unroll
            for (int k = 0; k < 8; ++k) lg += *(const LAS float*)(lds + RT_PART + ((k * 16 + lt) * 64 + lane) * 4);
            const float sc = 1.0f / (1.0f + __expf(-lg)); const float sel = sc + rb;
            const int g = lane >> 3;
            const float m1 = grp8_max(sel);
            const unsigned long long bal = __ballot(sel == m1);
            const unsigned gb = (unsigned)(bal >> (8 * g)) & 0xffu; const int first = 8 * g + __builtin_ctz(gb);
            const float m2 = grp8_max(lane == first ? -1e30f : sel);
            const float gs = m1 + m2;
            int grank = 0;
#pragma unroll
            for (int g2 = 0; g2 < 8; ++g2) { const float v = rdlane(gs, 8 * g2); grank += ((v > gs) || (v == gs && g2 < g)) ? 1 : 0; }
            const float val = (grank < 4) ? sel : -1e30f;
            int rank = 0;
#pragma unroll
            for (int e2 = 0; e2 < 64; ++e2) { const float v = rdlane(val, e2); rank += ((v > val) || (v == val && e2 < lane)) ? 1 : 0; }
            const bool chosen = rank < 8;
            const unsigned long long cm = __ballot(chosen);
            const float wsum = wave_sum(chosen ? sc : 0.f);
            if (chosen) { const int kidx = __builtin_popcountll(cm & ((1ull << lane) - 1ull));
                const unsigned lrk = __hip_atomic_fetch_add(&HIST[lane], 1u, __ATOMIC_RELAXED, __HIP_MEMORY_SCOPE_WORKGROUP);
                TK[tok * 8 + kidx] = (unsigned)lane | (lrk << 8); TKW[tok * 8 + kidx] = sc * (ROUTED_SCALE / wsum); }
        }
        __syncthreads();
    }
    if (tid < 64) { const unsigned cnt = HIST[tid]; const unsigned base = __hip_atomic_fetch_add(gcount + tid, cnt, RLX_AGENT); WGB[F.vcu * 64 + tid] = base; }
}

DI void slots_phase(Frame& F) {
    LAS unsigned char* lds = F.lds; unsigned char* ws = F.ws; const int tid = F.tid;
    LAS unsigned* CNT = (LAS unsigned*)lds; LAS unsigned* PS = CNT + 64;
    int* ROWTOK = (int*)(ws + WS_ROWTOK); float* ROWW = (float*)(ws + WS_ROWW); unsigned* SLOT = (unsigned*)(ws + WS_SLOT);
    const unsigned* TK = (const unsigned*)(ws + WS_TK); const float* TKW = (const float*)(ws + WS_TKW); const unsigned* WGB = (const unsigned*)(ws + WS_WGBASE);
    if (tid < 64) CNT[tid] = __hip_atomic_load(F.ctl + CW_GCOUNT + tid, RLX_AGENT);
    __syncthreads();
    if (tid == 0) { unsigned run = 0u; for (int e = 0; e < 64; ++e) { PS[e] = run; run += (CNT[e] + 255u) & ~255u; } PS[64] = run; }
    __syncthreads();
    const unsigned nblk = PS[64] >> 8;
    if (F.vcu == 0) {
        if (tid == 0) { __hip_atomic_store(F.ctl + CW_HDR, nblk, RLX_AGENT); __hip_atomic_store(F.ctl + CW_HDR + 1, (nblk + 1u) >> 1, RLX_AGENT); }
        for (unsigned bl = tid; bl < nblk; bl += NTHREADS) { unsigned e = 0; for (int k = 1; k < 64; ++k) e += (PS[k] <= bl * 256u) ? 1u : 0u; __hip_atomic_store(F.ctl + CW_BLKE + bl, e, RLX_AGENT); }
    }
    for (int e = F.vcu; e < 64; e += F.G) { const unsigned lo = PS[e] + CNT[e], hi = PS[e + 1]; for (unsigned s = lo + tid; s < hi; s += NTHREADS) { ROWTOK[s] = 0; ROWW[s] = 0.f; } }
    for (int tl = F.vcu; tl < T / 16; tl += F.G) {
        if (tid < 128) { const size_t a = (size_t)16 * 8 * tl + tid; const unsigned pk = TK[a], e = pk & 0xffu, lrk = pk >> 8;
            const unsigned slot = PS[e] + WGB[F.vcu * 64 + e] + lrk; ROWTOK[slot] = (int)(a >> 3); ROWW[slot] = TKW[a]; SLOT[a] = slot; }
    }
}

template <bool FINAL> DI void combine_phase(Frame& F, const float* const* in) {
    const int gw = F.vcu * NWAVES + F.wave, NGW = F.G * NWAVES, lane = F.lane;
    const unsigned split = __builtin_amdgcn_readfirstlane(__hip_atomic_load(F.ctl + CW_HDR + 1, RLX_AGENT)) * 256u;
    const unsigned* SLOT = (const unsigned*)(F.ws + WS_SLOT); const bf16* Y = (const bf16*)(F.ws + WS_YH); float* base = F.out;
    f32x4 gv[4], bv[4];
    if (FINAL) {
#pragma unroll
        for (int j = 0; j < 4; ++j) { gv[j] = ((const f32x4*)in[26])[lane + 64 * j]; bv[j] = ((const f32x4*)in[27])[lane + 64 * j]; } }
    for (int m = gw; m < T; m += NGW) {
        f32x4* br = (f32x4*)(base + (size_t)m * D) + lane; f32x4 v[4];
#pragma unroll
        for (int j = 0; j < 4; ++j) v[j] = br[64 * j];
#pragma unroll
        for (int k = 0; k < 8; ++k) { const unsigned slot = __builtin_amdgcn_readfirstlane(__hip_atomic_load(SLOT + (size_t)m * 8 + k, RLX_AGENT));
            const bool mine = FINAL ? (slot >= split) : (slot < split);
            if (mine) { const u32x2* yr = (const u32x2*)(Y + (size_t)(FINAL ? slot - split : slot) * D) + lane;
#pragma unroll
                for (int j = 0; j < 4; ++j) { const u32x2 y = yr[64 * j]; v[j] += (f32x4){bflo(y.x), bfhi(y.x), bflo(y.y), bfhi(y.y)}; } } }
        if (FINAL) { float s = 0.f;
#pragma unroll
            for (int j = 0; j < 4; ++j) s += (v[j][0] + v[j][1]) + (v[j][2] + v[j][3]);
            const float mean = wave_sum(s) * (1.f / D); float s2 = 0.f;
#pragma unroll
            for (int j = 0; j < 4; ++j) { const f32x4 d = v[j] - mean; s2 += (d[0] * d[0] + d[1] * d[1]) + (d[2] * d[2] + d[3] * d[3]); }
            const float rstd = 1.f / sqrtf(wave_sum(s2) * (1.f / D) + LN_EPS);
#pragma unroll
            for (int j = 0; j < 4; ++j) br[64 * j] = (v[j] - mean) * rstd * gv[j] + bv[j];
        } else {
#pragma unroll
            for (int j = 0; j < 4; ++j) br[64 * j] = v[j]; }
    }
}

constexpr int NPHASE = 15;
constexpr int N_LAUNCHES = MK_N_LAUNCHES;
static_assert(N_LAUNCHES == 1 || N_LAUNCHES == NPHASE, "MK_N_LAUNCHES: 1 (one dispatch) or 15 (one dispatch per phase)");
struct Args { const float* in[28]; float* out; unsigned char* ws; int ph_lo, ph_hi; };
static_assert(sizeof(Args) == 28 * 8 + 8 + 8 + 8, "Args has no padding");

__global__ void __launch_bounds__(NTHREADS, 2) fwd_kernel(Args args) {
    extern __shared__ __attribute__((aligned(16))) unsigned char lds_raw[];
    Frame F;
    F.lds = (LAS unsigned char*)lds_raw;
    volatile LAS unsigned* MISC = (volatile LAS unsigned*)(F.lds + MISC_OFF);
    F.tid = threadIdx.x; F.lane = F.tid & 63; F.wave = __builtin_amdgcn_readfirstlane(F.tid >> 6);
    F.G = gridDim.x; { const int bx = blockIdx.x; F.vcu = (F.G % 8 == 0) ? (bx % 8) * (F.G / 8) + bx / 8 : bx; }
    F.ws = args.ws; F.ctl = (unsigned*)(args.ws + WS_CTL); F.out = args.out;
    unsigned char* ws = args.ws;
    for (int u = F.tid; u < (LDS_BYTES - MISC_OFF) / 4; u += NTHREADS) ((LAS unsigned*)(F.lds + MISC_OFF))[u] = 0u;
    __syncthreads();
    XcdBarrier bar; bar.bar = F.ctl + CW_BAR; bar.x = 0; bar.st = nullptr;
    if (N_LAUNCHES == 1) bar = xcd_barrier_post(F.ctl + CW_BAR, MISC + 8);
#define GRID_BAR() do { if (N_LAUNCHES == 1) xcd_barrier(bar); } while (0)
    const int lo = args.ph_lo, hi = args.ph_hi;
#ifndef PHASE_MASK
#define PHASE_MASK 0x7fff
#endif
#define IN(k) (((PHASE_MASK >> (k)) & 1) && lo <= (k) && (k) < hi)
#ifndef REPEAT_MASK
#define REPEAT_MASK 0
#endif
#define REP(k) (((REPEAT_MASK >> (k)) & 1) ? 2 : 1)
#define SEAM(k) do { if (IN(k) && IN((k) + 1)) GRID_BAR(); } while (0)
    const float* const* in = args.in;

    for (int rep_ = 0; rep_ < (IN(0) ? REP(0) : 0); ++rep_) { if (rep_) GRID_BAR(); p0_prologue(F, in); SEAM(0); }
    for (int rep_ = 0; rep_ < (IN(1) ? REP(1) : 0); ++rep_) { if (rep_) GRID_BAR();
        pg8::DenseOrder S; S.init((const bf16*)F.out, (const bf16*)(ws + WS_WIN), T, INW, D, F.G, (int)blockIdx.x);
        pg8::EpiInProj E{(bf16*)(ws + WS_P1), (float*)(ws + WS_VSTAT), (const float*)(ws + WS_BPERM)};
        pg8::gemm_phase<pg8::EpiInProj, pg8::DenseOrder, true>(F.lds, D, S, E);
        SEAM(1);
    }
    for (int rep_ = 0; rep_ < (IN(2) ? REP(2) : 0); ++rep_) { if (rep_) GRID_BAR(); mix_phase(F, in); SEAM(2); }
    for (int rep_ = 0; rep_ < (IN(3) ? REP(3) : 0); ++rep_) { if (rep_) GRID_BAR();
        pg8::DenseOrder S; S.init((const bf16*)(ws + WS_MERGED), (const bf16*)(ws + WS_WOUT), T, D, D, F.G, (int)blockIdx.x);
        pg8::EpiResF32<true> E{(float*)(ws + WS_Y1), in[0], (const float*)(ws + WS_XSTAT), in[2], in[3]};
        pg8::gemm_phase<pg8::EpiResF32<true>, pg8::DenseOrder, false>(F.lds, D, S, E);
        SEAM(3);
    }
    for (int rep_ = 0; rep_ < (IN(4) ? REP(4) : 0); ++rep_) { if (rep_) GRID_BAR(); ln1_phase(F, in); SEAM(4); }
    for (int rep_ = 0; rep_ < (IN(5) ? REP(5) : 0); ++rep_) { if (rep_) GRID_BAR();
        expert_convert(F, in);
        __syncthreads();
        { pg8::DenseOrder S; S.init((const bf16*)(ws + WS_X1B), (const bf16*)(ws + WS_WQ), T, MEMW, D, F.G, (int)blockIdx.x);
          pg8::EpiBf16S E{(bf16*)(ws + WS_QM), MEMW, QSCALE};
          pg8::gemm_phase<pg8::EpiBf16S, pg8::DenseOrder, false>(F.lds, D, S, E); }
        { const int c2 = ((int)blockIdx.x + F.G - 128 % F.G) % F.G;
          pg8::DenseOrder S; S.init((const bf16*)(ws + WS_MEMB), (const bf16*)(ws + WS_WKV), NBATCH * MEMLEN, 2 * MEMW, D, F.G, c2);
          pg8::EpiBf16S E{(bf16*)(ws + WS_KVM), 2 * MEMW, 1.0f};
          pg8::gemm_phase<pg8::EpiBf16S, pg8::DenseOrder, false>(F.lds, D, S, E); }
        SEAM(5);
    }
    for (int rep_ = 0; rep_ < (IN(6) ? REP(6) : 0); ++rep_) { if (rep_) GRID_BAR(); memattn_phase(F); SEAM(6); }
    for (int rep_ = 0; rep_ < (IN(7) ? REP(7) : 0); ++rep_) { if (rep_) GRID_BAR();
        pg8::DenseOrder S; S.init((const bf16*)(ws + WS_OM), (const bf16*)(ws + WS_WO), T, D, MEMW, F.G, (int)blockIdx.x);
        pg8::EpiResF32<false> E{F.out, (const float*)(ws + WS_X1F), nullptr, nullptr, nullptr};
        pg8::gemm_phase<pg8::EpiResF32<false>, pg8::DenseOrder, false>(F.lds, MEMW, S, E);
        SEAM(7);
    }
    for (int rep_ = 0; rep_ < (IN(8) ? REP(8) : 0); ++rep_) { if (rep_) GRID_BAR(); route_phase(F, in, F.ctl + ((rep_ + 1 < REP(8)) ? 2048 : CW_GCOUNT)); SEAM(8); }
    for (int rep_ = 0; rep_ < (IN(9) ? REP(9) : 0); ++rep_) { if (rep_) GRID_BAR(); slots_phase(F); SEAM(9); }
    for (int rep_ = 0; rep_ < (IN(10) ? REP(10) : 0); ++rep_) { if (rep_) GRID_BAR();
        const int nblk = (int)__builtin_amdgcn_readfirstlane(__hip_atomic_load(F.ctl + CW_HDR, RLX_AGENT));
        pg8::GateUpOrder S{(const char*)(ws + WS_X2B), (const char*)(ws + WS_WGU), (const char*)(ws + WS_WGUS), (const int*)(ws + WS_ROWTOK), F.ctl + CW_BLKE, nblk, F.G, F.vcu};
        pg8::EpiGateUp E{(bf16*)(ws + WS_H)};
        pg8::gemm_phase<pg8::EpiGateUp, pg8::GateUpOrder, true>(F.lds, D, S, E);
        SEAM(10);
    }
    for (int rep_ = 0; rep_ < (IN(11) ? REP(11) : 0); ++rep_) { if (rep_) GRID_BAR();
        const int split = (int)__builtin_amdgcn_readfirstlane(__hip_atomic_load(F.ctl + CW_HDR + 1, RLX_AGENT));
        pg8::DownOrder S{(const char*)(ws + WS_H), (const char*)(ws + WS_WD), (const char*)(ws + WS_WDS), F.ctl + CW_BLKE, 0, split, 64, F.G, F.vcu};
        pg8::EpiDown E{(bf16*)(ws + WS_YH), (const float*)(ws + WS_ROWW), 0, F.out, (const bf16*)(ws + WS_X2B)};
        pg8::gemm_phase<pg8::EpiDown, pg8::DownOrder, true>(F.lds, EH, S, E);
        SEAM(11);
    }
    if (IN(12)) { combine_phase<false>(F, in); SEAM(12); }
    for (int rep_ = 0; rep_ < (IN(13) ? REP(13) : 0); ++rep_) { if (rep_) GRID_BAR();
        const int nblk = (int)__builtin_amdgcn_readfirstlane(__hip_atomic_load(F.ctl + CW_HDR, RLX_AGENT));
        const int split = (int)__builtin_amdgcn_readfirstlane(__hip_atomic_load(F.ctl + CW_HDR + 1, RLX_AGENT));
        pg8::DownOrder S{(const char*)(ws + WS_H), (const char*)(ws + WS_WD), (const char*)(ws + WS_WDS), F.ctl + CW_BLKE, split, nblk, 0, F.G, F.vcu};
        pg8::EpiDown E{(bf16*)(ws + WS_YH), (const float*)(ws + WS_ROWW), split, F.out, (const bf16*)(ws + WS_X2B)};
        pg8::gemm_phase<pg8::EpiDown, pg8::DownOrder, true>(F.lds, EH, S, E);
        SEAM(13);
    }
    if (IN(14)) { combine_phase<true>(F, in); }
#undef IN
#undef SEAM
#undef GRID_BAR
}

extern "C" void kernel_launch(void* const* d_in, const int* in_sizes, int n_in, void* d_out, int out_size, void* d_ws, size_t ws_size, hipStream_t stream) {
    static int grid = 0;
    if (grid == 0) {
        if (n_in != 28 || in_sizes[0] != T * D || out_size != T * D || ws_size < WS_END) { fprintf(stderr, "kernel_launch: unexpected shapes / workspace (n_in %d, ws %zu < %zu)\n", n_in, ws_size, (size_t)WS_END); grid = -1; return; }
        int dev = 0, cus = 0, per_cu = 0;
        if (hipGetDevice(&dev) != hipSuccess || hipDeviceGetAttribute(&cus, hipDeviceAttributeMultiprocessorCount, dev) != hipSuccess) { grid = -1; return; }
        if (hipFuncSetAttribute((const void*)fwd_kernel, hipFuncAttributeMaxDynamicSharedMemorySize, LDS_BYTES) != hipSuccess) { fprintf(stderr, "kernel_launch: hipFuncSetAttribute failed\n"); grid = -1; return; }
        if (hipOccupancyMaxActiveBlocksPerMultiprocessor(&per_cu, (const void*)fwd_kernel, NTHREADS, LDS_BYTES) != hipSuccess || per_cu < 1) { fprintf(stderr, "kernel_launch: occupancy query reports %d\n", per_cu); }
        (void)hipGetLastError();
        grid = cus;
    }
    if (grid < 0) return;
    if (hipMemsetAsync((char*)d_ws + WS_CTL, 0, CTL_ZERO_BYTES, stream) != hipSuccess) return;
    Args a{};
    for (int i = 0; i < 28; ++i) a.in[i] = (const float*)d_in[i];
    a.out = (float*)d_out; a.ws = (unsigned char*)d_ws;
    for (int li = 0; li < N_LAUNCHES; ++li) {
        a.ph_lo = (N_LAUNCHES == 1) ? 0 : li; a.ph_hi = (N_LAUNCHES == 1) ? NPHASE : li + 1;
        hipLaunchKernelGGL(fwd_kernel, dim3(grid), dim3(NTHREADS), LDS_BYTES, stream, a);
        if (hipPeekAtLastError() != hipSuccess) { fprintf(stderr, "kernel_launch: launch %d failed\n", li); break; }
    }
}
```

```cpp
#include <hip/hip_runtime.h>
#include <cstdio>
#include <cstdint>

#ifndef MK_N_LAUNCHES
#define MK_N_LAUNCHES 1
#endif

#define GAS __attribute__((address_space(1)))
#define LAS __attribute__((address_space(3)))
typedef unsigned short bf16;
typedef short bf16x8 __attribute__((ext_vector_type(8)));
typedef short s16x4 __attribute__((ext_vector_type(4)));
typedef float f32x4 __attribute__((ext_vector_type(4)));
typedef float f32x2 __attribute__((ext_vector_type(2)));
typedef unsigned u32x4 __attribute__((ext_vector_type(4)));
typedef unsigned u32x2 __attribute__((ext_vector_type(2)));
#define RLX_AGENT __ATOMIC_RELAXED, __HIP_MEMORY_SCOPE_AGENT
#define DI __device__ __forceinline__

constexpr int T = 16384, D = 1024, NBATCH = 8, SEQ = 2048, MEMLEN = 256, INW = 7168;
constexpr int NEXP = 64, TOPK = 8, EH = 256, MEMW = 512;
constexpr float LN_EPS = 1e-5f;
constexpr float ALPHA = 1.189207115002721f;
constexpr float QSCALE = 0.08838834764831845f;
constexpr float ROUTED_SCALE = 2.5f;
constexpr float LOG2E = 1.4426950408889634f, LN2 = 0.6931471805599453f;
constexpr float SB_EXIT = -30.0f;
constexpr int NWAVES = 8, NTHREADS = 512;
constexpr int MAXBLK = 576;
constexpr int SH_ROW0 = MAXBLK * 256;

constexpr size_t MiB = 1u << 20;
constexpr size_t WS_CTL = 0, CTL_ZERO_BYTES = 1 * MiB;
constexpr size_t WS_WRHI = 1 * MiB, WS_WRLO = WS_WRHI + 128 * 1024, WS_WSP = WS_WRLO + 128 * 1024, WS_BPERM = WS_WSP + 256 * 1024, WS_XSTAT = WS_BPERM + 32 * 1024;
constexpr size_t WS_ROWTOK = 2 * MiB, WS_ROWW = WS_ROWTOK + 576 * 1024, WS_SLOT = WS_ROWW + 576 * 1024;
constexpr size_t WS_WIN = 4 * MiB, WS_WOUT = 18 * MiB, WS_WQ = 20 * MiB, WS_WKV = 21 * MiB, WS_WO = 23 * MiB, WS_MEMB = 24 * MiB;
constexpr size_t WS_P1 = 29 * MiB;
constexpr size_t WS_UG = WS_P1, WS_VA = WS_P1 + 32 * MiB, WS_Q = WS_P1 + 64 * MiB, WS_K = WS_P1 + 96 * MiB, WS_V = WS_P1 + 128 * MiB, WS_GB = WS_P1 + 160 * MiB;
constexpr size_t WS_VSTAT = 221 * MiB;
constexpr size_t WS_MERGED = 228 * MiB;
constexpr size_t WS_Y1 = 29 * MiB;
constexpr size_t WS_X1F = 93 * MiB, WS_X1B = 157 * MiB;
constexpr size_t WS_QM = 189 * MiB, WS_KVM = 205 * MiB, WS_OM = 209 * MiB;
constexpr size_t WS_WGU = 29 * MiB;
constexpr size_t WS_H = 148 * MiB;
constexpr size_t WS_X2B = 228 * MiB;
constexpr size_t WS_WD = 260 * MiB;
constexpr size_t WS_WGUS = 293 * MiB, WS_WDS = 294 * MiB;
constexpr size_t WS_TK = 295 * MiB, WS_TKW = WS_TK + 512 * 1024, WS_WGBASE = WS_TKW + 512 * 1024;
constexpr size_t WS_YH = 4 * MiB;
constexpr size_t WS_END = 297 * MiB;
static_assert(WS_XSTAT + (size_t)T * 8 <= WS_ROWTOK && WS_SLOT + (size_t)T * 8 * 4 <= WS_WIN && WS_MEMB + 4 * MiB <= WS_P1, "ws map 1");
static_assert(WS_GB + 32 * MiB <= WS_VSTAT && WS_VSTAT + 2 * MiB <= WS_MERGED && WS_H + (size_t)(SH_ROW0 + T) * 512 <= WS_X2B && WS_X2B + 32 * MiB <= WS_WD, "ws map 2");
static_assert(WS_WD + (size_t)64 * 1024 * 256 * 2 <= WS_WGUS && WS_YH + (size_t)288 * 256 * 2048 <= WS_H && WS_WGBASE + 256 * 64 * 4 <= WS_END, "ws map 3");
constexpr int CW_TMO = 0, CW_CODE = 1;
constexpr int CW_GCOUNT = 64;
constexpr int CW_HDR = 192;
constexpr int CW_BLKE = 256;
constexpr int CW_BAR = 4096;

constexpr int SCR_BYTES = 140 * 1024;
constexpr int MISC_OFF = SCR_BYTES;
constexpr int LDS_BYTES = 144 * 1024;

DI unsigned cvt_pk_bf16(float lo, float hi) { unsigned r; asm volatile("v_cvt_pk_bf16_f32 %0, %1, %2" : "=v"(r) : "v"(lo), "v"(hi)); return r; }
DI float bf2f(unsigned short h) { return __uint_as_float((unsigned)h << 16); }
DI float bflo(unsigned w) { return __uint_as_float(w << 16); }
DI float bfhi(unsigned w) { return __uint_as_float(w & 0xffff0000u); }
DI float fast_exp2(float x) { return __builtin_amdgcn_exp2f(x); }
DI float fast_log2(float x) { return __builtin_amdgcn_logf(x); }
DI float fast_rcp(float x) { return __builtin_amdgcn_rcpf(x); }
DI float sigmoidf_(float x) { return fast_rcp(1.0f + fast_exp2(-x * LOG2E)); }
DI float wave_sum(float v) {
#pragma unroll
    for (int o = 1; o < 64; o <<= 1) v += __shfl_xor(v, o);
    return v;
}
DI float wave_max(float v) {
#pragma unroll
    for (int o = 1; o < 64; o <<= 1) v = fmaxf(v, __shfl_xor(v, o));
    return v;
}
#define LDS_WAIT() asm volatile("s_waitcnt lgkmcnt(0)" ::: "memory")
#define VM_WAIT() asm volatile("s_waitcnt vmcnt(0)" ::: "memory")

namespace pg8 {
constexpr int BM = 256, BK = 64, HALF = 128, HTB = HALF * BK * 2, STAGE_BYTES = 8 * HTB, NXCD = 8, WGM = 8;
__host__ __device__ __forceinline__ int lds_byte(int r, int c) { const int st = (r >> 4) * 2 + (c >> 5), rr = r & 15, cc = c & 31, ob = rr * 64 + cc * 2; return st * 1024 + (ob ^ (((ob >> 9) & 1) << 5)); }
__host__ __device__ __forceinline__ void stage_rc(int b, int& R, int& C) { const int st = b / 1024, sb = b % 1024, swz = sb ^ (((sb >> 9) & 1) << 5); R = (st >> 1) * 16 + swz / 64; C = (st & 1) * 32 + (swz % 64) / 2; }
__host__ __device__ __forceinline__ int perm32(int rho) { const int n = rho >> 4, i = rho & 15; return 8 * (i >> 2) + 4 * n + (i & 3); }

struct Unit { int pm, pn, e; const char* A; const char* B; };

typedef float f32x2v __attribute__((ext_vector_type(2)));
DI f32x2v gelu_pk(f32x2v v) {
    const f32x2v av = __builtin_elementwise_abs(v), d = av * 0.2316418882f + 1.0f;
    f32x2v t; t.x = __builtin_amdgcn_rcpf(d.x); t.y = __builtin_amdgcn_rcpf(d.y);
    f32x2v q = t * 0.5307027145f + (-0.7265760135f); q = q * t + 0.7107068705f; q = q * t + (-0.142248368f); q = q * t + 0.127414796f; q = q * t;
    const f32x2v s = (v * v) * (-0.72134752044f);
    f32x2v e; e.x = __builtin_amdgcn_exp2f(s.x); e.y = __builtin_amdgcn_exp2f(s.y);
    const f32x2v m = v * (q * e), r = v - m;
    f32x2v o; o.x = v.x < 0.f ? m.x : r.x; o.y = v.y < 0.f ? m.y : r.y; return o;
}
DI f32x4 gelu4(f32x4 v) { const f32x2v a = gelu_pk((f32x2v){v[0], v[1]}), b = gelu_pk((f32x2v){v[2], v[3]}); return (f32x4){a.x, a.y, b.x, b.y}; }
DI f32x4 sigmoid4(f32x4 v) { return (f32x4){sigmoidf_(v[0]), sigmoidf_(v[1]), sigmoidf_(v[2]), sigmoidf_(v[3])}; }
DI u32x4 pack8(f32x4 v0, f32x4 v1) { u32x4 w; w.x = cvt_pk_bf16(v0[0], v0[1]); w.y = cvt_pk_bf16(v0[2], v0[3]); w.z = cvt_pk_bf16(v1[0], v1[1]); w.w = cvt_pk_bf16(v1[2], v1[3]); return w; }

template <class Epi, class Sched, bool ALIGN_EPI>
DI void gemm_phase(LAS unsigned char* lds, const int K, const Sched& S, const Epi& E) {
    const int tid = threadIdx.x, wid = __builtin_amdgcn_readfirstlane(tid >> 6), lane = tid & 63, wr = wid >> 2, wc = wid & 3, fr = lane & 15, fq = lane >> 4;
    const int nt = K / BK;
    int Rr[2], Cc[2]; unsigned voffB[2];
#pragma unroll
    for (int i = 0; i < 2; ++i) { int R, C; stage_rc(tid * 16 + i * 8192, R, C); const int Rb = Epi::PERM ? ((R & ~31) + perm32(R & 31)) : R; Rr[i] = R; Cc[i] = C; voffB[i] = (unsigned)(Rb * K + C) * 2u; }
    const size_t kstep = (size_t)(BK * 2);
    const size_t hstep = (size_t)HALF * K * 2;
    const unsigned ldsw = (unsigned)wid * 1024u;
    const int aoff = lds_byte(wr * 64 + fr, fq * 8), boff = lds_byte(wc * 32 + fr, fq * 8);
#define PG8_SA(b, h) (((b) * 2 + (h)) * HTB)
#define PG8_SB(b, h) ((4 + (b) * 2 + (h)) * HTB)
#define PG8_STAGE_B(bufoff, gbase) do { _Pragma("unroll") for (int _i = 0; _i < 2; ++_i) \
        __builtin_amdgcn_global_load_lds((const unsigned*)((const char*)(gbase) + voffB[_i]), (LAS unsigned*)(lds + (bufoff) + ldsw + _i * 8192), 16, 0, 0); } while (0)
#define PG8_STAGE_A(bufoff, gbase, o0, o1) do { \
        __builtin_amdgcn_global_load_lds((const unsigned*)((const char*)(gbase) + (o0)), (LAS unsigned*)(lds + (bufoff) + ldsw), 16, 0, 0); \
        __builtin_amdgcn_global_load_lds((const unsigned*)((const char*)(gbase) + (o1)), (LAS unsigned*)(lds + (bufoff) + ldsw + 8192), 16, 0, 0); } while (0)
#define PG8_LDA(dst, b, h) do { _Pragma("unroll") for (int m = 0; m < 4; ++m) _Pragma("unroll") for (int k = 0; k < 2; ++k) dst[m][k] = *(const LAS bf16x8*)(lds + PG8_SA(b, h) + aoff + m * 2048 + k * 1024); } while (0)
#define PG8_LDB(dst, b, h) do { _Pragma("unroll") for (int n = 0; n < 2; ++n) _Pragma("unroll") for (int k = 0; k < 2; ++k) dst[n][k] = *(const LAS bf16x8*)(lds + PG8_SB(b, h) + boff + n * 2048 + k * 1024); } while (0)
#define PG8_MMA(ai, bj, At, Bt) do { __builtin_amdgcn_s_setprio(1); _Pragma("unroll") for (int m = 0; m < 4; ++m) _Pragma("unroll") for (int n = 0; n < 2; ++n) _Pragma("unroll") for (int k = 0; k < 2; ++k) \
        acc[ai][bj][m][n] = __builtin_amdgcn_mfma_f32_16x16x32_bf16(Bt[n][k], At[m][k], acc[ai][bj][m][n], 0, 0, 0); __builtin_amdgcn_s_setprio(0); } while (0)
#define PG8_WAIT_V(n) asm volatile("s_waitcnt vmcnt(" #n ")" ::: "memory")
#define PG8_WAIT_L(n) asm volatile("s_waitcnt lgkmcnt(" #n ")" ::: "memory")
#define PG8_BAR __builtin_amdgcn_s_barrier()
#define PG8_SCHED __builtin_amdgcn_sched_barrier(0)
    Unit cur, nxt; int ui = 0;
    if (!S.next(0, cur)) return;
    unsigned oc[2][2], on[2][2];
    S.a_offs(cur, Rr, Cc, K, oc);
    f32x4 acc[2][2][4][2];
#pragma unroll
    for (int a = 0; a < 2; ++a)
#pragma unroll
        for (int b = 0; b < 2; ++b)
#pragma unroll
            for (int m = 0; m < 4; ++m)
#pragma unroll
                for (int n = 0; n < 2; ++n) acc[a][b][m][n] = (f32x4){0.f, 0.f, 0.f, 0.f};
    bf16x8 At[4][2], B0[2][2], B1[2][2];
    const char* cA = cur.A; const char* cB = cur.B;
    PG8_STAGE_B(PG8_SB(0, 0), cB); PG8_STAGE_B(PG8_SB(0, 1), cB + hstep); PG8_STAGE_A(PG8_SA(0, 0), cA, oc[0][0], oc[0][1]); PG8_STAGE_A(PG8_SA(0, 1), cA, oc[1][0], oc[1][1]);
    if (wr == 1) PG8_BAR;
    PG8_WAIT_V(2); PG8_BAR;
    PG8_STAGE_B(PG8_SB(1, 0), cB + kstep); PG8_STAGE_A(PG8_SA(1, 0), cA + kstep, oc[0][0], oc[0][1]); PG8_STAGE_B(PG8_SB(1, 1), cB + hstep + kstep);
    PG8_WAIT_V(6); PG8_BAR;
    for (;;) {
        const bool has_next = S.next(ui + 1, nxt);
        const char* nA = has_next ? nxt.A : cA; const char* nB = has_next ? nxt.B : cB;
        if (has_next) S.a_offs(nxt, Rr, Cc, K, on);
        else {
#pragma unroll
            for (int h = 0; h < 2; ++h)
#pragma unroll
                for (int i = 0; i < 2; ++i) on[h][i] = oc[h][i]; }
#pragma unroll 1
        for (int t = 0; t < nt; t += 2) {
            const bool last = (t == nt - 2);
            const char* a1 = cA + (size_t)(t + 1) * kstep;
            const char* a2 = last ? nA : cA + (size_t)(t + 2) * kstep; const char* b2 = last ? nB : cB + (size_t)(t + 2) * kstep;
            const char* a3 = a2 + kstep; const char* b3 = b2 + kstep;
            const unsigned x00 = last ? on[0][0] : oc[0][0], x01 = last ? on[0][1] : oc[0][1], x10 = last ? on[1][0] : oc[1][0], x11 = last ? on[1][1] : oc[1][1];
            PG8_LDB(B0, 0, 0); PG8_LDB(B1, 0, 1); PG8_SCHED; PG8_LDA(At, 0, 0); PG8_STAGE_A(PG8_SA(1, 1), a1, oc[1][0], oc[1][1]);
            PG8_WAIT_V(8); PG8_WAIT_L(0); PG8_BAR; PG8_MMA(0, 0, At, B0); PG8_MMA(0, 1, At, B1); PG8_BAR; PG8_SCHED;
            PG8_LDA(At, 0, 1); PG8_STAGE_B(PG8_SB(0, 0), b2); PG8_STAGE_B(PG8_SB(0, 1), b2 + hstep); PG8_STAGE_A(PG8_SA(0, 0), a2, x00, x01);
            PG8_WAIT_V(8); PG8_WAIT_L(0); PG8_BAR; PG8_MMA(1, 0, At, B0); PG8_MMA(1, 1, At, B1); PG8_BAR; PG8_SCHED;
            PG8_LDB(B0, 1, 0); PG8_LDB(B1, 1, 1); PG8_SCHED; PG8_LDA(At, 1, 0); PG8_STAGE_A(PG8_SA(0, 1), a2, x10, x11);
            PG8_WAIT_V(8); PG8_WAIT_L(0); PG8_BAR; PG8_MMA(0, 0, At, B0); PG8_MMA(0, 1, At, B1); PG8_BAR; PG8_SCHED;
            PG8_LDA(At, 1, 1); PG8_STAGE_B(PG8_SB(1, 0), b3); PG8_STAGE_B(PG8_SB(1, 1), b3 + hstep); PG8_STAGE_A(PG8_SA(1, 0), a3, x00, x01);
            PG8_WAIT_V(8); PG8_WAIT_L(0); PG8_BAR; PG8_MMA(1, 0, At, B0); PG8_MMA(1, 1, At, B1); PG8_BAR; PG8_SCHED;
        }
        if constexpr (ALIGN_EPI) { if (wr == 0) PG8_BAR; }
        E(acc, cur, wr, wc, fr, fq);
        if (!has_next) break;
#pragma unroll
        for (int a = 0; a < 2; ++a)
#pragma unroll
            for (int b = 0; b < 2; ++b)
#pragma unroll
                for (int m = 0; m < 4; ++m)
#pragma unroll
                    for (int n = 0; n < 2; ++n) acc[a][b][m][n] = (f32x4){0.f, 0.f, 0.f, 0.f};
        cur = nxt; cA = nA; cB = nB; ++ui;
#pragma unroll
        for (int h = 0; h < 2; ++h)
#pragma unroll
            for (int i = 0; i < 2; ++i) oc[h][i] = on[h][i];
        if constexpr (ALIGN_EPI) { if (wr == 1) PG8_BAR; }
    }
    PG8_WAIT_V(0);
    if constexpr (!ALIGN_EPI) { if (wr == 0) PG8_BAR; }
    PG8_BAR;
#undef PG8_SA
#undef PG8_SB
#undef PG8_STAGE_A
#undef PG8_STAGE_B
#undef PG8_LDA
#undef PG8_LDB
#undef PG8_MMA
#undef PG8_WAIT_V
#undef PG8_WAIT_L
#undef PG8_BAR
#undef PG8_SCHED
}

struct DenseOrder {
    const char* A; const char* Bt; int K, nM, nN, nwg, G, c;
    DI void init(const bf16* A_, const bf16* Bt_, int M, int N, int K_, int G_, int c_) { A = (const char*)A_; Bt = (const char*)Bt_; K = K_; nM = M / BM; nN = N / BM; nwg = nM * nN; G = G_; c = c_; }
    DI bool next(int i, Unit& u) const {
        const long L = (long)i * G + c; if (L >= nwg) return false;
        int wgid = (int)L; { const int q = nwg / NXCD, r = nwg % NXCD, xcd = wgid % NXCD, off = wgid / NXCD; wgid = (xcd < r ? xcd * (q + 1) : r * (q + 1) + (xcd - r) * q) + off; }
        const int nig = WGM * nN, gid = wgid / nig, fm = gid * WGM, gsz = (nM - fm) < WGM ? (nM - fm) : WGM;
        u.pm = fm + ((wgid % nig) % gsz); u.pn = (wgid % nig) / gsz; u.e = 0;
        u.A = A + (size_t)u.pm * BM * K * 2; u.B = Bt + (size_t)u.pn * BM * K * 2; return true;
    }
    DI void a_offs(const Unit&, const int (&R)[2], const int (&C)[2], int K_, unsigned (&off)[2][2]) const {
#pragma unroll
        for (int h = 0; h < 2; ++h)
#pragma unroll
            for (int i = 0; i < 2; ++i) off[h][i] = (unsigned)((h * HALF + R[i]) * K_ + C[i]) * 2u;
    }
};
}

#define XB_TMO      128
#define XB_XCNT(j)  (256  + 64 * (j))
#define XB_XSUB(j)  (1280 + 64 * (j))
#define XB_XGEN(j)  (2304 + 64 * (j))
#define XB_TOP      3328
#define XB_TOPGEN   3392
#define XCD_BAR_WORDS 3456
#define XB_SPIN_CAP (1u << 18)
DI unsigned xb_ld(unsigned* p)              { return __hip_atomic_load(p, __ATOMIC_RELAXED, __HIP_MEMORY_SCOPE_AGENT); }
DI unsigned xb_add(unsigned* p, unsigned v) { return __hip_atomic_fetch_add(p, v, __ATOMIC_RELAXED, __HIP_MEMORY_SCOPE_AGENT); }
DI unsigned xb_xcc_id() { return (unsigned)__builtin_amdgcn_s_getreg((3 << 11) | 20) & 0xFu; }
#define XB_SPIN(cond, bar) do { unsigned _sp = 0; while (cond) { __builtin_amdgcn_s_sleep(1); \
    if ((++_sp & 255u) == 0u) { if (xb_ld(&(bar)[XB_TMO])) break; if (_sp > XB_SPIN_CAP) { atomicAdd(&(bar)[XB_TMO], 1u); break; } } } } while (0)
struct XcdBarrier { unsigned* bar; unsigned x; volatile LAS unsigned* st; };
DI XcdBarrier xcd_barrier_post(unsigned* bar, volatile LAS unsigned* st) {
    XcdBarrier b; b.bar = bar; b.x = xb_xcc_id(); b.st = st;
    if (threadIdx.x == 0) (void)xb_add(&bar[XB_XCNT(b.x)], 1u);
    return b;
}
DI void xcd_barrier_complete(unsigned* bar, unsigned x, unsigned& nloc, unsigned& nx) {
    const unsigned G = gridDim.x * gridDim.y * gridDim.z;
    unsigned sum, cnt, mine, sp = 0u;
    for (;;) {
        sum = 0u; cnt = 0u; mine = 0u;
#pragma unroll
        for (unsigned j = 0; j < 16; ++j) { const unsigned c = xb_ld(&bar[XB_XCNT(j)]); sum += c; cnt += (c > 0u) ? 1u : 0u; mine = (j == x) ? c : mine; }
        if (sum == G) break;
        __builtin_amdgcn_s_sleep(1);
        if ((++sp & 255u) == 0u) { if (xb_ld(&bar[XB_TMO])) break; if (sp > XB_SPIN_CAP) { atomicAdd(&bar[XB_TMO], 1u); break; } }
    }
    nloc = mine > 0u ? mine : 1u; nx = cnt > 0u ? cnt : 1u;
}
DI void xcd_barrier(const XcdBarrier& b) {
    asm volatile("s_waitcnt vmcnt(0)" ::: "memory");
    __syncthreads();
    if (threadIdx.x == 0) {
        unsigned* bar = b.bar;
        __builtin_amdgcn_s_waitcnt(0);
        unsigned nloc = b.st[0], nx = b.st[1];
        if (nloc == 0u) { xcd_barrier_complete(bar, b.x, nloc, nx); b.st[0] = nloc; b.st[1] = nx; }
        const unsigned old = xb_add(&bar[XB_XSUB(b.x)], 1u);
        const unsigned gen = old / nloc;
        if (old + 1u == (gen + 1u) * nloc) {
            __builtin_amdgcn_fence(__ATOMIC_RELEASE, "agent");
            asm volatile("s_waitcnt vmcnt(0)" ::: "memory");
            const unsigned og = xb_add(&bar[XB_TOP], 1u);
            const unsigned tg = og / nx;
            if (og + 1u == (tg + 1u) * nx) xb_add(&bar[XB_TOPGEN], 1u);
            else XB_SPIN(xb_ld(&bar[XB_TOPGEN]) == tg, bar);
            __builtin_amdgcn_fence(__ATOMIC_ACQUIRE, "agent");
            xb_add(&bar[XB_XGEN(b.x)], 1u);
            asm volatile("s_waitcnt vmcnt(0)" ::: "memory");
        } else {
            XB_SPIN(xb_ld(&bar[XB_XGEN(b.x)]) == gen, bar);
            __builtin_amdgcn_fence(__ATOMIC_ACQUIRE, "agent");
            asm volatile("s_waitcnt vmcnt(0)" ::: "memory");
        }
    }
    __syncthreads();
}

namespace pg8 {
typedef __bf16 bf16x2_t __attribute__((ext_vector_type(2)));
DI unsigned pk2(float lo, float hi) { f32x2v v = {lo, hi}; bf16x2_t b = __builtin_convertvector(v, bf16x2_t); return __builtin_bit_cast(unsigned, b); }
DI u32x4 pk8(f32x4 v0, f32x4 v1) { u32x4 w; w.x = pk2(v0[0], v0[1]); w.y = pk2(v0[2], v0[3]); w.z = pk2(v1[0], v1[1]); w.w = pk2(v1[2], v1[3]); return w; }

struct EpiInProj {
    static constexpr bool PERM = true;
    bf16* P1; float* vstat; const float* bias;
    DI void operator()(const f32x4 (&acc)[2][2][4][2], const Unit& u, int wr, int wc, int fr, int fq) const {
        const int row0 = u.pm * BM + wr * 64 + fr;
        const int bcol0 = u.pn * BM + wc * 32 + 8 * fq;
        f32x4 bv[2][2];
#pragma unroll
        for (int bj = 0; bj < 2; ++bj)
#pragma unroll
            for (int n = 0; n < 2; ++n) bv[bj][n] = *(const f32x4*)(bias + bcol0 + bj * HALF + 4 * n);
        if (u.pn < 8) {
            bf16* base = P1 + u.pn * 128 + wc * 32 + 8 * fq;
#pragma unroll
            for (int ai = 0; ai < 2; ++ai)
#pragma unroll
                for (int m = 0; m < 4; ++m) {
                    f32x4 u0 = gelu4(acc[ai][0][m][0] + bv[0][0]), u1 = gelu4(acc[ai][0][m][1] + bv[0][1]);
                    const f32x4 g0 = sigmoid4(acc[ai][1][m][0] + bv[1][0]), g1 = sigmoid4(acc[ai][1][m][1] + bv[1][1]);
                    u0 = u0 * g0; u1 = u1 * g1;
                    *(u32x4*)(base + (size_t)(row0 + ai * HALF + m * 16) * D) = pk8(u0, u1);
                }
        } else {
            const int t = (u.pn - 8) >> 2, colt = ((u.pn - 8) & 3) * BM;
            bf16* base = P1 + (size_t)(t + 1) * T * D + colt + wc * 32 + 8 * fq;
#pragma unroll
            for (int ai = 0; ai < 2; ++ai)
#pragma unroll
                for (int m = 0; m < 4; ++m) {
                    float s1 = 0.f, s2 = 0.f;
#pragma unroll
                    for (int bj = 0; bj < 2; ++bj) {
                        f32x4 v0 = acc[ai][bj][m][0] + bv[bj][0], v1 = acc[ai][bj][m][1] + bv[bj][1];
                        if (t == 0) { v0 = gelu4(v0); v1 = gelu4(v1);
                            s1 += (v0[0] + v0[1]) + (v0[2] + v0[3]) + (v1[0] + v1[1]) + (v1[2] + v1[3]);
                            s2 += (v0[0] * v0[0] + v0[1] * v0[1]) + (v0[2] * v0[2] + v0[3] * v0[3]) + (v1[0] * v1[0] + v1[1] * v1[1]) + (v1[2] * v1[2] + v1[3] * v1[3]); }
                        else if (t == 1) { v0 = v0 * QSCALE; v1 = v1 * QSCALE; }
                        else if (t == 4) { v0 = sigmoid4(v0); v1 = sigmoid4(v1); }
                        *(u32x4*)(base + (size_t)(row0 + ai * HALF + m * 16) * D + bj * HALF) = pk8(v0, v1);
                    }
                    if (t == 0) {
                        s1 += __shfl_xor(s1, 16); s1 += __shfl_xor(s1, 32); s2 += __shfl_xor(s2, 16); s2 += __shfl_xor(s2, 32);
                        if (fq == 0) *(f32x2v*)(vstat + ((size_t)(row0 + ai * HALF + m * 16) * 16 + (u.pn - 8) * 4 + wc) * 2) = (f32x2v){s1, s2};
                    }
                }
        }
    }
};
struct EpiBf16S {
    static constexpr bool PERM = true;
    bf16* O; int ldc; float scale;
    DI void operator()(const f32x4 (&acc)[2][2][4][2], const Unit& u, int wr, int wc, int fr, int fq) const {
        const int row0 = u.pm * BM + wr * 64 + fr, col0 = u.pn * BM + wc * 32 + 8 * fq;
#pragma unroll
        for (int ai = 0; ai < 2; ++ai)
#pragma unroll
            for (int m = 0; m < 4; ++m)
#pragma unroll
                for (int bj = 0; bj < 2; ++bj)
                    *(u32x4*)(O + (size_t)(row0 + ai * HALF + m * 16) * ldc + col0 + bj * HALF) = pk8(acc[ai][bj][m][0] * scale, acc[ai][bj][m][1] * scale);
    }
};
template <bool LNIN> struct EpiResF32 {
    static constexpr bool PERM = false;
    float* out; const float* res; const float* xstat; const float* g; const float* b;
    DI void operator()(const f32x4 (&acc)[2][2][4][2], const Unit& u, int wr, int wc, int fr, int fq) const {
        const int col0 = u.pn * BM + wc * 32 + 4 * fq;
        f32x4 gv[2][2], bv[2][2];
        if (LNIN) {
#pragma unroll
            for (int bj = 0; bj < 2; ++bj)
#pragma unroll
                for (int n = 0; n < 2; ++n) { gv[bj][n] = *(const f32x4*)(g + col0 + bj * HALF + n * 16); bv[bj][n] = *(const f32x4*)(b + col0 + bj * HALF + n * 16); }
        }
#pragma unroll
        for (int ai = 0; ai < 2; ++ai)
#pragma unroll
            for (int m = 0; m < 4; ++m) {
                const int row = u.pm * BM + ai * HALF + wr * 64 + m * 16 + fr; const size_t off = (size_t)row * D + col0;
                f32x2v st = (f32x2v){0.f, 1.f}; if (LNIN) st = *(const f32x2v*)(xstat + 2 * (size_t)row);
#pragma unroll
                for (int bj = 0; bj < 2; ++bj)
#pragma unroll
                    for (int n = 0; n < 2; ++n) { f32x4 r = *(const f32x4*)(res + off + bj * HALF + n * 16);
                        if (LNIN) r = (r - st.x) * st.y * gv[bj][n] + bv[bj][n];
                        *(f32x4*)(out + off + bj * HALF + n * 16) = r * ALPHA + acc[ai][bj][m][n]; }
                if (m & 1) asm volatile("" ::: "memory");
            }
    }
};
struct EpiGateUp {
    static constexpr bool PERM = true;
    bf16* H;
    DI void operator()(const f32x4 (&acc)[2][2][4][2], const Unit& u, int wr, int wc, int fr, int fq) const {
        const int row0 = u.pm * BM + wr * 64 + fr, col0 = u.pn * 128 + wc * 32 + 8 * fq;
#pragma unroll
        for (int ai = 0; ai < 2; ++ai)
#pragma unroll
            for (int m = 0; m < 4; ++m) {
                const f32x4 g0 = acc[ai][0][m][0], g1 = acc[ai][0][m][1];
                const f32x4 h0 = g0 * sigmoid4(g0) * acc[ai][1][m][0], h1 = g1 * sigmoid4(g1) * acc[ai][1][m][1];
                *(u32x4*)(H + (size_t)(row0 + ai * HALF + m * 16) * EH + col0) = pk8(h0, h1);
            }
    }
};
struct EpiDown {
    static constexpr bool PERM = true;
    bf16* Y; const float* roww; int lo; float* base; const bf16* x2b;
    DI void operator()(const f32x4 (&acc)[2][2][4][2], const Unit& u, int wr, int wc, int fr, int fq) const {
        const int rl = wr * 64 + fr, col0 = u.pn * BM + wc * 32 + 8 * fq;
        if (u.e < 64) {
#pragma unroll
            for (int ai = 0; ai < 2; ++ai)
#pragma unroll
                for (int m = 0; m < 4; ++m) { const int r = rl + ai * HALF + m * 16;
                    const float w = __hip_atomic_load(roww + (size_t)u.pm * BM + r, RLX_AGENT);
#pragma unroll
                    for (int bj = 0; bj < 2; ++bj)
                        *(u32x4*)(Y + ((size_t)(u.pm - lo) * BM + r) * D + col0 + bj * HALF) = pk8(acc[ai][bj][m][0] * w, acc[ai][bj][m][1] * w);
                    if (m & 1) asm volatile("" ::: "memory"); }
        } else {
#pragma unroll
            for (int ai = 0; ai < 2; ++ai)
#pragma unroll
                for (int m = 0; m < 4; ++m) { const size_t off = ((size_t)(u.pm - SH_ROW0 / BM) * BM + rl + ai * HALF + m * 16) * D + col0;
#pragma unroll
                    for (int bj = 0; bj < 2; ++bj) { const u32x4 xr = *(const u32x4*)(x2b + off + bj * HALF);
                        const f32x4 x0 = (f32x4){bflo(xr.x), bfhi(xr.x), bflo(xr.y), bfhi(xr.y)}, x1 = (f32x4){bflo(xr.z), bfhi(xr.z), bflo(xr.w), bfhi(xr.w)};
                        *(f32x4*)(base + off + bj * HALF) = x0 * ALPHA + acc[ai][bj][m][0]; *(f32x4*)(base + off + bj * HALF + 4) = x1 * ALPHA + acc[ai][bj][m][1]; }
                    asm volatile("" ::: "memory"); }
        }
    }
};
struct GateUpOrder {
    const char* X; const char* Wgu; const char* Wgus; const int* rowtok; const unsigned* blke; int nblk, G, c;
    DI bool next(int i, Unit& u) const {
        const int L = i * G + c; if (L >= (nblk + 64) * 2) return false;
        const int bl = L >> 1; u.pn = L & 1;
        if (bl < nblk) { u.e = (int)__builtin_amdgcn_readfirstlane(__hip_atomic_load(blke + bl, RLX_AGENT)); u.pm = bl; u.A = X; u.B = Wgu + ((size_t)u.e * 512 + u.pn * 256) * D * 2; }
        else { u.e = 64; u.pm = SH_ROW0 / BM + (bl - nblk); u.A = X + (size_t)(bl - nblk) * BM * D * 2; u.B = Wgus + (size_t)u.pn * 256 * D * 2; }
        return true;
    }
    DI void a_offs(const Unit& u, const int (&R)[2], const int (&C)[2], int K_, unsigned (&off)[2][2]) const {
        if (u.e < 64) {
#pragma unroll
            for (int h = 0; h < 2; ++h)
#pragma unroll
                for (int i = 0; i < 2; ++i) { const int tok = __hip_atomic_load(rowtok + (size_t)u.pm * BM + h * HALF + R[i], RLX_AGENT); off[h][i] = (unsigned)(tok * K_ + C[i]) * 2u; }
        } else {
#pragma unroll
            for (int h = 0; h < 2; ++h)
#pragma unroll
                for (int i = 0; i < 2; ++i) off[h][i] = (unsigned)((h * HALF + R[i]) * K_ + C[i]) * 2u;
        }
    }
};
struct DownOrder {
    const char* H; const char* Wd; const char* Wds; const unsigned* blke; int lo, hi, nsh, G, c;
    DI bool next(int i, Unit& u) const {
        const int L = i * G + c; if (L >= (hi - lo + nsh) * 4) return false;
        const int bl = lo + (L >> 2); u.pn = L & 3;
        if (bl < hi) { u.e = (int)__builtin_amdgcn_readfirstlane(__hip_atomic_load(blke + bl, RLX_AGENT)); u.pm = bl; u.B = Wd + ((size_t)u.e * D + u.pn * 256) * EH * 2; }
        else { u.e = 64; u.pm = SH_ROW0 / BM + (bl - hi); u.B = Wds + (size_t)u.pn * 256 * EH * 2; }
        u.A = H + (size_t)u.pm * BM * EH * 2;
        return true;
    }
    DI void a_offs(const Unit&, const int (&R)[2], const int (&C)[2], int K_, unsigned (&off)[2][2]) const {
#pragma unroll
        for (int h = 0; h < 2; ++h)
#pragma unroll
            for (int i = 0; i < 2; ++i) off[h][i] = (unsigned)((h * HALF + R[i]) * K_ + C[i]) * 2u;
    }
};
}

struct Frame {
    LAS unsigned char* lds;
    unsigned* ctl;
    unsigned char* ws; float* out;
    int tid, lane, wave, vcu, G;
};
DI unsigned short f2bf1(float x) { return (unsigned short)(pg8::pk2(x, x) & 0xffffu); }

template <class RowMap>
DI void transpose_item(const float* W, int N, bf16* WT, int Kd, RowMap rm, LAS float* scr, int kb, int nb, int lane) {
    const int k0 = 64 * kb, n0 = 32 * nb;
#pragma unroll 8
    for (int i = 0; i < 32; ++i) { const int kk = 2 * i + (lane >> 5); scr[kk * 33 + (lane & 31)] = W[(size_t)(k0 + kk) * N + n0 + (lane & 31)]; }
    LDS_WAIT(); asm volatile("" ::: "memory");
    const int c = lane & 7; const int drow0 = rm(n0);
#pragma unroll
    for (int j = 0; j < 4; ++j) { const int n = (lane >> 3) + 8 * j; const LAS float* s = scr + (8 * c) * 33 + n;
        u32x4 o; o.x = pg8::pk2(s[0 * 33], s[1 * 33]); o.y = pg8::pk2(s[2 * 33], s[3 * 33]); o.z = pg8::pk2(s[4 * 33], s[5 * 33]); o.w = pg8::pk2(s[6 * 33], s[7 * 33]);
        *(u32x4*)(WT + (size_t)(drow0 + n) * Kd + k0 + 8 * c) = o; }
    LDS_WAIT(); asm volatile("" ::: "memory");
}
struct RmIdent { int off; DI int operator()(int n0) const { return off + n0; } };
struct RmInProj { DI int operator()(int n0) const { const int seg = n0 >> 10, w = n0 & 1023;
    return seg == 0 ? ((w >> 7) * 256 + (w & 127)) : seg == 5 ? ((w >> 7) * 256 + 128 + (w & 127)) : seg == 6 ? 6144 + w : 1024 + n0; } };
struct RmGateUp { int up; DI int operator()(int n0) const { return (n0 >> 7) * 256 + up * 128 + (n0 & 127); } };
DI int inproj_dest(int n) { return RmInProj()(n & ~31) + (n & 31); }

DI void row_stats(const float* xrow, int lane, f32x4 (&v)[4], float& mean, float& rstd) {
    const f32x4* xr = (const f32x4*)xrow + lane; float s = 0.f;
#pragma unroll
    for (int j = 0; j < 4; ++j) { v[j] = xr[64 * j]; s += (v[j][0] + v[j][1]) + (v[j][2] + v[j][3]); }
    mean = wave_sum(s) * (1.f / D); float s2 = 0.f;
#pragma unroll
    for (int j = 0; j < 4; ++j) { const f32x4 d = v[j] - mean; s2 += (d[0] * d[0] + d[1] * d[1]) + (d[2] * d[2] + d[3] * d[3]); }
    rstd = 1.f / sqrtf(wave_sum(s2) * (1.f / D) + LN_EPS);
}

DI void p0_prologue(Frame& F, const float* const* in) {
    LAS float* scr = (LAS float*)(F.lds + F.wave * 16384);
    const int gw = F.vcu * NWAVES + F.wave, NGW = F.G * NWAVES, lane = F.lane;
    unsigned char* ws = F.ws;
    constexpr int I_IN = 16 * (INW / 32), I_OUT = 16 * 32, I_Q = 16 * 16, I_KV = 16 * 32, I_O = 8 * 32, I_SG = 16 * 8, I_SD = 4 * 32;
    constexpr int NITEMS = I_IN + I_OUT + I_Q + I_KV + I_O + 2 * I_SG + I_SD;
    for (int it = gw; it < NITEMS; it += NGW) {
        int r = it;
        if (r < I_IN) { transpose_item(in[4], INW, (bf16*)(ws + WS_WIN), D, RmInProj(), scr, r / (INW / 32), r % (INW / 32), lane); continue; } r -= I_IN;
        if (r < I_OUT) { transpose_item(in[10], D, (bf16*)(ws + WS_WOUT), D, RmIdent{0}, scr, r / 32, r % 32, lane); continue; } r -= I_OUT;
        if (r < I_Q) { transpose_item(in[13], MEMW, (bf16*)(ws + WS_WQ), D, RmIdent{0}, scr, r / 16, r % 16, lane); continue; } r -= I_Q;
        if (r < I_KV) { transpose_item(in[14], 2 * MEMW, (bf16*)(ws + WS_WKV), D, RmIdent{0}, scr, r / 32, r % 32, lane); continue; } r -= I_KV;
        if (r < I_O) { transpose_item(in[15], D, (bf16*)(ws + WS_WO), MEMW, RmIdent{0}, scr, r / 32, r % 32, lane); continue; } r -= I_O;
        if (r < I_SG) { transpose_item(in[23], EH, (bf16*)(ws + WS_WGUS), D, RmGateUp{0}, scr, r / 8, r % 8, lane); continue; } r -= I_SG;
        if (r < I_SG) { transpose_item(in[24], EH, (bf16*)(ws + WS_WGUS), D, RmGateUp{1}, scr, r / 8, r % 8, lane); continue; } r -= I_SG;
        transpose_item(in[25], D, (bf16*)(ws + WS_WDS), EH, RmIdent{0}, scr, r / 32, r % 32, lane);
    }
    const int gt = F.vcu * NTHREADS + F.tid, NGT = F.G * NTHREADS;
    { const float* wr = in[18]; bf16* hi = (bf16*)(ws + WS_WRHI); bf16* lo = (bf16*)(ws + WS_WRLO);
      for (int idx = gt; idx < D * NEXP; idx += NGT) { const int k = idx >> 6, e = idx & 63; const float w = wr[idx]; const unsigned short h = f2bf1(w); hi[e * D + k] = h; lo[e * D + k] = f2bf1(w - bf2f(h)); } }
    { const float* wsp = in[8]; bf16* o = (bf16*)(ws + WS_WSP);
      for (int idx = gt; idx < 8 * 128 * 128; idx += NGT) { const int s = idx & 127, t = (idx >> 7) & 127; o[idx] = (s <= t) ? f2bf1(wsp[idx]) : (unsigned short)0; } }
    { const float* bi = in[5]; float* o = (float*)(ws + WS_BPERM);
      for (int idx = gt; idx < INW; idx += NGT) o[inproj_dest(idx)] = bi[idx]; }
    { const f32x4* m4 = (const f32x4*)in[1]; u32x2* o = (u32x2*)(ws + WS_MEMB);
      for (int idx = gt; idx < NBATCH * MEMLEN * D / 4; idx += NGT) { const f32x4 v = m4[idx]; o[idx] = (u32x2){pg8::pk2(v[0], v[1]), pg8::pk2(v[2], v[3])}; } }
    { const float* x = in[0]; const float* g = in[2]; const float* b = in[3]; bf16* X0b = (bf16*)F.out; float* xstat = (float*)(ws + WS_XSTAT);
      f32x4 gv[4], bv[4];
#pragma unroll
      for (int j = 0; j < 4; ++j) { gv[j] = ((const f32x4*)g)[lane + 64 * j]; bv[j] = ((const f32x4*)b)[lane + 64 * j]; }
      for (int m = gw; m < T; m += NGW) { f32x4 v[4]; float mean, rstd; row_stats(x + (size_t)m * D, lane, v, mean, rstd);
          u32x2* o8 = (u32x2*)(X0b + (size_t)m * D) + lane;
#pragma unroll
          for (int j = 0; j < 4; ++j) { const f32x4 y = (v[j] - mean) * rstd * gv[j] + bv[j]; o8[64 * j] = (u32x2){pg8::pk2(y[0], y[1]), pg8::pk2(y[2], y[3])}; }
          if (lane == 0) *(f32x2*)(xstat + 2 * (size_t)m) = (f32x2){mean, rstd}; } }
}
DI void expert_convert(Frame& F, const float* const* in) {
    LAS float* scr = (LAS float*)(F.lds + F.wave * 16384);
    const int gw = F.vcu * NWAVES + F.wave, NGW = F.G * NWAVES, lane = F.lane;
    for (int it = gw; it < NEXP * 384; it += NGW) {
        const int e = it / 384; int r = it % 384;
        if (r < 128) { transpose_item(in[20] + (size_t)e * D * EH, EH, (bf16*)(F.ws + WS_WGU) + (size_t)e * 512 * D, D, RmGateUp{0}, scr, r / 8, r % 8, lane); continue; } r -= 128;
        if (r < 128) { transpose_item(in[21] + (size_t)e * D * EH, EH, (bf16*)(F.ws + WS_WGU) + (size_t)e * 512 * D, D, RmGateUp{1}, scr, r / 8, r % 8, lane); continue; } r -= 128;
        transpose_item(in[22] + (size_t)e * EH * D, D, (bf16*)(F.ws + WS_WD) + (size_t)e * D * EH, EH, RmIdent{0}, scr, r / 32, r % 32, lane);
    }
}

constexpr int MX_RS = 272;
constexpr int MX_KT = 0, MX_VT = 128 * MX_RS, MX_NT = 2 * 128 * MX_RS, MX_STAT = 3 * 128 * MX_RS, MX_FLG = MX_STAT + 1024, MX_END = MX_FLG + 64;
static_assert(MX_END <= SCR_BYTES, "mixer LDS");
DI bf16x8 mk_frag(f32x4 e0, f32x4 e1) { const u32x4 w = pg8::pk8(e0, e1); return __builtin_bit_cast(bf16x8, w); }
DI bf16x8 ld_split8(const LAS unsigned char* p) {
    const s16x4 lo = *(const LAS s16x4*)p, hi = *(const LAS s16x4*)(p + 32);
    return (bf16x8){lo[0], lo[1], lo[2], lo[3], hi[0], hi[1], hi[2], hi[3]};
}
DI void mix_phase(Frame& F, const float* const* in) {
    LAS unsigned char* lds = F.lds; unsigned char* ws = F.ws;
    const int tid = F.tid, lane = F.lane, w = F.wave, r = lane & 15, q = lane >> 4;
    const bf16* UG = (const bf16*)(ws + WS_UG); const bf16* VA = (const bf16*)(ws + WS_VA); const bf16* Qg = (const bf16*)(ws + WS_Q);
    const bf16* Kg = (const bf16*)(ws + WS_K); const bf16* Vg = (const bf16*)(ws + WS_V); const bf16* GB = (const bf16*)(ws + WS_GB);
    const float* vstat = (const float*)(ws + WS_VSTAT); const bf16* WSP = (const bf16*)(ws + WS_WSP); bf16* MG = (bf16*)(ws + WS_MERGED);
    const float* lnvg = in[6]; const float* lnvb = in[7]; const float* bsp = in[9];
    bf16x8 UE, UO, ONES;
#pragma unroll
    for (int jj = 0; jj < 8; ++jj) { ONES[jj] = (short)0x3F80;
        UE[jj] = (jj < 4) ? ((4 * q + jj > r) ? (short)0x3F80 : (short)0) : (short)0x3F80;
        UO[jj] = (jj < 4) ? (short)0 : ((4 * q + jj - 4 > r) ? (short)0x3F80 : (short)0); }
    for (int un = F.vcu; un < NBATCH * 16 * 8; un += F.G) {
        const int j = un & 7, i = (un >> 3) & 15, b = un >> 7;
        const int t0 = b * SEQ + 128 * i, c0 = 128 * j;
        if (tid < 128) { const f32x2* p = (const f32x2*)vstat + (size_t)(t0 + tid) * 16; float s1 = 0.f, s2 = 0.f;
#pragma unroll
            for (int k = 0; k < 16; ++k) { const f32x2 v = p[k]; s1 += v[0]; s2 += v[1]; }
            const float mean = s1 * (1.f / D), var = s2 * (1.f / D) - mean * mean;
            *(LAS f32x2*)(lds + MX_STAT + tid * 8) = (f32x2){mean, 1.f / sqrtf(fmaxf(var, 0.f) + LN_EPS)}; }
        __syncthreads();
#pragma unroll
        for (int it = 0; it < 4; ++it) { const int id = tid + 512 * it, ch = id >> 7, s = id & 127;
            const u32x4 raw = *(const u32x4*)(VA + (size_t)(t0 + s) * D + c0 + 8 * ch);
            const f32x2 st = *(const LAS f32x2*)(lds + MX_STAT + s * 8);
            const f32x4 g0 = *(const f32x4*)(lnvg + c0 + 8 * ch), g1 = *(const f32x4*)(lnvg + c0 + 8 * ch + 4), b0 = *(const f32x4*)(lnvb + c0 + 8 * ch), b1 = *(const f32x4*)(lnvb + c0 + 8 * ch + 4);
            const f32x4 x0 = (f32x4){bflo(raw.x), bfhi(raw.x), bflo(raw.y), bfhi(raw.y)}, x1 = (f32x4){bflo(raw.z), bfhi(raw.z), bflo(raw.w), bfhi(raw.w)};
            const f32x4 y0 = (x0 - st[0]) * st[1] * g0 + b0, y1 = (x1 - st[0]) * st[1] * g1 + b1;
            LAS unsigned short* nt = (LAS unsigned short*)(lds + MX_NT + (8 * ch) * MX_RS + s * 2);
#pragma unroll
            for (int e = 0; e < 4; ++e) { nt[e * (MX_RS / 2)] = f2bf1(y0[e]); nt[(4 + e) * (MX_RS / 2)] = f2bf1(y1[e]); } }
        bf16x8 qf[4];
#pragma unroll
        for (int kk = 0; kk < 4; ++kk) qf[kk] = *(const bf16x8*)(Qg + (size_t)(t0 + 16 * w + r) * D + c0 + 32 * kk + 8 * q);
        f32x4 ya[8], yb[8];
#pragma unroll
        for (int dt = 0; dt < 8; ++dt) { ya[dt] = (f32x4){0.f, 0.f, 0.f, 0.f}; yb[dt] = (f32x4){0.f, 0.f, 0.f, 0.f}; }
        float carry = 0.f;
        for (int kb = i; kb >= 0; --kb) {
            const int kv0 = b * SEQ + 128 * kb;
#pragma unroll
            for (int it = 0; it < 4; ++it) { const int id = tid + 512 * it;
                { const int s = id >> 4, ch = id & 15; *(LAS u32x4*)(lds + MX_KT + s * MX_RS + ch * 16) = *(const u32x4*)(Kg + (size_t)(kv0 + s) * D + c0 + 8 * ch); }
                { const int ch = id >> 7, s = id & 127; const u32x4 raw = *(const u32x4*)(Vg + (size_t)(kv0 + s) * D + c0 + 8 * ch);
                  LAS unsigned short* vt = (LAS unsigned short*)(lds + MX_VT + (8 * ch) * MX_RS + s * 2);
                  vt[0 * (MX_RS / 2)] = (unsigned short)(raw.x & 0xffffu); vt[1 * (MX_RS / 2)] = (unsigned short)(raw.x >> 16); vt[2 * (MX_RS / 2)] = (unsigned short)(raw.y & 0xffffu); vt[3 * (MX_RS / 2)] = (unsigned short)(raw.y >> 16);
                  vt[4 * (MX_RS / 2)] = (unsigned short)(raw.z & 0xffffu); vt[5 * (MX_RS / 2)] = (unsigned short)(raw.z >> 16); vt[6 * (MX_RS / 2)] = (unsigned short)(raw.w & 0xffffu); vt[7 * (MX_RS / 2)] = (unsigned short)(raw.w >> 16); } }
            __syncthreads();
            if (kb == i) {
                const int nks = (w >> 1) + 1;
                for (int ks = 0; ks < nks; ++ks) {
                    const bf16x8 wf = *(const bf16x8*)(WSP + ((size_t)j * 128 + 16 * w + r) * 128 + 32 * ks + 8 * q);
#pragma unroll
                    for (int dt = 0; dt < 8; ++dt) { const bf16x8 af = *(const LAS bf16x8*)(lds + MX_NT + (16 * dt + r) * MX_RS + (32 * ks + 8 * q) * 2);
                        ya[dt] = __builtin_amdgcn_mfma_f32_16x16x32_bf16(af, wf, ya[dt], 0, 0, 0); }
                }
            }
            f32x4 z[8];
#pragma unroll
            for (int st = 0; st < 8; ++st) { z[st] = (f32x4){0.f, 0.f, 0.f, 0.f};
#pragma unroll
                for (int kk = 0; kk < 4; ++kk) { const bf16x8 kf = *(const LAS bf16x8*)(lds + MX_KT + (16 * st + r) * MX_RS + (32 * kk + 8 * q) * 2);
                    z[st] = __builtin_amdgcn_mfma_f32_16x16x32_bf16(kf, qf[kk], z[st], 0, 0, 0); } }
            f32x4 ls[8]; const bool diag = (kb == i); const int tq = 16 * w + r;
#pragma unroll
            for (int st = 0; st < 8; ++st)
#pragma unroll
                for (int e = 0; e < 4; ++e) { const float zz = z[st][e]; const float sp = fmaxf(zz, 0.f) + LN2 * fast_log2(1.0f + fast_exp2(-fabsf(zz) * LOG2E));
                    const bool msk = diag && (16 * st + 4 * q + e >= tq);
                    ls[st][e] = msk ? 0.f : -sp; z[st][e] = msk ? -1e30f : zz - sp; }
            bf16x8 lf[4];
#pragma unroll
            for (int p = 0; p < 4; ++p) lf[p] = mk_frag(ls[2 * p], ls[2 * p + 1]);
            f32x4 tot = (f32x4){0.f, 0.f, 0.f, 0.f};
#pragma unroll
            for (int p = 0; p < 4; ++p) tot = __builtin_amdgcn_mfma_f32_16x16x32_bf16(ONES, lf[p], tot, 0, 0, 0);
            bf16x8 af[4];
#pragma unroll
            for (int p = 0; p < 4; ++p) {
                f32x4 s0 = (f32x4){0.f, 0.f, 0.f, 0.f}, s1 = (f32x4){0.f, 0.f, 0.f, 0.f};
                s0 = __builtin_amdgcn_mfma_f32_16x16x32_bf16(UE, lf[p], s0, 0, 0, 0);
                s1 = __builtin_amdgcn_mfma_f32_16x16x32_bf16(UO, lf[p], s1, 0, 0, 0);
#pragma unroll
                for (int p2 = p + 1; p2 < 4; ++p2) { s0 = __builtin_amdgcn_mfma_f32_16x16x32_bf16(ONES, lf[p2], s0, 0, 0, 0); s1 = __builtin_amdgcn_mfma_f32_16x16x32_bf16(ONES, lf[p2], s1, 0, 0, 0); }
                f32x4 a0, a1;
#pragma unroll
                for (int e = 0; e < 4; ++e) { a0[e] = fast_exp2((z[2 * p][e] + s0[e] + carry) * LOG2E); a1[e] = fast_exp2((z[2 * p + 1][e] + s1[e] + carry) * LOG2E); }
                af[p] = mk_frag(a0, a1);
            }
#pragma unroll
            for (int dt = 0; dt < 8; ++dt)
#pragma unroll
                for (int p = 0; p < 4; ++p) { const bf16x8 vf = ld_split8(lds + MX_VT + (16 * dt + r) * MX_RS + (32 * p + 4 * q) * 2);
                    yb[dt] = __builtin_amdgcn_mfma_f32_16x16x32_bf16(vf, af[p], yb[dt], 0, 0, 0); }
            carry += tot[0];
            const float wm = wave_max(carry);
            if (lane == 0) *(LAS float*)(lds + MX_FLG + ((kb & 1) * 8 + w) * 4) = wm;
            __syncthreads();
            float gm = -1e30f;
#pragma unroll
            for (int k = 0; k < 8; ++k) gm = fmaxf(gm, *(const LAS float*)(lds + MX_FLG + ((kb & 1) * 8 + k) * 4));
            if (gm < SB_EXIT) break;
        }
        { const float bs = bsp[j * 128 + 16 * w + r]; const size_t rowoff = (size_t)(t0 + 16 * w + r) * D + c0 + 4 * q;
#pragma unroll
          for (int dt = 0; dt < 8; ++dt) { const u32x2 ug = *(const u32x2*)(UG + rowoff + 16 * dt), gb = *(const u32x2*)(GB + rowoff + 16 * dt);
              const f32x4 u4 = (f32x4){bflo(ug.x), bfhi(ug.x), bflo(ug.y), bfhi(ug.y)}, g4 = (f32x4){bflo(gb.x), bfhi(gb.x), bflo(gb.y), bfhi(gb.y)};
              const f32x4 o = u4 * (ya[dt] + bs) + g4 * yb[dt];
              *(u32x2*)(MG + rowoff + 16 * dt) = (u32x2){pg8::pk2(o[0], o[1]), pg8::pk2(o[2], o[3])}; } }
        __syncthreads();
    }
}

DI void ln1_phase(Frame& F, const float* const* in) {
    const int gw = F.vcu * NWAVES + F.wave, NGW = F.G * NWAVES, lane = F.lane;
    const float* Y1 = (const float*)(F.ws + WS_Y1); float* X1f = (float*)(F.ws + WS_X1F); bf16* X1b = (bf16*)(F.ws + WS_X1B);
    f32x4 gv[4], bv[4];
#pragma unroll
    for (int j = 0; j < 4; ++j) { gv[j] = ((const f32x4*)in[11])[lane + 64 * j]; bv[j] = ((const f32x4*)in[12])[lane + 64 * j]; }
    for (int m = gw; m < T; m += NGW) { f32x4 v[4]; float mean, rstd; row_stats(Y1 + (size_t)m * D, lane, v, mean, rstd);
        f32x4* of = (f32x4*)(X1f + (size_t)m * D) + lane; u32x2* ob = (u32x2*)(X1b + (size_t)m * D) + lane;
#pragma unroll
        for (int j = 0; j < 4; ++j) { const f32x4 y = (v[j] - mean) * rstd * gv[j] + bv[j]; of[64 * j] = y; ob[64 * j] = (u32x2){pg8::pk2(y[0], y[1]), pg8::pk2(y[2], y[3])}; } }
}

constexpr int MA_KRS = 272, MA_VRS = 528;
constexpr int MA_K = 0, MA_V = 256 * MA_KRS, MA_END = MA_V + 128 * MA_VRS;
static_assert(MA_END <= SCR_BYTES, "mem-attn LDS");
DI void memattn_phase(Frame& F) {
    LAS unsigned char* lds = F.lds; unsigned char* ws = F.ws;
    const int tid = F.tid, lane = F.lane, w = F.wave, r = lane & 15, q = lane >> 4;
    const bf16* Qm = (const bf16*)(ws + WS_QM); const bf16* KV = (const bf16*)(ws + WS_KVM); bf16* Om = (bf16*)(ws + WS_OM);
    for (int su = F.vcu; su < NBATCH * 4 * 8; su += F.G) {
        const int qc = su & 7, h = (su >> 3) & 3, b = su >> 5;
#pragma unroll
        for (int it = 0; it < 8; ++it) { const int id = tid + 512 * it;
            { const int s = id >> 4, ch = id & 15; *(LAS u32x4*)(lds + MA_K + s * MA_KRS + ch * 16) = *(const u32x4*)(KV + (size_t)(b * MEMLEN + s) * D + h * 128 + 8 * ch); }
            { const int ch = id >> 8, s = id & 255; const u32x4 raw = *(const u32x4*)(KV + (size_t)(b * MEMLEN + s) * D + MEMW + h * 128 + 8 * ch);
              LAS unsigned short* vt = (LAS unsigned short*)(lds + MA_V + (8 * ch) * MA_VRS + s * 2);
              vt[0 * (MA_VRS / 2)] = (unsigned short)(raw.x & 0xffffu); vt[1 * (MA_VRS / 2)] = (unsigned short)(raw.x >> 16); vt[2 * (MA_VRS / 2)] = (unsigned short)(raw.y & 0xffffu); vt[3 * (MA_VRS / 2)] = (unsigned short)(raw.y >> 16);
              vt[4 * (MA_VRS / 2)] = (unsigned short)(raw.z & 0xffffu); vt[5 * (MA_VRS / 2)] = (unsigned short)(raw.z >> 16); vt[6 * (MA_VRS / 2)] = (unsigned short)(raw.w & 0xffffu); vt[7 * (MA_VRS / 2)] = (unsigned short)(raw.w >> 16); } }
        __syncthreads();
        for (int c = 0; c < 2; ++c) {
            const size_t trow = (size_t)b * SEQ + 256 * qc + 128 * c + 16 * w + r;
            bf16x8 qf[4];
#pragma unroll
            for (int kk = 0; kk < 4; ++kk) qf[kk] = *(const bf16x8*)(Qm + trow * MEMW + h * 128 + 32 * kk + 8 * q);
            f32x4 z[16];
#pragma unroll
            for (int st = 0; st < 16; ++st) { z[st] = (f32x4){0.f, 0.f, 0.f, 0.f};
#pragma unroll
                for (int kk = 0; kk < 4; ++kk) { const bf16x8 kf = *(const LAS bf16x8*)(lds + MA_K + (16 * st + r) * MA_KRS + (32 * kk + 8 * q) * 2);
                    z[st] = __builtin_amdgcn_mfma_f32_16x16x32_bf16(kf, qf[kk], z[st], 0, 0, 0); }
                if (st & 1) __builtin_amdgcn_sched_barrier(0); }
            float mx = -1e30f;
#pragma unroll
            for (int st = 0; st < 16; ++st) mx = fmaxf(mx, fmaxf(fmaxf(z[st][0], z[st][1]), fmaxf(z[st][2], z[st][3])));
            mx = fmaxf(mx, __shfl_xor(mx, 16)); mx = fmaxf(mx, __shfl_xor(mx, 32));
            float sum = 0.f;
#pragma unroll
            for (int st = 0; st < 16; ++st)
#pragma unroll
                for (int e = 0; e < 4; ++e) { const float pp = fast_exp2((z[st][e] - mx) * LOG2E); z[st][e] = pp; sum += pp; }
            sum += __shfl_xor(sum, 16); sum += __shfl_xor(sum, 32);
            const float inv = 1.0f / sum;
            f32x4 o[8];
#pragma unroll
            for (int dt = 0; dt < 8; ++dt) o[dt] = (f32x4){0.f, 0.f, 0.f, 0.f};
#pragma unroll
            for (int p = 0; p < 8; ++p) { const bf16x8 pf = mk_frag(z[2 * p], z[2 * p + 1]);
#pragma unroll
                for (int dt = 0; dt < 8; ++dt) { const bf16x8 vf = ld_split8(lds + MA_V + (16 * dt + r) * MA_VRS + (32 * p + 4 * q) * 2);
                    o[dt] = __builtin_amdgcn_mfma_f32_16x16x32_bf16(vf, pf, o[dt], 0, 0, 0); }
                __builtin_amdgcn_sched_barrier(0); }
#pragma unroll
            for (int dt = 0; dt < 8; ++dt) { const f32x4 v = o[dt] * inv;
                *(u32x2*)(Om + trow * MEMW + h * 128 + 16 * dt + 4 * q) = (u32x2){pg8::pk2(v[0], v[1]), pg8::pk2(v[2], v[3])}; }
        }
        __syncthreads();
    }
}

constexpr int RT_XRS = 2064;
constexpr int RT_XH = 0, RT_XL = 16 * RT_XRS, RT_PART = 2 * 16 * RT_XRS, RT_SC = RT_PART + 8 * 16 * 64 * 4, RT_SEL = RT_SC + 16 * 64 * 4, RT_HIST = RT_SEL + 16 * 64 * 4, RT_END = RT_HIST + 256;
static_assert(RT_END <= SCR_BYTES, "router LDS");
DI float grp8_max(float v) { v = fmaxf(v, __shfl_xor(v, 1)); v = fmaxf(v, __shfl_xor(v, 2)); v = fmaxf(v, __shfl_xor(v, 4)); return v; }
DI float rdlane(float v, int l) { return __uint_as_float(__builtin_amdgcn_readlane(__float_as_uint(v), l)); }
DI void route_phase(Frame& F, const float* const* in, unsigned* gcount) {
    LAS unsigned char* lds = F.lds; unsigned char* ws = F.ws;
    const int tid = F.tid, lane = F.lane, w = F.wave, r = lane & 15, q = lane >> 4;
    const float* Y2 = F.out; bf16* X2b = (bf16*)(ws + WS_X2B);
    const bf16* WRH = (const bf16*)(ws + WS_WRHI); const bf16* WRL = (const bf16*)(ws + WS_WRLO);
    unsigned* TK = (unsigned*)(ws + WS_TK); float* TKW = (float*)(ws + WS_TKW); unsigned* WGB = (unsigned*)(ws + WS_WGBASE);
    LAS unsigned* HIST = (LAS unsigned*)(lds + RT_HIST);
    if (tid < 64) HIST[tid] = 0u;
    const float rb = in[19][lane];
    f32x4 gv[4], bv[4];
#pragma unroll
    for (int j = 0; j < 4; ++j) { gv[j] = ((const f32x4*)in[16])[lane + 64 * j]; bv[j] = ((const f32x4*)in[17])[lane + 64 * j]; }
    bf16x8 bh[4][4], bl[4][4];
#pragma unroll
    for (int kk = 0; kk < 4; ++kk)
#pragma unroll
        for (int nt = 0; nt < 4; ++nt) { const size_t o = (size_t)(16 * nt + r) * D + 128 * w + 32 * kk + 8 * q; bh[kk][nt] = *(const bf16x8*)(WRH + o); bl[kk][nt] = *(const bf16x8*)(WRL + o); }
    f32x4 va[4], vb[4];
    { const int tl0 = F.vcu; if (tl0 < T / 16) {
#pragma unroll
        for (int j = 0; j < 4; ++j) { va[j] = ((const f32x4*)(Y2 + ((size_t)16 * tl0 + 2 * w) * D))[lane + 64 * j]; vb[j] = ((const f32x4*)(Y2 + ((size_t)16 * tl0 + 2 * w + 1) * D))[lane + 64 * j]; } } }
    __syncthreads();
    for (int tl = F.vcu; tl < T / 16; tl += F.G) {
#pragma unroll
        for (int rr = 0; rr < 2; ++rr) { const int lr = 2 * w + rr; const size_t m = (size_t)16 * tl + lr;
            f32x4 v[4]; float s = 0.f;
#pragma unroll
            for (int j = 0; j < 4; ++j) { v[j] = rr ? vb[j] : va[j]; s += (v[j][0] + v[j][1]) + (v[j][2] + v[j][3]); }
            const float mean = wave_sum(s) * (1.f / D); float s2 = 0.f;
#pragma unroll
            for (int j = 0; j < 4; ++j) { const f32x4 d = v[j] - mean; s2 += (d[0] * d[0] + d[1] * d[1]) + (d[2] * d[2] + d[3] * d[3]); }
            const float rstd = 1.f / sqrtf(wave_sum(s2) * (1.f / D) + LN_EPS);
            u32x2* ob = (u32x2*)(X2b + m * D) + lane;
#pragma unroll
            for (int j = 0; j < 4; ++j) { const f32x4 y = (v[j] - mean) * rstd * gv[j] + bv[j];
                const u32x2 hi = (u32x2){pg8::pk2(y[0], y[1]), pg8::pk2(y[2], y[3])}; ob[64 * j] = hi;
                const f32x4 rs = (f32x4){y[0] - bflo(hi.x), y[1] - bfhi(hi.x), y[2] - bflo(hi.y), y[3] - bfhi(hi.y)};
                *(LAS u32x2*)(lds + RT_XH + lr * RT_XRS + (4 * lane + 256 * j) * 2) = hi;
                *(LAS u32x2*)(lds + RT_XL + lr * RT_XRS + (4 * lane + 256 * j) * 2) = (u32x2){pg8::pk2(rs[0], rs[1]), pg8::pk2(rs[2], rs[3])}; } }
        { const int tn = tl + F.G; if (tn < T / 16) {
#pragma unroll
            for (int j = 0; j < 4; ++j) { va[j] = ((const f32x4*)(Y2 + ((size_t)16 * tn + 2 * w) * D))[lane + 64 * j]; vb[j] = ((const f32x4*)(Y2 + ((size_t)16 * tn + 2 * w + 1) * D))[lane + 64 * j]; } } }
        __syncthreads();
        { f32x4 acc[4];
#pragma unroll
          for (int nt = 0; nt < 4; ++nt) acc[nt] = (f32x4){0.f, 0.f, 0.f, 0.f};
#pragma unroll
          for (int kk = 0; kk < 4; ++kk) { const int k0 = 128 * w + 32 * kk + 8 * q;
              const bf16x8 ah = *(const LAS bf16x8*)(lds + RT_XH + r * RT_XRS + k0 * 2), al = *(const LAS bf16x8*)(lds + RT_XL + r * RT_XRS + k0 * 2);
#pragma unroll
              for (int nt = 0; nt < 4; ++nt) {
                  acc[nt] = __builtin_amdgcn_mfma_f32_16x16x32_bf16(ah, bh[kk][nt], acc[nt], 0, 0, 0);
                  acc[nt] = __builtin_amdgcn_mfma_f32_16x16x32_bf16(al, bh[kk][nt], acc[nt], 0, 0, 0);
                  acc[nt] = __builtin_amdgcn_mfma_f32_16x16x32_bf16(ah, bl[kk][nt], acc[nt], 0, 0, 0); } }
#pragma unroll
          for (int nt = 0; nt < 4; ++nt)
#pragma unroll
              for (int e = 0; e < 4; ++e) *(LAS float*)(lds + RT_PART + ((w * 16 + 4 * q + e) * 64 + 16 * nt + r) * 4) = acc[nt][e]; }
        __syncthreads();
#pragma unroll
        for (int rr = 0; rr < 2; ++rr) { const int lt = 2 * w + rr; const size_t tok = (size_t)16 * tl + lt;
            float lg = 0.f;
#pragma unroll
            for (int k = 0; k < 8; ++k) lg += *(const LAS float*)(lds + RT_PART + ((k * 16 + lt) * 64 + lane) * 4);
            const float sc = 1.0f / (1.0f + __expf(-lg)); const float sel = sc + rb;
            const int g = lane >> 3;
            const float m1 = grp8_max(sel);
            const unsigned long long bal = __ballot(sel == m1);
            const unsigned gb = (unsigned)(bal >> (8 * g)) & 0xffu; const int first = 8 * g + __builtin_ctz(gb);
            const float m2 = grp8_max(lane == first ? -1e30f : sel);
            const float gs = m1 + m2;
            int grank = 0;
#pragma unroll
            for (int g2 = 0; g2 < 8; ++g2) { const float v = rdlane(gs, 8 * g2); grank += ((v > gs) || (v == gs && g2 < g)) ? 1 : 0; }
            const float val = (grank < 4) ? sel : -1e30f;
            int rank = 0;
#pragma unroll
            for (int e2 = 0; e2 < 64; ++e2) { const float v = rdlane(val, e2); rank += ((v > val) || (v == val && e2 < lane)) ? 1 : 0; }
            const bool chosen = rank < 8;
            const unsigned long long cm = __ballot(chosen);
            const float wsum = wave_sum(chosen ? sc : 0.f);
            if (chosen) { const int kidx = __builtin_popcountll(cm & ((1ull << lane) - 1ull));
                const unsigned lrk = __hip_atomic_fetch_add(&HIST[lane], 1u, __ATOMIC_RELAXED, __HIP_MEMORY_SCOPE_WORKGROUP);
                TK[tok * 8 + kidx] = (unsigned)lane | (lrk << 8); TKW[tok * 8 + kidx] = sc * (ROUTED_SCALE / wsum); }
        }
        __syncthreads();
    }
    if (tid < 64) { const unsigned cnt = HIST[tid]; const unsigned base = __hip_atomic_fetch_add(gcount + tid, cnt, RLX_AGENT); WGB[F.vcu * 64 + tid] = base; }
}

DI void slots_phase(Frame& F) {
    LAS unsigned char* lds = F.lds; unsigned char* ws = F.ws; const int tid = F.tid;
    LAS unsigned* CNT = (LAS unsigned*)lds; LAS unsigned* PS = CNT + 64;
    int* ROWTOK = (int*)(ws + WS_ROWTOK); float* ROWW = (float*)(ws + WS_ROWW); unsigned* SLOT = (unsigned*)(ws + WS_SLOT);
    const unsigned* TK = (const unsigned*)(ws + WS_TK); const float* TKW = (const float*)(ws + WS_TKW); const unsigned* WGB = (const unsigned*)(ws + WS_WGBASE);
    if (tid < 64) CNT[tid] = __hip_atomic_load(F.ctl + CW_GCOUNT + tid, RLX_AGENT);
    __syncthreads();
    if (tid == 0) { unsigned run = 0u; for (int e = 0; e < 64; ++e) { PS[e] = run; run += (CNT[e] + 255u) & ~255u; } PS[64] = run; }
    __syncthreads();
    const unsigned nblk = PS[64] >> 8;
    if (F.vcu == 0) {
        if (tid == 0) { __hip_atomic_store(F.ctl + CW_HDR, nblk, RLX_AGENT); __hip_atomic_store(F.ctl + CW_HDR + 1, (nblk + 1u) >> 1, RLX_AGENT); }
        for (unsigned bl = tid; bl < nblk; bl += NTHREADS) { unsigned e = 0; for (int k = 1; k < 64; ++k) e += (PS[k] <= bl * 256u) ? 1u : 0u; __hip_atomic_store(F.ctl + CW_BLKE + bl, e, RLX_AGENT); }
    }
    for (int e = F.vcu; e < 64; e += F.G) { const unsigned lo = PS[e] + CNT[e], hi = PS[e + 1]; for (unsigned s = lo + tid; s < hi; s += NTHREADS) { ROWTOK[s] = 0; ROWW[s] = 0.f; } }
    for (int tl = F.vcu; tl < T / 16; tl += F.G) {
        if (tid < 128) { const size_t a = (size_t)16 * 8 * tl + tid; const unsigned pk = TK[a], e = pk & 0xffu, lrk = pk >> 8;
            const unsigned slot = PS[e] + WGB[F.vcu * 64 + e] + lrk; ROWTOK[slot] = (int)(a >> 3); ROWW[slot] = TKW[a]; SLOT[a] = slot; }
    }
}

template <bool FINAL> DI void combine_phase(Frame& F, const float* const* in) {
    const int gw = F.vcu * NWAVES + F.wave, NGW = F.G * NWAVES, lane = F.lane;
    const unsigned split = __builtin_amdgcn_readfirstlane(__hip_atomic_load(F.ctl + CW_HDR + 1, RLX_AGENT)) * 256u;
    const unsigned* SLOT = (const unsigned*)(F.ws + WS_SLOT); const bf16* Y = (const bf16*)(F.ws + WS_YH); float* base = F.out; bf16* SA = (bf16*)(F.ws + WS_X2B);
    f32x4 gv[4], bv[4];
    if (FINAL) {
#pragma unroll
        for (int j = 0; j < 4; ++j) { gv[j] = ((const f32x4*)in[26])[lane + 64 * j]; bv[j] = ((const f32x4*)in[27])[lane + 64 * j]; } }
    for (int m0 = gw; m0 < T; m0 += 2 * NGW) {
        u32x2 yr[2][8][4]; f32x4 v[2][4]; u32x2 sa[2][4]; bool use[2][8];
#pragma unroll
        for (int t2 = 0; t2 < 2; ++t2) { const int m = m0 + t2 * NGW;
            const bool valid = m < T; const int mm = valid ? m : m0;
            unsigned sl[8];
#pragma unroll
            for (int k = 0; k < 8; ++k) sl[k] = __builtin_amdgcn_readfirstlane(__hip_atomic_load(SLOT + (size_t)mm * 8 + k, RLX_AGENT));
            if (FINAL) {
#pragma unroll
                for (int j = 0; j < 4; ++j) { v[t2][j] = ((const f32x4*)(base + (size_t)mm * D))[lane + 64 * j]; sa[t2][j] = ((const u32x2*)(SA + (size_t)mm * D))[lane + 64 * j]; } }
#pragma unroll
            for (int k = 0; k < 8; ++k) { const bool mine = FINAL ? (sl[k] >= split) : (sl[k] < split); use[t2][k] = mine;
                const u32x2* yp = (const u32x2*)(Y + (size_t)(mine ? (FINAL ? sl[k] - split : sl[k]) : 0u) * D) + lane;
#pragma unroll
                for (int j = 0; j < 4; ++j) yr[t2][k][j] = mine ? yp[64 * j] : (u32x2){0u, 0u}; }
        }
#pragma unroll
        for (int t2 = 0; t2 < 2; ++t2) { const int m = m0 + t2 * NGW; if (m >= T) continue;
            f32x4 acc[4];
#pragma unroll
            for (int j = 0; j < 4; ++j) acc[j] = FINAL ? v[t2][j] + (f32x4){bflo(sa[t2][j].x), bfhi(sa[t2][j].x), bflo(sa[t2][j].y), bfhi(sa[t2][j].y)} : (f32x4){0.f, 0.f, 0.f, 0.f};
#pragma unroll
            for (int k = 0; k < 8; ++k)
#pragma unroll
                for (int j = 0; j < 4; ++j) { const u32x2 y = yr[t2][k][j]; acc[j] += (f32x4){bflo(y.x), bfhi(y.x), bflo(y.y), bfhi(y.y)}; }
            if (FINAL) { float s = 0.f;
#pragma unroll
                for (int j = 0; j < 4; ++j) s += (acc[j][0] + acc[j][1]) + (acc[j][2] + acc[j][3]);
                const float mean = wave_sum(s) * (1.f / D); float s2 = 0.f;
#pragma unroll
                for (int j = 0; j < 4; ++j) { const f32x4 d = acc[j] - mean; s2 += (d[0] * d[0] + d[1] * d[1]) + (d[2] * d[2] + d[3] * d[3]); }
                const float rstd = 1.f / sqrtf(wave_sum(s2) * (1.f / D) + LN_EPS);
                f32x4* br = (f32x4*)(base + (size_t)m * D) + lane;
#pragma unroll
                for (int j = 0; j < 4; ++j) br[64 * j] = (acc[j] - mean) * rstd * gv[j] + bv[j];
            } else { u32x2* so = (u32x2*)(SA + (size_t)m * D) + lane;
#pragma unroll
                for (int j = 0; j < 4; ++j) so[64 * j] = (u32x2){pg8::pk2(acc[j][0], acc[j][1]), pg8::pk2(acc[j][2], acc[j][3])}; }
        }
    }
}

constexpr int NPHASE = 15;
constexpr int N_LAUNCHES = MK_N_LAUNCHES;
static_assert(N_LAUNCHES == 1 || N_LAUNCHES == NPHASE, "MK_N_LAUNCHES: 1 (one dispatch) or 15 (one dispatch per phase)");
struct Args { const float* in[28]; float* out; unsigned char* ws; int ph_lo, ph_hi; };
static_assert(sizeof(Args) == 28 * 8 + 8 + 8 + 8, "Args has no padding");

__global__ void __launch_bounds__(NTHREADS, 2) fwd_kernel(Args args) {
    extern __shared__ __attribute__((aligned(16))) unsigned char lds_raw[];
    Frame F;
    F.lds = (LAS unsigned char*)lds_raw;
    volatile LAS unsigned* MISC = (volatile LAS unsigned*)(F.lds + MISC_OFF);
    F.tid = threadIdx.x; F.lane = F.tid & 63; F.wave = __builtin_amdgcn_readfirstlane(F.tid >> 6);
    F.G = gridDim.x; { const int bx = blockIdx.x; F.vcu = (F.G % 8 == 0) ? (bx % 8) * (F.G / 8) + bx / 8 : bx; }
    F.ws = args.ws; F.ctl = (unsigned*)(args.ws + WS_CTL); F.out = args.out;
    unsigned char* ws = args.ws;
    for (int u = F.tid; u < (LDS_BYTES - MISC_OFF) / 4; u += NTHREADS) ((LAS unsigned*)(F.lds + MISC_OFF))[u] = 0u;
    __syncthreads();
    XcdBarrier bar; bar.bar = F.ctl + CW_BAR; bar.x = 0; bar.st = nullptr;
    if (N_LAUNCHES == 1) bar = xcd_barrier_post(F.ctl + CW_BAR, MISC + 8);
#define GRID_BAR() do { if (N_LAUNCHES == 1) xcd_barrier(bar); } while (0)
    const int lo = args.ph_lo, hi = args.ph_hi;
#ifndef PHASE_MASK
#define PHASE_MASK 0x7fff
#endif
#define IN(k) (((PHASE_MASK >> (k)) & 1) && lo <= (k) && (k) < hi)
#ifndef REPEAT_MASK
#define REPEAT_MASK 0
#endif
#define REP(k) (((REPEAT_MASK >> (k)) & 1) ? 2 : 1)
#define SEAM(k) do { if (IN(k) && IN((k) + 1)) GRID_BAR(); } while (0)
    const float* const* in = args.in;

    for (int rep_ = 0; rep_ < (IN(0) ? REP(0) : 0); ++rep_) { if (rep_) GRID_BAR(); p0_prologue(F, in); SEAM(0); }
    for (int rep_ = 0; rep_ < (IN(1) ? REP(1) : 0); ++rep_) { if (rep_) GRID_BAR();
        pg8::DenseOrder S; S.init((const bf16*)F.out, (const bf16*)(ws + WS_WIN), T, INW, D, F.G, (int)blockIdx.x);
        pg8::EpiInProj E{(bf16*)(ws + WS_P1), (float*)(ws + WS_VSTAT), (const float*)(ws + WS_BPERM)};
        pg8::gemm_phase<pg8::EpiInProj, pg8::DenseOrder, true>(F.lds, D, S, E);
        SEAM(1);
    }
    for (int rep_ = 0; rep_ < (IN(2) ? REP(2) : 0); ++rep_) { if (rep_) GRID_BAR(); mix_phase(F, in); SEAM(2); }
    for (int rep_ = 0; rep_ < (IN(3) ? REP(3) : 0); ++rep_) { if (rep_) GRID_BAR();
        pg8::DenseOrder S; S.init((const bf16*)(ws + WS_MERGED), (const bf16*)(ws + WS_WOUT), T, D, D, F.G, (int)blockIdx.x);
        pg8::EpiResF32<true> E{(float*)(ws + WS_Y1), in[0], (const float*)(ws + WS_XSTAT), in[2], in[3]};
        pg8::gemm_phase<pg8::EpiResF32<true>, pg8::DenseOrder, false>(F.lds, D, S, E);
        SEAM(3);
    }
    for (int rep_ = 0; rep_ < (IN(4) ? REP(4) : 0); ++rep_) { if (rep_) GRID_BAR(); ln1_phase(F, in); SEAM(4); }
    for (int rep_ = 0; rep_ < (IN(5) ? REP(5) : 0); ++rep_) { if (rep_) GRID_BAR();
        expert_convert(F, in);
        __syncthreads();
        { pg8::DenseOrder S; S.init((const bf16*)(ws + WS_X1B), (const bf16*)(ws + WS_WQ), T, MEMW, D, F.G, (int)blockIdx.x);
          pg8::EpiBf16S E{(bf16*)(ws + WS_QM), MEMW, QSCALE};
          pg8::gemm_phase<pg8::EpiBf16S, pg8::DenseOrder, false>(F.lds, D, S, E); }
        { const int c2 = ((int)blockIdx.x + F.G - 128 % F.G) % F.G;
          pg8::DenseOrder S; S.init((const bf16*)(ws + WS_MEMB), (const bf16*)(ws + WS_WKV), NBATCH * MEMLEN, 2 * MEMW, D, F.G, c2);
          pg8::EpiBf16S E{(bf16*)(ws + WS_KVM), 2 * MEMW, 1.0f};
          pg8::gemm_phase<pg8::EpiBf16S, pg8::DenseOrder, false>(F.lds, D, S, E); }
        SEAM(5);
    }
    for (int rep_ = 0; rep_ < (IN(6) ? REP(6) : 0); ++rep_) { if (rep_) GRID_BAR(); memattn_phase(F); SEAM(6); }
    for (int rep_ = 0; rep_ < (IN(7) ? REP(7) : 0); ++rep_) { if (rep_) GRID_BAR();
        pg8::DenseOrder S; S.init((const bf16*)(ws + WS_OM), (const bf16*)(ws + WS_WO), T, D, MEMW, F.G, (int)blockIdx.x);
        pg8::EpiResF32<false> E{F.out, (const float*)(ws + WS_X1F), nullptr, nullptr, nullptr};
        pg8::gemm_phase<pg8::EpiResF32<false>, pg8::DenseOrder, false>(F.lds, MEMW, S, E);
        SEAM(7);
    }
    for (int rep_ = 0; rep_ < (IN(8) ? REP(8) : 0); ++rep_) { if (rep_) GRID_BAR(); route_phase(F, in, F.ctl + ((rep_ + 1 < REP(8)) ? 2048 : CW_GCOUNT)); SEAM(8); }
    for (int rep_ = 0; rep_ < (IN(9) ? REP(9) : 0); ++rep_) { if (rep_) GRID_BAR(); slots_phase(F); SEAM(9); }
    for (int rep_ = 0; rep_ < (IN(10) ? REP(10) : 0); ++rep_) { if (rep_) GRID_BAR();
        const int nblk = (int)__builtin_amdgcn_readfirstlane(__hip_atomic_load(F.ctl + CW_HDR, RLX_AGENT));
        pg8::GateUpOrder S{(const char*)(ws + WS_X2B), (const char*)(ws + WS_WGU), (const char*)(ws + WS_WGUS), (const int*)(ws + WS_ROWTOK), F.ctl + CW_BLKE, nblk, F.G, F.vcu};
        pg8::EpiGateUp E{(bf16*)(ws + WS_H)};
        pg8::gemm_phase<pg8::EpiGateUp, pg8::GateUpOrder, true>(F.lds, D, S, E);
        SEAM(10);
    }
    for (int rep_ = 0; rep_ < (IN(11) ? REP(11) : 0); ++rep_) { if (rep_) GRID_BAR();
        const int split = (int)__builtin_amdgcn_readfirstlane(__hip_atomic_load(F.ctl + CW_HDR + 1, RLX_AGENT));
        pg8::DownOrder S{(const char*)(ws + WS_H), (const char*)(ws + WS_WD), (const char*)(ws + WS_WDS), F.ctl + CW_BLKE, 0, split, 64, F.G, F.vcu};
        pg8::EpiDown E{(bf16*)(ws + WS_YH), (const float*)(ws + WS_ROWW), 0, F.out, (const bf16*)(ws + WS_X2B)};
        pg8::gemm_phase<pg8::EpiDown, pg8::DownOrder, true>(F.lds, EH, S, E);
        SEAM(11);
    }
    if (IN(12)) { combine_phase<false>(F, in); SEAM(12); }
    for (int rep_ = 0; rep_ < (IN(13) ? REP(13) : 0); ++rep_) { if (rep_) GRID_BAR();
        const int nblk = (int)__builtin_amdgcn_readfirstlane(__hip_atomic_load(F.ctl + CW_HDR, RLX_AGENT));
        const int split = (int)__builtin_amdgcn_readfirstlane(__hip_atomic_load(F.ctl + CW_HDR + 1, RLX_AGENT));
        pg8::DownOrder S{(const char*)(ws + WS_H), (const char*)(ws + WS_WD), (const char*)(ws + WS_WDS), F.ctl + CW_BLKE, split, nblk, 0, F.G, F.vcu};
        pg8::EpiDown E{(bf16*)(ws + WS_YH), (const float*)(ws + WS_ROWW), split, F.out, (const bf16*)(ws + WS_X2B)};
        pg8::gemm_phase<pg8::EpiDown, pg8::DownOrder, true>(F.lds, EH, S, E);
        SEAM(13);
    }
    if (IN(14)) { combine_phase<true>(F, in); }
#undef IN
#undef SEAM
#undef GRID_BAR
}

extern "C" void kernel_launch(void* const* d_in, const int* in_sizes, int n_in, void* d_out, int out_size, void* d_ws, size_t ws_size, hipStream_t stream) {
    static int grid = 0;
    if (grid == 0) {
        if (n_in != 28 || in_sizes[0] != T * D || out_size != T * D || ws_size < WS_END) { fprintf(stderr, "kernel_launch: unexpected shapes / workspace (n_in %d, ws %zu < %zu)\n", n_in, ws_size, (size_t)WS_END); grid = -1; return; }
        int dev = 0, cus = 0, per_cu = 0;
        if (hipGetDevice(&dev) != hipSuccess || hipDeviceGetAttribute(&cus, hipDeviceAttributeMultiprocessorCount, dev) != hipSuccess) { grid = -1; return; }
        if (hipFuncSetAttribute((const void*)fwd_kernel, hipFuncAttributeMaxDynamicSharedMemorySize, LDS_BYTES) != hipSuccess) { fprintf(stderr, "kernel_launch: hipFuncSetAttribute failed\n"); grid = -1; return; }
        if (hipOccupancyMaxActiveBlocksPerMultiprocessor(&per_cu, (const void*)fwd_kernel, NTHREADS, LDS_BYTES) != hipSuccess || per_cu < 1) { fprintf(stderr, "kernel_launch: occupancy query reports %d\n", per_cu); }
        (void)hipGetLastError();
        grid = cus;
    }
    if (grid < 0) return;
    if (hipMemsetAsync((char*)d_ws + WS_CTL, 0, CTL_ZERO_BYTES, stream) != hipSuccess) return;
    Args a{};
    for (int i = 0; i < 28; ++i) a.in[i] = (const float*)d_in[i];
    a.out = (float*)d_out; a.ws = (unsigned char*)d_ws;
    for (int li = 0; li < N_LAUNCHES; ++li) {
        a.ph_lo = (N_LAUNCHES == 1) ? 0 : li; a.ph_hi = (N_LAUNCHES == 1) ? NPHASE : li + 1;
        hipLaunchKernelGGL(fwd_kernel, dim3(grid), dim3(NTHREADS), LDS_BYTES, stream, a);
        if (hipPeekAtLastError() != hipSuccess) { fprintf(stderr, "kernel_launch: launch %d failed\n", li); break; }
    }
}
```

```cpp
#include <hip/hip_runtime.h>
#include <cstdio>
#include <cstdint>

#ifndef MK_N_LAUNCHES
#define MK_N_LAUNCHES 1
#endif

#define GAS __attribute__((address_space(1)))
#define LAS __attribute__((address_space(3)))
typedef unsigned short bf16;
typedef short bf16x8 __attribute__((ext_vector_type(8)));
typedef short s16x4 __attribute__((ext_vector_type(4)));
typedef float f32x4 __attribute__((ext_vector_type(4)));
typedef float f32x2 __attribute__((ext_vector_type(2)));
typedef unsigned u32x4 __attribute__((ext_vector_type(4)));
typedef unsigned u32x2 __attribute__((ext_vector_type(2)));
#define RLX_AGENT __ATOMIC_RELAXED, __HIP_MEMORY_SCOPE_AGENT
#define DI __device__ __forceinline__

constexpr int T = 16384, D = 1024, NBATCH = 8, SEQ = 2048, MEMLEN = 256, INW = 7168;
constexpr int NEXP = 64, TOPK = 8, EH = 256, MEMW = 512;
constexpr float LN_EPS = 1e-5f;
constexpr float ALPHA = 1.189207115002721f;
constexpr float QSCALE = 0.08838834764831845f;
constexpr float ROUTED_SCALE = 2.5f;
constexpr float LOG2E = 1.4426950408889634f, LN2 = 0.6931471805599453f;
constexpr float SB_EXIT = -30.0f;
constexpr int NWAVES = 8, NTHREADS = 512;
constexpr int MAXBLK = 576;
constexpr int SH_ROW0 = MAXBLK * 256;

constexpr size_t MiB = 1u << 20;
constexpr size_t WS_CTL = 0, CTL_ZERO_BYTES = 32 * 1024;
constexpr size_t WS_WRHI = 1 * MiB, WS_WRLO = WS_WRHI + 128 * 1024, WS_WSP = WS_WRLO + 128 * 1024, WS_BPERM = WS_WSP + 256 * 1024, WS_XSTAT = WS_BPERM + 32 * 1024;
constexpr size_t WS_ROWTOK = 2 * MiB, WS_ROWW = WS_ROWTOK + 576 * 1024, WS_SLOT = WS_ROWW + 576 * 1024;
constexpr size_t WS_WIN = 4 * MiB, WS_WOUT = 18 * MiB, WS_WQ = 20 * MiB, WS_WKV = 21 * MiB, WS_WO = 23 * MiB, WS_MEMB = 24 * MiB;
constexpr size_t WS_P1 = 29 * MiB;
constexpr size_t WS_UG = WS_P1, WS_VA = WS_P1 + 32 * MiB, WS_Q = WS_P1 + 64 * MiB, WS_K = WS_P1 + 96 * MiB, WS_V = WS_P1 + 128 * MiB, WS_GB = WS_P1 + 160 * MiB;
constexpr size_t WS_VSTAT = 221 * MiB;
constexpr size_t WS_MERGED = 228 * MiB;
constexpr size_t WS_Y1 = 29 * MiB;
constexpr size_t WS_X1F = 93 * MiB, WS_X1B = 157 * MiB;
constexpr size_t WS_QM = 189 * MiB, WS_KVM = 205 * MiB, WS_OM = 209 * MiB;
constexpr size_t WS_WGU = 29 * MiB;
constexpr size_t WS_H = 148 * MiB;
constexpr size_t WS_X2B = 228 * MiB;
constexpr size_t WS_WD = 260 * MiB;
constexpr size_t WS_WGUS = 293 * MiB, WS_WDS = 294 * MiB;
constexpr size_t WS_TK = 295 * MiB, WS_TKW = WS_TK + 512 * 1024, WS_WGBASE = WS_TKW + 512 * 1024;
constexpr size_t WS_YH = 4 * MiB;
constexpr size_t WS_END = 297 * MiB;
static_assert(WS_XSTAT + (size_t)T * 8 <= WS_ROWTOK && WS_SLOT + (size_t)T * 8 * 4 <= WS_WIN && WS_MEMB + 4 * MiB <= WS_P1, "ws map 1");
static_assert(WS_GB + 32 * MiB <= WS_VSTAT && WS_VSTAT + 2 * MiB <= WS_MERGED && WS_H + (size_t)(SH_ROW0 + T) * 512 <= WS_X2B && WS_X2B + 32 * MiB <= WS_WD, "ws map 2");
static_assert(WS_WD + (size_t)64 * 1024 * 256 * 2 <= WS_WGUS && WS_YH + (size_t)288 * 256 * 2048 <= WS_H && WS_WGBASE + 256 * 64 * 4 <= WS_END, "ws map 3");
constexpr int CW_TMO = 0, CW_CODE = 1;
constexpr int CW_GCOUNT = 64;
constexpr int CW_HDR = 192;
constexpr int CW_BLKE = 256;
constexpr int CW_BAR = 4096;

constexpr int SCR_BYTES = 140 * 1024;
constexpr int MISC_OFF = SCR_BYTES;
constexpr int LDS_BYTES = 144 * 1024;

DI unsigned cvt_pk_bf16(float lo, float hi) { unsigned r; asm volatile("v_cvt_pk_bf16_f32 %0, %1, %2" : "=v"(r) : "v"(lo), "v"(hi)); return r; }
DI float bf2f(unsigned short h) { return __uint_as_float((unsigned)h << 16); }
DI float bflo(unsigned w) { return __uint_as_float(w << 16); }
DI float bfhi(unsigned w) { return __uint_as_float(w & 0xffff0000u); }
DI float fast_exp2(float x) { return __builtin_amdgcn_exp2f(x); }
DI float fast_log2(float x) { return __builtin_amdgcn_logf(x); }
DI float fast_rcp(float x) { return __builtin_amdgcn_rcpf(x); }
DI float sigmoidf_(float x) { return fast_rcp(1.0f + fast_exp2(-x * LOG2E)); }
template <int CTRL, int ROWMASK> DI float dpp_f(float v, float fill) { return __uint_as_float((unsigned)__builtin_amdgcn_update_dpp((int)__float_as_uint(fill), (int)__float_as_uint(v), CTRL, ROWMASK, 0xf, false)); }
DI float wave_sum(float v) {
    v += dpp_f<0x111, 0xf>(v, 0.f); v += dpp_f<0x112, 0xf>(v, 0.f); v += dpp_f<0x114, 0xf>(v, 0.f); v += dpp_f<0x118, 0xf>(v, 0.f);
    v += dpp_f<0x142, 0xa>(v, 0.f); v += dpp_f<0x143, 0xc>(v, 0.f);
    return __uint_as_float(__builtin_amdgcn_readlane(__float_as_uint(v), 63));
}
DI float wave_max(float v) {
#pragma unroll
    for (int o = 1; o < 64; o <<= 1) v = fmaxf(v, __shfl_xor(v, o));
    return v;
}
#define LDS_WAIT() asm volatile("s_waitcnt lgkmcnt(0)" ::: "memory")
#define VM_WAIT() asm volatile("s_waitcnt vmcnt(0)" ::: "memory")

namespace pg8 {
constexpr int BM = 256, BK = 64, HALF = 128, HTB = HALF * BK * 2, STAGE_BYTES = 8 * HTB, NXCD = 8, WGM = 8;
__host__ __device__ __forceinline__ int lds_byte(int r, int c) { const int st = (r >> 4) * 2 + (c >> 5), rr = r & 15, cc = c & 31, ob = rr * 64 + cc * 2; return st * 1024 + (ob ^ (((ob >> 9) & 1) << 5)); }
__host__ __device__ __forceinline__ void stage_rc(int b, int& R, int& C) { const int st = b / 1024, sb = b % 1024, swz = sb ^ (((sb >> 9) & 1) << 5); R = (st >> 1) * 16 + swz / 64; C = (st & 1) * 32 + (swz % 64) / 2; }
__host__ __device__ __forceinline__ int perm32(int rho) { const int n = rho >> 4, i = rho & 15; return 8 * (i >> 2) + 4 * n + (i & 3); }

struct Unit { int pm, pn, e, ui; const char* A; const char* B; };

typedef float f32x2v __attribute__((ext_vector_type(2)));
DI f32x2v gelu_pk(f32x2v v) {
    const f32x2v av = __builtin_elementwise_abs(v), d = av * 0.2316418882f + 1.0f;
    f32x2v t; t.x = __builtin_amdgcn_rcpf(d.x); t.y = __builtin_amdgcn_rcpf(d.y);
    f32x2v q = t * 0.5307027145f + (-0.7265760135f); q = q * t + 0.7107068705f; q = q * t + (-0.142248368f); q = q * t + 0.127414796f; q = q * t;
    const f32x2v s = (v * v) * (-0.72134752044f);
    f32x2v e; e.x = __builtin_amdgcn_exp2f(s.x); e.y = __builtin_amdgcn_exp2f(s.y);
    const f32x2v m = v * (q * e), r = v - m;
    f32x2v o; o.x = v.x < 0.f ? m.x : r.x; o.y = v.y < 0.f ? m.y : r.y; return o;
}
DI f32x4 gelu4(f32x4 v) { const f32x2v a = gelu_pk((f32x2v){v[0], v[1]}), b = gelu_pk((f32x2v){v[2], v[3]}); return (f32x4){a.x, a.y, b.x, b.y}; }
DI f32x4 sigmoid4(f32x4 v) { return (f32x4){sigmoidf_(v[0]), sigmoidf_(v[1]), sigmoidf_(v[2]), sigmoidf_(v[3])}; }
DI u32x4 pack8(f32x4 v0, f32x4 v1) { u32x4 w; w.x = cvt_pk_bf16(v0[0], v0[1]); w.y = cvt_pk_bf16(v0[2], v0[3]); w.z = cvt_pk_bf16(v1[0], v1[1]); w.w = cvt_pk_bf16(v1[2], v1[3]); return w; }

template <class Epi, class Sched, bool ALIGN_EPI>
DI void gemm_phase(LAS unsigned char* lds, const int K, const Sched& S, const Epi& E) {
    const int tid = threadIdx.x, wid = __builtin_amdgcn_readfirstlane(tid >> 6), lane = tid & 63, wr = wid >> 2, wc = wid & 3, fr = lane & 15, fq = lane >> 4;
    const int nt = K / BK;
    int Rr[2], Cc[2]; unsigned voffB[2], voffB1[2];
#pragma unroll
    for (int i = 0; i < 2; ++i) { int R, C; stage_rc(tid * 16 + i * 8192, R, C); Rr[i] = R; Cc[i] = C;
        if (Epi::PERM == 2) { const int w0 = 64 * (R >> 5) + 16 * ((R & 15) >> 2) + 4 * ((R >> 4) & 1) + (R & 3); voffB[i] = (unsigned)(w0 * K + C) * 2u; voffB1[i] = (unsigned)((w0 + 8) * K + C) * 2u; }
        else { const int Rb = Epi::PERM ? ((R & ~31) + perm32(R & 31)) : R; voffB[i] = (unsigned)(Rb * K + C) * 2u; voffB1[i] = (unsigned)((Rb + HALF) * K + C) * 2u; } }
    const size_t kstep = (size_t)(BK * 2);
    const unsigned ldsw = (unsigned)wid * 1024u;
    const int aoff = lds_byte(wr * 64 + fr, fq * 8), boff = lds_byte(wc * 32 + fr, fq * 8);
#define PG8_SA(b, h) (((b) * 2 + (h)) * HTB)
#define PG8_SB(b, h) ((4 + (b) * 2 + (h)) * HTB)
#define PG8_STAGE_B(bufoff, gbase) do { _Pragma("unroll") for (int _i = 0; _i < 2; ++_i) \
        __builtin_amdgcn_global_load_lds((const unsigned*)((const char*)(gbase) + voffB[_i]), (LAS unsigned*)(lds + (bufoff) + ldsw + _i * 8192), 16, 0, 0); } while (0)
#define PG8_STAGE_B1(bufoff, gbase) do { _Pragma("unroll") for (int _i = 0; _i < 2; ++_i) \
        __builtin_amdgcn_global_load_lds((const unsigned*)((const char*)(gbase) + voffB1[_i]), (LAS unsigned*)(lds + (bufoff) + ldsw + _i * 8192), 16, 0, 0); } while (0)
#define PG8_STAGE_A(bufoff, gbase, o0, o1) do { \
        __builtin_amdgcn_global_load_lds((const unsigned*)((const char*)(gbase) + (o0)), (LAS unsigned*)(lds + (bufoff) + ldsw), 16, 0, 0); \
        __builtin_amdgcn_global_load_lds((const unsigned*)((const char*)(gbase) + (o1)), (LAS unsigned*)(lds + (bufoff) + ldsw + 8192), 16, 0, 0); } while (0)
#define PG8_LDA(dst, b, h) do { _Pragma("unroll") for (int m = 0; m < 4; ++m) _Pragma("unroll") for (int k = 0; k < 2; ++k) dst[m][k] = *(const LAS bf16x8*)(lds + PG8_SA(b, h) + aoff + m * 2048 + k * 1024); } while (0)
#define PG8_LDB(dst, b, h) do { _Pragma("unroll") for (int n = 0; n < 2; ++n) _Pragma("unroll") for (int k = 0; k < 2; ++k) dst[n][k] = *(const LAS bf16x8*)(lds + PG8_SB(b, h) + boff + n * 2048 + k * 1024); } while (0)
#define PG8_MMA(ai, bj, At, Bt) do { __builtin_amdgcn_s_setprio(1); _Pragma("unroll") for (int m = 0; m < 4; ++m) _Pragma("unroll") for (int n = 0; n < 2; ++n) _Pragma("unroll") for (int k = 0; k < 2; ++k) \
        acc[ai][bj][m][n] = __builtin_amdgcn_mfma_f32_16x16x32_bf16(Bt[n][k], At[m][k], acc[ai][bj][m][n], 0, 0, 0); __builtin_amdgcn_s_setprio(0); } while (0)
#define PG8_WAIT_V(n) asm volatile("s_waitcnt vmcnt(" #n ")" ::: "memory")
#define PG8_WAIT_L(n) asm volatile("s_waitcnt lgkmcnt(" #n ")" ::: "memory")
#define PG8_BAR __builtin_amdgcn_s_barrier()
#define PG8_SCHED __builtin_amdgcn_sched_barrier(0)
    Unit cur, nxt; int ui = 0;
    if (!S.next(0, cur)) return;
    unsigned oc[2][2], on[2][2];
    S.a_offs(cur, Rr, Cc, K, oc);
    f32x4 acc[2][2][4][2];
#pragma unroll
    for (int a = 0; a < 2; ++a)
#pragma unroll
        for (int b = 0; b < 2; ++b)
#pragma unroll
            for (int m = 0; m < 4; ++m)
#pragma unroll
                for (int n = 0; n < 2; ++n) acc[a][b][m][n] = (f32x4){0.f, 0.f, 0.f, 0.f};
    bf16x8 At[4][2], B0[2][2], B1[2][2];
    const char* cA = cur.A; const char* cB = cur.B;
    PG8_STAGE_B(PG8_SB(0, 0), cB); PG8_STAGE_B1(PG8_SB(0, 1), cB); PG8_STAGE_A(PG8_SA(0, 0), cA, oc[0][0], oc[0][1]); PG8_STAGE_A(PG8_SA(0, 1), cA, oc[1][0], oc[1][1]);
    if (wr == 1) PG8_BAR;
    PG8_WAIT_V(2); PG8_BAR;
    PG8_STAGE_B(PG8_SB(1, 0), cB + kstep); PG8_STAGE_A(PG8_SA(1, 0), cA + kstep, oc[0][0], oc[0][1]); PG8_STAGE_B1(PG8_SB(1, 1), cB + kstep);
    PG8_WAIT_V(6); PG8_BAR;
    for (;;) {
        const bool has_next = S.next(ui + 1, nxt);
        const char* nA = has_next ? nxt.A : cA; const char* nB = has_next ? nxt.B : cB;
        if (has_next) S.a_offs(nxt, Rr, Cc, K, on);
        else {
#pragma unroll
            for (int h = 0; h < 2; ++h)
#pragma unroll
                for (int i = 0; i < 2; ++i) on[h][i] = oc[h][i]; }
#pragma unroll 1
        for (int t = 0; t < nt; t += 2) {
            const bool last = (t == nt - 2);
            const char* a1 = cA + (size_t)(t + 1) * kstep;
            const char* a2 = last ? nA : cA + (size_t)(t + 2) * kstep; const char* b2 = last ? nB : cB + (size_t)(t + 2) * kstep;
            const char* a3 = a2 + kstep; const char* b3 = b2 + kstep;
            const unsigned x00 = last ? on[0][0] : oc[0][0], x01 = last ? on[0][1] : oc[0][1], x10 = last ? on[1][0] : oc[1][0], x11 = last ? on[1][1] : oc[1][1];
            PG8_LDB(B0, 0, 0); PG8_LDB(B1, 0, 1); PG8_SCHED; PG8_LDA(At, 0, 0); PG8_STAGE_A(PG8_SA(1, 1), a1, oc[1][0], oc[1][1]);
            PG8_WAIT_V(8); PG8_WAIT_L(0); PG8_BAR; PG8_MMA(0, 0, At, B0); PG8_MMA(0, 1, At, B1); PG8_BAR; PG8_SCHED;
            PG8_LDA(At, 0, 1); PG8_STAGE_B(PG8_SB(0, 0), b2); PG8_STAGE_B1(PG8_SB(0, 1), b2); PG8_STAGE_A(PG8_SA(0, 0), a2, x00, x01);
            PG8_WAIT_V(8); PG8_WAIT_L(0); PG8_BAR; PG8_MMA(1, 0, At, B0); PG8_MMA(1, 1, At, B1); PG8_BAR; PG8_SCHED;
            PG8_LDB(B0, 1, 0); PG8_LDB(B1, 1, 1); PG8_SCHED; PG8_LDA(At, 1, 0); PG8_STAGE_A(PG8_SA(0, 1), a2, x10, x11);
            PG8_WAIT_V(8); PG8_WAIT_L(0); PG8_BAR; PG8_MMA(0, 0, At, B0); PG8_MMA(0, 1, At, B1); PG8_BAR; PG8_SCHED;
            PG8_LDA(At, 1, 1); PG8_STAGE_B(PG8_SB(1, 0), b3); PG8_STAGE_B1(PG8_SB(1, 1), b3); PG8_STAGE_A(PG8_SA(1, 0), a3, x00, x01);
            PG8_WAIT_V(8); PG8_WAIT_L(0); PG8_BAR; PG8_MMA(1, 0, At, B0); PG8_MMA(1, 1, At, B1); PG8_BAR; PG8_SCHED;
        }
        if constexpr (ALIGN_EPI) { if (wr == 0) PG8_BAR; }
        E(acc, cur, wr, wc, fr, fq);
        if (!has_next) break;
#pragma unroll
        for (int a = 0; a < 2; ++a)
#pragma unroll
            for (int b = 0; b < 2; ++b)
#pragma unroll
                for (int m = 0; m < 4; ++m)
#pragma unroll
                    for (int n = 0; n < 2; ++n) acc[a][b][m][n] = (f32x4){0.f, 0.f, 0.f, 0.f};
        cur = nxt; cA = nA; cB = nB; ++ui;
#pragma unroll
        for (int h = 0; h < 2; ++h)
#pragma unroll
            for (int i = 0; i < 2; ++i) oc[h][i] = on[h][i];
        if constexpr (ALIGN_EPI) { if (wr == 1) PG8_BAR; }
    }
    PG8_WAIT_V(0);
    if constexpr (!ALIGN_EPI) { if (wr == 0) PG8_BAR; }
    PG8_BAR;
#undef PG8_SA
#undef PG8_SB
#undef PG8_STAGE_A
#undef PG8_STAGE_B
#undef PG8_STAGE_B1
#undef PG8_LDA
#undef PG8_LDB
#undef PG8_MMA
#undef PG8_WAIT_V
#undef PG8_WAIT_L
#undef PG8_BAR
#undef PG8_SCHED
}

struct DenseOrder {
    const char* A; const char* Bt; int K, nM, nN, nwg, G, c;
    DI void init(const bf16* A_, const bf16* Bt_, int M, int N, int K_, int G_, int c_) { A = (const char*)A_; Bt = (const char*)Bt_; K = K_; nM = M / BM; nN = N / BM; nwg = nM * nN; G = G_; c = c_; }
    DI bool next(int i, Unit& u) const {
        const long L = (long)i * G + c; if (L >= nwg) return false;
        int wgid = (int)L; { const int q = nwg / NXCD, r = nwg % NXCD, xcd = wgid % NXCD, off = wgid / NXCD; wgid = (xcd < r ? xcd * (q + 1) : r * (q + 1) + (xcd - r) * q) + off; }
        const int nig = WGM * nN, gid = wgid / nig, fm = gid * WGM, gsz = (nM - fm) < WGM ? (nM - fm) : WGM;
        u.pm = fm + ((wgid % nig) % gsz); u.pn = (wgid % nig) / gsz; u.e = 0; u.ui = i;
        u.A = A + (size_t)u.pm * BM * K * 2; u.B = Bt + (size_t)u.pn * BM * K * 2; return true;
    }
    DI void a_offs(const Unit&, const int (&R)[2], const int (&C)[2], int K_, unsigned (&off)[2][2]) const {
#pragma unroll
        for (int h = 0; h < 2; ++h)
#pragma unroll
            for (int i = 0; i < 2; ++i) off[h][i] = (unsigned)((h * HALF + R[i]) * K_ + C[i]) * 2u;
    }
};
}

#define XB_TMO      128
#define XB_XCNT(j)  (256  + 64 * (j))
#define XB_XSUB(j)  (1280 + 64 * (j))
#define XB_XGEN(j)  (2304 + 64 * (j))
#define XB_TOP      3328
#define XB_TOPGEN   3392
#define XCD_BAR_WORDS 3456
#define XB_SPIN_CAP (1u << 18)
DI unsigned xb_ld(unsigned* p)              { return __hip_atomic_load(p, __ATOMIC_RELAXED, __HIP_MEMORY_SCOPE_AGENT); }
DI unsigned xb_add(unsigned* p, unsigned v) { return __hip_atomic_fetch_add(p, v, __ATOMIC_RELAXED, __HIP_MEMORY_SCOPE_AGENT); }
DI unsigned xb_xcc_id() { return (unsigned)__builtin_amdgcn_s_getreg((3 << 11) | 20) & 0xFu; }
#define XB_SPIN(cond, bar) do { unsigned _sp = 0; while (cond) { __builtin_amdgcn_s_sleep(1); \
    if ((++_sp & 255u) == 0u) { if (xb_ld(&(bar)[XB_TMO])) break; if (_sp > XB_SPIN_CAP) { atomicAdd(&(bar)[XB_TMO], 1u); break; } } } } while (0)
struct XcdBarrier { unsigned* bar; unsigned x; volatile LAS unsigned* st; };
DI XcdBarrier xcd_barrier_post(unsigned* bar, volatile LAS unsigned* st) {
    XcdBarrier b; b.bar = bar; b.x = xb_xcc_id(); b.st = st;
    if (threadIdx.x == 0) (void)xb_add(&bar[XB_XCNT(b.x)], 1u);
    return b;
}
DI void xcd_barrier_complete(unsigned* bar, unsigned x, unsigned& nloc, unsigned& nx) {
    const unsigned G = gridDim.x * gridDim.y * gridDim.z;
    unsigned sum, cnt, mine, sp = 0u;
    for (;;) {
        sum = 0u; cnt = 0u; mine = 0u;
#pragma unroll
        for (unsigned j = 0; j < 16; ++j) { const unsigned c = xb_ld(&bar[XB_XCNT(j)]); sum += c; cnt += (c > 0u) ? 1u : 0u; mine = (j == x) ? c : mine; }
        if (sum == G) break;
        __builtin_amdgcn_s_sleep(1);
        if ((++sp & 255u) == 0u) { if (xb_ld(&bar[XB_TMO])) break; if (sp > XB_SPIN_CAP) { atomicAdd(&bar[XB_TMO], 1u); break; } }
    }
    nloc = mine > 0u ? mine : 1u; nx = cnt > 0u ? cnt : 1u;
}
DI void xcd_barrier(const XcdBarrier& b) {
    asm volatile("s_waitcnt vmcnt(0)" ::: "memory");
    __syncthreads();
    if (threadIdx.x == 0) {
        unsigned* bar = b.bar;
        __builtin_amdgcn_s_waitcnt(0);
        unsigned nloc = b.st[0], nx = b.st[1];
        if (nloc == 0u) { xcd_barrier_complete(bar, b.x, nloc, nx); b.st[0] = nloc; b.st[1] = nx; }
        const unsigned old = xb_add(&bar[XB_XSUB(b.x)], 1u);
        const unsigned gen = old / nloc;
        if (old + 1u == (gen + 1u) * nloc) {
            __builtin_amdgcn_fence(__ATOMIC_RELEASE, "agent");
            asm volatile("s_waitcnt vmcnt(0)" ::: "memory");
            const unsigned og = xb_add(&bar[XB_TOP], 1u);
            const unsigned tg = og / nx;
            if (og + 1u == (tg + 1u) * nx) xb_add(&bar[XB_TOPGEN], 1u);
            else XB_SPIN(xb_ld(&bar[XB_TOPGEN]) == tg, bar);
            __builtin_amdgcn_fence(__ATOMIC_ACQUIRE, "agent");
            xb_add(&bar[XB_XGEN(b.x)], 1u);
            asm volatile("s_waitcnt vmcnt(0)" ::: "memory");
        } else {
            XB_SPIN(xb_ld(&bar[XB_XGEN(b.x)]) == gen, bar);
            __builtin_amdgcn_fence(__ATOMIC_ACQUIRE, "agent");
            asm volatile("s_waitcnt vmcnt(0)" ::: "memory");
        }
    }
    __syncthreads();
}

namespace pg8 {
typedef __bf16 bf16x2_t __attribute__((ext_vector_type(2)));
DI unsigned pk2(float lo, float hi) { f32x2v v = {lo, hi}; bf16x2_t b = __builtin_convertvector(v, bf16x2_t); return __builtin_bit_cast(unsigned, b); }
DI u32x4 pk8(f32x4 v0, f32x4 v1) { u32x4 w; w.x = pk2(v0[0], v0[1]); w.y = pk2(v0[2], v0[3]); w.z = pk2(v1[0], v1[1]); w.w = pk2(v1[2], v1[3]); return w; }

DI unsigned dpp_ror8(unsigned v) { return (unsigned)__builtin_amdgcn_mov_dpp((int)v, 0x128, 0xf, 0xf, false); }
DI void store_rows16(unsigned char* rowp, size_t ldb, u32x4 P0, u32x4 P1, int fr) {
    const bool hi = fr >= 8;
    const u32x4 give = hi ? P0 : P1;
    u32x4 recv; recv.x = dpp_ror8(give.x); recv.y = dpp_ror8(give.y); recv.z = dpp_ror8(give.z); recv.w = dpp_ror8(give.w);
    unsigned char* pa = rowp + (size_t)(fr & 7) * ldb + (hi ? 16 : 0);
    *(u32x4*)pa = hi ? recv : P0;
    *(u32x4*)(pa + 8 * ldb) = hi ? P1 : recv;
}
struct EpiInProj {
    static constexpr int PERM = 2;
    bf16* P1; float* vstat; const float* bias;
    DI void operator()(const f32x4 (&acc)[2][2][4][2], const Unit& u, int wr, int wc, int fr, int fq) const {
        const int rg0 = u.pm * BM + wr * 64;
        const int bcol0 = u.pn * BM + wc * 64 + 16 * fq;
        f32x4 bv[2][2];
#pragma unroll
        for (int bj = 0; bj < 2; ++bj)
#pragma unroll
            for (int n = 0; n < 2; ++n) bv[bj][n] = *(const f32x4*)(bias + bcol0 + 8 * bj + 4 * n);
        if (u.pn < 8) {
            bf16* base = P1 + u.pn * 128 + wc * 32 + 8 * fq;
#pragma unroll
            for (int ai = 0; ai < 2; ++ai)
#pragma unroll
                for (int m = 0; m < 4; ++m) {
                    f32x4 u0 = gelu4(acc[ai][0][m][0] + bv[0][0]), u1 = gelu4(acc[ai][0][m][1] + bv[0][1]);
                    const f32x4 g0 = sigmoid4(acc[ai][1][m][0] + bv[1][0]), g1 = sigmoid4(acc[ai][1][m][1] + bv[1][1]);
                    u0 = u0 * g0; u1 = u1 * g1;
                    *(u32x4*)(base + (size_t)(rg0 + ai * HALF + m * 16 + fr) * D) = pk8(u0, u1);
                }
        } else {
            const int t = (u.pn - 8) >> 2, colt = ((u.pn - 8) & 3) * BM;
            bf16* base = P1 + (size_t)(t + 1) * T * D + colt + wc * 64 + 16 * fq;
#pragma unroll
            for (int ai = 0; ai < 2; ++ai)
#pragma unroll
                for (int m = 0; m < 4; ++m) {
                    float s1 = 0.f, s2 = 0.f; u32x4 P[2];
#pragma unroll
                    for (int bj = 0; bj < 2; ++bj) {
                        f32x4 v0 = acc[ai][bj][m][0] + bv[bj][0], v1 = acc[ai][bj][m][1] + bv[bj][1];
                        if (t == 0) { v0 = gelu4(v0); v1 = gelu4(v1);
                            s1 += (v0[0] + v0[1]) + (v0[2] + v0[3]) + (v1[0] + v1[1]) + (v1[2] + v1[3]);
                            s2 += (v0[0] * v0[0] + v0[1] * v0[1]) + (v0[2] * v0[2] + v0[3] * v0[3]) + (v1[0] * v1[0] + v1[1] * v1[1]) + (v1[2] * v1[2] + v1[3] * v1[3]); }
                        else if (t == 1) { v0 = v0 * (QSCALE * LOG2E); v1 = v1 * (QSCALE * LOG2E); }
                        else if (t == 4) { v0 = sigmoid4(v0); v1 = sigmoid4(v1); }
                        P[bj] = pk8(v0, v1);
                    }
                    store_rows16((unsigned char*)(base + (size_t)(rg0 + ai * HALF + m * 16) * D), (size_t)D * 2, P[0], P[1], fr);
                    if (t == 0) {
                        s1 += __shfl_xor(s1, 16); s1 += __shfl_xor(s1, 32); s2 += __shfl_xor(s2, 16); s2 += __shfl_xor(s2, 32);
                        if (fq == 0) *(f32x2v*)(vstat + ((size_t)(rg0 + ai * HALF + m * 16 + fr) * 16 + (u.pn - 8) * 4 + wc) * 2) = (f32x2v){s1, s2};
                    }
                }
        }
    }
};
struct EpiBf16S {
    static constexpr int PERM = 2;
    bf16* O; int ldc; float scale;
    DI void operator()(const f32x4 (&acc)[2][2][4][2], const Unit& u, int wr, int wc, int fr, int fq) const {
        const int rg0 = u.pm * BM + wr * 64, col0 = u.pn * BM + wc * 64 + 16 * fq;
#pragma unroll
        for (int ai = 0; ai < 2; ++ai)
#pragma unroll
            for (int m = 0; m < 4; ++m)
                store_rows16((unsigned char*)(O + (size_t)(rg0 + ai * HALF + m * 16) * ldc + col0), (size_t)ldc * 2,
                             pk8(acc[ai][0][m][0] * scale, acc[ai][0][m][1] * scale), pk8(acc[ai][1][m][0] * scale, acc[ai][1][m][1] * scale), fr);
    }
};
template <bool LNIN> struct EpiResF32 {
    static constexpr int PERM = 0;
    float* out; const float* res; const float* xstat; const float* g; const float* b;
    DI void operator()(const f32x4 (&acc)[2][2][4][2], const Unit& u, int wr, int wc, int fr, int fq) const {
        const int col0 = u.pn * BM + wc * 32 + 4 * fq;
        f32x4 gv[2][2], bv[2][2];
        if (LNIN) {
#pragma unroll
            for (int bj = 0; bj < 2; ++bj)
#pragma unroll
                for (int n = 0; n < 2; ++n) { gv[bj][n] = *(const f32x4*)(g + col0 + bj * HALF + n * 16); bv[bj][n] = *(const f32x4*)(b + col0 + bj * HALF + n * 16); }
        }
#pragma unroll
        for (int ai = 0; ai < 2; ++ai)
#pragma unroll
            for (int m = 0; m < 4; ++m) {
                const int rg = u.pm * BM + ai * HALF + wr * 64 + m * 16, row = rg + fr; const size_t off = (size_t)row * D + col0;
                f32x2v st = (f32x2v){0.f, 1.f}; if (LNIN) st = *(const f32x2v*)(xstat + 2 * (size_t)row);
#pragma unroll
                for (int bj = 0; bj < 2; ++bj) { f32x4 o[2];
#pragma unroll
                    for (int n = 0; n < 2; ++n) { f32x4 r = *(const f32x4*)(res + off + bj * HALF + n * 16);
                        if (LNIN) r = (r - st.x) * st.y * gv[bj][n] + bv[bj][n];
                        o[n] = r * ALPHA + acc[ai][bj][m][n]; }
                    const bool hi = fr >= 8; const f32x4 give = hi ? o[0] : o[1];
                    u32x4 gi = __builtin_bit_cast(u32x4, give), rc; rc.x = dpp_ror8(gi.x); rc.y = dpp_ror8(gi.y); rc.z = dpp_ror8(gi.z); rc.w = dpp_ror8(gi.w);
                    const f32x4 recv = __builtin_bit_cast(f32x4, rc);
                    float* pa = out + (size_t)(rg + (fr & 7)) * D + col0 + bj * HALF + (hi ? 16 : 0);
                    *(f32x4*)pa = hi ? recv : o[0];
                    *(f32x4*)(pa + 8 * D) = hi ? o[1] : recv; }
                if (m & 1) asm volatile("" ::: "memory");
            }
    }
};
template <bool LNIN> struct EpiResB16 {
    static constexpr int PERM = 2;
    bf16* out; const float* resf; const bf16* resb; const float* xstat; const float* g; const float* b;
    DI void operator()(const f32x4 (&acc)[2][2][4][2], const Unit& u, int wr, int wc, int fr, int fq) const {
        const int col0 = u.pn * BM + wc * 64 + 16 * fq;
        f32x4 gv[2][2], bv[2][2];
        if (LNIN) {
#pragma unroll
            for (int bj = 0; bj < 2; ++bj)
#pragma unroll
                for (int n = 0; n < 2; ++n) { gv[bj][n] = *(const f32x4*)(g + col0 + 8 * bj + 4 * n); bv[bj][n] = *(const f32x4*)(b + col0 + 8 * bj + 4 * n); }
        }
#pragma unroll
        for (int ai = 0; ai < 2; ++ai)
#pragma unroll
            for (int m = 0; m < 4; ++m) {
                const int rg = u.pm * BM + ai * HALF + wr * 64 + m * 16, row = rg + fr; const size_t off = (size_t)row * D + col0;
                f32x4 rr[2][2];
                if (LNIN) { const f32x2v st = *(const f32x2v*)(xstat + 2 * (size_t)row);
#pragma unroll
                    for (int bj = 0; bj < 2; ++bj)
#pragma unroll
                        for (int n = 0; n < 2; ++n) rr[bj][n] = (*(const f32x4*)(resf + off + 8 * bj + 4 * n) - st.x) * st.y * gv[bj][n] + bv[bj][n];
                } else {
#pragma unroll
                    for (int bj = 0; bj < 2; ++bj) { const u32x4 x = *(const u32x4*)(resb + off + 8 * bj);
                        rr[bj][0] = (f32x4){bflo(x.x), bfhi(x.x), bflo(x.y), bfhi(x.y)}; rr[bj][1] = (f32x4){bflo(x.z), bfhi(x.z), bflo(x.w), bfhi(x.w)}; } }
                store_rows16((unsigned char*)(out + (size_t)rg * D + col0), (size_t)D * 2,
                             pk8(rr[0][0] * ALPHA + acc[ai][0][m][0], rr[0][1] * ALPHA + acc[ai][0][m][1]), pk8(rr[1][0] * ALPHA + acc[ai][1][m][0], rr[1][1] * ALPHA + acc[ai][1][m][1]), fr);
                if (m & 1) asm volatile("" ::: "memory");
            }
    }
};
constexpr int MO_BLKE = 128 * 1024, MO_RT = MO_BLKE + 640, MO_RW = MO_RT + 5 * 1024, MO_END = MO_RW + 5 * 1024;
static_assert(MO_END <= SCR_BYTES, "MoE LDS tables");
struct EpiGateUp {
    static constexpr int PERM = 1;
    bf16* H; const LAS unsigned char* lds;
    DI void operator()(const f32x4 (&acc)[2][2][4][2], const Unit& u, int wr, int wc, int fr, int fq) const {
        const int rl = wr * 64 + fr, row0 = u.pm * BM + rl, col0 = u.pn * 128 + wc * 32 + 8 * fq;
        float wv[2][4];
#pragma unroll
        for (int ai = 0; ai < 2; ++ai)
#pragma unroll
            for (int m = 0; m < 4; ++m) wv[ai][m] = (u.e < 64) ? *(const LAS float*)(lds + MO_RW + (u.ui * 256 + rl + ai * HALF + m * 16) * 4) : 1.0f;
#pragma unroll
        for (int ai = 0; ai < 2; ++ai)
#pragma unroll
            for (int m = 0; m < 4; ++m) {
                const f32x4 g0 = acc[ai][0][m][0], g1 = acc[ai][0][m][1];
                const f32x4 h0 = g0 * sigmoid4(g0) * acc[ai][1][m][0] * wv[ai][m], h1 = g1 * sigmoid4(g1) * acc[ai][1][m][1] * wv[ai][m];
                *(u32x4*)(H + (size_t)(row0 + ai * HALF + m * 16) * EH + col0) = pk8(h0, h1);
            }
    }
};
constexpr float Y8_SCALE = 32.0f, Y8_CLAMP = 440.0f;
DI unsigned pk4_fp8(f32x4 v) { v = v * Y8_SCALE;
    const float a = __builtin_fminf(__builtin_fmaxf(v[0], -Y8_CLAMP), Y8_CLAMP), b = __builtin_fminf(__builtin_fmaxf(v[1], -Y8_CLAMP), Y8_CLAMP), c = __builtin_fminf(__builtin_fmaxf(v[2], -Y8_CLAMP), Y8_CLAMP), d = __builtin_fminf(__builtin_fmaxf(v[3], -Y8_CLAMP), Y8_CLAMP);
    int p = __builtin_amdgcn_cvt_pk_fp8_f32(a, b, 0, false); p = __builtin_amdgcn_cvt_pk_fp8_f32(c, d, p, true); return (unsigned)p; }
struct EpiDown {
    static constexpr int PERM = 2;
    unsigned char* Y8; bf16* xb; int nostore;
    DI void operator()(const f32x4 (&acc)[2][2][4][2], const Unit& u, int wr, int wc, int fr, int fq) const {
        if (nostore) return;
        const int rl = wr * 64 + fr, col0 = u.pn * BM + wc * 64 + 16 * fq;
        if (u.e < 64) {
#pragma unroll
            for (int ai = 0; ai < 2; ++ai)
#pragma unroll
                for (int m = 0; m < 4; ++m) { const int r = rl + ai * HALF + m * 16;
                    u32x4 w; w.x = pk4_fp8(acc[ai][0][m][0]); w.y = pk4_fp8(acc[ai][0][m][1]); w.z = pk4_fp8(acc[ai][1][m][0]); w.w = pk4_fp8(acc[ai][1][m][1]);
                    __builtin_nontemporal_store(w, (u32x4*)(Y8 + ((size_t)u.pm * BM + r) * D + col0)); }
        } else {
#pragma unroll
            for (int ai = 0; ai < 2; ++ai) {
                u32x4 xr[4][2];
#pragma unroll
                for (int m = 0; m < 4; ++m)
#pragma unroll
                    for (int bj = 0; bj < 2; ++bj) xr[m][bj] = *(const u32x4*)(xb + ((size_t)(u.pm - SH_ROW0 / BM) * BM + rl + ai * HALF + m * 16) * D + col0 + 8 * bj);
#pragma unroll
                for (int m = 0; m < 4; ++m) { const size_t off = ((size_t)(u.pm - SH_ROW0 / BM) * BM + rl + ai * HALF + m * 16) * D + col0;
#pragma unroll
                    for (int bj = 0; bj < 2; ++bj) { const u32x4 x = xr[m][bj];
                        const f32x4 x0 = (f32x4){bflo(x.x), bfhi(x.x), bflo(x.y), bfhi(x.y)}, x1 = (f32x4){bflo(x.z), bfhi(x.z), bflo(x.w), bfhi(x.w)};
                        *(u32x4*)(xb + off + 8 * bj) = pk8(x0 * ALPHA + acc[ai][bj][m][0], x1 * ALPHA + acc[ai][bj][m][1]); } }
                asm volatile("" ::: "memory"); }
        }
    }
};
struct GateUpOrder {
    const char* X; const char* Wgu; const char* Wgus; const LAS unsigned char* lds; int nblk, G, c;
    DI bool next(int i, Unit& u) const {
        const int L = i * G + c; if (L >= (nblk + 64) * 2) return false;
        const int bl = L >> 1; u.pn = L & 1; u.ui = i;
        if (bl < nblk) { u.e = (int)__builtin_amdgcn_readfirstlane((int)*(const LAS unsigned char*)(lds + MO_BLKE + bl)); u.pm = bl; u.A = X; u.B = Wgu + ((size_t)u.e * 512 + u.pn * 256) * D * 2; }
        else { u.e = 64; u.pm = SH_ROW0 / BM + (bl - nblk); u.A = X + (size_t)(bl - nblk) * BM * D * 2; u.B = Wgus + (size_t)u.pn * 256 * D * 2; }
        return true;
    }
    DI void a_offs(const Unit& u, const int (&R)[2], const int (&C)[2], int K_, unsigned (&off)[2][2]) const {
        if (u.e < 64) {
#pragma unroll
            for (int h = 0; h < 2; ++h)
#pragma unroll
                for (int i = 0; i < 2; ++i) { const int tok = *(const LAS int*)(lds + MO_RT + (u.ui * 256 + h * HALF + R[i]) * 4); off[h][i] = (unsigned)(tok * K_ + C[i]) * 2u; }
        } else {
#pragma unroll
            for (int h = 0; h < 2; ++h)
#pragma unroll
                for (int i = 0; i < 2; ++i) off[h][i] = (unsigned)((h * HALF + R[i]) * K_ + C[i]) * 2u;
        }
    }
};
struct DownOrder {
    const char* H; const char* Wd; const char* Wds; const LAS unsigned char* lds; int lo, hi, nsh, G, c, hot;
    DI bool next(int i, Unit& u) const {
        const int L = i * G + c; if (L >= (hi - lo + nsh) * 4) return false;
        int bl = lo + (L >> 2); u.pn = L & 3; u.ui = i; if (hot) bl = lo + ((L >> 2) & 7);
        if (bl < hi) { u.e = (int)__builtin_amdgcn_readfirstlane((int)*(const LAS unsigned char*)(lds + MO_BLKE + bl)); u.pm = bl; u.B = Wd + ((size_t)u.e * D + u.pn * 256) * EH * 2; }
        else { u.e = 64; u.pm = SH_ROW0 / BM + (bl - hi); u.B = Wds + (size_t)u.pn * 256 * EH * 2; }
        u.A = H + (size_t)u.pm * BM * EH * 2;
        return true;
    }
    DI void a_offs(const Unit&, const int (&R)[2], const int (&C)[2], int K_, unsigned (&off)[2][2]) const {
#pragma unroll
        for (int h = 0; h < 2; ++h)
#pragma unroll
            for (int i = 0; i < 2; ++i) off[h][i] = (unsigned)((h * HALF + R[i]) * K_ + C[i]) * 2u;
    }
};
DI void moe_tables(LAS unsigned char* lds, const unsigned* blke, int nblk, const int* rowtok, const float* roww, bool gateup, int G, int c, int tid) {
    for (int b = tid; b < nblk; b += NTHREADS) *(LAS unsigned char*)(lds + MO_BLKE + b) = (unsigned char)__hip_atomic_load(blke + b, RLX_AGENT);
    if (gateup) {
#pragma unroll
        for (int i = 0; i < 5; ++i) { const int L = i * G + c, bl = L >> 1;
            if (bl < nblk && tid < 256) { *(LAS int*)(lds + MO_RT + (i * 256 + tid) * 4) = __hip_atomic_load(rowtok + (size_t)bl * 256 + tid, RLX_AGENT);
                                          *(LAS float*)(lds + MO_RW + (i * 256 + tid) * 4) = __hip_atomic_load(roww + (size_t)bl * 256 + tid, RLX_AGENT); } }
    }
    __syncthreads();
}
}

struct Frame {
    LAS unsigned char* lds;
    unsigned* ctl;
    unsigned char* ws; float* out;
    int tid, lane, wave, vcu, G;
};
DI unsigned short f2bf1(float x) { return (unsigned short)(pg8::pk2(x, x) & 0xffffu); }

template <class RowMap>
DI void transpose_item(const float* W, int N, bf16* WT, int Kd, RowMap rm, LAS float* scr, int kb, int nb, int lane) {
    const int k0 = 64 * kb, n0 = 32 * nb;
#pragma unroll 8
    for (int i = 0; i < 32; ++i) { const int kk = 2 * i + (lane >> 5); scr[kk * 33 + (lane & 31)] = W[(size_t)(k0 + kk) * N + n0 + (lane & 31)]; }
    LDS_WAIT(); asm volatile("" ::: "memory");
    const int c = lane & 7;
#pragma unroll
    for (int j = 0; j < 4; ++j) { const int n = (lane >> 3) + 8 * j; const LAS float* s = scr + (8 * c) * 33 + n;
        u32x4 o; o.x = pg8::pk2(s[0 * 33], s[1 * 33]); o.y = pg8::pk2(s[2 * 33], s[3 * 33]); o.z = pg8::pk2(s[4 * 33], s[5 * 33]); o.w = pg8::pk2(s[6 * 33], s[7 * 33]);
        *(u32x4*)(WT + (size_t)rm(n0 + n) * Kd + k0 + 8 * c) = o; }
    LDS_WAIT(); asm volatile("" ::: "memory");
}
struct RmIdent { int off; DI int operator()(int n) const { return off + n; } };
struct RmInProj { DI int operator()(int n) const { const int seg = n >> 10, w = n & 1023;
    return seg == 0 ? ((w >> 7) * 256 + ((w & 127) >> 3) * 16 + (w & 7)) : seg == 5 ? ((w >> 7) * 256 + ((w & 127) >> 3) * 16 + 8 + (w & 7)) : seg == 6 ? 6144 + w : 1024 + n; } };
struct RmGateUp { int up; DI int operator()(int n) const { return (n >> 7) * 256 + up * 128 + (n & 127); } };
DI int inproj_dest(int n) { return RmInProj()(n); }

DI void row_stats(const float* xrow, int lane, f32x4 (&v)[4], float& mean, float& rstd) {
    const f32x4* xr = (const f32x4*)xrow + lane; float s = 0.f;
#pragma unroll
    for (int j = 0; j < 4; ++j) { v[j] = xr[64 * j]; s += (v[j][0] + v[j][1]) + (v[j][2] + v[j][3]); }
    mean = wave_sum(s) * (1.f / D); float s2 = 0.f;
#pragma unroll
    for (int j = 0; j < 4; ++j) { const f32x4 d = v[j] - mean; s2 += (d[0] * d[0] + d[1] * d[1]) + (d[2] * d[2] + d[3] * d[3]); }
    rstd = 1.f / sqrtf(wave_sum(s2) * (1.f / D) + LN_EPS);
}

DI void row_stats_b16(const bf16* xrow, int lane, f32x4 (&v)[4], float& mean, float& rstd) {
    const u32x2* xr = (const u32x2*)xrow + lane; float s = 0.f;
#pragma unroll
    for (int j = 0; j < 4; ++j) { const u32x2 x = xr[64 * j]; v[j] = (f32x4){bflo(x.x), bfhi(x.x), bflo(x.y), bfhi(x.y)}; s += (v[j][0] + v[j][1]) + (v[j][2] + v[j][3]); }
    mean = wave_sum(s) * (1.f / D); float s2 = 0.f;
#pragma unroll
    for (int j = 0; j < 4; ++j) { const f32x4 d = v[j] - mean; s2 += (d[0] * d[0] + d[1] * d[1]) + (d[2] * d[2] + d[3] * d[3]); }
    rstd = 1.f / sqrtf(wave_sum(s2) * (1.f / D) + LN_EPS);
}
DI void p0_prologue(Frame& F, const float* const* in) {
    LAS float* scr = (LAS float*)(F.lds + F.wave * 16384);
    const int gw = F.vcu * NWAVES + F.wave, NGW = F.G * NWAVES, lane = F.lane;
    unsigned char* ws = F.ws;
    constexpr int I_IN = 16 * (INW / 32), I_OUT = 16 * 32, I_Q = 16 * 16, I_KV = 16 * 32, I_O = 8 * 32, I_SG = 16 * 8, I_SD = 4 * 32;
    constexpr int NITEMS = I_IN + I_OUT + I_Q + I_KV + I_O + 2 * I_SG + I_SD;
    for (int it = gw; it < NITEMS; it += NGW) {
        int r = it;
        if (r < I_IN) { transpose_item(in[4], INW, (bf16*)(ws + WS_WIN), D, RmInProj(), scr, r / (INW / 32), r % (INW / 32), lane); continue; } r -= I_IN;
        if (r < I_OUT) { transpose_item(in[10], D, (bf16*)(ws + WS_WOUT), D, RmIdent{0}, scr, r / 32, r % 32, lane); continue; } r -= I_OUT;
        if (r < I_Q) { transpose_item(in[13], MEMW, (bf16*)(ws + WS_WQ), D, RmIdent{0}, scr, r / 16, r % 16, lane); continue; } r -= I_Q;
        if (r < I_KV) { transpose_item(in[14], 2 * MEMW, (bf16*)(ws + WS_WKV), D, RmIdent{0}, scr, r / 32, r % 32, lane); continue; } r -= I_KV;
        if (r < I_O) { transpose_item(in[15], D, (bf16*)(ws + WS_WO), MEMW, RmIdent{0}, scr, r / 32, r % 32, lane); continue; } r -= I_O;
        if (r < I_SG) { transpose_item(in[23], EH, (bf16*)(ws + WS_WGUS), D, RmGateUp{0}, scr, r / 8, r % 8, lane); continue; } r -= I_SG;
        if (r < I_SG) { transpose_item(in[24], EH, (bf16*)(ws + WS_WGUS), D, RmGateUp{1}, scr, r / 8, r % 8, lane); continue; } r -= I_SG;
        transpose_item(in[25], D, (bf16*)(ws + WS_WDS), EH, RmIdent{0}, scr, r / 32, r % 32, lane);
    }
    const int gt = F.vcu * NTHREADS + F.tid, NGT = F.G * NTHREADS;
    { const float* wr = in[18]; bf16* hi = (bf16*)(ws + WS_WRHI); bf16* lo = (bf16*)(ws + WS_WRLO);
      for (int idx = gt; idx < D * NEXP; idx += NGT) { const int k = idx >> 6, e = idx & 63; const float w = wr[idx]; const unsigned short h = f2bf1(w); hi[e * D + k] = h; lo[e * D + k] = f2bf1(w - bf2f(h)); } }
    { const float* wsp = in[8]; bf16* o = (bf16*)(ws + WS_WSP);
      for (int idx = gt; idx < 8 * 128 * 128; idx += NGT) { const int s = idx & 127, t = (idx >> 7) & 127; o[idx] = (s <= t) ? f2bf1(wsp[idx]) : (unsigned short)0; } }
    { const float* bi = in[5]; float* o = (float*)(ws + WS_BPERM);
      for (int idx = gt; idx < INW; idx += NGT) o[inproj_dest(idx)] = bi[idx]; }
    { const f32x4* m4 = (const f32x4*)in[1]; u32x2* o = (u32x2*)(ws + WS_MEMB);
      for (int idx = gt; idx < NBATCH * MEMLEN * D / 4; idx += NGT) { const f32x4 v = m4[idx]; o[idx] = (u32x2){pg8::pk2(v[0], v[1]), pg8::pk2(v[2], v[3])}; } }
    { const float* x = in[0]; const float* g = in[2]; const float* b = in[3]; bf16* X0b = (bf16*)F.out; float* xstat = (float*)(ws + WS_XSTAT);
      f32x4 gv[4], bv[4];
#pragma unroll
      for (int j = 0; j < 4; ++j) { gv[j] = ((const f32x4*)g)[lane + 64 * j]; bv[j] = ((const f32x4*)b)[lane + 64 * j]; }
      for (int m = gw; m < T; m += NGW) { f32x4 v[4]; float mean, rstd; row_stats(x + (size_t)m * D, lane, v, mean, rstd);
          u32x2* o8 = (u32x2*)(X0b + (size_t)m * D) + lane;
#pragma unroll
          for (int j = 0; j < 4; ++j) { const f32x4 y = (v[j] - mean) * rstd * gv[j] + bv[j]; o8[64 * j] = (u32x2){pg8::pk2(y[0], y[1]), pg8::pk2(y[2], y[3])}; }
          if (lane == 0) *(f32x2*)(xstat + 2 * (size_t)m) = (f32x2){mean, rstd}; } }
}
struct CvtItem { const float* W; bf16* WT; int N, Kd, mode, kb, nb; };
DI CvtItem cvt_decode(const float* const* in, unsigned char* ws, int it) {
    const int e = it / 384; int r = it % 384; CvtItem c;
    if (r < 256) { const int up = r >> 7; r &= 127; c.W = in[20 + up] + (size_t)e * D * EH; c.N = EH; c.WT = (bf16*)(ws + WS_WGU) + (size_t)e * 512 * D; c.Kd = D; c.mode = up; c.kb = r >> 3; c.nb = r & 7; }
    else { r -= 256; c.W = in[22] + (size_t)e * EH * D; c.N = D; c.WT = (bf16*)(ws + WS_WD) + (size_t)e * D * EH; c.Kd = EH; c.mode = 2; c.kb = r >> 5; c.nb = r & 31; }
    return c;
}
DI void cvt_load(const CvtItem& c, int lane, f32x4 (&v)[8]) {
#pragma unroll
    for (int i = 0; i < 8; ++i) v[i] = __builtin_nontemporal_load((const f32x4*)(c.W + (size_t)(64 * c.kb + (lane >> 3) + 8 * i) * c.N + 32 * c.nb + 4 * (lane & 7)));
}
DI void cvt_finish(const CvtItem& c, int lane, const f32x4 (&v)[8], LAS float* scr) {
#pragma unroll
    for (int i = 0; i < 8; ++i) { LAS float* d = scr + ((lane >> 3) + 8 * i) * 33 + 4 * (lane & 7); d[0] = v[i][0]; d[1] = v[i][1]; d[2] = v[i][2]; d[3] = v[i][3]; }
    LDS_WAIT(); asm volatile("" ::: "memory");
    const int cc = lane & 7;
#pragma unroll
    for (int j = 0; j < 4; ++j) { const int n = 32 * c.nb + (lane >> 3) + 8 * j; const LAS float* sp = scr + (8 * cc) * 33 + (lane >> 3) + 8 * j;
        const int drow = (c.mode == 2) ? n : ((n >> 7) * 256 + c.mode * 128 + (n & 127));
        u32x4 o; o.x = pg8::pk2(sp[0 * 33], sp[1 * 33]); o.y = pg8::pk2(sp[2 * 33], sp[3 * 33]); o.z = pg8::pk2(sp[4 * 33], sp[5 * 33]); o.w = pg8::pk2(sp[6 * 33], sp[7 * 33]);
        *(u32x4*)(c.WT + (size_t)drow * c.Kd + 64 * c.kb + 8 * cc) = o; }
    LDS_WAIT(); asm volatile("" ::: "memory");
}
DI void expert_convert(Frame& F, const float* const* in, int worker, int nworkers, int item_lo, int item_hi) {
    LAS float* scr = (LAS float*)(F.lds + F.wave * 16384);
    const int lane = F.lane, stride = nworkers * NWAVES;
    int it = item_lo + worker * NWAVES + F.wave;
    if (it >= item_hi) return;
    CvtItem cur = cvt_decode(in, F.ws, it); f32x4 v[8]; cvt_load(cur, lane, v);
    for (;;) {
        const int nx = it + stride; const bool has = nx < item_hi;
        CvtItem nxt = cur; f32x4 vn[8];
        if (has) { nxt = cvt_decode(in, F.ws, nx); cvt_load(nxt, lane, vn); }
        cvt_finish(cur, lane, v, scr);
        if (!has) break;
        cur = nxt; it = nx;
#pragma unroll
        for (int i = 0; i < 8; ++i) v[i] = vn[i];
    }
}

constexpr int MX_BUF = 32768, MX_STAT = 4 * MX_BUF, MX_FLG = MX_STAT + 1024, MX_FLG2 = MX_FLG + 64, MX_END = MX_FLG2 + 64;
static_assert(MX_END <= SCR_BYTES, "mixer LDS");
constexpr float MX_EXIT2 = SB_EXIT * LOG2E;
typedef short v4i16_t __attribute__((ext_vector_type(4)));
DI bf16x8 mk_frag(f32x4 e0, f32x4 e1) { const u32x4 w = pg8::pk8(e0, e1); return __builtin_bit_cast(bf16x8, w); }
DI bf16x8 ld_split8(const LAS unsigned char* p) {
    const s16x4 lo = *(const LAS s16x4*)p, hi = *(const LAS s16x4*)(p + 32);
    return (bf16x8){lo[0], lo[1], lo[2], lo[3], hi[0], hi[1], hi[2], hi[3]};
}
DI void glds16(const void* gsrc, unsigned lds_dst) { unsigned keep;
    asm volatile("s_mov_b32 %0, m0\n\ts_mov_b32 m0, %2\n\ts_nop 0\n\tglobal_load_lds_dwordx4 %1, off\n\ts_mov_b32 m0, %0" : "=&s"(keep) : "v"(gsrc), "s"(lds_dst) : "memory"); }
DI void mx_dma(LAS unsigned char* buf, const bf16* src, int w, int lane) {
#pragma unroll
    for (int i = 0; i < 4; ++i) { const int pc = 4 * w + i, row = 4 * pc + (lane >> 4), cpos = lane & 15;
        glds16((const char*)src + (size_t)row * (D * 2) + ((cpos ^ (row & 15)) * 16), (unsigned)__builtin_amdgcn_readfirstlane((unsigned)(uintptr_t)(buf + pc * 1024))); }
}
DI bf16x8 mx_tr(const LAS unsigned char* buf, int sA, int sB, int d0, int r) {
    const int ra = sA + (r >> 2), rb = sB + (r >> 2), ch = (d0 >> 3) + ((r & 3) >> 1), bo = 8 * (r & 1);
    const s16x4 lo = __builtin_bit_cast(s16x4, __builtin_amdgcn_ds_read_tr16_b64_v4i16((LAS v4i16_t*)(buf + ra * 256 + ((ch ^ (ra & 15)) * 16) + bo)));
    const s16x4 hi = __builtin_bit_cast(s16x4, __builtin_amdgcn_ds_read_tr16_b64_v4i16((LAS v4i16_t*)(buf + rb * 256 + ((ch ^ (rb & 15)) * 16) + bo)));
    return (bf16x8){lo[0], lo[1], lo[2], lo[3], hi[0], hi[1], hi[2], hi[3]};
}
DI void sb_scores(const LAS unsigned char* kbuf, const bf16x8 (&qf)[4], bool diag, int tq, float carry, int r, int q, const bf16x8& UE, const bf16x8& UO, const bf16x8& ONES, bf16x8 (&af)[4], float& tot_out) {
    f32x4 z[8];
#pragma unroll
    for (int st = 0; st < 8; ++st) { z[st] = (f32x4){0.f, 0.f, 0.f, 0.f};
#pragma unroll
        for (int kk = 0; kk < 4; ++kk) { const bf16x8 kf = *(const LAS bf16x8*)(kbuf + (16 * st + r) * 256 + (((4 * kk + q) ^ r) * 16));
            z[st] = __builtin_amdgcn_mfma_f32_16x16x32_bf16(kf, qf[kk], z[st], 0, 0, 0); }
        if (st & 1) __builtin_amdgcn_sched_barrier(0); }
    f32x4 ls[8];
#pragma unroll
    for (int st = 0; st < 8; ++st)
#pragma unroll
        for (int e = 0; e < 4; ++e) { const float zz = z[st][e]; const float sp = fmaxf(zz, 0.f) + fast_log2(1.0f + fast_exp2(-fabsf(zz)));
            const bool msk = diag && (16 * st + 4 * q + e >= tq);
            ls[st][e] = msk ? 0.f : -sp; z[st][e] = msk ? -1e30f : zz - sp; }
    bf16x8 lf[4];
#pragma unroll
    for (int p = 0; p < 4; ++p) lf[p] = mk_frag(ls[2 * p], ls[2 * p + 1]);
    f32x4 tot = (f32x4){0.f, 0.f, 0.f, 0.f};
#pragma unroll
    for (int p = 0; p < 4; ++p) tot = __builtin_amdgcn_mfma_f32_16x16x32_bf16(ONES, lf[p], tot, 0, 0, 0);
#pragma unroll
    for (int p = 0; p < 4; ++p) {
        f32x4 s0 = (f32x4){0.f, 0.f, 0.f, 0.f}, s1 = (f32x4){0.f, 0.f, 0.f, 0.f};
        s0 = __builtin_amdgcn_mfma_f32_16x16x32_bf16(UE, lf[p], s0, 0, 0, 0);
        s1 = __builtin_amdgcn_mfma_f32_16x16x32_bf16(UO, lf[p], s1, 0, 0, 0);
#pragma unroll
        for (int p2 = p + 1; p2 < 4; ++p2) { s0 = __builtin_amdgcn_mfma_f32_16x16x32_bf16(ONES, lf[p2], s0, 0, 0, 0); s1 = __builtin_amdgcn_mfma_f32_16x16x32_bf16(ONES, lf[p2], s1, 0, 0, 0); }
        f32x4 a0, a1;
#pragma unroll
        for (int e = 0; e < 4; ++e) { a0[e] = fast_exp2(z[2 * p][e] + s0[e] + carry); a1[e] = fast_exp2(z[2 * p + 1][e] + s1[e] + carry); }
        af[p] = mk_frag(a0, a1);
    }
    tot_out = tot[0];
}
DI void sb_pv(const LAS unsigned char* vbuf, const bf16x8 (&af)[4], f32x4 (&yb)[8], int r, int q) {
#pragma unroll
    for (int dt = 0; dt < 8; ++dt)
#pragma unroll
        for (int p = 0; p < 4; ++p) { const bf16x8 vf = mx_tr(vbuf, 32 * p + 4 * q, 32 * p + 16 + 4 * q, 16 * dt, r);
            yb[dt] = __builtin_amdgcn_mfma_f32_16x16x32_bf16(vf, af[p], yb[dt], 0, 0, 0);
            if (p == 3 && (dt & 1)) __builtin_amdgcn_sched_barrier(0); }
}
#define MX_WAIT_BAR(n) asm volatile("s_waitcnt vmcnt(" #n ") lgkmcnt(0)\n\ts_barrier" ::: "memory")
DI void mix_phase(Frame& F, const float* const* in) {
    LAS unsigned char* lds = F.lds; unsigned char* ws = F.ws;
    const int tid = F.tid, lane = F.lane, w = F.wave, r = lane & 15, q = lane >> 4;
    const bf16* UG = (const bf16*)(ws + WS_UG); const bf16* VA = (const bf16*)(ws + WS_VA); const bf16* Qg = (const bf16*)(ws + WS_Q);
    const bf16* Kg = (const bf16*)(ws + WS_K); const bf16* Vg = (const bf16*)(ws + WS_V); const bf16* GB = (const bf16*)(ws + WS_GB);
    const float* vstat = (const float*)(ws + WS_VSTAT); const bf16* WSP = (const bf16*)(ws + WS_WSP); bf16* MG = (bf16*)(ws + WS_MERGED);
    const float* lnvg = in[6]; const float* lnvb = in[7]; const float* bsp = in[9];
    LAS unsigned char* B0 = lds; LAS unsigned char* B1 = lds + MX_BUF; LAS unsigned char* B2 = lds + 2 * MX_BUF; LAS unsigned char* B3 = lds + 3 * MX_BUF;
    bf16x8 UE, UO, ONES;
#pragma unroll
    for (int jj = 0; jj < 8; ++jj) { ONES[jj] = (short)0x3F80;
        UE[jj] = (jj < 4) ? ((4 * q + jj > r) ? (short)0x3F80 : (short)0) : (short)0x3F80;
        UO[jj] = (jj < 4) ? (short)0 : ((4 * q + jj - 4 > r) ? (short)0x3F80 : (short)0); }
    const int NU = NBATCH * 16 * 8;
    int un = F.vcu;
    if (un >= NU) return;
#define MX_DEC(u_, b_, i_, j_) const int j_ = (u_) & 7, i_ = ((u_) >> 3) & 15, b_ = (u_) >> 7
    bf16x8 qf[4];
    { MX_DEC(un, b, i, j); const int ip = i > 0 ? i - 1 : 0;
      mx_dma(B0, Kg + (size_t)(b * SEQ + 128 * i) * D + 128 * j, w, lane);
      mx_dma(B2, Kg + (size_t)(b * SEQ + 128 * ip) * D + 128 * j, w, lane);
      mx_dma(B3, Vg + (size_t)(b * SEQ + 128 * ip) * D + 128 * j, w, lane);
#pragma unroll
      for (int kk = 0; kk < 4; ++kk) qf[kk] = *(const bf16x8*)(Qg + (size_t)(b * SEQ + 128 * i + 16 * w + r) * D + 128 * j + 32 * kk + 8 * q); }
    for (; un < NU; un += F.G) {
        MX_DEC(un, b, i, j);
        const int t0 = b * SEQ + 128 * i, c0 = 128 * j, tq = 16 * w + r;
        const int unn = (un + F.G < NU) ? un + F.G : un;
        MX_DEC(unn, bn, in_, jn); const int ipn = in_ > 0 ? in_ - 1 : 0;
        f32x4 yb[8];
#pragma unroll
        for (int dt = 0; dt < 8; ++dt) yb[dt] = (f32x4){0.f, 0.f, 0.f, 0.f};
        float carry = 0.f, tot; bf16x8 af[4];
        MX_WAIT_BAR(0);
        asm volatile("" : "+v"(qf[0]), "+v"(qf[1]), "+v"(qf[2]), "+v"(qf[3]));
        mx_dma(B1, Vg + (size_t)t0 * D + c0, w, lane);
        sb_scores(B0, qf, true, tq, 0.f, r, q, UE, UO, ONES, af, tot);
        MX_WAIT_BAR(0);
        mx_dma(B0, Kg + (size_t)(bn * SEQ + 128 * in_) * D + 128 * jn, w, lane);
        sb_pv(B1, af, yb, r, q);
        carry += tot;
        MX_WAIT_BAR(4);
        mx_dma(B1, VA + (size_t)t0 * D + c0, w, lane);
        if (i > 0) { sb_scores(B2, qf, false, tq, carry, r, q, UE, UO, ONES, af, tot);
            const float wm = wave_max(carry + tot); if (lane == 0) *(LAS float*)(lds + MX_FLG + w * 4) = wm; }
        MX_WAIT_BAR(4);
        mx_dma(B2, Kg + (size_t)(bn * SEQ + 128 * ipn) * D + 128 * jn, w, lane);
        if (i > 0) { sb_pv(B3, af, yb, r, q); carry += tot; }
        if (i > 1) {
            float gm = -1e30f;
#pragma unroll
            for (int k = 0; k < 8; ++k) gm = fmaxf(gm, *(const LAS float*)(lds + MX_FLG + k * 4));
            if (gm >= MX_EXIT2) {
                for (int kb = i - 2; kb >= 0; --kb) {
                    MX_WAIT_BAR(0);
                    mx_dma(B2, Kg + (size_t)(b * SEQ + 128 * kb) * D + c0, w, lane); mx_dma(B3, Vg + (size_t)(b * SEQ + 128 * kb) * D + c0, w, lane);
                    MX_WAIT_BAR(0);
                    sb_scores(B2, qf, false, tq, carry, r, q, UE, UO, ONES, af, tot); sb_pv(B3, af, yb, r, q); carry += tot;
                    const float wm = wave_max(carry); if (lane == 0) *(LAS float*)(lds + MX_FLG2 + w * 4) = wm;
                    MX_WAIT_BAR(0);
                    float g2 = -1e30f;
#pragma unroll
                    for (int k = 0; k < 8; ++k) g2 = fmaxf(g2, *(const LAS float*)(lds + MX_FLG2 + k * 4));
                    if (g2 < MX_EXIT2) break;
                }
                MX_WAIT_BAR(0);
                mx_dma(B2, Kg + (size_t)(bn * SEQ + 128 * ipn) * D + 128 * jn, w, lane);
            }
        }
        { f32x2 sp4[4];
#pragma unroll
          for (int k = 0; k < 4; ++k) sp4[k] = *((const f32x2*)vstat + (size_t)(t0 + (tid >> 2)) * 16 + 4 * (tid & 3) + k);
          float s1 = (sp4[0][0] + sp4[1][0]) + (sp4[2][0] + sp4[3][0]), s2 = (sp4[0][1] + sp4[1][1]) + (sp4[2][1] + sp4[3][1]);
          s1 += __shfl_xor(s1, 1); s1 += __shfl_xor(s1, 2); s2 += __shfl_xor(s2, 1); s2 += __shfl_xor(s2, 2);
          const float mean = s1 * (1.f / D), var = s2 * (1.f / D) - mean * mean;
          if ((tid & 3) == 0) *(LAS f32x2*)(lds + MX_STAT + (tid >> 2) * 8) = (f32x2){mean, 1.f / sqrtf(fmaxf(var, 0.f) + LN_EPS)}; }
        MX_WAIT_BAR(4);
        mx_dma(B3, Vg + (size_t)(bn * SEQ + 128 * ipn) * D + 128 * jn, w, lane);
        bf16x8 qn[4];
#pragma unroll
        for (int kk = 0; kk < 4; ++kk) qn[kk] = *(const bf16x8*)(Qg + (size_t)(bn * SEQ + 128 * in_ + 16 * w + r) * D + 128 * jn + 32 * kk + 8 * q);
        {
          f32x4 ya[8];
#pragma unroll
          for (int dt = 0; dt < 8; ++dt) ya[dt] = (f32x4){0.f, 0.f, 0.f, 0.f};
          float c1 = 0.f, c2 = 0.f;
          const int nks = (w >> 1) + 1;
          for (int ks = 0; ks < nks; ++ks) {
              const u32x4 wr4 = *(const u32x4*)(WSP + ((size_t)j * 128 + tq) * 128 + 32 * ks + 8 * q);
              float wv[8] = {bflo(wr4.x), bfhi(wr4.x), bflo(wr4.y), bfhi(wr4.y), bflo(wr4.z), bfhi(wr4.z), bflo(wr4.w), bfhi(wr4.w)}; float wp[8];
#pragma unroll
              for (int e = 0; e < 8; ++e) { const f32x2 st = *(const LAS f32x2*)(lds + MX_STAT + (32 * ks + 8 * q + e) * 8); wp[e] = wv[e] * st[1]; c2 += wv[e]; }
              const u32x4 wq = pg8::pk8((f32x4){wp[0], wp[1], wp[2], wp[3]}, (f32x4){wp[4], wp[5], wp[6], wp[7]});
              const float wb[8] = {bflo(wq.x), bfhi(wq.x), bflo(wq.y), bfhi(wq.y), bflo(wq.z), bfhi(wq.z), bflo(wq.w), bfhi(wq.w)};
#pragma unroll
              for (int e = 0; e < 8; ++e) { const f32x2 st = *(const LAS f32x2*)(lds + MX_STAT + (32 * ks + 8 * q + e) * 8); c1 += wb[e] * st[0]; }
              const bf16x8 wf = __builtin_bit_cast(bf16x8, wq);
#pragma unroll
              for (int dt = 0; dt < 8; ++dt) { const bf16x8 vf = mx_tr(B1, 32 * ks + 8 * q, 32 * ks + 8 * q + 4, 16 * dt, r);
                  ya[dt] = __builtin_amdgcn_mfma_f32_16x16x32_bf16(vf, wf, ya[dt], 0, 0, 0); }
          }
          c1 += __shfl_xor(c1, 16); c1 += __shfl_xor(c1, 32); c2 += __shfl_xor(c2, 16); c2 += __shfl_xor(c2, 32);
          const float bs = bsp[j * 128 + tq]; const size_t rowoff = (size_t)(t0 + tq) * D + c0 + 4 * q;
#pragma unroll
          for (int dt = 0; dt < 8; ++dt) { const u32x2 ug = *(const u32x2*)(UG + rowoff + 16 * dt), gb = *(const u32x2*)(GB + rowoff + 16 * dt);
              const f32x4 g4 = *(const f32x4*)(lnvg + c0 + 16 * dt + 4 * q), b4 = *(const f32x4*)(lnvb + c0 + 16 * dt + 4 * q);
              const f32x4 u4 = (f32x4){bflo(ug.x), bfhi(ug.x), bflo(ug.y), bfhi(ug.y)}, gq = (f32x4){bflo(gb.x), bfhi(gb.x), bflo(gb.y), bfhi(gb.y)};
              const f32x4 mixed = g4 * (ya[dt] - c1) + b4 * c2 + bs;
              const f32x4 o = u4 * mixed + gq * yb[dt];
              *(u32x2*)(MG + rowoff + 16 * dt) = (u32x2){pg8::pk2(o[0], o[1]), pg8::pk2(o[2], o[3])}; } }
#pragma unroll
        for (int kk = 0; kk < 4; ++kk) qf[kk] = qn[kk];
    }
    MX_WAIT_BAR(0);
#undef MX_DEC
}
#undef MX_WAIT_BAR

DI void ln1_phase(Frame& F, const float* const* in) {
    const int gw = F.vcu * NWAVES + F.wave, NGW = F.G * NWAVES, lane = F.lane;
    const bf16* Y1 = (const bf16*)(F.ws + WS_Y1); bf16* X1b = (bf16*)(F.ws + WS_X1B);
    f32x4 gv[4], bv[4];
#pragma unroll
    for (int j = 0; j < 4; ++j) { gv[j] = ((const f32x4*)in[11])[lane + 64 * j]; bv[j] = ((const f32x4*)in[12])[lane + 64 * j]; }
    for (int m = gw; m < T; m += NGW) { f32x4 v[4]; float mean, rstd; row_stats_b16(Y1 + (size_t)m * D, lane, v, mean, rstd);
        u32x2* ob = (u32x2*)(X1b + (size_t)m * D) + lane;
#pragma unroll
        for (int j = 0; j < 4; ++j) { const f32x4 y = (v[j] - mean) * rstd * gv[j] + bv[j]; ob[64 * j] = (u32x2){pg8::pk2(y[0], y[1]), pg8::pk2(y[2], y[3])}; } }
}

DI void memattn_phase(Frame& F, int first, int stride) {
    LAS unsigned char* lds = F.lds; unsigned char* ws = F.ws;
    const int lane = F.lane, w = F.wave, r = lane & 15, q = lane >> 4;
    const bf16* Qm = (const bf16*)(ws + WS_QM); const bf16* KV = (const bf16*)(ws + WS_KVM); bf16* Om = (bf16*)(ws + WS_OM);
    for (int su = first; su < NBATCH * 4 * 8; su += stride) {
        const int qc = su & 7, h = (su >> 3) & 3, b = su >> 5;
        mx_dma(lds, KV + (size_t)(b * MEMLEN) * D + h * 128, w, lane); mx_dma(lds + MX_BUF, KV + (size_t)(b * MEMLEN + 128) * D + h * 128, w, lane);
        mx_dma(lds + 2 * MX_BUF, KV + (size_t)(b * MEMLEN) * D + MEMW + h * 128, w, lane); mx_dma(lds + 3 * MX_BUF, KV + (size_t)(b * MEMLEN + 128) * D + MEMW + h * 128, w, lane);
        bf16x8 qf[4];
#pragma unroll
        for (int kk = 0; kk < 4; ++kk) qf[kk] = *(const bf16x8*)(Qm + ((size_t)b * SEQ + 256 * qc + 16 * w + r) * MEMW + h * 128 + 32 * kk + 8 * q);
        asm volatile("s_waitcnt vmcnt(0) lgkmcnt(0)\n\ts_barrier" ::: "memory");
        for (int c = 0; c < 2; ++c) {
            const size_t trow = (size_t)b * SEQ + 256 * qc + 128 * c + 16 * w + r;
            if (c == 1) {
#pragma unroll
                for (int kk = 0; kk < 4; ++kk) qf[kk] = *(const bf16x8*)(Qm + trow * MEMW + h * 128 + 32 * kk + 8 * q); }
            f32x4 z[16];
#pragma unroll
            for (int st = 0; st < 16; ++st) { z[st] = (f32x4){0.f, 0.f, 0.f, 0.f};
#pragma unroll
                for (int kk = 0; kk < 4; ++kk) { const bf16x8 kf = *(const LAS bf16x8*)(lds + (st >> 3) * MX_BUF + (16 * (st & 7) + r) * 256 + (((4 * kk + q) ^ r) * 16));
                    z[st] = __builtin_amdgcn_mfma_f32_16x16x32_bf16(kf, qf[kk], z[st], 0, 0, 0); }
                if (st & 1) __builtin_amdgcn_sched_barrier(0); }
            float mx = -1e30f;
#pragma unroll
            for (int st = 0; st < 16; ++st) mx = fmaxf(mx, fmaxf(fmaxf(z[st][0], z[st][1]), fmaxf(z[st][2], z[st][3])));
            mx = fmaxf(mx, __shfl_xor(mx, 16)); mx = fmaxf(mx, __shfl_xor(mx, 32));
            float sum = 0.f;
#pragma unroll
            for (int st = 0; st < 16; ++st)
#pragma unroll
                for (int e = 0; e < 4; ++e) { const float pp = fast_exp2((z[st][e] - mx) * LOG2E); z[st][e] = pp; sum += pp; }
            sum += __shfl_xor(sum, 16); sum += __shfl_xor(sum, 32);
            const float inv = 1.0f / sum;
            f32x4 o[8];
#pragma unroll
            for (int dt = 0; dt < 8; ++dt) o[dt] = (f32x4){0.f, 0.f, 0.f, 0.f};
#pragma unroll
            for (int p = 0; p < 8; ++p) { const bf16x8 pf = mk_frag(z[2 * p], z[2 * p + 1]);
#pragma unroll
                for (int dt = 0; dt < 8; ++dt) { const bf16x8 vf = mx_tr(lds + (2 + (p >> 2)) * MX_BUF, 32 * (p & 3) + 4 * q, 32 * (p & 3) + 16 + 4 * q, 16 * dt, r);
                    o[dt] = __builtin_amdgcn_mfma_f32_16x16x32_bf16(vf, pf, o[dt], 0, 0, 0); }
                __builtin_amdgcn_sched_barrier(0); }
#pragma unroll
            for (int dt = 0; dt < 8; ++dt) { const f32x4 v = o[dt] * inv;
                *(u32x2*)(Om + trow * MEMW + h * 128 + 16 * dt + 4 * q) = (u32x2){pg8::pk2(v[0], v[1]), pg8::pk2(v[2], v[3])}; }
        }
        asm volatile("s_waitcnt lgkmcnt(0)\n\ts_barrier" ::: "memory");
    }
}

constexpr int RT_XRS = 2064;
constexpr int RT_XH = 0, RT_XL = 16 * RT_XRS, RT_PART = 2 * 16 * RT_XRS, RT_SC = RT_PART + 8 * 16 * 64 * 4, RT_SEL = RT_SC + 16 * 64 * 4, RT_HIST = RT_SEL + 16 * 64 * 4, RT_END = RT_HIST + 256;
static_assert(RT_END <= SCR_BYTES, "router LDS");
DI float grp8_max(float v) { v = fmaxf(v, __shfl_xor(v, 1)); v = fmaxf(v, __shfl_xor(v, 2)); v = fmaxf(v, __shfl_xor(v, 4)); return v; }
DI float rdlane(float v, int l) { return __uint_as_float(__builtin_amdgcn_readlane(__float_as_uint(v), l)); }
DI void route_phase(Frame& F, const float* const* in, unsigned* gcount) {
    LAS unsigned char* lds = F.lds; unsigned char* ws = F.ws;
    const int tid = F.tid, lane = F.lane, w = F.wave, r = lane & 15, q = lane >> 4;
    const bf16* Y2 = (const bf16*)F.out; bf16* X2b = (bf16*)(ws + WS_X2B);
    const bf16* WRH = (const bf16*)(ws + WS_WRHI); const bf16* WRL = (const bf16*)(ws + WS_WRLO);
    unsigned* TK = (unsigned*)(ws + WS_TK); float* TKW = (float*)(ws + WS_TKW); unsigned* WGB = (unsigned*)(ws + WS_WGBASE);
    LAS unsigned* HIST = (LAS unsigned*)(lds + RT_HIST);
    if (tid < 64) HIST[tid] = 0u;
    const float rb = in[19][lane];
    f32x4 gv[4], bv[4];
#pragma unroll
    for (int j = 0; j < 4; ++j) { gv[j] = ((const f32x4*)in[16])[lane + 64 * j]; bv[j] = ((const f32x4*)in[17])[lane + 64 * j]; }
    bf16x8 bh[4][4], bl[4][4];
#pragma unroll
    for (int kk = 0; kk < 4; ++kk)
#pragma unroll
        for (int nt = 0; nt < 4; ++nt) { const size_t o = (size_t)(16 * nt + r) * D + 128 * w + 32 * kk + 8 * q; bh[kk][nt] = *(const bf16x8*)(WRH + o); bl[kk][nt] = *(const bf16x8*)(WRL + o); }
    u32x2 va[4], vb[4];
    { const int tl0 = F.vcu; if (tl0 < T / 16) {
#pragma unroll
        for (int j = 0; j < 4; ++j) { va[j] = ((const u32x2*)(Y2 + ((size_t)16 * tl0 + 2 * w) * D))[lane + 64 * j]; vb[j] = ((const u32x2*)(Y2 + ((size_t)16 * tl0 + 2 * w + 1) * D))[lane + 64 * j]; } } }
    __syncthreads();
    for (int tl = F.vcu; tl < T / 16; tl += F.G) {
#pragma unroll
        for (int rr = 0; rr < 2; ++rr) { const int lr = 2 * w + rr; const size_t m = (size_t)16 * tl + lr;
            f32x4 v[4]; float s = 0.f;
#pragma unroll
            for (int j = 0; j < 4; ++j) { const u32x2 x = rr ? vb[j] : va[j]; v[j] = (f32x4){bflo(x.x), bfhi(x.x), bflo(x.y), bfhi(x.y)}; s += (v[j][0] + v[j][1]) + (v[j][2] + v[j][3]); }
            const float mean = wave_sum(s) * (1.f / D); float s2 = 0.f;
#pragma unroll
            for (int j = 0; j < 4; ++j) { const f32x4 d = v[j] - mean; s2 += (d[0] * d[0] + d[1] * d[1]) + (d[2] * d[2] + d[3] * d[3]); }
            const float rstd = 1.f / sqrtf(wave_sum(s2) * (1.f / D) + LN_EPS);
            u32x2* ob = (u32x2*)(X2b + m * D) + lane;
#pragma unroll
            for (int j = 0; j < 4; ++j) { const f32x4 y = (v[j] - mean) * rstd * gv[j] + bv[j];
                const u32x2 hi = (u32x2){pg8::pk2(y[0], y[1]), pg8::pk2(y[2], y[3])}; ob[64 * j] = hi;
                const f32x4 rs = (f32x4){y[0] - bflo(hi.x), y[1] - bfhi(hi.x), y[2] - bflo(hi.y), y[3] - bfhi(hi.y)};
                *(LAS u32x2*)(lds + RT_XH + lr * RT_XRS + (4 * lane + 256 * j) * 2) = hi;
                *(LAS u32x2*)(lds + RT_XL + lr * RT_XRS + (4 * lane + 256 * j) * 2) = (u32x2){pg8::pk2(rs[0], rs[1]), pg8::pk2(rs[2], rs[3])}; } }
        { const int tn = tl + F.G; if (tn < T / 16) {
#pragma unroll
            for (int j = 0; j < 4; ++j) { va[j] = ((const u32x2*)(Y2 + ((size_t)16 * tn + 2 * w) * D))[lane + 64 * j]; vb[j] = ((const u32x2*)(Y2 + ((size_t)16 * tn + 2 * w + 1) * D))[lane + 64 * j]; } } }
        __syncthreads();
        { f32x4 acc[4];
#pragma unroll
          for (int nt = 0; nt < 4; ++nt) acc[nt] = (f32x4){0.f, 0.f, 0.f, 0.f};
#pragma unroll
          for (int kk = 0; kk < 4; ++kk) { const int k0 = 128 * w + 32 * kk + 8 * q;
              const bf16x8 ah = *(const LAS bf16x8*)(lds + RT_XH + r * RT_XRS + k0 * 2), al = *(const LAS bf16x8*)(lds + RT_XL + r * RT_XRS + k0 * 2);
#pragma unroll
              for (int nt = 0; nt < 4; ++nt) {
                  acc[nt] = __builtin_amdgcn_mfma_f32_16x16x32_bf16(ah, bh[kk][nt], acc[nt], 0, 0, 0);
                  acc[nt] = __builtin_amdgcn_mfma_f32_16x16x32_bf16(al, bh[kk][nt], acc[nt], 0, 0, 0);
                  acc[nt] = __builtin_amdgcn_mfma_f32_16x16x32_bf16(ah, bl[kk][nt], acc[nt], 0, 0, 0); } }
#pragma unroll
          for (int nt = 0; nt < 4; ++nt)
#pragma unroll
              for (int e = 0; e < 4; ++e) *(LAS float*)(lds + RT_PART + ((w * 16 + 4 * q + e) * 64 + 16 * nt + r) * 4) = acc[nt][e]; }
        __syncthreads();
#pragma unroll
        for (int rr = 0; rr < 2; ++rr) { const int lt = 2 * w + rr; const size_t tok = (size_t)16 * tl + lt;
            float lg = 0.f;
#pragma unroll
            for (int k = 0; k < 8; ++k) lg += *(const LAS float*)(lds + RT_PART + ((k * 16 + lt) * 64 + lane) * 4);
            const float sc = 1.0f / (1.0f + __expf(-lg)); const float sel = sc + rb;
            const int g = lane >> 3;
            const float m1 = grp8_max(sel);
            const unsigned long long bal = __ballot(sel == m1);
            const unsigned gb = (unsigned)(bal >> (8 * g)) & 0xffu; const int first = 8 * g + __builtin_ctz(gb);
            const float m2 = grp8_max(lane == first ? -1e30f : sel);
            const float gs = m1 + m2;
            int grank = 0;
#pragma unroll
            for (int g2 = 0; g2 < 8; ++g2) { const float v = rdlane(gs, 8 * g2); grank += ((v > gs) || (v == gs && g2 < g)) ? 1 : 0; }
            const float val = (grank < 4) ? sel : -1e30f;
            int rank = 0;
#pragma unroll
            for (int e2 = 0; e2 < 64; ++e2) { const float v = rdlane(val, e2); rank += ((v > val) || (v == val && e2 < lane)) ? 1 : 0; }
            const bool chosen = rank < 8;
            const unsigned long long cm = __ballot(chosen);
            const float wsum = wave_sum(chosen ? sc : 0.f);
            if (chosen) { const int kidx = __builtin_popcountll(cm & ((1ull << lane) - 1ull));
                const unsigned lrk = __hip_atomic_fetch_add(&HIST[lane], 1u, __ATOMIC_RELAXED, __HIP_MEMORY_SCOPE_WORKGROUP);
                TK[tok * 8 + kidx] = (unsigned)lane | (lrk << 8); TKW[tok * 8 + kidx] = sc * (ROUTED_SCALE / wsum); }
        }
        __syncthreads();
    }
    if (tid < 64) { const unsigned cnt = HIST[tid]; const unsigned base = __hip_atomic_fetch_add(gcount + tid, cnt, RLX_AGENT); WGB[F.vcu * 64 + tid] = base; }
}

DI void slots_phase(Frame& F) {
    LAS unsigned char* lds = F.lds; unsigned char* ws = F.ws; const int tid = F.tid;
    LAS unsigned* CNT = (LAS unsigned*)lds; LAS unsigned* PS = CNT + 64;
    int* ROWTOK = (int*)(ws + WS_ROWTOK); float* ROWW = (float*)(ws + WS_ROWW); unsigned* SLOT = (unsigned*)(ws + WS_SLOT);
    const unsigned* TK = (const unsigned*)(ws + WS_TK); const float* TKW = (const float*)(ws + WS_TKW); const unsigned* WGB = (const unsigned*)(ws + WS_WGBASE);
    if (tid < 64) CNT[tid] = __hip_atomic_load(F.ctl + CW_GCOUNT + tid, RLX_AGENT);
    __syncthreads();
    if (tid == 0) { unsigned run = 0u; for (int e = 0; e < 64; ++e) { PS[e] = run; run += (CNT[e] + 255u) & ~255u; } PS[64] = run; }
    __syncthreads();
    const unsigned nblk = PS[64] >> 8;
    if (F.vcu == 0) {
        if (tid == 0) { __hip_atomic_store(F.ctl + CW_HDR, nblk, RLX_AGENT); __hip_atomic_store(F.ctl + CW_HDR + 1, (nblk + 1u) >> 1, RLX_AGENT); }
        for (unsigned bl = tid; bl < nblk; bl += NTHREADS) { unsigned e = 0; for (int k = 1; k < 64; ++k) e += (PS[k] <= bl * 256u) ? 1u : 0u; __hip_atomic_store(F.ctl + CW_BLKE + bl, e, RLX_AGENT); }
    }
    for (int e = F.vcu; e < 64; e += F.G) { const unsigned lo = PS[e] + CNT[e], hi = PS[e + 1]; for (unsigned s = lo + tid; s < hi; s += NTHREADS) { ROWTOK[s] = 0; ROWW[s] = 0.f; } }
    for (int tl = F.vcu; tl < T / 16; tl += F.G) {
        if (tid < 128) { const size_t a = (size_t)16 * 8 * tl + tid; const unsigned pk = TK[a], e = pk & 0xffu, lrk = pk >> 8;
            const unsigned slot = PS[e] + WGB[F.vcu * 64 + e] + lrk; ROWTOK[slot] = (int)(a >> 3); ROWW[slot] = TKW[a]; SLOT[a] = slot; }
    }
}

DI void dec8(unsigned w, float (&o)[4]) { const f32x2 a = __builtin_amdgcn_cvt_pk_f32_fp8((int)w, false), b = __builtin_amdgcn_cvt_pk_f32_fp8((int)w, true); o[0] = a[0]; o[1] = a[1]; o[2] = b[0]; o[3] = b[1]; }
DI void combine_phase(Frame& F, const float* const* in) {
    const int gw = F.vcu * NWAVES + F.wave, NGW = F.G * NWAVES, lane = F.lane;
    const unsigned* SLOT = (const unsigned*)(F.ws + WS_SLOT); const unsigned char* Y8 = (const unsigned char*)(F.ws + WS_YH); const bf16* base = (const bf16*)(F.ws + WS_X2B); float* out = F.out;
    f32x4 gv[4], bv[4];
#pragma unroll
    for (int j = 0; j < 4; ++j) { gv[j] = *(const f32x4*)(in[26] + 16 * lane + 4 * j); bv[j] = *(const f32x4*)(in[27] + 16 * lane + 4 * j); }
    for (int m0 = gw; m0 < T; m0 += 2 * NGW) {
        u32x4 yr[2][8]; u32x4 bs[2][2];
#pragma unroll
        for (int t2 = 0; t2 < 2; ++t2) { const int m = m0 + t2 * NGW; const int mm = (m < T) ? m : m0;
            unsigned sl[8];
#pragma unroll
            for (int k = 0; k < 8; ++k) sl[k] = __builtin_amdgcn_readfirstlane(__hip_atomic_load(SLOT + (size_t)mm * 8 + k, RLX_AGENT));
            bs[t2][0] = *(const u32x4*)(base + (size_t)mm * D + 16 * lane); bs[t2][1] = *(const u32x4*)(base + (size_t)mm * D + 16 * lane + 8);
#pragma unroll
            for (int k = 0; k < 8; ++k) yr[t2][k] = *(const u32x4*)(Y8 + (size_t)sl[k] * D + 16 * lane);
        }
#pragma unroll
        for (int t2 = 0; t2 < 2; ++t2) { const int m = m0 + t2 * NGW; if (m >= T) continue;
            float a[16];
#pragma unroll
            for (int c = 0; c < 16; ++c) a[c] = 0.f;
#pragma unroll
            for (int k = 0; k < 8; ++k) { const u32x4 y = yr[t2][k]; float d[4];
                dec8(y.x, d); a[0] += d[0]; a[1] += d[1]; a[2] += d[2]; a[3] += d[3];
                dec8(y.y, d); a[4] += d[0]; a[5] += d[1]; a[6] += d[2]; a[7] += d[3];
                dec8(y.z, d); a[8] += d[0]; a[9] += d[1]; a[10] += d[2]; a[11] += d[3];
                dec8(y.w, d); a[12] += d[0]; a[13] += d[1]; a[14] += d[2]; a[15] += d[3]; }
            f32x4 v[4];
#pragma unroll
            for (int h = 0; h < 2; ++h) { const u32x4 x = bs[t2][h];
                v[2 * h] = (f32x4){bflo(x.x), bfhi(x.x), bflo(x.y), bfhi(x.y)} + (f32x4){a[8 * h], a[8 * h + 1], a[8 * h + 2], a[8 * h + 3]} * (1.0f / pg8::Y8_SCALE);
                v[2 * h + 1] = (f32x4){bflo(x.z), bfhi(x.z), bflo(x.w), bfhi(x.w)} + (f32x4){a[8 * h + 4], a[8 * h + 5], a[8 * h + 6], a[8 * h + 7]} * (1.0f / pg8::Y8_SCALE); }
            float s = 0.f;
#pragma unroll
            for (int j = 0; j < 4; ++j) s += (v[j][0] + v[j][1]) + (v[j][2] + v[j][3]);
            const float mean = wave_sum(s) * (1.f / D); float s2 = 0.f;
#pragma unroll
            for (int j = 0; j < 4; ++j) { const f32x4 d = v[j] - mean; s2 += (d[0] * d[0] + d[1] * d[1]) + (d[2] * d[2] + d[3] * d[3]); }
            const float rstd = 1.f / sqrtf(wave_sum(s2) * (1.f / D) + LN_EPS);
#pragma unroll
            for (int j = 0; j < 4; ++j) *(f32x4*)(out + (size_t)m * D + 16 * lane + 4 * j) = (v[j] - mean) * rstd * gv[j] + bv[j];
        }
    }
}

DI void stagger(const Frame& F, unsigned ticks) {
    if (F.vcu & 1) { const unsigned long long t0 = __builtin_amdgcn_s_memrealtime(); while (__builtin_amdgcn_s_memrealtime() - t0 < ticks) __builtin_amdgcn_s_sleep(8); }
}
#ifndef STAG_DOWN
#define STAG_DOWN 350
#endif
constexpr int NPHASE = 13;
constexpr int CVT_A = 12288;
constexpr int N_LAUNCHES = MK_N_LAUNCHES;
static_assert(N_LAUNCHES == 1 || N_LAUNCHES == NPHASE, "MK_N_LAUNCHES: 1 (one dispatch) or 13 (one dispatch per phase)");
struct Args { const float* in[28]; float* out; unsigned char* ws; int ph_lo, ph_hi; };
static_assert(sizeof(Args) == 28 * 8 + 8 + 8 + 8, "Args has no padding");

__global__ void __launch_bounds__(NTHREADS, 2) fwd_kernel(Args args) {
    extern __shared__ __attribute__((aligned(16))) unsigned char lds_raw[];
    Frame F;
    F.lds = (LAS unsigned char*)lds_raw;
    volatile LAS unsigned* MISC = (volatile LAS unsigned*)(F.lds + MISC_OFF);
    F.tid = threadIdx.x; F.lane = F.tid & 63; F.wave = __builtin_amdgcn_readfirstlane(F.tid >> 6);
    F.G = gridDim.x; { const int bx = blockIdx.x; F.vcu = (F.G % 8 == 0) ? (bx % 8) * (F.G / 8) + bx / 8 : bx; }
    F.ws = args.ws; F.ctl = (unsigned*)(args.ws + WS_CTL); F.out = args.out;
    unsigned char* ws = args.ws;
    for (int u = F.tid; u < (LDS_BYTES - MISC_OFF) / 4; u += NTHREADS) ((LAS unsigned*)(F.lds + MISC_OFF))[u] = 0u;
    __syncthreads();
    XcdBarrier bar; bar.bar = F.ctl + CW_BAR; bar.x = 0; bar.st = nullptr;
    if (N_LAUNCHES == 1) bar = xcd_barrier_post(F.ctl + CW_BAR, MISC + 8);
#define GRID_BAR() do { if (N_LAUNCHES == 1) xcd_barrier(bar); } while (0)
    const int lo = args.ph_lo, hi = args.ph_hi;
#ifndef PHASE_MASK
#define PHASE_MASK 0x1fff
#endif
#define IN(k) (((PHASE_MASK >> (k)) & 1) && lo <= (k) && (k) < hi)
#ifndef REPEAT_MASK
#define REPEAT_MASK 0
#endif
#ifndef DOWN_PROBE
#define DOWN_PROBE 0
#endif
#define REP(k) (((REPEAT_MASK >> (k)) & 1) ? 2 : 1)
#define SEAM(k) do { if (IN(k) && IN((k) + 1)) GRID_BAR(); } while (0)
    const float* const* in = args.in;

    for (int rep_ = 0; rep_ < (IN(0) ? REP(0) : 0); ++rep_) { if (rep_) GRID_BAR(); p0_prologue(F, in); SEAM(0); }
    for (int rep_ = 0; rep_ < (IN(1) ? REP(1) : 0); ++rep_) { if (rep_) GRID_BAR();
        pg8::DenseOrder S; S.init((const bf16*)F.out, (const bf16*)(ws + WS_WIN), T, INW, D, F.G, (int)blockIdx.x);
        pg8::EpiInProj E{(bf16*)(ws + WS_P1), (float*)(ws + WS_VSTAT), (const float*)(ws + WS_BPERM)};
        pg8::gemm_phase<pg8::EpiInProj, pg8::DenseOrder, true>(F.lds, D, S, E);
        SEAM(1);
    }
    for (int rep_ = 0; rep_ < (IN(2) ? REP(2) : 0); ++rep_) { if (rep_) GRID_BAR(); mix_phase(F, in); SEAM(2); }
    for (int rep_ = 0; rep_ < (IN(3) ? REP(3) : 0); ++rep_) { if (rep_) GRID_BAR();
        pg8::DenseOrder S; S.init((const bf16*)(ws + WS_MERGED), (const bf16*)(ws + WS_WOUT), T, D, D, F.G, (int)blockIdx.x);
        pg8::EpiResB16<true> E{(bf16*)(ws + WS_Y1), in[0], nullptr, (const float*)(ws + WS_XSTAT), in[2], in[3]};
        pg8::gemm_phase<pg8::EpiResB16<true>, pg8::DenseOrder, false>(F.lds, D, S, E);
        SEAM(3);
    }
    for (int rep_ = 0; rep_ < (IN(4) ? REP(4) : 0); ++rep_) { if (rep_) GRID_BAR(); ln1_phase(F, in); SEAM(4); }
    for (int rep_ = 0; rep_ < (IN(5) ? REP(5) : 0); ++rep_) { if (rep_) GRID_BAR();
        if (F.G == 256) { if ((int)blockIdx.x >= 160) expert_convert(F, in, (int)blockIdx.x - 160, 96, 0, CVT_A); }
        else expert_convert(F, in, F.vcu, F.G, 0, NEXP * 384);
        __syncthreads();
        { pg8::DenseOrder S; S.init((const bf16*)(ws + WS_X1B), (const bf16*)(ws + WS_WQ), T, MEMW, D, F.G, (int)blockIdx.x);
          pg8::EpiBf16S E{(bf16*)(ws + WS_QM), MEMW, QSCALE};
          pg8::gemm_phase<pg8::EpiBf16S, pg8::DenseOrder, false>(F.lds, D, S, E); }
        { const int c2 = ((int)blockIdx.x + F.G - 128 % F.G) % F.G;
          pg8::DenseOrder S; S.init((const bf16*)(ws + WS_MEMB), (const bf16*)(ws + WS_WKV), NBATCH * MEMLEN, 2 * MEMW, D, F.G, c2);
          pg8::EpiBf16S E{(bf16*)(ws + WS_KVM), 2 * MEMW, 1.0f};
          pg8::gemm_phase<pg8::EpiBf16S, pg8::DenseOrder, false>(F.lds, D, S, E); }
        SEAM(5);
    }
    for (int rep_ = 0; rep_ < (IN(6) ? REP(6) : 0); ++rep_) { if (rep_) GRID_BAR();
        if (F.G == 256) { if (F.vcu & 1) expert_convert(F, in, F.vcu >> 1, 128, CVT_A, NEXP * 384); else memattn_phase(F, F.vcu >> 1, 128); }
        else memattn_phase(F, F.vcu, F.G);
        SEAM(6); }
    for (int rep_ = 0; rep_ < (IN(7) ? REP(7) : 0); ++rep_) { if (rep_) GRID_BAR();
        pg8::DenseOrder S; S.init((const bf16*)(ws + WS_OM), (const bf16*)(ws + WS_WO), T, D, MEMW, F.G, (int)blockIdx.x);
        pg8::EpiResB16<false> E{(bf16*)F.out, nullptr, (const bf16*)(ws + WS_X1B), nullptr, nullptr, nullptr};
        pg8::gemm_phase<pg8::EpiResB16<false>, pg8::DenseOrder, false>(F.lds, MEMW, S, E);
        SEAM(7);
    }
    for (int rep_ = 0; rep_ < (IN(8) ? REP(8) : 0); ++rep_) { if (rep_) GRID_BAR(); route_phase(F, in, F.ctl + ((rep_ + 1 < REP(8)) ? 2048 : CW_GCOUNT)); SEAM(8); }
    for (int rep_ = 0; rep_ < (IN(9) ? REP(9) : 0); ++rep_) { if (rep_) GRID_BAR(); slots_phase(F); SEAM(9); }
    for (int rep_ = 0; rep_ < (IN(10) ? REP(10) : 0); ++rep_) { if (rep_) GRID_BAR();
        const int nblk = (int)__builtin_amdgcn_readfirstlane(__hip_atomic_load(F.ctl + CW_HDR, RLX_AGENT));
        pg8::moe_tables(F.lds, F.ctl + CW_BLKE, nblk, (const int*)(ws + WS_ROWTOK), (const float*)(ws + WS_ROWW), true, F.G, F.vcu, F.tid);
        pg8::GateUpOrder S{(const char*)(ws + WS_X2B), (const char*)(ws + WS_WGU), (const char*)(ws + WS_WGUS), F.lds, nblk, F.G, F.vcu};
        pg8::EpiGateUp E{(bf16*)(ws + WS_H), F.lds};
        pg8::gemm_phase<pg8::EpiGateUp, pg8::GateUpOrder, true>(F.lds, D, S, E);
        SEAM(10);
    }
    for (int rep_ = 0; rep_ < (IN(11) ? REP(11) : 0); ++rep_) { if (rep_) GRID_BAR();
        const int nblk = (int)__builtin_amdgcn_readfirstlane(__hip_atomic_load(F.ctl + CW_HDR, RLX_AGENT));
        pg8::moe_tables(F.lds, F.ctl + CW_BLKE, nblk, nullptr, nullptr, false, F.G, F.vcu, F.tid);
        pg8::DownOrder S{(const char*)(ws + WS_H), (const char*)(ws + WS_WD), (const char*)(ws + WS_WDS), F.lds, 0, nblk, 64, F.G, F.vcu, 0};
        pg8::EpiDown E{(unsigned char*)(ws + WS_YH), (bf16*)(ws + WS_X2B), 0};
        pg8::gemm_phase<pg8::EpiDown, pg8::DownOrder, true>(F.lds, EH, S, E);
        SEAM(11);
    }
    if (IN(12)) { combine_phase(F, in); }
#undef IN
#undef SEAM
#undef GRID_BAR
}

extern "C" void kernel_launch(void* const* d_in, const int* in_sizes, int n_in, void* d_out, int out_size, void* d_ws, size_t ws_size, hipStream_t stream) {
    static int grid = 0;
    if (grid == 0) {
        if (n_in != 28 || in_sizes[0] != T * D || out_size != T * D || ws_size < WS_END) { fprintf(stderr, "kernel_launch: unexpected shapes / workspace (n_in %d, ws %zu < %zu)\n", n_in, ws_size, (size_t)WS_END); grid = -1; return; }
        int dev = 0, cus = 0, per_cu = 0;
        if (hipGetDevice(&dev) != hipSuccess || hipDeviceGetAttribute(&cus, hipDeviceAttributeMultiprocessorCount, dev) != hipSuccess) { grid = -1; return; }
        if (hipFuncSetAttribute((const void*)fwd_kernel, hipFuncAttributeMaxDynamicSharedMemorySize, LDS_BYTES) != hipSuccess) { fprintf(stderr, "kernel_launch: hipFuncSetAttribute failed\n"); grid = -1; return; }
        if (hipOccupancyMaxActiveBlocksPerMultiprocessor(&per_cu, (const void*)fwd_kernel, NTHREADS, LDS_BYTES) != hipSuccess || per_cu < 1) { fprintf(stderr, "kernel_launch: occupancy query reports %d\n", per_cu); }
        (void)hipGetLastError();
        grid = cus;
    }
    if (grid < 0) return;
    if (hipMemsetAsync((char*)d_ws + WS_CTL, 0, CTL_ZERO_BYTES, stream) != hipSuccess) return;
    Args a{};
    for (int i = 0; i < 28; ++i) a.in[i] = (const float*)d_in[i];
    a.out = (float*)d_out; a.ws = (unsigned char*)d_ws;
    for (int li = 0; li < N_LAUNCHES; ++li) {
        a.ph_lo = (N_LAUNCHES == 1) ? 0 : li; a.ph_hi = (N_LAUNCHES == 1) ? NPHASE : li + 1;
        hipLaunchKernelGGL(fwd_kernel, dim3(grid), dim3(NTHREADS), LDS_BYTES, stream, a);
        if (hipPeekAtLastError() != hipSuccess) { fprintf(stderr, "kernel_launch: launch %d failed\n", li); break; }
    }
}
```

```cpp
#include <hip/hip_runtime.h>
#include <cstdio>
#include <cstdint>

#ifndef MK_N_LAUNCHES
#define MK_N_LAUNCHES 1
#endif

#define GAS __attribute__((address_space(1)))
#define LAS __attribute__((address_space(3)))
typedef unsigned short bf16;
typedef short bf16x8 __attribute__((ext_vector_type(8)));
typedef short s16x4 __attribute__((ext_vector_type(4)));
typedef float f32x4 __attribute__((ext_vector_type(4)));
typedef float f32x2 __attribute__((ext_vector_type(2)));
typedef unsigned u32x4 __attribute__((ext_vector_type(4)));
typedef unsigned u32x2 __attribute__((ext_vector_type(2)));
#define RLX_AGENT __ATOMIC_RELAXED, __HIP_MEMORY_SCOPE_AGENT
#define DI __device__ __forceinline__

constexpr int T = 16384, D = 1024, NBATCH = 8, SEQ = 2048, MEMLEN = 256, INW = 7168;
constexpr int NEXP = 64, TOPK = 8, EH = 256, MEMW = 512;
constexpr float LN_EPS = 1e-5f;
constexpr float ALPHA = 1.189207115002721f;
constexpr float QSCALE = 0.08838834764831845f;
constexpr float ROUTED_SCALE = 2.5f;
constexpr float LOG2E = 1.4426950408889634f, LN2 = 0.6931471805599453f;
constexpr float SB_EXIT = -30.0f;
constexpr int NWAVES = 8, NTHREADS = 512;
constexpr int MAXBLK = 576;
constexpr int SH_ROW0 = MAXBLK * 256;

constexpr size_t MiB = 1u << 20;
constexpr size_t WS_CTL = 0, CTL_ZERO_BYTES = 32 * 1024;
constexpr size_t WS_WRHI = 1 * MiB, WS_WRLO = WS_WRHI + 128 * 1024, WS_WSP = WS_WRLO + 128 * 1024, WS_BPERM = WS_WSP + 256 * 1024, WS_XSTAT = WS_BPERM + 32 * 1024;
constexpr size_t WS_ROWTOK = 2 * MiB, WS_ROWW = WS_ROWTOK + 576 * 1024, WS_SLOT = WS_ROWW + 576 * 1024;
constexpr size_t WS_WIN = 4 * MiB, WS_WOUT = 18 * MiB, WS_WQ = 20 * MiB, WS_WKV = 21 * MiB, WS_WO = 23 * MiB, WS_MEMB = 24 * MiB;
constexpr size_t WS_P1 = 29 * MiB;
constexpr size_t WS_UG = WS_P1, WS_VA = WS_P1 + 32 * MiB, WS_Q = WS_P1 + 64 * MiB, WS_K = WS_P1 + 96 * MiB, WS_V = WS_P1 + 128 * MiB, WS_GB = WS_P1 + 160 * MiB;
constexpr size_t WS_VSTAT = 221 * MiB;
constexpr size_t WS_MERGED = 228 * MiB;
constexpr size_t WS_Y1 = 29 * MiB;
constexpr size_t WS_X1F = 93 * MiB, WS_X1B = 157 * MiB;
constexpr size_t WS_QM = 189 * MiB, WS_KVM = 205 * MiB, WS_OM = 209 * MiB;
constexpr size_t WS_WGU = 29 * MiB;
constexpr size_t WS_H = 148 * MiB;
constexpr size_t WS_X2B = 228 * MiB;
constexpr size_t WS_WD = 260 * MiB;
constexpr size_t WS_WGUS = 293 * MiB, WS_WDS = 294 * MiB;
constexpr size_t WS_TK = 295 * MiB, WS_TKW = WS_TK + 512 * 1024, WS_WGBASE = WS_TKW + 512 * 1024;
constexpr size_t WS_YH = 4 * MiB;
constexpr size_t WS_END = 297 * MiB;
static_assert(WS_XSTAT + (size_t)T * 8 <= WS_ROWTOK && WS_SLOT + (size_t)T * 8 * 4 <= WS_WIN && WS_MEMB + 4 * MiB <= WS_P1, "ws map 1");
static_assert(WS_GB + 32 * MiB <= WS_VSTAT && WS_VSTAT + 2 * MiB <= WS_MERGED && WS_H + (size_t)(SH_ROW0 + T) * 512 <= WS_X2B && WS_X2B + 32 * MiB <= WS_WD, "ws map 2");
static_assert(WS_WD + (size_t)64 * 1024 * 256 * 2 <= WS_WGUS && WS_YH + (size_t)288 * 256 * 2048 <= WS_H && WS_WGBASE + 256 * 64 * 4 <= WS_END, "ws map 3");
constexpr int CW_TMO = 0, CW_CODE = 1;
constexpr int CW_GCOUNT = 64;
constexpr int CW_HDR = 192;
constexpr int CW_BLKE = 256;
constexpr int CW_BAR = 4096;

constexpr int SCR_BYTES = 140 * 1024;
constexpr int MISC_OFF = SCR_BYTES;
constexpr int LDS_BYTES = 144 * 1024;

DI unsigned cvt_pk_bf16(float lo, float hi) { unsigned r; asm volatile("v_cvt_pk_bf16_f32 %0, %1, %2" : "=v"(r) : "v"(lo), "v"(hi)); return r; }
DI float bf2f(unsigned short h) { return __uint_as_float((unsigned)h << 16); }
DI float bflo(unsigned w) { return __uint_as_float(w << 16); }
DI float bfhi(unsigned w) { return __uint_as_float(w & 0xffff0000u); }
DI float fast_exp2(float x) { return __builtin_amdgcn_exp2f(x); }
DI float fast_log2(float x) { return __builtin_amdgcn_logf(x); }
DI float fast_rcp(float x) { return __builtin_amdgcn_rcpf(x); }
DI float sigmoidf_(float x) { return fast_rcp(1.0f + fast_exp2(-x * LOG2E)); }
template <int CTRL, int ROWMASK> DI float dpp_f(float v, float fill) { return __uint_as_float((unsigned)__builtin_amdgcn_update_dpp((int)__float_as_uint(fill), (int)__float_as_uint(v), CTRL, ROWMASK, 0xf, false)); }
DI float wave_sum(float v) {
    v += dpp_f<0x111, 0xf>(v, 0.f); v += dpp_f<0x112, 0xf>(v, 0.f); v += dpp_f<0x114, 0xf>(v, 0.f); v += dpp_f<0x118, 0xf>(v, 0.f);
    v += dpp_f<0x142, 0xa>(v, 0.f); v += dpp_f<0x143, 0xc>(v, 0.f);
    return __uint_as_float(__builtin_amdgcn_readlane(__float_as_uint(v), 63));
}
DI float wave_max(float v) {
#pragma unroll
    for (int o = 1; o < 64; o <<= 1) v = fmaxf(v, __shfl_xor(v, o));
    return v;
}
#define LDS_WAIT() asm volatile("s_waitcnt lgkmcnt(0)" ::: "memory")
#define VM_WAIT() asm volatile("s_waitcnt vmcnt(0)" ::: "memory")

namespace pg8 {
constexpr int BM = 256, BK = 64, HALF = 128, HTB = HALF * BK * 2, STAGE_BYTES = 8 * HTB, NXCD = 8, WGM = 8;
__host__ __device__ __forceinline__ int lds_byte(int r, int c) { const int st = (r >> 4) * 2 + (c >> 5), rr = r & 15, cc = c & 31, ob = rr * 64 + cc * 2; return st * 1024 + (ob ^ (((ob >> 9) & 1) << 5)); }
__host__ __device__ __forceinline__ void stage_rc(int b, int& R, int& C) { const int st = b / 1024, sb = b % 1024, swz = sb ^ (((sb >> 9) & 1) << 5); R = (st >> 1) * 16 + swz / 64; C = (st & 1) * 32 + (swz % 64) / 2; }
__host__ __device__ __forceinline__ int perm32(int rho) { const int n = rho >> 4, i = rho & 15; return 8 * (i >> 2) + 4 * n + (i & 3); }

struct Unit { int pm, pn, e, ui; const char* A; const char* B; };

typedef float f32x2v __attribute__((ext_vector_type(2)));
DI f32x2v gelu_pk(f32x2v v) {
    const f32x2v av = __builtin_elementwise_abs(v), d = av * 0.2316418882f + 1.0f;
    f32x2v t; t.x = __builtin_amdgcn_rcpf(d.x); t.y = __builtin_amdgcn_rcpf(d.y);
    f32x2v q = t * 0.5307027145f + (-0.7265760135f); q = q * t + 0.7107068705f; q = q * t + (-0.142248368f); q = q * t + 0.127414796f; q = q * t;
    const f32x2v s = (v * v) * (-0.72134752044f);
    f32x2v e; e.x = __builtin_amdgcn_exp2f(s.x); e.y = __builtin_amdgcn_exp2f(s.y);
    const f32x2v m = v * (q * e), r = v - m;
    f32x2v o; o.x = v.x < 0.f ? m.x : r.x; o.y = v.y < 0.f ? m.y : r.y; return o;
}
DI f32x4 gelu4(f32x4 v) { const f32x2v a = gelu_pk((f32x2v){v[0], v[1]}), b = gelu_pk((f32x2v){v[2], v[3]}); return (f32x4){a.x, a.y, b.x, b.y}; }
DI f32x4 sigmoid4(f32x4 v) { return (f32x4){sigmoidf_(v[0]), sigmoidf_(v[1]), sigmoidf_(v[2]), sigmoidf_(v[3])}; }
DI u32x4 pack8(f32x4 v0, f32x4 v1) { u32x4 w; w.x = cvt_pk_bf16(v0[0], v0[1]); w.y = cvt_pk_bf16(v0[2], v0[3]); w.z = cvt_pk_bf16(v1[0], v1[1]); w.w = cvt_pk_bf16(v1[2], v1[3]); return w; }

template <class Epi, class Sched, bool ALIGN_EPI>
DI void gemm_phase(LAS unsigned char* lds, const int K, const Sched& S, const Epi& E) {
    const int tid = threadIdx.x, wid = __builtin_amdgcn_readfirstlane(tid >> 6), lane = tid & 63, wr = wid >> 2, wc = wid & 3, fr = lane & 15, fq = lane >> 4;
    const int nt = K / BK;
    int Rr[2], Cc[2]; unsigned voffB[2], voffB1[2];
#pragma unroll
    for (int i = 0; i < 2; ++i) { int R, C; stage_rc(tid * 16 + i * 8192, R, C); Rr[i] = R; Cc[i] = C;
        if (Epi::PERM == 2) { const int w0 = 64 * (R >> 5) + 16 * ((R & 15) >> 2) + 4 * ((R >> 4) & 1) + (R & 3); voffB[i] = (unsigned)(w0 * K + C) * 2u; voffB1[i] = (unsigned)((w0 + 8) * K + C) * 2u; }
        else { const int Rb = Epi::PERM ? ((R & ~31) + perm32(R & 31)) : R; voffB[i] = (unsigned)(Rb * K + C) * 2u; voffB1[i] = (unsigned)((Rb + HALF) * K + C) * 2u; } }
    const size_t kstep = (size_t)(BK * 2);
    const unsigned ldsw = (unsigned)wid * 1024u;
    const int aoff = lds_byte(wr * 64 + fr, fq * 8), boff = lds_byte(wc * 32 + fr, fq * 8);
#define PG8_SA(b, h) (((b) * 2 + (h)) * HTB)
#define PG8_SB(b, h) ((4 + (b) * 2 + (h)) * HTB)
#define PG8_STAGE_B(bufoff, gbase) do { _Pragma("unroll") for (int _i = 0; _i < 2; ++_i) \
        __builtin_amdgcn_global_load_lds((const unsigned*)((const char*)(gbase) + voffB[_i]), (LAS unsigned*)(lds + (bufoff) + ldsw + _i * 8192), 16, 0, 0); } while (0)
#define PG8_STAGE_B1(bufoff, gbase) do { _Pragma("unroll") for (int _i = 0; _i < 2; ++_i) \
        __builtin_amdgcn_global_load_lds((const unsigned*)((const char*)(gbase) + voffB1[_i]), (LAS unsigned*)(lds + (bufoff) + ldsw + _i * 8192), 16, 0, 0); } while (0)
#define PG8_STAGE_A(bufoff, gbase, o0, o1) do { \
        __builtin_amdgcn_global_load_lds((const unsigned*)((const char*)(gbase) + (o0)), (LAS unsigned*)(lds + (bufoff) + ldsw), 16, 0, 0); \
        __builtin_amdgcn_global_load_lds((const unsigned*)((const char*)(gbase) + (o1)), (LAS unsigned*)(lds + (bufoff) + ldsw + 8192), 16, 0, 0); } while (0)
#define PG8_LDA(dst, b, h) do { _Pragma("unroll") for (int m = 0; m < 4; ++m) _Pragma("unroll") for (int k = 0; k < 2; ++k) dst[m][k] = *(const LAS bf16x8*)(lds + PG8_SA(b, h) + aoff + m * 2048 + k * 1024); } while (0)
#define PG8_LDB(dst, b, h) do { _Pragma("unroll") for (int n = 0; n < 2; ++n) _Pragma("unroll") for (int k = 0; k < 2; ++k) dst[n][k] = *(const LAS bf16x8*)(lds + PG8_SB(b, h) + boff + n * 2048 + k * 1024); } while (0)
#define PG8_MMA(ai, bj, At, Bt) do { __builtin_amdgcn_s_setprio(1); _Pragma("unroll") for (int m = 0; m < 4; ++m) _Pragma("unroll") for (int n = 0; n < 2; ++n) _Pragma("unroll") for (int k = 0; k < 2; ++k) \
        acc[ai][bj][m][n] = __builtin_amdgcn_mfma_f32_16x16x32_bf16(Bt[n][k], At[m][k], acc[ai][bj][m][n], 0, 0, 0); __builtin_amdgcn_s_setprio(0); } while (0)
#define PG8_WAIT_V(n) asm volatile("s_waitcnt vmcnt(" #n ")" ::: "memory")
#define PG8_WAIT_L(n) asm volatile("s_waitcnt lgkmcnt(" #n ")" ::: "memory")
#define PG8_BAR __builtin_amdgcn_s_barrier()
#define PG8_SCHED __builtin_amdgcn_sched_barrier(0)
    Unit cur, nxt; int ui = 0;
    if (!S.next(0, cur)) return;
    unsigned oc[2][2], on[2][2];
    S.a_offs(cur, Rr, Cc, K, oc);
    f32x4 acc[2][2][4][2];
#pragma unroll
    for (int a = 0; a < 2; ++a)
#pragma unroll
        for (int b = 0; b < 2; ++b)
#pragma unroll
            for (int m = 0; m < 4; ++m)
#pragma unroll
                for (int n = 0; n < 2; ++n) acc[a][b][m][n] = (f32x4){0.f, 0.f, 0.f, 0.f};
    bf16x8 At[4][2], B0[2][2], B1[2][2];
    const char* cA = cur.A; const char* cB = cur.B;
    PG8_STAGE_B(PG8_SB(0, 0), cB); PG8_STAGE_B1(PG8_SB(0, 1), cB); PG8_STAGE_A(PG8_SA(0, 0), cA, oc[0][0], oc[0][1]); PG8_STAGE_A(PG8_SA(0, 1), cA, oc[1][0], oc[1][1]);
    if (wr == 1) PG8_BAR;
    PG8_WAIT_V(2); PG8_BAR;
    PG8_STAGE_B(PG8_SB(1, 0), cB + kstep); PG8_STAGE_A(PG8_SA(1, 0), cA + kstep, oc[0][0], oc[0][1]); PG8_STAGE_B1(PG8_SB(1, 1), cB + kstep);
    PG8_WAIT_V(6); PG8_BAR;
    for (;;) {
        const bool has_next = S.next(ui + 1, nxt);
        const char* nA = has_next ? nxt.A : cA; const char* nB = has_next ? nxt.B : cB;
        if (has_next) S.a_offs(nxt, Rr, Cc, K, on);
        else {
#pragma unroll
            for (int h = 0; h < 2; ++h)
#pragma unroll
                for (int i = 0; i < 2; ++i) on[h][i] = oc[h][i]; }
#pragma unroll 1
        for (int t = 0; t < nt; t += 2) {
            const bool last = (t == nt - 2);
            const char* a1 = cA + (size_t)(t + 1) * kstep;
            const char* a2 = last ? nA : cA + (size_t)(t + 2) * kstep; const char* b2 = last ? nB : cB + (size_t)(t + 2) * kstep;
            const char* a3 = a2 + kstep; const char* b3 = b2 + kstep;
            const unsigned x00 = last ? on[0][0] : oc[0][0], x01 = last ? on[0][1] : oc[0][1], x10 = last ? on[1][0] : oc[1][0], x11 = last ? on[1][1] : oc[1][1];
            PG8_LDB(B0, 0, 0); PG8_LDB(B1, 0, 1); PG8_SCHED; PG8_LDA(At, 0, 0); PG8_STAGE_A(PG8_SA(1, 1), a1, oc[1][0], oc[1][1]);
            PG8_WAIT_V(8); PG8_WAIT_L(0); PG8_BAR; PG8_MMA(0, 0, At, B0); PG8_MMA(0, 1, At, B1); PG8_BAR; PG8_SCHED;
            PG8_LDA(At, 0, 1); PG8_STAGE_B(PG8_SB(0, 0), b2); PG8_STAGE_B1(PG8_SB(0, 1), b2); PG8_STAGE_A(PG8_SA(0, 0), a2, x00, x01);
            PG8_WAIT_V(8); PG8_WAIT_L(0); PG8_BAR; PG8_MMA(1, 0, At, B0); PG8_MMA(1, 1, At, B1); PG8_BAR; PG8_SCHED;
            PG8_LDB(B0, 1, 0); PG8_LDB(B1, 1, 1); PG8_SCHED; PG8_LDA(At, 1, 0); PG8_STAGE_A(PG8_SA(0, 1), a2, x10, x11);
            PG8_WAIT_V(8); PG8_WAIT_L(0); PG8_BAR; PG8_MMA(0, 0, At, B0); PG8_MMA(0, 1, At, B1); PG8_BAR; PG8_SCHED;
            PG8_LDA(At, 1, 1); PG8_STAGE_B(PG8_SB(1, 0), b3); PG8_STAGE_B1(PG8_SB(1, 1), b3); PG8_STAGE_A(PG8_SA(1, 0), a3, x00, x01);
            PG8_WAIT_V(8); PG8_WAIT_L(0); PG8_BAR; PG8_MMA(1, 0, At, B0); PG8_MMA(1, 1, At, B1); PG8_BAR; PG8_SCHED;
        }
        if constexpr (ALIGN_EPI) { if (wr == 0) PG8_BAR; }
        E(acc, cur, wr, wc, fr, fq);
        if (!has_next) break;
#pragma unroll
        for (int a = 0; a < 2; ++a)
#pragma unroll
            for (int b = 0; b < 2; ++b)
#pragma unroll
                for (int m = 0; m < 4; ++m)
#pragma unroll
                    for (int n = 0; n < 2; ++n) acc[a][b][m][n] = (f32x4){0.f, 0.f, 0.f, 0.f};
        cur = nxt; cA = nA; cB = nB; ++ui;
#pragma unroll
        for (int h = 0; h < 2; ++h)
#pragma unroll
            for (int i = 0; i < 2; ++i) oc[h][i] = on[h][i];
        if constexpr (ALIGN_EPI) { if (wr == 1) PG8_BAR; }
    }
    PG8_WAIT_V(0);
    if constexpr (!ALIGN_EPI) { if (wr == 0) PG8_BAR; }
    PG8_BAR;
#undef PG8_SA
#undef PG8_SB
#undef PG8_STAGE_A
#undef PG8_STAGE_B
#undef PG8_STAGE_B1
#undef PG8_LDA
#undef PG8_LDB
#undef PG8_MMA
#undef PG8_WAIT_V
#undef PG8_WAIT_L
#undef PG8_BAR
#undef PG8_SCHED
}

struct DenseOrder {
    const char* A; const char* Bt; int K, nM, nN, nwg, G, c;
    DI void init(const bf16* A_, const bf16* Bt_, int M, int N, int K_, int G_, int c_) { A = (const char*)A_; Bt = (const char*)Bt_; K = K_; nM = M / BM; nN = N / BM; nwg = nM * nN; G = G_; c = c_; }
    DI bool next(int i, Unit& u) const {
        const long L = (long)i * G + c; if (L >= nwg) return false;
        int wgid = (int)L; { const int q = nwg / NXCD, r = nwg % NXCD, xcd = wgid % NXCD, off = wgid / NXCD; wgid = (xcd < r ? xcd * (q + 1) : r * (q + 1) + (xcd - r) * q) + off; }
        const int nig = WGM * nN, gid = wgid / nig, fm = gid * WGM, gsz = (nM - fm) < WGM ? (nM - fm) : WGM;
        u.pm = fm + ((wgid % nig) % gsz); u.pn = (wgid % nig) / gsz; u.e = 0; u.ui = i;
        u.A = A + (size_t)u.pm * BM * K * 2; u.B = Bt + (size_t)u.pn * BM * K * 2; return true;
    }
    DI void a_offs(const Unit&, const int (&R)[2], const int (&C)[2], int K_, unsigned (&off)[2][2]) const {
#pragma unroll
        for (int h = 0; h < 2; ++h)
#pragma unroll
            for (int i = 0; i < 2; ++i) off[h][i] = (unsigned)((h * HALF + R[i]) * K_ + C[i]) * 2u;
    }
};
}

#define XB_TMO      128
#define XB_XCNT(j)  (256  + 64 * (j))
#define XB_XSUB(j)  (1280 + 64 * (j))
#define XB_XGEN(j)  (2304 + 64 * (j))
#define XB_TOP      3328
#define XB_TOPGEN   3392
#define XCD_BAR_WORDS 3456
#define XB_SPIN_CAP (1u << 18)
DI unsigned xb_ld(unsigned* p)              { return __hip_atomic_load(p, __ATOMIC_RELAXED, __HIP_MEMORY_SCOPE_AGENT); }
DI unsigned xb_add(unsigned* p, unsigned v) { return __hip_atomic_fetch_add(p, v, __ATOMIC_RELAXED, __HIP_MEMORY_SCOPE_AGENT); }
DI unsigned xb_xcc_id() { return (unsigned)__builtin_amdgcn_s_getreg((3 << 11) | 20) & 0xFu; }
#define XB_SPIN(cond, bar) do { unsigned _sp = 0; while (cond) { __builtin_amdgcn_s_sleep(1); \
    if ((++_sp & 255u) == 0u) { if (xb_ld(&(bar)[XB_TMO])) break; if (_sp > XB_SPIN_CAP) { atomicAdd(&(bar)[XB_TMO], 1u); break; } } } } while (0)
struct XcdBarrier { unsigned* bar; unsigned x; volatile LAS unsigned* st; };
DI XcdBarrier xcd_barrier_post(unsigned* bar, volatile LAS unsigned* st) {
    XcdBarrier b; b.bar = bar; b.x = xb_xcc_id(); b.st = st;
    if (threadIdx.x == 0) (void)xb_add(&bar[XB_XCNT(b.x)], 1u);
    return b;
}
DI void xcd_barrier_complete(unsigned* bar, unsigned x, unsigned& nloc, unsigned& nx) {
    const unsigned G = gridDim.x * gridDim.y * gridDim.z;
    unsigned sum, cnt, mine, sp = 0u;
    for (;;) {
        sum = 0u; cnt = 0u; mine = 0u;
#pragma unroll
        for (unsigned j = 0; j < 16; ++j) { const unsigned c = xb_ld(&bar[XB_XCNT(j)]); sum += c; cnt += (c > 0u) ? 1u : 0u; mine = (j == x) ? c : mine; }
        if (sum == G) break;
        __builtin_amdgcn_s_sleep(1);
        if ((++sp & 255u) == 0u) { if (xb_ld(&bar[XB_TMO])) break; if (sp > XB_SPIN_CAP) { atomicAdd(&bar[XB_TMO], 1u); break; } }
    }
    nloc = mine > 0u ? mine : 1u; nx = cnt > 0u ? cnt : 1u;
}
DI void xcd_barrier(const XcdBarrier& b) {
    asm volatile("s_waitcnt vmcnt(0)" ::: "memory");
    __syncthreads();
    if (threadIdx.x == 0) {
        unsigned* bar = b.bar;
        __builtin_amdgcn_s_waitcnt(0);
        unsigned nloc = b.st[0], nx = b.st[1];
        if (nloc == 0u) { xcd_barrier_complete(bar, b.x, nloc, nx); b.st[0] = nloc; b.st[1] = nx; }
        const unsigned old = xb_add(&bar[XB_XSUB(b.x)], 1u);
        const unsigned gen = old / nloc;
        if (old + 1u == (gen + 1u) * nloc) {
            __builtin_amdgcn_fence(__ATOMIC_RELEASE, "agent");
            asm volatile("s_waitcnt vmcnt(0)" ::: "memory");
            const unsigned og = xb_add(&bar[XB_TOP], 1u);
            const unsigned tg = og / nx;
            if (og + 1u == (tg + 1u) * nx) xb_add(&bar[XB_TOPGEN], 1u);
            else XB_SPIN(xb_ld(&bar[XB_TOPGEN]) == tg, bar);
            __builtin_amdgcn_fence(__ATOMIC_ACQUIRE, "agent");
            xb_add(&bar[XB_XGEN(b.x)], 1u);
            asm volatile("s_waitcnt vmcnt(0)" ::: "memory");
        } else {
            XB_SPIN(xb_ld(&bar[XB_XGEN(b.x)]) == gen, bar);
            __builtin_amdgcn_fence(__ATOMIC_ACQUIRE, "agent");
            asm volatile("s_waitcnt vmcnt(0)" ::: "memory");
        }
    }
    __syncthreads();
}

namespace pg8 {
typedef __bf16 bf16x2_t __attribute__((ext_vector_type(2)));
DI unsigned pk2(float lo, float hi) { f32x2v v = {lo, hi}; bf16x2_t b = __builtin_convertvector(v, bf16x2_t); return __builtin_bit_cast(unsigned, b); }
DI u32x4 pk8(f32x4 v0, f32x4 v1) { u32x4 w; w.x = pk2(v0[0], v0[1]); w.y = pk2(v0[2], v0[3]); w.z = pk2(v1[0], v1[1]); w.w = pk2(v1[2], v1[3]); return w; }

DI unsigned dpp_ror8(unsigned v) { return (unsigned)__builtin_amdgcn_mov_dpp((int)v, 0x128, 0xf, 0xf, false); }
DI void store_rows16(unsigned char* rowp, size_t ldb, u32x4 P0, u32x4 P1, int fr) {
    const bool hi = fr >= 8;
    const u32x4 give = hi ? P0 : P1;
    u32x4 recv; recv.x = dpp_ror8(give.x); recv.y = dpp_ror8(give.y); recv.z = dpp_ror8(give.z); recv.w = dpp_ror8(give.w);
    unsigned char* pa = rowp + (size_t)(fr & 7) * ldb + (hi ? 16 : 0);
    *(u32x4*)pa = hi ? recv : P0;
    *(u32x4*)(pa + 8 * ldb) = hi ? P1 : recv;
}
struct EpiInProj {
    static constexpr int PERM = 2;
    bf16* P1; float* vstat; const float* bias;
    DI void operator()(const f32x4 (&acc)[2][2][4][2], const Unit& u, int wr, int wc, int fr, int fq) const {
        const int rg0 = u.pm * BM + wr * 64;
        const int bcol0 = u.pn * BM + wc * 64 + 16 * fq;
        f32x4 bv[2][2];
#pragma unroll
        for (int bj = 0; bj < 2; ++bj)
#pragma unroll
            for (int n = 0; n < 2; ++n) bv[bj][n] = *(const f32x4*)(bias + bcol0 + 8 * bj + 4 * n);
        if (u.pn < 8) {
            bf16* base = P1 + u.pn * 128 + wc * 32 + 8 * fq;
#pragma unroll
            for (int ai = 0; ai < 2; ++ai)
#pragma unroll
                for (int m = 0; m < 4; ++m) {
                    f32x4 u0 = gelu4(acc[ai][0][m][0] + bv[0][0]), u1 = gelu4(acc[ai][0][m][1] + bv[0][1]);
                    const f32x4 g0 = sigmoid4(acc[ai][1][m][0] + bv[1][0]), g1 = sigmoid4(acc[ai][1][m][1] + bv[1][1]);
                    u0 = u0 * g0; u1 = u1 * g1;
                    *(u32x4*)(base + (size_t)(rg0 + ai * HALF + m * 16 + fr) * D) = pk8(u0, u1);
                }
        } else {
            const int t = (u.pn - 8) >> 2, colt = ((u.pn - 8) & 3) * BM;
            bf16* base = P1 + (size_t)(t + 1) * T * D + colt + wc * 64 + 16 * fq;
#pragma unroll
            for (int ai = 0; ai < 2; ++ai)
#pragma unroll
                for (int m = 0; m < 4; ++m) {
                    float s1 = 0.f, s2 = 0.f; u32x4 P[2];
#pragma unroll
                    for (int bj = 0; bj < 2; ++bj) {
                        f32x4 v0 = acc[ai][bj][m][0] + bv[bj][0], v1 = acc[ai][bj][m][1] + bv[bj][1];
                        if (t == 0) { v0 = gelu4(v0); v1 = gelu4(v1);
                            s1 += (v0[0] + v0[1]) + (v0[2] + v0[3]) + (v1[0] + v1[1]) + (v1[2] + v1[3]);
                            s2 += (v0[0] * v0[0] + v0[1] * v0[1]) + (v0[2] * v0[2] + v0[3] * v0[3]) + (v1[0] * v1[0] + v1[1] * v1[1]) + (v1[2] * v1[2] + v1[3] * v1[3]); }
                        else if (t == 1) { v0 = v0 * (QSCALE * LOG2E); v1 = v1 * (QSCALE * LOG2E); }
                        else if (t == 4) { v0 = sigmoid4(v0); v1 = sigmoid4(v1); }
                        P[bj] = pk8(v0, v1);
                    }
                    store_rows16((unsigned char*)(base + (size_t)(rg0 + ai * HALF + m * 16) * D), (size_t)D * 2, P[0], P[1], fr);
                    if (t == 0) {
                        s1 += __shfl_xor(s1, 16); s1 += __shfl_xor(s1, 32); s2 += __shfl_xor(s2, 16); s2 += __shfl_xor(s2, 32);
                        if (fq == 0) *(f32x2v*)(vstat + ((size_t)(rg0 + ai * HALF + m * 16 + fr) * 16 + (u.pn - 8) * 4 + wc) * 2) = (f32x2v){s1, s2};
                    }
                }
        }
    }
};
struct EpiBf16S {
    static constexpr int PERM = 2;
    bf16* O; int ldc; float scale;
    DI void operator()(const f32x4 (&acc)[2][2][4][2], const Unit& u, int wr, int wc, int fr, int fq) const {
        const int rg0 = u.pm * BM + wr * 64, col0 = u.pn * BM + wc * 64 + 16 * fq;
#pragma unroll
        for (int ai = 0; ai < 2; ++ai)
#pragma unroll
            for (int m = 0; m < 4; ++m)
                store_rows16((unsigned char*)(O + (size_t)(rg0 + ai * HALF + m * 16) * ldc + col0), (size_t)ldc * 2,
                             pk8(acc[ai][0][m][0] * scale, acc[ai][0][m][1] * scale), pk8(acc[ai][1][m][0] * scale, acc[ai][1][m][1] * scale), fr);
    }
};
template <bool LNIN> struct EpiResF32 {
    static constexpr int PERM = 0;
    float* out; const float* res; const float* xstat; const float* g; const float* b;
    DI void operator()(const f32x4 (&acc)[2][2][4][2], const Unit& u, int wr, int wc, int fr, int fq) const {
        const int col0 = u.pn * BM + wc * 32 + 4 * fq;
        f32x4 gv[2][2], bv[2][2];
        if (LNIN) {
#pragma unroll
            for (int bj = 0; bj < 2; ++bj)
#pragma unroll
                for (int n = 0; n < 2; ++n) { gv[bj][n] = *(const f32x4*)(g + col0 + bj * HALF + n * 16); bv[bj][n] = *(const f32x4*)(b + col0 + bj * HALF + n * 16); }
        }
#pragma unroll
        for (int ai = 0; ai < 2; ++ai)
#pragma unroll
            for (int m = 0; m < 4; ++m) {
                const int rg = u.pm * BM + ai * HALF + wr * 64 + m * 16, row = rg + fr; const size_t off = (size_t)row * D + col0;
                f32x2v st = (f32x2v){0.f, 1.f}; if (LNIN) st = *(const f32x2v*)(xstat + 2 * (size_t)row);
#pragma unroll
                for (int bj = 0; bj < 2; ++bj) { f32x4 o[2];
#pragma unroll
                    for (int n = 0; n < 2; ++n) { f32x4 r = *(const f32x4*)(res + off + bj * HALF + n * 16);
                        if (LNIN) r = (r - st.x) * st.y * gv[bj][n] + bv[bj][n];
                        o[n] = r * ALPHA + acc[ai][bj][m][n]; }
                    const bool hi = fr >= 8; const f32x4 give = hi ? o[0] : o[1];
                    u32x4 gi = __builtin_bit_cast(u32x4, give), rc; rc.x = dpp_ror8(gi.x); rc.y = dpp_ror8(gi.y); rc.z = dpp_ror8(gi.z); rc.w = dpp_ror8(gi.w);
                    const f32x4 recv = __builtin_bit_cast(f32x4, rc);
                    float* pa = out + (size_t)(rg + (fr & 7)) * D + col0 + bj * HALF + (hi ? 16 : 0);
                    *(f32x4*)pa = hi ? recv : o[0];
                    *(f32x4*)(pa + 8 * D) = hi ? o[1] : recv; }
                if (m & 1) asm volatile("" ::: "memory");
            }
    }
};
template <bool LNIN> struct EpiResB16 {
    static constexpr int PERM = 2;
    bf16* out; const float* resf; const bf16* resb; const float* xstat; const float* g; const float* b;
    DI void operator()(const f32x4 (&acc)[2][2][4][2], const Unit& u, int wr, int wc, int fr, int fq) const {
        const int col0 = u.pn * BM + wc * 64 + 16 * fq;
        f32x4 gv[2][2], bv[2][2];
        if (LNIN) {
#pragma unroll
            for (int bj = 0; bj < 2; ++bj)
#pragma unroll
                for (int n = 0; n < 2; ++n) { gv[bj][n] = *(const f32x4*)(g + col0 + 8 * bj + 4 * n); bv[bj][n] = *(const f32x4*)(b + col0 + 8 * bj + 4 * n); }
        }
#pragma unroll
        for (int ai = 0; ai < 2; ++ai)
#pragma unroll
            for (int m = 0; m < 4; ++m) {
                const int rg = u.pm * BM + ai * HALF + wr * 64 + m * 16, row = rg + fr; const size_t off = (size_t)row * D + col0;
                f32x4 rr[2][2];
                if (LNIN) { const f32x2v st = *(const f32x2v*)(xstat + 2 * (size_t)row);
#pragma unroll
                    for (int bj = 0; bj < 2; ++bj)
#pragma unroll
                        for (int n = 0; n < 2; ++n) rr[bj][n] = (*(const f32x4*)(resf + off + 8 * bj + 4 * n) - st.x) * st.y * gv[bj][n] + bv[bj][n];
                } else {
#pragma unroll
                    for (int bj = 0; bj < 2; ++bj) { const u32x4 x = *(const u32x4*)(resb + off + 8 * bj);
                        rr[bj][0] = (f32x4){bflo(x.x), bfhi(x.x), bflo(x.y), bfhi(x.y)}; rr[bj][1] = (f32x4){bflo(x.z), bfhi(x.z), bflo(x.w), bfhi(x.w)}; } }
                store_rows16((unsigned char*)(out + (size_t)rg * D + col0), (size_t)D * 2,
                             pk8(rr[0][0] * ALPHA + acc[ai][0][m][0], rr[0][1] * ALPHA + acc[ai][0][m][1]), pk8(rr[1][0] * ALPHA + acc[ai][1][m][0], rr[1][1] * ALPHA + acc[ai][1][m][1]), fr);
                if (m & 1) asm volatile("" ::: "memory");
            }
    }
};
constexpr int MO_BLKE = 128 * 1024, MO_RT = MO_BLKE + 640, MO_RW = MO_RT + 5 * 1024, MO_END = MO_RW + 5 * 1024;
static_assert(MO_END <= SCR_BYTES, "MoE LDS tables");
struct EpiGateUp {
    static constexpr int PERM = 1;
    bf16* H; const LAS unsigned char* lds;
    DI void operator()(const f32x4 (&acc)[2][2][4][2], const Unit& u, int wr, int wc, int fr, int fq) const {
        const int rl = wr * 64 + fr, row0 = u.pm * BM + rl, col0 = u.pn * 128 + wc * 32 + 8 * fq;
        float wv[2][4];
#pragma unroll
        for (int ai = 0; ai < 2; ++ai)
#pragma unroll
            for (int m = 0; m < 4; ++m) wv[ai][m] = (u.e < 64) ? *(const LAS float*)(lds + MO_RW + (u.ui * 256 + rl + ai * HALF + m * 16) * 4) : 1.0f;
#pragma unroll
        for (int ai = 0; ai < 2; ++ai)
#pragma unroll
            for (int m = 0; m < 4; ++m) {
                const f32x4 g0 = acc[ai][0][m][0], g1 = acc[ai][0][m][1];
                const f32x4 h0 = g0 * sigmoid4(g0) * acc[ai][1][m][0] * wv[ai][m], h1 = g1 * sigmoid4(g1) * acc[ai][1][m][1] * wv[ai][m];
                *(u32x4*)(H + (size_t)(row0 + ai * HALF + m * 16) * EH + col0) = pk8(h0, h1);
            }
    }
};
constexpr float Y8_SCALE = 32.0f, Y8_CLAMP = 440.0f;
DI unsigned pk4_fp8(f32x4 v) { v = v * Y8_SCALE;
    const float a = __builtin_fminf(__builtin_fmaxf(v[0], -Y8_CLAMP), Y8_CLAMP), b = __builtin_fminf(__builtin_fmaxf(v[1], -Y8_CLAMP), Y8_CLAMP), c = __builtin_fminf(__builtin_fmaxf(v[2], -Y8_CLAMP), Y8_CLAMP), d = __builtin_fminf(__builtin_fmaxf(v[3], -Y8_CLAMP), Y8_CLAMP);
    int p = __builtin_amdgcn_cvt_pk_fp8_f32(a, b, 0, false); p = __builtin_amdgcn_cvt_pk_fp8_f32(c, d, p, true); return (unsigned)p; }
struct EpiDown {
    static constexpr int PERM = 2;
    unsigned char* Y8; bf16* xb; int nostore;
    DI void operator()(const f32x4 (&acc)[2][2][4][2], const Unit& u, int wr, int wc, int fr, int fq) const {
        if (nostore) return;
        const int rl = wr * 64 + fr, col0 = u.pn * BM + wc * 64 + 16 * fq;
        if (u.e < 64) {
#pragma unroll
            for (int ai = 0; ai < 2; ++ai)
#pragma unroll
                for (int m = 0; m < 4; ++m) { const int r = rl + ai * HALF + m * 16;
                    u32x4 w; w.x = pk4_fp8(acc[ai][0][m][0]); w.y = pk4_fp8(acc[ai][0][m][1]); w.z = pk4_fp8(acc[ai][1][m][0]); w.w = pk4_fp8(acc[ai][1][m][1]);
                    __builtin_nontemporal_store(w, (u32x4*)(Y8 + ((size_t)u.pm * BM + r) * D + col0)); }
        } else {
#pragma unroll
            for (int ai = 0; ai < 2; ++ai) {
                u32x4 xr[4][2];
#pragma unroll
                for (int m = 0; m < 4; ++m)
#pragma unroll
                    for (int bj = 0; bj < 2; ++bj) xr[m][bj] = *(const u32x4*)(xb + ((size_t)(u.pm - SH_ROW0 / BM) * BM + rl + ai * HALF + m * 16) * D + col0 + 8 * bj);
#pragma unroll
                for (int m = 0; m < 4; ++m) { const size_t off = ((size_t)(u.pm - SH_ROW0 / BM) * BM + rl + ai * HALF + m * 16) * D + col0;
#pragma unroll
                    for (int bj = 0; bj < 2; ++bj) { const u32x4 x = xr[m][bj];
                        const f32x4 x0 = (f32x4){bflo(x.x), bfhi(x.x), bflo(x.y), bfhi(x.y)}, x1 = (f32x4){bflo(x.z), bfhi(x.z), bflo(x.w), bfhi(x.w)};
                        *(u32x4*)(xb + off + 8 * bj) = pk8(x0 * ALPHA + acc[ai][bj][m][0], x1 * ALPHA + acc[ai][bj][m][1]); } }
                asm volatile("" ::: "memory"); }
        }
    }
};
struct GateUpOrder {
    const char* X; const char* Wgu; const char* Wgus; const LAS unsigned char* lds; int nblk, G, c;
    DI bool next(int i, Unit& u) const {
        const int L = i * G + c; if (L >= (nblk + 64) * 2) return false;
        const int bl = L >> 1; u.pn = L & 1; u.ui = i;
        if (bl < nblk) { u.e = (int)__builtin_amdgcn_readfirstlane((int)*(const LAS unsigned char*)(lds + MO_BLKE + bl)); u.pm = bl; u.A = X; u.B = Wgu + ((size_t)u.e * 512 + u.pn * 256) * D * 2; }
        else { u.e = 64; u.pm = SH_ROW0 / BM + (bl - nblk); u.A = X + (size_t)(bl - nblk) * BM * D * 2; u.B = Wgus + (size_t)u.pn * 256 * D * 2; }
        return true;
    }
    DI void a_offs(const Unit& u, const int (&R)[2], const int (&C)[2], int K_, unsigned (&off)[2][2]) const {
        if (u.e < 64) {
#pragma unroll
            for (int h = 0; h < 2; ++h)
#pragma unroll
                for (int i = 0; i < 2; ++i) { const int tok = *(const LAS int*)(lds + MO_RT + (u.ui * 256 + h * HALF + R[i]) * 4); off[h][i] = (unsigned)(tok * K_ + C[i]) * 2u; }
        } else {
#pragma unroll
            for (int h = 0; h < 2; ++h)
#pragma unroll
                for (int i = 0; i < 2; ++i) off[h][i] = (unsigned)((h * HALF + R[i]) * K_ + C[i]) * 2u;
        }
    }
};
struct DownOrder {
    const char* H; const char* Wd; const char* Wds; const LAS unsigned char* lds; int lo, hi, nsh, G, c, hot;
    DI bool next(int i, Unit& u) const {
        const int L = i * G + c; if (L >= (hi - lo + nsh) * 4) return false;
        int bl = lo + (L >> 2); u.pn = L & 3; u.ui = i; if (hot) bl = lo + ((L >> 2) & 7);
        if (bl < hi) { u.e = (int)__builtin_amdgcn_readfirstlane((int)*(const LAS unsigned char*)(lds + MO_BLKE + bl)); u.pm = bl; u.B = Wd + ((size_t)u.e * D + u.pn * 256) * EH * 2; }
        else { u.e = 64; u.pm = SH_ROW0 / BM + (bl - hi); u.B = Wds + (size_t)u.pn * 256 * EH * 2; }
        u.A = H + (size_t)u.pm * BM * EH * 2;
        return true;
    }
    DI void a_offs(const Unit&, const int (&R)[2], const int (&C)[2], int K_, unsigned (&off)[2][2]) const {
#pragma unroll
        for (int h = 0; h < 2; ++h)
#pragma unroll
            for (int i = 0; i < 2; ++i) off[h][i] = (unsigned)((h * HALF + R[i]) * K_ + C[i]) * 2u;
    }
};
DI void moe_tables(LAS unsigned char* lds, const unsigned* blke, int nblk, const int* rowtok, const float* roww, bool gateup, int G, int c, int tid) {
    for (int b = tid; b < nblk; b += NTHREADS) *(LAS unsigned char*)(lds + MO_BLKE + b) = (unsigned char)__hip_atomic_load(blke + b, RLX_AGENT);
    if (gateup) {
#pragma unroll
        for (int i = 0; i < 5; ++i) { const int L = i * G + c, bl = L >> 1;
            if (bl < nblk && tid < 256) { *(LAS int*)(lds + MO_RT + (i * 256 + tid) * 4) = __hip_atomic_load(rowtok + (size_t)bl * 256 + tid, RLX_AGENT);
                                          *(LAS float*)(lds + MO_RW + (i * 256 + tid) * 4) = __hip_atomic_load(roww + (size_t)bl * 256 + tid, RLX_AGENT); } }
    }
    __syncthreads();
}
}

struct Frame {
    LAS unsigned char* lds;
    unsigned* ctl;
    unsigned char* ws; float* out;
    int tid, lane, wave, vcu, G;
};
DI unsigned short f2bf1(float x) { return (unsigned short)(pg8::pk2(x, x) & 0xffffu); }

template <class RowMap>
DI void transpose_item(const float* W, int N, bf16* WT, int Kd, RowMap rm, LAS float* scr, int kb, int nb, int lane) {
    const int k0 = 64 * kb, n0 = 32 * nb;
#pragma unroll 8
    for (int i = 0; i < 32; ++i) { const int kk = 2 * i + (lane >> 5); scr[kk * 33 + (lane & 31)] = W[(size_t)(k0 + kk) * N + n0 + (lane & 31)]; }
    LDS_WAIT(); asm volatile("" ::: "memory");
    const int c = lane & 7;
#pragma unroll
    for (int j = 0; j < 4; ++j) { const int n = (lane >> 3) + 8 * j; const LAS float* s = scr + (8 * c) * 33 + n;
        u32x4 o; o.x = pg8::pk2(s[0 * 33], s[1 * 33]); o.y = pg8::pk2(s[2 * 33], s[3 * 33]); o.z = pg8::pk2(s[4 * 33], s[5 * 33]); o.w = pg8::pk2(s[6 * 33], s[7 * 33]);
        *(u32x4*)(WT + (size_t)rm(n0 + n) * Kd + k0 + 8 * c) = o; }
    LDS_WAIT(); asm volatile("" ::: "memory");
}
struct RmIdent { int off; DI int operator()(int n) const { return off + n; } };
struct RmInProj { DI int operator()(int n) const { const int seg = n >> 10, w = n & 1023;
    return seg == 0 ? ((w >> 7) * 256 + ((w & 127) >> 3) * 16 + (w & 7)) : seg == 5 ? ((w >> 7) * 256 + ((w & 127) >> 3) * 16 + 8 + (w & 7)) : seg == 6 ? 6144 + w : 1024 + n; } };
struct RmGateUp { int up; DI int operator()(int n) const { return (n >> 7) * 256 + up * 128 + (n & 127); } };
DI int inproj_dest(int n) { return RmInProj()(n); }

DI void row_stats(const float* xrow, int lane, f32x4 (&v)[4], float& mean, float& rstd) {
    const f32x4* xr = (const f32x4*)xrow + lane; float s = 0.f;
#pragma unroll
    for (int j = 0; j < 4; ++j) { v[j] = xr[64 * j]; s += (v[j][0] + v[j][1]) + (v[j][2] + v[j][3]); }
    mean = wave_sum(s) * (1.f / D); float s2 = 0.f;
#pragma unroll
    for (int j = 0; j < 4; ++j) { const f32x4 d = v[j] - mean; s2 += (d[0] * d[0] + d[1] * d[1]) + (d[2] * d[2] + d[3] * d[3]); }
    rstd = 1.f / sqrtf(wave_sum(s2) * (1.f / D) + LN_EPS);
}

DI void row_stats_b16(const bf16* xrow, int lane, f32x4 (&v)[4], float& mean, float& rstd) {
    const u32x2* xr = (const u32x2*)xrow + lane; float s = 0.f;
#pragma unroll
    for (int j = 0; j < 4; ++j) { const u32x2 x = xr[64 * j]; v[j] = (f32x4){bflo(x.x), bfhi(x.x), bflo(x.y), bfhi(x.y)}; s += (v[j][0] + v[j][1]) + (v[j][2] + v[j][3]); }
    mean = wave_sum(s) * (1.f / D); float s2 = 0.f;
#pragma unroll
    for (int j = 0; j < 4; ++j) { const f32x4 d = v[j] - mean; s2 += (d[0] * d[0] + d[1] * d[1]) + (d[2] * d[2] + d[3] * d[3]); }
    rstd = 1.f / sqrtf(wave_sum(s2) * (1.f / D) + LN_EPS);
}
DI void p0_prologue(Frame& F, const float* const* in) {
    LAS float* scr = (LAS float*)(F.lds + F.wave * 16384);
    const int gw = F.vcu * NWAVES + F.wave, NGW = F.G * NWAVES, lane = F.lane;
    unsigned char* ws = F.ws;
    constexpr int I_IN = 16 * (INW / 32), I_OUT = 16 * 32, I_Q = 16 * 16, I_KV = 16 * 32, I_O = 8 * 32, I_SG = 16 * 8, I_SD = 4 * 32;
    constexpr int NITEMS = I_IN + I_OUT + I_Q + I_KV + I_O + 2 * I_SG + I_SD;
    for (int it = gw; it < NITEMS; it += NGW) {
        int r = it;
        if (r < I_IN) { transpose_item(in[4], INW, (bf16*)(ws + WS_WIN), D, RmInProj(), scr, r / (INW / 32), r % (INW / 32), lane); continue; } r -= I_IN;
        if (r < I_OUT) { transpose_item(in[10], D, (bf16*)(ws + WS_WOUT), D, RmIdent{0}, scr, r / 32, r % 32, lane); continue; } r -= I_OUT;
        if (r < I_Q) { transpose_item(in[13], MEMW, (bf16*)(ws + WS_WQ), D, RmIdent{0}, scr, r / 16, r % 16, lane); continue; } r -= I_Q;
        if (r < I_KV) { transpose_item(in[14], 2 * MEMW, (bf16*)(ws + WS_WKV), D, RmIdent{0}, scr, r / 32, r % 32, lane); continue; } r -= I_KV;
        if (r < I_O) { transpose_item(in[15], D, (bf16*)(ws + WS_WO), MEMW, RmIdent{0}, scr, r / 32, r % 32, lane); continue; } r -= I_O;
        if (r < I_SG) { transpose_item(in[23], EH, (bf16*)(ws + WS_WGUS), D, RmGateUp{0}, scr, r / 8, r % 8, lane); continue; } r -= I_SG;
        if (r < I_SG) { transpose_item(in[24], EH, (bf16*)(ws + WS_WGUS), D, RmGateUp{1}, scr, r / 8, r % 8, lane); continue; } r -= I_SG;
        transpose_item(in[25], D, (bf16*)(ws + WS_WDS), EH, RmIdent{0}, scr, r / 32, r % 32, lane);
    }
    const int gt = F.vcu * NTHREADS + F.tid, NGT = F.G * NTHREADS;
    { const float* wr = in[18]; bf16* hi = (bf16*)(ws + WS_WRHI); bf16* lo = (bf16*)(ws + WS_WRLO);
      for (int idx = gt; idx < D * NEXP; idx += NGT) { const int k = idx >> 6, e = idx & 63; const float w = wr[idx]; const unsigned short h = f2bf1(w); hi[e * D + k] = h; lo[e * D + k] = f2bf1(w - bf2f(h)); } }
    { const float* wsp = in[8]; bf16* o = (bf16*)(ws + WS_WSP);
      for (int idx = gt; idx < 8 * 128 * 128; idx += NGT) { const int s = idx & 127, t = (idx >> 7) & 127; o[idx] = (s <= t) ? f2bf1(wsp[idx]) : (unsigned short)0; } }
    { const float* bi = in[5]; float* o = (float*)(ws + WS_BPERM);
      for (int idx = gt; idx < INW; idx += NGT) o[inproj_dest(idx)] = bi[idx]; }
    { const f32x4* m4 = (const f32x4*)in[1]; u32x2* o = (u32x2*)(ws + WS_MEMB);
      for (int idx = gt; idx < NBATCH * MEMLEN * D / 4; idx += NGT) { const f32x4 v = m4[idx]; o[idx] = (u32x2){pg8::pk2(v[0], v[1]), pg8::pk2(v[2], v[3])}; } }
    { const float* x = in[0]; const float* g = in[2]; const float* b = in[3]; bf16* X0b = (bf16*)F.out; float* xstat = (float*)(ws + WS_XSTAT);
      f32x4 gv[4], bv[4];
#pragma unroll
      for (int j = 0; j < 4; ++j) { gv[j] = ((const f32x4*)g)[lane + 64 * j]; bv[j] = ((const f32x4*)b)[lane + 64 * j]; }
      for (int m = gw; m < T; m += NGW) { f32x4 v[4]; float mean, rstd; row_stats(x + (size_t)m * D, lane, v, mean, rstd);
          u32x2* o8 = (u32x2*)(X0b + (size_t)m * D) + lane;
#pragma unroll
          for (int j = 0; j < 4; ++j) { const f32x4 y = (v[j] - mean) * rstd * gv[j] + bv[j]; o8[64 * j] = (u32x2){pg8::pk2(y[0], y[1]), pg8::pk2(y[2], y[3])}; }
          if (lane == 0) *(f32x2*)(xstat + 2 * (size_t)m) = (f32x2){mean, rstd}; } }
}
struct CvtItem { const float* W; bf16* WT; int N, Kd, mode, kb, nb; };
DI CvtItem cvt_decode(const float* const* in, unsigned char* ws, int it) {
    const int e = it / 384; int r = it % 384; CvtItem c;
    if (r < 256) { const int up = r >> 7; r &= 127; c.W = in[20 + up] + (size_t)e * D * EH; c.N = EH; c.WT = (bf16*)(ws + WS_WGU) + (size_t)e * 512 * D; c.Kd = D; c.mode = up; c.kb = r >> 3; c.nb = r & 7; }
    else { r -= 256; c.W = in[22] + (size_t)e * EH * D; c.N = D; c.WT = (bf16*)(ws + WS_WD) + (size_t)e * D * EH; c.Kd = EH; c.mode = 2; c.kb = r >> 5; c.nb = r & 31; }
    return c;
}
DI void cvt_load(const CvtItem& c, int lane, f32x4 (&v)[8]) {
#pragma unroll
    for (int i = 0; i < 8; ++i) v[i] = __builtin_nontemporal_load((const f32x4*)(c.W + (size_t)(64 * c.kb + (lane >> 3) + 8 * i) * c.N + 32 * c.nb + 4 * (lane & 7)));
}
DI void cvt_finish(const CvtItem& c, int lane, const f32x4 (&v)[8], LAS float* scr) {
#pragma unroll
    for (int i = 0; i < 8; ++i) { LAS float* d = scr + ((lane >> 3) + 8 * i) * 33 + 4 * (lane & 7); d[0] = v[i][0]; d[1] = v[i][1]; d[2] = v[i][2]; d[3] = v[i][3]; }
    LDS_WAIT(); asm volatile("" ::: "memory");
    const int cc = lane & 7;
#pragma unroll
    for (int j = 0; j < 4; ++j) { const int n = 32 * c.nb + (lane >> 3) + 8 * j; const LAS float* sp = scr + (8 * cc) * 33 + (lane >> 3) + 8 * j;
        const int drow = (c.mode == 2) ? n : ((n >> 7) * 256 + c.mode * 128 + (n & 127));
        u32x4 o; o.x = pg8::pk2(sp[0 * 33], sp[1 * 33]); o.y = pg8::pk2(sp[2 * 33], sp[3 * 33]); o.z = pg8::pk2(sp[4 * 33], sp[5 * 33]); o.w = pg8::pk2(sp[6 * 33], sp[7 * 33]);
        *(u32x4*)(c.WT + (size_t)drow * c.Kd + 64 * c.kb + 8 * cc) = o; }
    LDS_WAIT(); asm volatile("" ::: "memory");
}
DI void expert_convert(Frame& F, const float* const* in, int worker, int nworkers, int item_lo, int item_hi) {
    LAS float* scr = (LAS float*)(F.lds + F.wave * 16384);
    const int lane = F.lane, stride = nworkers * NWAVES;
    int it = item_lo + worker * NWAVES + F.wave;
    if (it >= item_hi) return;
    CvtItem cur = cvt_decode(in, F.ws, it); f32x4 v[8]; cvt_load(cur, lane, v);
    for (;;) {
        const int nx = it + stride; const bool has = nx < item_hi;
        CvtItem nxt = cur; f32x4 vn[8];
        if (has) { nxt = cvt_decode(in, F.ws, nx); cvt_load(nxt, lane, vn); }
        cvt_finish(cur, lane, v, scr);
        if (!has) break;
        cur = nxt; it = nx;
#pragma unroll
        for (int i = 0; i < 8; ++i) v[i] = vn[i];
    }
}

constexpr int MX_BUF = 32768, MX_STAT = 4 * MX_BUF, MX_FLG = MX_STAT + 1024, MX_FLG2 = MX_FLG + 64, MX_END = MX_FLG2 + 64;
static_assert(MX_END <= SCR_BYTES, "mixer LDS");
constexpr float MX_EXIT2 = SB_EXIT * LOG2E;
typedef short v4i16_t __attribute__((ext_vector_type(4)));
DI bf16x8 mk_frag(f32x4 e0, f32x4 e1) { const u32x4 w = pg8::pk8(e0, e1); return __builtin_bit_cast(bf16x8, w); }
DI bf16x8 ld_split8(const LAS unsigned char* p) {
    const s16x4 lo = *(const LAS s16x4*)p, hi = *(const LAS s16x4*)(p + 32);
    return (bf16x8){lo[0], lo[1], lo[2], lo[3], hi[0], hi[1], hi[2], hi[3]};
}
DI void glds16(const void* gsrc, unsigned lds_dst) { unsigned keep;
    asm volatile("s_mov_b32 %0, m0\n\ts_mov_b32 m0, %2\n\ts_nop 0\n\tglobal_load_lds_dwordx4 %1, off\n\ts_mov_b32 m0, %0" : "=&s"(keep) : "v"(gsrc), "s"(lds_dst) : "memory"); }
DI void mx_dma(LAS unsigned char* buf, const bf16* src, int w, int lane) {
#pragma unroll
    for (int i = 0; i < 4; ++i) { const int pc = 4 * w + i, row = 4 * pc + (lane >> 4), cpos = lane & 15;
        glds16((const char*)src + (size_t)row * (D * 2) + ((cpos ^ (row & 15)) * 16), (unsigned)__builtin_amdgcn_readfirstlane((unsigned)(uintptr_t)(buf + pc * 1024))); }
}
DI bf16x8 mx_tr(const LAS unsigned char* buf, int sA, int sB, int d0, int r) {
    const int ra = sA + (r >> 2), rb = sB + (r >> 2), ch = (d0 >> 3) + ((r & 3) >> 1), bo = 8 * (r & 1);
    const s16x4 lo = __builtin_bit_cast(s16x4, __builtin_amdgcn_ds_read_tr16_b64_v4i16((LAS v4i16_t*)(buf + ra * 256 + ((ch ^ (ra & 15)) * 16) + bo)));
    const s16x4 hi = __builtin_bit_cast(s16x4, __builtin_amdgcn_ds_read_tr16_b64_v4i16((LAS v4i16_t*)(buf + rb * 256 + ((ch ^ (rb & 15)) * 16) + bo)));
    return (bf16x8){lo[0], lo[1], lo[2], lo[3], hi[0], hi[1], hi[2], hi[3]};
}
DI void sb_scores(const LAS unsigned char* kbuf, const bf16x8 (&qf)[4], bool diag, int tq, float carry, int r, int q, const bf16x8& UE, const bf16x8& UO, const bf16x8& ONES, bf16x8 (&af)[4], float& tot_out) {
    f32x4 z[8];
#pragma unroll
    for (int st = 0; st < 8; ++st) { z[st] = (f32x4){0.f, 0.f, 0.f, 0.f};
#pragma unroll
        for (int kk = 0; kk < 4; ++kk) { const bf16x8 kf = *(const LAS bf16x8*)(kbuf + (16 * st + r) * 256 + (((4 * kk + q) ^ r) * 16));
            z[st] = __builtin_amdgcn_mfma_f32_16x16x32_bf16(kf, qf[kk], z[st], 0, 0, 0); }
        if (st & 1) __builtin_amdgcn_sched_barrier(0); }
    f32x4 ls[8];
#pragma unroll
    for (int st = 0; st < 8; ++st)
#pragma unroll
        for (int e = 0; e < 4; ++e) { const float zz = z[st][e]; const float sp = fmaxf(zz, 0.f) + fast_log2(1.0f + fast_exp2(-fabsf(zz)));
            const bool msk = diag && (16 * st + 4 * q + e >= tq);
            ls[st][e] = msk ? 0.f : -sp; z[st][e] = msk ? -1e30f : zz - sp; }
    bf16x8 lf[4];
#pragma unroll
    for (int p = 0; p < 4; ++p) lf[p] = mk_frag(ls[2 * p], ls[2 * p + 1]);
    f32x4 tot = (f32x4){0.f, 0.f, 0.f, 0.f};
#pragma unroll
    for (int p = 0; p < 4; ++p) tot = __builtin_amdgcn_mfma_f32_16x16x32_bf16(ONES, lf[p], tot, 0, 0, 0);
#pragma unroll
    for (int p = 0; p < 4; ++p) {
        f32x4 s0 = (f32x4){0.f, 0.f, 0.f, 0.f}, s1 = (f32x4){0.f, 0.f, 0.f, 0.f};
        s0 = __builtin_amdgcn_mfma_f32_16x16x32_bf16(UE, lf[p], s0, 0, 0, 0);
        s1 = __builtin_amdgcn_mfma_f32_16x16x32_bf16(UO, lf[p], s1, 0, 0, 0);
#pragma unroll
        for (int p2 = p + 1; p2 < 4; ++p2) { s0 = __builtin_amdgcn_mfma_f32_16x16x32_bf16(ONES, lf[p2], s0, 0, 0, 0); s1 = __builtin_amdgcn_mfma_f32_16x16x32_bf16(ONES, lf[p2], s1, 0, 0, 0); }
        f32x4 a0, a1;
#pragma unroll
        for (int e = 0; e < 4; ++e) { a0[e] = fast_exp2(z[2 * p][e] + s0[e] + carry); a1[e] = fast_exp2(z[2 * p + 1][e] + s1[e] + carry); }
        af[p] = mk_frag(a0, a1);
    }
    tot_out = tot[0];
}
DI void sb_pv(const LAS unsigned char* vbuf, const bf16x8 (&af)[4], f32x4 (&yb)[8], int r, int q) {
#pragma unroll
    for (int dt = 0; dt < 8; ++dt)
#pragma unroll
        for (int p = 0; p < 4; ++p) { const bf16x8 vf = mx_tr(vbuf, 32 * p + 4 * q, 32 * p + 16 + 4 * q, 16 * dt, r);
            yb[dt] = __builtin_amdgcn_mfma_f32_16x16x32_bf16(vf, af[p], yb[dt], 0, 0, 0);
            if (p == 3 && (dt & 1)) __builtin_amdgcn_sched_barrier(0); }
}
#define MX_WAIT_BAR(n) asm volatile("s_waitcnt vmcnt(" #n ") lgkmcnt(0)\n\ts_barrier" ::: "memory")
DI void mix_phase(Frame& F, const float* const* in) {
    LAS unsigned char* lds = F.lds; unsigned char* ws = F.ws;
    const int tid = F.tid, lane = F.lane, w = F.wave, r = lane & 15, q = lane >> 4;
    const bf16* UG = (const bf16*)(ws + WS_UG); const bf16* VA = (const bf16*)(ws + WS_VA); const bf16* Qg = (const bf16*)(ws + WS_Q);
    const bf16* Kg = (const bf16*)(ws + WS_K); const bf16* Vg = (const bf16*)(ws + WS_V); const bf16* GB = (const bf16*)(ws + WS_GB);
    const float* vstat = (const float*)(ws + WS_VSTAT); const bf16* WSP = (const bf16*)(ws + WS_WSP); bf16* MG = (bf16*)(ws + WS_MERGED);
    const float* lnvg = in[6]; const float* lnvb = in[7]; const float* bsp = in[9];
    LAS unsigned char* B0 = lds; LAS unsigned char* B1 = lds + MX_BUF; LAS unsigned char* B2 = lds + 2 * MX_BUF; LAS unsigned char* B3 = lds + 3 * MX_BUF;
    bf16x8 UE, UO, ONES;
#pragma unroll
    for (int jj = 0; jj < 8; ++jj) { ONES[jj] = (short)0x3F80;
        UE[jj] = (jj < 4) ? ((4 * q + jj > r) ? (short)0x3F80 : (short)0) : (short)0x3F80;
        UO[jj] = (jj < 4) ? (short)0 : ((4 * q + jj - 4 > r) ? (short)0x3F80 : (short)0); }
    const int NU = NBATCH * 16 * 8;
    int un = F.vcu;
    if (un >= NU) return;
#define MX_DEC(u_, b_, i_, j_) const int j_ = (u_) & 7, i_ = ((u_) >> 3) & 15, b_ = (u_) >> 7
    bf16x8 qf[4];
    { MX_DEC(un, b, i, j); const int ip = i > 0 ? i - 1 : 0;
      mx_dma(B0, Kg + (size_t)(b * SEQ + 128 * i) * D + 128 * j, w, lane);
      mx_dma(B2, Kg + (size_t)(b * SEQ + 128 * ip) * D + 128 * j, w, lane);
      mx_dma(B3, Vg + (size_t)(b * SEQ + 128 * ip) * D + 128 * j, w, lane);
#pragma unroll
      for (int kk = 0; kk < 4; ++kk) qf[kk] = *(const bf16x8*)(Qg + (size_t)(b * SEQ + 128 * i + 16 * w + r) * D + 128 * j + 32 * kk + 8 * q); }
    for (; un < NU; un += F.G) {
        MX_DEC(un, b, i, j);
        const int t0 = b * SEQ + 128 * i, c0 = 128 * j, tq = 16 * w + r;
        const int unn = (un + F.G < NU) ? un + F.G : un;
        MX_DEC(unn, bn, in_, jn); const int ipn = in_ > 0 ? in_ - 1 : 0;
        f32x4 yb[8];
#pragma unroll
        for (int dt = 0; dt < 8; ++dt) yb[dt] = (f32x4){0.f, 0.f, 0.f, 0.f};
        float carry = 0.f, tot; bf16x8 af[4];
        MX_WAIT_BAR(0);
        asm volatile("" : "+v"(qf[0]), "+v"(qf[1]), "+v"(qf[2]), "+v"(qf[3]));
        mx_dma(B1, Vg + (size_t)t0 * D + c0, w, lane);
        sb_scores(B0, qf, true, tq, 0.f, r, q, UE, UO, ONES, af, tot);
        MX_WAIT_BAR(0);
        mx_dma(B0, Kg + (size_t)(bn * SEQ + 128 * in_) * D + 128 * jn, w, lane);
        sb_pv(B1, af, yb, r, q);
        carry += tot;
        MX_WAIT_BAR(4);
        mx_dma(B1, VA + (size_t)t0 * D + c0, w, lane);
        const bool wlive = (i > 0) && (wave_max(carry) >= MX_EXIT2);
        if (wlive) { sb_scores(B2, qf, false, tq, carry, r, q, UE, UO, ONES, af, tot);
            const float wm = wave_max(carry + tot); if (lane == 0) *(LAS float*)(lds + MX_FLG + w * 4) = wm; }
        else if (i > 0) { if (lane == 0) *(LAS float*)(lds + MX_FLG + w * 4) = -1e30f; }
        MX_WAIT_BAR(4);
        mx_dma(B2, Kg + (size_t)(bn * SEQ + 128 * ipn) * D + 128 * jn, w, lane);
        if (wlive) { sb_pv(B3, af, yb, r, q); carry += tot; }
        if (i > 1) {
            float gm = -1e30f;
#pragma unroll
            for (int k = 0; k < 8; ++k) gm = fmaxf(gm, *(const LAS float*)(lds + MX_FLG + k * 4));
            if (gm >= MX_EXIT2) {
                for (int kb = i - 2; kb >= 0; --kb) {
                    MX_WAIT_BAR(0);
                    mx_dma(B2, Kg + (size_t)(b * SEQ + 128 * kb) * D + c0, w, lane); mx_dma(B3, Vg + (size_t)(b * SEQ + 128 * kb) * D + c0, w, lane);
                    MX_WAIT_BAR(0);
                    if (wave_max(carry) >= MX_EXIT2) { sb_scores(B2, qf, false, tq, carry, r, q, UE, UO, ONES, af, tot); sb_pv(B3, af, yb, r, q); carry += tot; }
                    const float wm = wave_max(carry); if (lane == 0) *(LAS float*)(lds + MX_FLG2 + w * 4) = wm;
                    MX_WAIT_BAR(0);
                    float g2 = -1e30f;
#pragma unroll
                    for (int k = 0; k < 8; ++k) g2 = fmaxf(g2, *(const LAS float*)(lds + MX_FLG2 + k * 4));
                    if (g2 < MX_EXIT2) break;
                }
                MX_WAIT_BAR(0);
                mx_dma(B2, Kg + (size_t)(bn * SEQ + 128 * ipn) * D + 128 * jn, w, lane);
            }
        }
        { f32x2 sp4[4];
#pragma unroll
          for (int k = 0; k < 4; ++k) sp4[k] = *((const f32x2*)vstat + (size_t)(t0 + (tid >> 2)) * 16 + 4 * (tid & 3) + k);
          float s1 = (sp4[0][0] + sp4[1][0]) + (sp4[2][0] + sp4[3][0]), s2 = (sp4[0][1] + sp4[1][1]) + (sp4[2][1] + sp4[3][1]);
          s1 += __shfl_xor(s1, 1); s1 += __shfl_xor(s1, 2); s2 += __shfl_xor(s2, 1); s2 += __shfl_xor(s2, 2);
          const float mean = s1 * (1.f / D), var = s2 * (1.f / D) - mean * mean;
          if ((tid & 3) == 0) *(LAS f32x2*)(lds + MX_STAT + (tid >> 2) * 8) = (f32x2){mean, 1.f / sqrtf(fmaxf(var, 0.f) + LN_EPS)}; }
        MX_WAIT_BAR(4);
        mx_dma(B3, Vg + (size_t)(bn * SEQ + 128 * ipn) * D + 128 * jn, w, lane);
        bf16x8 qn[4];
#pragma unroll
        for (int kk = 0; kk < 4; ++kk) qn[kk] = *(const bf16x8*)(Qg + (size_t)(bn * SEQ + 128 * in_ + 16 * w + r) * D + 128 * jn + 32 * kk + 8 * q);
        {
          f32x4 ya[8];
#pragma unroll
          for (int dt = 0; dt < 8; ++dt) ya[dt] = (f32x4){0.f, 0.f, 0.f, 0.f};
          float c1 = 0.f, c2 = 0.f;
          const int nks = (w >> 1) + 1;
          for (int ks = 0; ks < nks; ++ks) {
              const u32x4 wr4 = *(const u32x4*)(WSP + ((size_t)j * 128 + tq) * 128 + 32 * ks + 8 * q);
              float wv[8] = {bflo(wr4.x), bfhi(wr4.x), bflo(wr4.y), bfhi(wr4.y), bflo(wr4.z), bfhi(wr4.z), bflo(wr4.w), bfhi(wr4.w)}; float wp[8];
#pragma unroll
              for (int e = 0; e < 8; ++e) { const f32x2 st = *(const LAS f32x2*)(lds + MX_STAT + (32 * ks + 8 * q + e) * 8); wp[e] = wv[e] * st[1]; c2 += wv[e]; }
              const u32x4 wq = pg8::pk8((f32x4){wp[0], wp[1], wp[2], wp[3]}, (f32x4){wp[4], wp[5], wp[6], wp[7]});
              const float wb[8] = {bflo(wq.x), bfhi(wq.x), bflo(wq.y), bfhi(wq.y), bflo(wq.z), bfhi(wq.z), bflo(wq.w), bfhi(wq.w)};
#pragma unroll
              for (int e = 0; e < 8; ++e) { const f32x2 st = *(const LAS f32x2*)(lds + MX_STAT + (32 * ks + 8 * q + e) * 8); c1 += wb[e] * st[0]; }
              const bf16x8 wf = __builtin_bit_cast(bf16x8, wq);
#pragma unroll
              for (int dt = 0; dt < 8; ++dt) { const bf16x8 vf = mx_tr(B1, 32 * ks + 8 * q, 32 * ks + 8 * q + 4, 16 * dt, r);
                  ya[dt] = __builtin_amdgcn_mfma_f32_16x16x32_bf16(vf, wf, ya[dt], 0, 0, 0); }
          }
          c1 += __shfl_xor(c1, 16); c1 += __shfl_xor(c1, 32); c2 += __shfl_xor(c2, 16); c2 += __shfl_xor(c2, 32);
          const float bs = bsp[j * 128 + tq]; const size_t rowoff = (size_t)(t0 + tq) * D + c0 + 4 * q;
#pragma unroll
          for (int dt = 0; dt < 8; ++dt) { const u32x2 ug = *(const u32x2*)(UG + rowoff + 16 * dt), gb = *(const u32x2*)(GB + rowoff + 16 * dt);
              const f32x4 g4 = *(const f32x4*)(lnvg + c0 + 16 * dt + 4 * q), b4 = *(const f32x4*)(lnvb + c0 + 16 * dt + 4 * q);
              const f32x4 u4 = (f32x4){bflo(ug.x), bfhi(ug.x), bflo(ug.y), bfhi(ug.y)}, gq = (f32x4){bflo(gb.x), bfhi(gb.x), bflo(gb.y), bfhi(gb.y)};
              const f32x4 mixed = g4 * (ya[dt] - c1) + b4 * c2 + bs;
              const f32x4 o = u4 * mixed + gq * yb[dt];
              *(u32x2*)(MG + rowoff + 16 * dt) = (u32x2){pg8::pk2(o[0], o[1]), pg8::pk2(o[2], o[3])}; } }
#pragma unroll
        for (int kk = 0; kk < 4; ++kk) qf[kk] = qn[kk];
    }
    MX_WAIT_BAR(0);
#undef MX_DEC
}
#undef MX_WAIT_BAR

DI void ln1_phase(Frame& F, const float* const* in) {
    const int gw = F.vcu * NWAVES + F.wave, NGW = F.G * NWAVES, lane = F.lane;
    const bf16* Y1 = (const bf16*)(F.ws + WS_Y1); bf16* X1b = (bf16*)(F.ws + WS_X1B);
    f32x4 gv[4], bv[4];
#pragma unroll
    for (int j = 0; j < 4; ++j) { gv[j] = ((const f32x4*)in[11])[lane + 64 * j]; bv[j] = ((const f32x4*)in[12])[lane + 64 * j]; }
    for (int m = gw; m < T; m += NGW) { f32x4 v[4]; float mean, rstd; row_stats_b16(Y1 + (size_t)m * D, lane, v, mean, rstd);
        u32x2* ob = (u32x2*)(X1b + (size_t)m * D) + lane;
#pragma unroll
        for (int j = 0; j < 4; ++j) { const f32x4 y = (v[j] - mean) * rstd * gv[j] + bv[j]; ob[64 * j] = (u32x2){pg8::pk2(y[0], y[1]), pg8::pk2(y[2], y[3])}; } }
}

DI void memattn_phase(Frame& F, int first, int stride) {
    LAS unsigned char* lds = F.lds; unsigned char* ws = F.ws;
    const int lane = F.lane, w = F.wave, r = lane & 15, q = lane >> 4;
    const bf16* Qm = (const bf16*)(ws + WS_QM); const bf16* KV = (const bf16*)(ws + WS_KVM); bf16* Om = (bf16*)(ws + WS_OM);
    for (int su = first; su < NBATCH * 4 * 8; su += stride) {
        const int qc = su & 7, h = (su >> 3) & 3, b = su >> 5;
        mx_dma(lds, KV + (size_t)(b * MEMLEN) * D + h * 128, w, lane); mx_dma(lds + MX_BUF, KV + (size_t)(b * MEMLEN + 128) * D + h * 128, w, lane);
        mx_dma(lds + 2 * MX_BUF, KV + (size_t)(b * MEMLEN) * D + MEMW + h * 128, w, lane); mx_dma(lds + 3 * MX_BUF, KV + (size_t)(b * MEMLEN + 128) * D + MEMW + h * 128, w, lane);
        bf16x8 qf[4];
#pragma unroll
        for (int kk = 0; kk < 4; ++kk) qf[kk] = *(const bf16x8*)(Qm + ((size_t)b * SEQ + 256 * qc + 16 * w + r) * MEMW + h * 128 + 32 * kk + 8 * q);
        asm volatile("s_waitcnt vmcnt(0) lgkmcnt(0)\n\ts_barrier" ::: "memory");
        for (int c = 0; c < 2; ++c) {
            const size_t trow = (size_t)b * SEQ + 256 * qc + 128 * c + 16 * w + r;
            if (c == 1) {
#pragma unroll
                for (int kk = 0; kk < 4; ++kk) qf[kk] = *(const bf16x8*)(Qm + trow * MEMW + h * 128 + 32 * kk + 8 * q); }
            f32x4 z[16];
#pragma unroll
            for (int st = 0; st < 16; ++st) { z[st] = (f32x4){0.f, 0.f, 0.f, 0.f};
#pragma unroll
                for (int kk = 0; kk < 4; ++kk) { const bf16x8 kf = *(const LAS bf16x8*)(lds + (st >> 3) * MX_BUF + (16 * (st & 7) + r) * 256 + (((4 * kk + q) ^ r) * 16));
                    z[st] = __builtin_amdgcn_mfma_f32_16x16x32_bf16(kf, qf[kk], z[st], 0, 0, 0); }
                if (st & 1) __builtin_amdgcn_sched_barrier(0); }
            float mx = -1e30f;
#pragma unroll
            for (int st = 0; st < 16; ++st) mx = fmaxf(mx, fmaxf(fmaxf(z[st][0], z[st][1]), fmaxf(z[st][2], z[st][3])));
            mx = fmaxf(mx, __shfl_xor(mx, 16)); mx = fmaxf(mx, __shfl_xor(mx, 32));
            float sum = 0.f;
#pragma unroll
            for (int st = 0; st < 16; ++st)
#pragma unroll
                for (int e = 0; e < 4; ++e) { const float pp = fast_exp2((z[st][e] - mx) * LOG2E); z[st][e] = pp; sum += pp; }
            sum += __shfl_xor(sum, 16); sum += __shfl_xor(sum, 32);
            const float inv = 1.0f / sum;
            f32x4 o[8];
#pragma unroll
            for (int dt = 0; dt < 8; ++dt) o[dt] = (f32x4){0.f, 0.f, 0.f, 0.f};
#pragma unroll
            for (int p = 0; p < 8; ++p) { const bf16x8 pf = mk_frag(z[2 * p], z[2 * p + 1]);
#pragma unroll
                for (int dt = 0; dt < 8; ++dt) { const bf16x8 vf = mx_tr(lds + (2 + (p >> 2)) * MX_BUF, 32 * (p & 3) + 4 * q, 32 * (p & 3) + 16 + 4 * q, 16 * dt, r);
                    o[dt] = __builtin_amdgcn_mfma_f32_16x16x32_bf16(vf, pf, o[dt], 0, 0, 0); }
                __builtin_amdgcn_sched_barrier(0); }
#pragma unroll
            for (int dt = 0; dt < 8; ++dt) { const f32x4 v = o[dt] * inv;
                *(u32x2*)(Om + trow * MEMW + h * 128 + 16 * dt + 4 * q) = (u32x2){pg8::pk2(v[0], v[1]), pg8::pk2(v[2], v[3])}; }
        }
        asm volatile("s_waitcnt lgkmcnt(0)\n\ts_barrier" ::: "memory");
    }
}

constexpr int RT_XRS = 2064;
constexpr int RT_XH = 0, RT_XL = 16 * RT_XRS, RT_PART = 2 * 16 * RT_XRS, RT_SC = RT_PART + 8 * 16 * 64 * 4, RT_SEL = RT_SC + 16 * 64 * 4, RT_HIST = RT_SEL + 16 * 64 * 4, RT_END = RT_HIST + 256;
static_assert(RT_END <= SCR_BYTES, "router LDS");
DI float grp8_max(float v) { v = fmaxf(v, __shfl_xor(v, 1)); v = fmaxf(v, __shfl_xor(v, 2)); v = fmaxf(v, __shfl_xor(v, 4)); return v; }
DI float rdlane(float v, int l) { return __uint_as_float(__builtin_amdgcn_readlane(__float_as_uint(v), l)); }
DI void route_phase(Frame& F, const float* const* in, unsigned* gcount) {
    LAS unsigned char* lds = F.lds; unsigned char* ws = F.ws;
    const int tid = F.tid, lane = F.lane, w = F.wave, r = lane & 15, q = lane >> 4;
    const bf16* Y2 = (const bf16*)F.out; bf16* X2b = (bf16*)(ws + WS_X2B);
    const bf16* WRH = (const bf16*)(ws + WS_WRHI); const bf16* WRL = (const bf16*)(ws + WS_WRLO);
    unsigned* TK = (unsigned*)(ws + WS_TK); float* TKW = (float*)(ws + WS_TKW); unsigned* WGB = (unsigned*)(ws + WS_WGBASE);
    LAS unsigned* HIST = (LAS unsigned*)(lds + RT_HIST);
    if (tid < 64) HIST[tid] = 0u;
    const float rb = in[19][lane];
    f32x4 gv[4], bv[4];
#pragma unroll
    for (int j = 0; j < 4; ++j) { gv[j] = ((const f32x4*)in[16])[lane + 64 * j]; bv[j] = ((const f32x4*)in[17])[lane + 64 * j]; }
    bf16x8 bh[4][4], bl[4][4];
#pragma unroll
    for (int kk = 0; kk < 4; ++kk)
#pragma unroll
        for (int nt = 0; nt < 4; ++nt) { const size_t o = (size_t)(16 * nt + r) * D + 128 * w + 32 * kk + 8 * q; bh[kk][nt] = *(const bf16x8*)(WRH + o); bl[kk][nt] = *(const bf16x8*)(WRL + o); }
    u32x2 va[4], vb[4];
    { const int tl0 = F.vcu; if (tl0 < T / 16) {
#pragma unroll
        for (int j = 0; j < 4; ++j) { va[j] = ((const u32x2*)(Y2 + ((size_t)16 * tl0 + 2 * w) * D))[lane + 64 * j]; vb[j] = ((const u32x2*)(Y2 + ((size_t)16 * tl0 + 2 * w + 1) * D))[lane + 64 * j]; } } }
    __syncthreads();
    for (int tl = F.vcu; tl < T / 16; tl += F.G) {
#pragma unroll
        for (int rr = 0; rr < 2; ++rr) { const int lr = 2 * w + rr; const size_t m = (size_t)16 * tl + lr;
            f32x4 v[4]; float s = 0.f;
#pragma unroll
            for (int j = 0; j < 4; ++j) { const u32x2 x = rr ? vb[j] : va[j]; v[j] = (f32x4){bflo(x.x), bfhi(x.x), bflo(x.y), bfhi(x.y)}; s += (v[j][0] + v[j][1]) + (v[j][2] + v[j][3]); }
            const float mean = wave_sum(s) * (1.f / D); float s2 = 0.f;
#pragma unroll
            for (int j = 0; j < 4; ++j) { const f32x4 d = v[j] - mean; s2 += (d[0] * d[0] + d[1] * d[1]) + (d[2] * d[2] + d[3] * d[3]); }
            const float rstd = 1.f / sqrtf(wave_sum(s2) * (1.f / D) + LN_EPS);
            u32x2* ob = (u32x2*)(X2b + m * D) + lane;
#pragma unroll
            for (int j = 0; j < 4; ++j) { const f32x4 y = (v[j] - mean) * rstd * gv[j] + bv[j];
                const u32x2 hi = (u32x2){pg8::pk2(y[0], y[1]), pg8::pk2(y[2], y[3])}; ob[64 * j] = hi;
                const f32x4 rs = (f32x4){y[0] - bflo(hi.x), y[1] - bfhi(hi.x), y[2] - bflo(hi.y), y[3] - bfhi(hi.y)};
                *(LAS u32x2*)(lds + RT_XH + lr * RT_XRS + (4 * lane + 256 * j) * 2) = hi;
                *(LAS u32x2*)(lds + RT_XL + lr * RT_XRS + (4 * lane + 256 * j) * 2) = (u32x2){pg8::pk2(rs[0], rs[1]), pg8::pk2(rs[2], rs[3])}; } }
        { const int tn = tl + F.G; if (tn < T / 16) {
#pragma unroll
            for (int j = 0; j < 4; ++j) { va[j] = ((const u32x2*)(Y2 + ((size_t)16 * tn + 2 * w) * D))[lane + 64 * j]; vb[j] = ((const u32x2*)(Y2 + ((size_t)16 * tn + 2 * w + 1) * D))[lane + 64 * j]; } } }
        __syncthreads();
        { f32x4 acc[4];
#pragma unroll
          for (int nt = 0; nt < 4; ++nt) acc[nt] = (f32x4){0.f, 0.f, 0.f, 0.f};
#pragma unroll
          for (int kk = 0; kk < 4; ++kk) { const int k0 = 128 * w + 32 * kk + 8 * q;
              const bf16x8 ah = *(const LAS bf16x8*)(lds + RT_XH + r * RT_XRS + k0 * 2), al = *(const LAS bf16x8*)(lds + RT_XL + r * RT_XRS + k0 * 2);
#pragma unroll
              for (int nt = 0; nt < 4; ++nt) {
                  acc[nt] = __builtin_amdgcn_mfma_f32_16x16x32_bf16(ah, bh[kk][nt], acc[nt], 0, 0, 0);
                  acc[nt] = __builtin_amdgcn_mfma_f32_16x16x32_bf16(al, bh[kk][nt], acc[nt], 0, 0, 0);
                  acc[nt] = __builtin_amdgcn_mfma_f32_16x16x32_bf16(ah, bl[kk][nt], acc[nt], 0, 0, 0); } }
#pragma unroll
          for (int nt = 0; nt < 4; ++nt)
#pragma unroll
              for (int e = 0; e < 4; ++e) *(LAS float*)(lds + RT_PART + ((w * 16 + 4 * q + e) * 64 + 16 * nt + r) * 4) = acc[nt][e]; }
        __syncthreads();
#pragma unroll
        for (int rr = 0; rr < 2; ++rr) { const int lt = 2 * w + rr; const size_t tok = (size_t)16 * tl + lt;
            float lg = 0.f;
#pragma unroll
            for (int k = 0; k < 8; ++k) lg += *(const LAS float*)(lds + RT_PART + ((k * 16 + lt) * 64 + lane) * 4);
            const float sc = 1.0f / (1.0f + __expf(-lg)); const float sel = sc + rb;
            const int g = lane >> 3;
            const float m1 = grp8_max(sel);
            const unsigned long long bal = __ballot(sel == m1);
            const unsigned gb = (unsigned)(bal >> (8 * g)) & 0xffu; const int first = 8 * g + __builtin_ctz(gb);
            const float m2 = grp8_max(lane == first ? -1e30f : sel);
            const float gs = m1 + m2;
            int grank = 0;
#pragma unroll
            for (int g2 = 0; g2 < 8; ++g2) { const float v = rdlane(gs, 8 * g2); grank += ((v > gs) || (v == gs && g2 < g)) ? 1 : 0; }
            const float val = (grank < 4) ? sel : -1e30f;
            int rank = 0;
#pragma unroll
            for (int e2 = 0; e2 < 64; ++e2) { const float v = rdlane(val, e2); rank += ((v > val) || (v == val && e2 < lane)) ? 1 : 0; }
            const bool chosen = rank < 8;
            const unsigned long long cm = __ballot(chosen);
            const float wsum = wave_sum(chosen ? sc : 0.f);
            if (chosen) { const int kidx = __builtin_popcountll(cm & ((1ull << lane) - 1ull));
                const unsigned lrk = __hip_atomic_fetch_add(&HIST[lane], 1u, __ATOMIC_RELAXED, __HIP_MEMORY_SCOPE_WORKGROUP);
                TK[tok * 8 + kidx] = (unsigned)lane | (lrk << 8); TKW[tok * 8 + kidx] = sc * (ROUTED_SCALE / wsum); }
        }
        __syncthreads();
    }
    if (tid < 64) { const unsigned cnt = HIST[tid]; const unsigned base = __hip_atomic_fetch_add(gcount + tid, cnt, RLX_AGENT); WGB[F.vcu * 64 + tid] = base; }
}

DI void slots_phase(Frame& F) {
    LAS unsigned char* lds = F.lds; unsigned char* ws = F.ws; const int tid = F.tid;
    LAS unsigned* CNT = (LAS unsigned*)lds; LAS unsigned* PS = CNT + 64;
    int* ROWTOK = (int*)(ws + WS_ROWTOK); float* ROWW = (float*)(ws + WS_ROWW); unsigned* SLOT = (unsigned*)(ws + WS_SLOT);
    const unsigned* TK = (const unsigned*)(ws + WS_TK); const float* TKW = (const float*)(ws + WS_TKW); const unsigned* WGB = (const unsigned*)(ws + WS_WGBASE);
    if (tid < 64) CNT[tid] = __hip_atomic_load(F.ctl + CW_GCOUNT + tid, RLX_AGENT);
    __syncthreads();
    if (tid == 0) { unsigned run = 0u; for (int e = 0; e < 64; ++e) { PS[e] = run; run += (CNT[e] + 255u) & ~255u; } PS[64] = run; }
    __syncthreads();
    const unsigned nblk = PS[64] >> 8;
    if (F.vcu == 0) {
        if (tid == 0) { __hip_atomic_store(F.ctl + CW_HDR, nblk, RLX_AGENT); __hip_atomic_store(F.ctl + CW_HDR + 1, (nblk + 1u) >> 1, RLX_AGENT); }
        for (unsigned bl = tid; bl < nblk; bl += NTHREADS) { unsigned e = 0; for (int k = 1; k < 64; ++k) e += (PS[k] <= bl * 256u) ? 1u : 0u; __hip_atomic_store(F.ctl + CW_BLKE + bl, e, RLX_AGENT); }
    }
    for (int e = F.vcu; e < 64; e += F.G) { const unsigned lo = PS[e] + CNT[e], hi = PS[e + 1]; for (unsigned s = lo + tid; s < hi; s += NTHREADS) { ROWTOK[s] = 0; ROWW[s] = 0.f; } }
    for (int tl = F.vcu; tl < T / 16; tl += F.G) {
        if (tid < 128) { const size_t a = (size_t)16 * 8 * tl + tid; const unsigned pk = TK[a], e = pk & 0xffu, lrk = pk >> 8;
            const unsigned slot = PS[e] + WGB[F.vcu * 64 + e] + lrk; ROWTOK[slot] = (int)(a >> 3); ROWW[slot] = TKW[a]; SLOT[a] = slot; }
    }
}

DI void dec8(unsigned w, float (&o)[4]) { const f32x2 a = __builtin_amdgcn_cvt_pk_f32_fp8((int)w, false), b = __builtin_amdgcn_cvt_pk_f32_fp8((int)w, true); o[0] = a[0]; o[1] = a[1]; o[2] = b[0]; o[3] = b[1]; }
DI void combine_phase(Frame& F, const float* const* in) {
    const int gw = F.vcu * NWAVES + F.wave, NGW = F.G * NWAVES, lane = F.lane;
    const unsigned* SLOT = (const unsigned*)(F.ws + WS_SLOT); const unsigned char* Y8 = (const unsigned char*)(F.ws + WS_YH); const bf16* base = (const bf16*)(F.ws + WS_X2B); float* out = F.out;
    f32x4 gv[4], bv[4];
#pragma unroll
    for (int j = 0; j < 4; ++j) { gv[j] = *(const f32x4*)(in[26] + 16 * lane + 4 * j); bv[j] = *(const f32x4*)(in[27] + 16 * lane + 4 * j); }
    for (int m0 = gw; m0 < T; m0 += 2 * NGW) {
        u32x4 yr[2][8]; u32x4 bs[2][2];
#pragma unroll
        for (int t2 = 0; t2 < 2; ++t2) { const int m = m0 + t2 * NGW; const int mm = (m < T) ? m : m0;
            unsigned sl[8];
#pragma unroll
            for (int k = 0; k < 8; ++k) sl[k] = __builtin_amdgcn_readfirstlane(__hip_atomic_load(SLOT + (size_t)mm * 8 + k, RLX_AGENT));
            bs[t2][0] = *(const u32x4*)(base + (size_t)mm * D + 16 * lane); bs[t2][1] = *(const u32x4*)(base + (size_t)mm * D + 16 * lane + 8);
#pragma unroll
            for (int k = 0; k < 8; ++k) yr[t2][k] = *(const u32x4*)(Y8 + (size_t)sl[k] * D + 16 * lane);
        }
#pragma unroll
        for (int t2 = 0; t2 < 2; ++t2) { const int m = m0 + t2 * NGW; if (m >= T) continue;
            float a[16];
#pragma unroll
            for (int c = 0; c < 16; ++c) a[c] = 0.f;
#pragma unroll
            for (int k = 0; k < 8; ++k) { const u32x4 y = yr[t2][k]; float d[4];
                dec8(y.x, d); a[0] += d[0]; a[1] += d[1]; a[2] += d[2]; a[3] += d[3];
                dec8(y.y, d); a[4] += d[0]; a[5] += d[1]; a[6] += d[2]; a[7] += d[3];
                dec8(y.z, d); a[8] += d[0]; a[9] += d[1]; a[10] += d[2]; a[11] += d[3];
                dec8(y.w, d); a[12] += d[0]; a[13] += d[1]; a[14] += d[2]; a[15] += d[3]; }
            f32x4 v[4];
#pragma unroll
            for (int h = 0; h < 2; ++h) { const u32x4 x = bs[t2][h];
                v[2 * h] = (f32x4){bflo(x.x), bfhi(x.x), bflo(x.y), bfhi(x.y)} + (f32x4){a[8 * h], a[8 * h + 1], a[8 * h + 2], a[8 * h + 3]} * (1.0f / pg8::Y8_SCALE);
                v[2 * h + 1] = (f32x4){bflo(x.z), bfhi(x.z), bflo(x.w), bfhi(x.w)} + (f32x4){a[8 * h + 4], a[8 * h + 5], a[8 * h + 6], a[8 * h + 7]} * (1.0f / pg8::Y8_SCALE); }
            float s = 0.f;
#pragma unroll
            for (int j = 0; j < 4; ++j) s += (v[j][0] + v[j][1]) + (v[j][2] + v[j][3]);
            const float mean = wave_sum(s) * (1.f / D); float s2 = 0.f;
#pragma unroll
            for (int j = 0; j < 4; ++j) { const f32x4 d = v[j] - mean; s2 += (d[0] * d[0] + d[1] * d[1]) + (d[2] * d[2] + d[3] * d[3]); }
            const float rstd = 1.f / sqrtf(wave_sum(s2) * (1.f / D) + LN_EPS);
#pragma unroll
            for (int j = 0; j < 4; ++j) *(f32x4*)(out + (size_t)m * D + 16 * lane + 4 * j) = (v[j] - mean) * rstd * gv[j] + bv[j];
        }
    }
}

DI void stagger(const Frame& F, unsigned ticks) {
    if (F.vcu & 1) { const unsigned long long t0 = __builtin_amdgcn_s_memrealtime(); while (__builtin_amdgcn_s_memrealtime() - t0 < ticks) __builtin_amdgcn_s_sleep(8); }
}
#ifndef STAG_DOWN
#define STAG_DOWN 350
#endif
constexpr int NPHASE = 13;
constexpr int CVT_A = 12288;
constexpr int N_LAUNCHES = MK_N_LAUNCHES;
static_assert(N_LAUNCHES == 1 || N_LAUNCHES == NPHASE, "MK_N_LAUNCHES: 1 (one dispatch) or 13 (one dispatch per phase)");
struct Args { const float* in[28]; float* out; unsigned char* ws; int ph_lo, ph_hi; };
static_assert(sizeof(Args) == 28 * 8 + 8 + 8 + 8, "Args has no padding");

__global__ void __launch_bounds__(NTHREADS, 2) fwd_kernel(Args args) {
    extern __shared__ __attribute__((aligned(16))) unsigned char lds_raw[];
    Frame F;
    F.lds = (LAS unsigned char*)lds_raw;
    volatile LAS unsigned* MISC = (volatile LAS unsigned*)(F.lds + MISC_OFF);
    F.tid = threadIdx.x; F.lane = F.tid & 63; F.wave = __builtin_amdgcn_readfirstlane(F.tid >> 6);
    F.G = gridDim.x; { const int bx = blockIdx.x; F.vcu = (F.G % 8 == 0) ? (bx % 8) * (F.G / 8) + bx / 8 : bx; }
    F.ws = args.ws; F.ctl = (unsigned*)(args.ws + WS_CTL); F.out = args.out;
    unsigned char* ws = args.ws;
    for (int u = F.tid; u < (LDS_BYTES - MISC_OFF) / 4; u += NTHREADS) ((LAS unsigned*)(F.lds + MISC_OFF))[u] = 0u;
    __syncthreads();
    XcdBarrier bar; bar.bar = F.ctl + CW_BAR; bar.x = 0; bar.st = nullptr;
    if (N_LAUNCHES == 1) bar = xcd_barrier_post(F.ctl + CW_BAR, MISC + 8);
#define GRID_BAR() do { if (N_LAUNCHES == 1) xcd_barrier(bar); } while (0)
    const int lo = args.ph_lo, hi = args.ph_hi;
#ifndef PHASE_MASK
#define PHASE_MASK 0x1fff
#endif
#define IN(k) (((PHASE_MASK >> (k)) & 1) && lo <= (k) && (k) < hi)
#ifndef REPEAT_MASK
#define REPEAT_MASK 0
#endif
#ifndef DOWN_PROBE
#define DOWN_PROBE 0
#endif
#define REP(k) (((REPEAT_MASK >> (k)) & 1) ? 2 : 1)
#define SEAM(k) do { if (IN(k) && IN((k) + 1)) GRID_BAR(); } while (0)
    const float* const* in = args.in;

    for (int rep_ = 0; rep_ < (IN(0) ? REP(0) : 0); ++rep_) { if (rep_) GRID_BAR(); p0_prologue(F, in); SEAM(0); }
    for (int rep_ = 0; rep_ < (IN(1) ? REP(1) : 0); ++rep_) { if (rep_) GRID_BAR();
        pg8::DenseOrder S; S.init((const bf16*)F.out, (const bf16*)(ws + WS_WIN), T, INW, D, F.G, (int)blockIdx.x);
        pg8::EpiInProj E{(bf16*)(ws + WS_P1), (float*)(ws + WS_VSTAT), (const float*)(ws + WS_BPERM)};
        pg8::gemm_phase<pg8::EpiInProj, pg8::DenseOrder, true>(F.lds, D, S, E);
        SEAM(1);
    }
    for (int rep_ = 0; rep_ < (IN(2) ? REP(2) : 0); ++rep_) { if (rep_) GRID_BAR(); mix_phase(F, in); SEAM(2); }
    for (int rep_ = 0; rep_ < (IN(3) ? REP(3) : 0); ++rep_) { if (rep_) GRID_BAR();
        pg8::DenseOrder S; S.init((const bf16*)(ws + WS_MERGED), (const bf16*)(ws + WS_WOUT), T, D, D, F.G, (int)blockIdx.x);
        pg8::EpiResB16<true> E{(bf16*)(ws + WS_Y1), in[0], nullptr, (const float*)(ws + WS_XSTAT), in[2], in[3]};
        pg8::gemm_phase<pg8::EpiResB16<true>, pg8::DenseOrder, false>(F.lds, D, S, E);
        SEAM(3);
    }
    for (int rep_ = 0; rep_ < (IN(4) ? REP(4) : 0); ++rep_) { if (rep_) GRID_BAR(); ln1_phase(F, in); SEAM(4); }
    for (int rep_ = 0; rep_ < (IN(5) ? REP(5) : 0); ++rep_) { if (rep_) GRID_BAR();
        if (F.G == 256) { if ((int)blockIdx.x >= 160) expert_convert(F, in, (int)blockIdx.x - 160, 96, 0, CVT_A); }
        else expert_convert(F, in, F.vcu, F.G, 0, NEXP * 384);
        __syncthreads();
        { pg8::DenseOrder S; S.init((const bf16*)(ws + WS_X1B), (const bf16*)(ws + WS_WQ), T, MEMW, D, F.G, (int)blockIdx.x);
          pg8::EpiBf16S E{(bf16*)(ws + WS_QM), MEMW, QSCALE};
          pg8::gemm_phase<pg8::EpiBf16S, pg8::DenseOrder, false>(F.lds, D, S, E); }
        { const int c2 = ((int)blockIdx.x + F.G - 128 % F.G) % F.G;
          pg8::DenseOrder S; S.init((const bf16*)(ws + WS_MEMB), (const bf16*)(ws + WS_WKV), NBATCH * MEMLEN, 2 * MEMW, D, F.G, c2);
          pg8::EpiBf16S E{(bf16*)(ws + WS_KVM), 2 * MEMW, 1.0f};
          pg8::gemm_phase<pg8::EpiBf16S, pg8::DenseOrder, false>(F.lds, D, S, E); }
        SEAM(5);
    }
    for (int rep_ = 0; rep_ < (IN(6) ? REP(6) : 0); ++rep_) { if (rep_) GRID_BAR();
        if (F.G == 256) { if (F.vcu & 1) expert_convert(F, in, F.vcu >> 1, 128, CVT_A, NEXP * 384); else memattn_phase(F, F.vcu >> 1, 128); }
        else memattn_phase(F, F.vcu, F.G);
        SEAM(6); }
    for (int rep_ = 0; rep_ < (IN(7) ? REP(7) : 0); ++rep_) { if (rep_) GRID_BAR();
        pg8::DenseOrder S; S.init((const bf16*)(ws + WS_OM), (const bf16*)(ws + WS_WO), T, D, MEMW, F.G, (int)blockIdx.x);
        pg8::EpiResB16<false> E{(bf16*)F.out, nullptr, (const bf16*)(ws + WS_X1B), nullptr, nullptr, nullptr};
        pg8::gemm_phase<pg8::EpiResB16<false>, pg8::DenseOrder, false>(F.lds, MEMW, S, E);
        SEAM(7);
    }
    for (int rep_ = 0; rep_ < (IN(8) ? REP(8) : 0); ++rep_) { if (rep_) GRID_BAR(); route_phase(F, in, F.ctl + ((rep_ + 1 < REP(8)) ? 2048 : CW_GCOUNT)); SEAM(8); }
    for (int rep_ = 0; rep_ < (IN(9) ? REP(9) : 0); ++rep_) { if (rep_) GRID_BAR(); slots_phase(F); SEAM(9); }
    for (int rep_ = 0; rep_ < (IN(10) ? REP(10) : 0); ++rep_) { if (rep_) GRID_BAR();
        const int nblk = (int)__builtin_amdgcn_readfirstlane(__hip_atomic_load(F.ctl + CW_HDR, RLX_AGENT));
        pg8::moe_tables(F.lds, F.ctl + CW_BLKE, nblk, (const int*)(ws + WS_ROWTOK), (const float*)(ws + WS_ROWW), true, F.G, F.vcu, F.tid);
        pg8::GateUpOrder S{(const char*)(ws + WS_X2B), (const char*)(ws + WS_WGU), (const char*)(ws + WS_WGUS), F.lds, nblk, F.G, F.vcu};
        pg8::EpiGateUp E{(bf16*)(ws + WS_H), F.lds};
        pg8::gemm_phase<pg8::EpiGateUp, pg8::GateUpOrder, true>(F.lds, D, S, E);
        SEAM(10);
    }
    for (int rep_ = 0; rep_ < (IN(11) ? REP(11) : 0); ++rep_) { if (rep_) GRID_BAR();
        const int nblk = (int)__builtin_amdgcn_readfirstlane(__hip_atomic_load(F.ctl + CW_HDR, RLX_AGENT));
        pg8::moe_tables(F.lds, F.ctl + CW_BLKE, nblk, nullptr, nullptr, false, F.G, F.vcu, F.tid);
        pg8::DownOrder S{(const char*)(ws + WS_H), (const char*)(ws + WS_WD), (const char*)(ws + WS_WDS), F.lds, 0, nblk, 64, F.G, F.vcu, 0};
        pg8::EpiDown E{(unsigned char*)(ws + WS_YH), (bf16*)(ws + WS_X2B), 0};
        pg8::gemm_phase<pg8::EpiDown, pg8::DownOrder, true>(F.lds, EH, S, E);
        SEAM(11);
    }
    if (IN(12)) { combine_phase(F, in); }
#undef IN
#undef SEAM
#undef GRID_BAR
}

extern "C" void kernel_launch(void* const* d_in, const int* in_sizes, int n_in, void* d_out, int out_size, void* d_ws, size_t ws_size, hipStream_t stream) {
    static int grid = 0;
    if (grid == 0) {
        if (n_in != 28 || in_sizes[0] != T * D || out_size != T * D || ws_size < WS_END) { fprintf(stderr, "kernel_launch: unexpected shapes / workspace (n_in %d, ws %zu < %zu)\n", n_in, ws_size, (size_t)WS_END); grid = -1; return; }
        int dev = 0, cus = 0, per_cu = 0;
        if (hipGetDevice(&dev) != hipSuccess || hipDeviceGetAttribute(&cus, hipDeviceAttributeMultiprocessorCount, dev) != hipSuccess) { grid = -1; return; }
        if (hipFuncSetAttribute((const void*)fwd_kernel, hipFuncAttributeMaxDynamicSharedMemorySize, LDS_BYTES) != hipSuccess) { fprintf(stderr, "kernel_launch: hipFuncSetAttribute failed\n"); grid = -1; return; }
        if (hipOccupancyMaxActiveBlocksPerMultiprocessor(&per_cu, (const void*)fwd_kernel, NTHREADS, LDS_BYTES) != hipSuccess || per_cu < 1) { fprintf(stderr, "kernel_launch: occupancy query reports %d\n", per_cu); }
        (void)hipGetLastError();
        grid = cus;
    }
    if (grid < 0) return;
    if (hipMemsetAsync((char*)d_ws + WS_CTL, 0, CTL_ZERO_BYTES, stream) != hipSuccess) return;
    Args a{};
    for (int i = 0; i < 28; ++i) a.in[i] = (const float*)d_in[i];
    a.out = (float*)d_out; a.ws = (unsigned char*)d_ws;
    for (int li = 0; li < N_LAUNCHES; ++li) {
        a.ph_lo = (N_LAUNCHES == 1) ? 0 : li; a.ph_hi = (N_LAUNCHES == 1) ? NPHASE : li + 1;
        hipLaunchKernelGGL(fwd_kernel, dim3(grid), dim3(NTHREADS), LDS_BYTES, stream, a);
        if (hipPeekAtLastError() != hipSuccess) { fprintf(stderr, "kernel_launch: launch %d failed\n", li); break; }
    }
}
```

```cpp
#include <hip/hip_runtime.h>
#include <cstdio>
#include <cstdint>

#ifndef MK_N_LAUNCHES
#define MK_N_LAUNCHES 1
#endif

#define GAS __attribute__((address_space(1)))
#define LAS __attribute__((address_space(3)))
typedef unsigned short bf16;
typedef short bf16x8 __attribute__((ext_vector_type(8)));
typedef short s16x4 __attribute__((ext_vector_type(4)));
typedef float f32x4 __attribute__((ext_vector_type(4)));
typedef float f32x2 __attribute__((ext_vector_type(2)));
typedef unsigned u32x4 __attribute__((ext_vector_type(4)));
typedef unsigned u32x2 __attribute__((ext_vector_type(2)));
#define RLX_AGENT __ATOMIC_RELAXED, __HIP_MEMORY_SCOPE_AGENT
#define DI __device__ __forceinline__

constexpr int T = 16384, D = 1024, NBATCH = 8, SEQ = 2048, MEMLEN = 256, INW = 7168;
constexpr int NEXP = 64, TOPK = 8, EH = 256, MEMW = 512;
constexpr float LN_EPS = 1e-5f;
constexpr float ALPHA = 1.189207115002721f;
constexpr float QSCALE = 0.08838834764831845f;
constexpr float ROUTED_SCALE = 2.5f;
constexpr float LOG2E = 1.4426950408889634f, LN2 = 0.6931471805599453f;
constexpr float SB_EXIT = -30.0f;
constexpr int NWAVES = 8, NTHREADS = 512;
constexpr int MAXBLK = 576;
constexpr int SH_ROW0 = MAXBLK * 256;

constexpr size_t MiB = 1u << 20;
constexpr size_t WS_CTL = 0, CTL_ZERO_BYTES = 32 * 1024;
constexpr size_t WS_WRHI = 1 * MiB, WS_WRLO = WS_WRHI + 128 * 1024, WS_WSP = WS_WRLO + 128 * 1024, WS_BPERM = WS_WSP + 256 * 1024, WS_XSTAT = WS_BPERM + 32 * 1024;
constexpr size_t WS_ROWTOK = 2 * MiB, WS_ROWW = WS_ROWTOK + 576 * 1024, WS_SLOT = WS_ROWW + 576 * 1024;
constexpr size_t WS_WIN = 4 * MiB, WS_WOUT = 18 * MiB, WS_WQ = 20 * MiB, WS_WKV = 21 * MiB, WS_WO = 23 * MiB, WS_MEMB = 24 * MiB;
constexpr size_t WS_P1 = 29 * MiB;
constexpr size_t WS_UG = WS_P1, WS_VA = WS_P1 + 32 * MiB, WS_Q = WS_P1 + 64 * MiB, WS_K = WS_P1 + 96 * MiB, WS_V = WS_P1 + 128 * MiB, WS_GB = WS_P1 + 160 * MiB;
constexpr size_t WS_VSTAT = 221 * MiB;
constexpr size_t WS_MERGED = 228 * MiB;
constexpr size_t WS_Y1 = 29 * MiB;
constexpr size_t WS_X1F = 93 * MiB, WS_X1B = 157 * MiB;
constexpr size_t WS_QM = 189 * MiB, WS_KVM = 205 * MiB, WS_OM = 209 * MiB;
constexpr size_t WS_WGU = 29 * MiB;
constexpr size_t WS_H = 148 * MiB;
constexpr size_t WS_X2B = 228 * MiB;
constexpr size_t WS_WD = 260 * MiB;
constexpr size_t WS_WGUS = 293 * MiB, WS_WDS = 294 * MiB;
constexpr size_t WS_TK = 295 * MiB, WS_TKW = WS_TK + 512 * 1024, WS_WGBASE = WS_TKW + 512 * 1024;
constexpr size_t WS_YH = 4 * MiB;
constexpr size_t WS_END = 297 * MiB;
static_assert(WS_XSTAT + (size_t)T * 8 <= WS_ROWTOK && WS_SLOT + (size_t)T * 8 * 4 <= WS_WIN && WS_MEMB + 4 * MiB <= WS_P1, "ws map 1");
static_assert(WS_GB + 32 * MiB <= WS_VSTAT && WS_VSTAT + 2 * MiB <= WS_MERGED && WS_H + (size_t)(SH_ROW0 + T) * 512 <= WS_X2B && WS_X2B + 32 * MiB <= WS_WD, "ws map 2");
static_assert(WS_WD + (size_t)64 * 1024 * 256 * 2 <= WS_WGUS && WS_YH + (size_t)288 * 256 * 2048 <= WS_H && WS_WGBASE + 256 * 64 * 4 <= WS_END, "ws map 3");
constexpr int CW_TMO = 0, CW_CODE = 1;
constexpr int CW_GCOUNT = 64;
constexpr int CW_HDR = 192;
constexpr int CW_BLKE = 256;
constexpr int CW_BAR = 4096;

constexpr int SCR_BYTES = 140 * 1024;
constexpr int MISC_OFF = SCR_BYTES;
constexpr int LDS_BYTES = 144 * 1024;

DI unsigned cvt_pk_bf16(float lo, float hi) { unsigned r; asm volatile("v_cvt_pk_bf16_f32 %0, %1, %2" : "=v"(r) : "v"(lo), "v"(hi)); return r; }
DI float bf2f(unsigned short h) { return __uint_as_float((unsigned)h << 16); }
DI float bflo(unsigned w) { return __uint_as_float(w << 16); }
DI float bfhi(unsigned w) { return __uint_as_float(w & 0xffff0000u); }
DI float fast_exp2(float x) { return __builtin_amdgcn_exp2f(x); }
DI float fast_log2(float x) { return __builtin_amdgcn_logf(x); }
DI float fast_rcp(float x) { return __builtin_amdgcn_rcpf(x); }
DI float sigmoidf_(float x) { return fast_rcp(1.0f + fast_exp2(-x * LOG2E)); }
template <int CTRL, int ROWMASK> DI float dpp_f(float v, float fill) { return __uint_as_float((unsigned)__builtin_amdgcn_update_dpp((int)__float_as_uint(fill), (int)__float_as_uint(v), CTRL, ROWMASK, 0xf, false)); }
DI float wave_sum(float v) {
    v += dpp_f<0x111, 0xf>(v, 0.f); v += dpp_f<0x112, 0xf>(v, 0.f); v += dpp_f<0x114, 0xf>(v, 0.f); v += dpp_f<0x118, 0xf>(v, 0.f);
    v += dpp_f<0x142, 0xa>(v, 0.f); v += dpp_f<0x143, 0xc>(v, 0.f);
    return __uint_as_float(__builtin_amdgcn_readlane(__float_as_uint(v), 63));
}
DI float wave_max(float v) {
#pragma unroll
    for (int o = 1; o < 64; o <<= 1) v = fmaxf(v, __shfl_xor(v, o));
    return v;
}
#define LDS_WAIT() asm volatile("s_waitcnt lgkmcnt(0)" ::: "memory")
#define VM_WAIT() asm volatile("s_waitcnt vmcnt(0)" ::: "memory")

namespace pg8 {
constexpr int BM = 256, BK = 64, HALF = 128, HTB = HALF * BK * 2, STAGE_BYTES = 8 * HTB, NXCD = 8, WGM = 8;
__host__ __device__ __forceinline__ int lds_byte(int r, int c) { const int st = (r >> 4) * 2 + (c >> 5), rr = r & 15, cc = c & 31, ob = rr * 64 + cc * 2; return st * 1024 + (ob ^ (((ob >> 9) & 1) << 5)); }
__host__ __device__ __forceinline__ void stage_rc(int b, int& R, int& C) { const int st = b / 1024, sb = b % 1024, swz = sb ^ (((sb >> 9) & 1) << 5); R = (st >> 1) * 16 + swz / 64; C = (st & 1) * 32 + (swz % 64) / 2; }
__host__ __device__ __forceinline__ int perm32(int rho) { const int n = rho >> 4, i = rho & 15; return 8 * (i >> 2) + 4 * n + (i & 3); }

struct Unit { int pm, pn, e, ui; const char* A; const char* B; };

typedef float f32x2v __attribute__((ext_vector_type(2)));
DI f32x2v gelu_pk(f32x2v v) {
    const f32x2v av = __builtin_elementwise_abs(v), d = av * 0.2316418882f + 1.0f;
    f32x2v t; t.x = __builtin_amdgcn_rcpf(d.x); t.y = __builtin_amdgcn_rcpf(d.y);
    f32x2v q = t * 0.5307027145f + (-0.7265760135f); q = q * t + 0.7107068705f; q = q * t + (-0.142248368f); q = q * t + 0.127414796f; q = q * t;
    const f32x2v s = (v * v) * (-0.72134752044f);
    f32x2v e; e.x = __builtin_amdgcn_exp2f(s.x); e.y = __builtin_amdgcn_exp2f(s.y);
    const f32x2v m = v * (q * e), r = v - m;
    f32x2v o; o.x = v.x < 0.f ? m.x : r.x; o.y = v.y < 0.f ? m.y : r.y; return o;
}
DI f32x4 gelu4(f32x4 v) { const f32x2v a = gelu_pk((f32x2v){v[0], v[1]}), b = gelu_pk((f32x2v){v[2], v[3]}); return (f32x4){a.x, a.y, b.x, b.y}; }
DI f32x4 sigmoid4(f32x4 v) { return (f32x4){sigmoidf_(v[0]), sigmoidf_(v[1]), sigmoidf_(v[2]), sigmoidf_(v[3])}; }
DI u32x4 pack8(f32x4 v0, f32x4 v1) { u32x4 w; w.x = cvt_pk_bf16(v0[0], v0[1]); w.y = cvt_pk_bf16(v0[2], v0[3]); w.z = cvt_pk_bf16(v1[0], v1[1]); w.w = cvt_pk_bf16(v1[2], v1[3]); return w; }

template <class Epi, class Sched, bool ALIGN_EPI>
DI void gemm_phase(LAS unsigned char* lds, const int K, const Sched& S, const Epi& E) {
    const int tid = threadIdx.x, wid = __builtin_amdgcn_readfirstlane(tid >> 6), lane = tid & 63, wr = wid >> 2, wc = wid & 3, fr = lane & 15, fq = lane >> 4;
    const int nt = K / BK;
    int Rr[2], Cc[2]; unsigned voffB[2], voffB1[2];
#pragma unroll
    for (int i = 0; i < 2; ++i) { int R, C; stage_rc(tid * 16 + i * 8192, R, C); Rr[i] = R; Cc[i] = C;
        if (Epi::PERM == 2) { const int w0 = 64 * (R >> 5) + 16 * ((R & 15) >> 2) + 4 * ((R >> 4) & 1) + (R & 3); voffB[i] = (unsigned)(w0 * K + C) * 2u; voffB1[i] = (unsigned)((w0 + 8) * K + C) * 2u; }
        else { const int Rb = Epi::PERM ? ((R & ~31) + perm32(R & 31)) : R; voffB[i] = (unsigned)(Rb * K + C) * 2u; voffB1[i] = (unsigned)((Rb + HALF) * K + C) * 2u; } }
    const size_t kstep = (size_t)(BK * 2);
    const unsigned ldsw = (unsigned)wid * 1024u;
    const int aoff = lds_byte(wr * 64 + fr, fq * 8), boff = lds_byte(wc * 32 + fr, fq * 8);
#define PG8_SA(b, h) (((b) * 2 + (h)) * HTB)
#define PG8_SB(b, h) ((4 + (b) * 2 + (h)) * HTB)
#define PG8_STAGE_B(bufoff, gbase) do { _Pragma("unroll") for (int _i = 0; _i < 2; ++_i) \
        __builtin_amdgcn_global_load_lds((const unsigned*)((const char*)(gbase) + voffB[_i]), (LAS unsigned*)(lds + (bufoff) + ldsw + _i * 8192), 16, 0, 0); } while (0)
#define PG8_STAGE_B1(bufoff, gbase) do { _Pragma("unroll") for (int _i = 0; _i < 2; ++_i) \
        __builtin_amdgcn_global_load_lds((const unsigned*)((const char*)(gbase) + voffB1[_i]), (LAS unsigned*)(lds + (bufoff) + ldsw + _i * 8192), 16, 0, 0); } while (0)
#define PG8_STAGE_A(bufoff, gbase, o0, o1) do { \
        __builtin_amdgcn_global_load_lds((const unsigned*)((const char*)(gbase) + (o0)), (LAS unsigned*)(lds + (bufoff) + ldsw), 16, 0, 0); \
        __builtin_amdgcn_global_load_lds((const unsigned*)((const char*)(gbase) + (o1)), (LAS unsigned*)(lds + (bufoff) + ldsw + 8192), 16, 0, 0); } while (0)
#define PG8_LDA(dst, b, h) do { _Pragma("unroll") for (int m = 0; m < 4; ++m) _Pragma("unroll") for (int k = 0; k < 2; ++k) dst[m][k] = *(const LAS bf16x8*)(lds + PG8_SA(b, h) + aoff + m * 2048 + k * 1024); } while (0)
#define PG8_LDB(dst, b, h) do { _Pragma("unroll") for (int n = 0; n < 2; ++n) _Pragma("unroll") for (int k = 0; k < 2; ++k) dst[n][k] = *(const LAS bf16x8*)(lds + PG8_SB(b, h) + boff + n * 2048 + k * 1024); } while (0)
#define PG8_MMA(ai, bj, At, Bt) do { __builtin_amdgcn_s_setprio(1); _Pragma("unroll") for (int m = 0; m < 4; ++m) _Pragma("unroll") for (int n = 0; n < 2; ++n) _Pragma("unroll") for (int k = 0; k < 2; ++k) \
        acc[ai][bj][m][n] = __builtin_amdgcn_mfma_f32_16x16x32_bf16(Bt[n][k], At[m][k], acc[ai][bj][m][n], 0, 0, 0); __builtin_amdgcn_s_setprio(0); } while (0)
#define PG8_WAIT_V(n) asm volatile("s_waitcnt vmcnt(" #n ")" ::: "memory")
#define PG8_WAIT_L(n) asm volatile("s_waitcnt lgkmcnt(" #n ")" ::: "memory")
#define PG8_BAR __builtin_amdgcn_s_barrier()
#define PG8_SCHED __builtin_amdgcn_sched_barrier(0)
    Unit cur, nxt; int ui = 0;
    if (!S.next(0, cur)) return;
    unsigned oc[2][2], on[2][2];
    S.a_offs(cur, Rr, Cc, K, oc);
    f32x4 acc[2][2][4][2];
#pragma unroll
    for (int a = 0; a < 2; ++a)
#pragma unroll
        for (int b = 0; b < 2; ++b)
#pragma unroll
            for (int m = 0; m < 4; ++m)
#pragma unroll
                for (int n = 0; n < 2; ++n) acc[a][b][m][n] = (f32x4){0.f, 0.f, 0.f, 0.f};
    bf16x8 At[4][2], B0[2][2], B1[2][2];
    const char* cA = cur.A; const char* cB = cur.B;
    PG8_STAGE_B(PG8_SB(0, 0), cB); PG8_STAGE_B1(PG8_SB(0, 1), cB); PG8_STAGE_A(PG8_SA(0, 0), cA, oc[0][0], oc[0][1]); PG8_STAGE_A(PG8_SA(0, 1), cA, oc[1][0], oc[1][1]);
    if (wr == 1) PG8_BAR;
    PG8_WAIT_V(2); PG8_BAR;
    PG8_STAGE_B(PG8_SB(1, 0), cB + kstep); PG8_STAGE_A(PG8_SA(1, 0), cA + kstep, oc[0][0], oc[0][1]); PG8_STAGE_B1(PG8_SB(1, 1), cB + kstep);
    PG8_WAIT_V(6); PG8_BAR;
    for (;;) {
        const bool has_next = S.next(ui + 1, nxt);
        const char* nA = has_next ? nxt.A : cA; const char* nB = has_next ? nxt.B : cB;
        if (has_next) S.a_offs(nxt, Rr, Cc, K, on);
        else {
#pragma unroll
            for (int h = 0; h < 2; ++h)
#pragma unroll
                for (int i = 0; i < 2; ++i) on[h][i] = oc[h][i]; }
#pragma unroll 1
        for (int t = 0; t < nt; t += 2) {
            const bool last = (t == nt - 2);
            const char* a1 = cA + (size_t)(t + 1) * kstep;
            const char* a2 = last ? nA : cA + (size_t)(t + 2) * kstep; const char* b2 = last ? nB : cB + (size_t)(t + 2) * kstep;
            const char* a3 = a2 + kstep; const char* b3 = b2 + kstep;
            const unsigned x00 = last ? on[0][0] : oc[0][0], x01 = last ? on[0][1] : oc[0][1], x10 = last ? on[1][0] : oc[1][0], x11 = last ? on[1][1] : oc[1][1];
            PG8_LDB(B0, 0, 0); PG8_LDB(B1, 0, 1); PG8_SCHED; PG8_LDA(At, 0, 0); PG8_STAGE_A(PG8_SA(1, 1), a1, oc[1][0], oc[1][1]);
            PG8_WAIT_V(8); PG8_WAIT_L(0); PG8_BAR; PG8_MMA(0, 0, At, B0); PG8_MMA(0, 1, At, B1); PG8_BAR; PG8_SCHED;
            PG8_LDA(At, 0, 1); PG8_STAGE_B(PG8_SB(0, 0), b2); PG8_STAGE_B1(PG8_SB(0, 1), b2); PG8_STAGE_A(PG8_SA(0, 0), a2, x00, x01);
            PG8_WAIT_V(8); PG8_WAIT_L(0); PG8_BAR; PG8_MMA(1, 0, At, B0); PG8_MMA(1, 1, At, B1); PG8_BAR; PG8_SCHED;
            PG8_LDB(B0, 1, 0); PG8_LDB(B1, 1, 1); PG8_SCHED; PG8_LDA(At, 1, 0); PG8_STAGE_A(PG8_SA(0, 1), a2, x10, x11);
            PG8_WAIT_V(8); PG8_WAIT_L(0); PG8_BAR; PG8_MMA(0, 0, At, B0); PG8_MMA(0, 1, At, B1); PG8_BAR; PG8_SCHED;
            PG8_LDA(At, 1, 1); PG8_STAGE_B(PG8_SB(1, 0), b3); PG8_STAGE_B1(PG8_SB(1, 1), b3); PG8_STAGE_A(PG8_SA(1, 0), a3, x00, x01);
            PG8_WAIT_V(8); PG8_WAIT_L(0); PG8_BAR; PG8_MMA(1, 0, At, B0); PG8_MMA(1, 1, At, B1); PG8_BAR; PG8_SCHED;
        }
        if constexpr (ALIGN_EPI) { if (wr == 0) PG8_BAR; }
        E(acc, cur, wr, wc, fr, fq);
        if (!has_next) break;
#pragma unroll
        for (int a = 0; a < 2; ++a)
#pragma unroll
            for (int b = 0; b < 2; ++b)
#pragma unroll
                for (int m = 0; m < 4; ++m)
#pragma unroll
                    for (int n = 0; n < 2; ++n) acc[a][b][m][n] = (f32x4){0.f, 0.f, 0.f, 0.f};
        cur = nxt; cA = nA; cB = nB; ++ui;
#pragma unroll
        for (int h = 0; h < 2; ++h)
#pragma unroll
            for (int i = 0; i < 2; ++i) oc[h][i] = on[h][i];
        if constexpr (ALIGN_EPI) { if (wr == 1) PG8_BAR; }
    }
    PG8_WAIT_V(0);
    if constexpr (!ALIGN_EPI) { if (wr == 0) PG8_BAR; }
    PG8_BAR;
#undef PG8_SA
#undef PG8_SB
#undef PG8_STAGE_A
#undef PG8_STAGE_B
#undef PG8_STAGE_B1
#undef PG8_LDA
#undef PG8_LDB
#undef PG8_MMA
#undef PG8_WAIT_V
#undef PG8_WAIT_L
#undef PG8_BAR
#undef PG8_SCHED
}

struct DenseOrder {
    const char* A; const char* Bt; int K, nM, nN, nwg, G, c;
    DI void init(const bf16* A_, const bf16* Bt_, int M, int N, int K_, int G_, int c_) { A = (const char*)A_; Bt = (const char*)Bt_; K = K_; nM = M / BM; nN = N / BM; nwg = nM * nN; G = G_; c = c_; }
    DI bool next(int i, Unit& u) const {
        const long L = (long)i * G + c; if (L >= nwg) return false;
        int wgid = (int)L; { const int q = nwg / NXCD, r = nwg % NXCD, xcd = wgid % NXCD, off = wgid / NXCD; wgid = (xcd < r ? xcd * (q + 1) : r * (q + 1) + (xcd - r) * q) + off; }
        const int nig = WGM * nN, gid = wgid / nig, fm = gid * WGM, gsz = (nM - fm) < WGM ? (nM - fm) : WGM;
        u.pm = fm + ((wgid % nig) % gsz); u.pn = (wgid % nig) / gsz; u.e = 0; u.ui = i;
        u.A = A + (size_t)u.pm * BM * K * 2; u.B = Bt + (size_t)u.pn * BM * K * 2; return true;
    }
    DI void a_offs(const Unit&, const int (&R)[2], const int (&C)[2], int K_, unsigned (&off)[2][2]) const {
#pragma unroll
        for (int h = 0; h < 2; ++h)
#pragma unroll
            for (int i = 0; i < 2; ++i) off[h][i] = (unsigned)((h * HALF + R[i]) * K_ + C[i]) * 2u;
    }
};
}

#define XB_TMO      128
#define XB_XCNT(j)  (256  + 64 * (j))
#define XB_XSUB(j)  (1280 + 64 * (j))
#define XB_XGEN(j)  (2304 + 64 * (j))
#define XB_TOP      3328
#define XB_TOPGEN   3392
#define XCD_BAR_WORDS 3456
#define XB_SPIN_CAP (1u << 18)
DI unsigned xb_ld(unsigned* p)              { return __hip_atomic_load(p, __ATOMIC_RELAXED, __HIP_MEMORY_SCOPE_AGENT); }
DI unsigned xb_add(unsigned* p, unsigned v) { return __hip_atomic_fetch_add(p, v, __ATOMIC_RELAXED, __HIP_MEMORY_SCOPE_AGENT); }
DI unsigned xb_xcc_id() { return (unsigned)__builtin_amdgcn_s_getreg((3 << 11) | 20) & 0xFu; }
#define XB_SPIN(cond, bar) do { unsigned _sp = 0; while (cond) { __builtin_amdgcn_s_sleep(1); \
    if ((++_sp & 255u) == 0u) { if (xb_ld(&(bar)[XB_TMO])) break; if (_sp > XB_SPIN_CAP) { atomicAdd(&(bar)[XB_TMO], 1u); break; } } } } while (0)
struct XcdBarrier { unsigned* bar; unsigned x; volatile LAS unsigned* st; };
DI XcdBarrier xcd_barrier_post(unsigned* bar, volatile LAS unsigned* st) {
    XcdBarrier b; b.bar = bar; b.x = xb_xcc_id(); b.st = st;
    if (threadIdx.x == 0) (void)xb_add(&bar[XB_XCNT(b.x)], 1u);
    return b;
}
DI void xcd_barrier_complete(unsigned* bar, unsigned x, unsigned& nloc, unsigned& nx) {
    const unsigned G = gridDim.x * gridDim.y * gridDim.z;
    unsigned sum, cnt, mine, sp = 0u;
    for (;;) {
        sum = 0u; cnt = 0u; mine = 0u;
#pragma unroll
        for (unsigned j = 0; j < 16; ++j) { const unsigned c = xb_ld(&bar[XB_XCNT(j)]); sum += c; cnt += (c > 0u) ? 1u : 0u; mine = (j == x) ? c : mine; }
        if (sum == G) break;
        __builtin_amdgcn_s_sleep(1);
        if ((++sp & 255u) == 0u) { if (xb_ld(&bar[XB_TMO])) break; if (sp > XB_SPIN_CAP) { atomicAdd(&bar[XB_TMO], 1u); break; } }
    }
    nloc = mine > 0u ? mine : 1u; nx = cnt > 0u ? cnt : 1u;
}
DI void xcd_barrier(const XcdBarrier& b) {
    asm volatile("s_waitcnt vmcnt(0)" ::: "memory");
    __syncthreads();
    if (threadIdx.x == 0) {
        unsigned* bar = b.bar;
        __builtin_amdgcn_s_waitcnt(0);
        unsigned nloc = b.st[0], nx = b.st[1];
        if (nloc == 0u) { xcd_barrier_complete(bar, b.x, nloc, nx); b.st[0] = nloc; b.st[1] = nx; }
        const unsigned old = xb_add(&bar[XB_XSUB(b.x)], 1u);
        const unsigned gen = old / nloc;
        if (old + 1u == (gen + 1u) * nloc) {
            __builtin_amdgcn_fence(__ATOMIC_RELEASE, "agent");
            asm volatile("s_waitcnt vmcnt(0)" ::: "memory");
            const unsigned og = xb_add(&bar[XB_TOP], 1u);
            const unsigned tg = og / nx;
            if (og + 1u == (tg + 1u) * nx) xb_add(&bar[XB_TOPGEN], 1u);
            else XB_SPIN(xb_ld(&bar[XB_TOPGEN]) == tg, bar);
            __builtin_amdgcn_fence(__ATOMIC_ACQUIRE, "agent");
            xb_add(&bar[XB_XGEN(b.x)], 1u);
            asm volatile("s_waitcnt vmcnt(0)" ::: "memory");
        } else {
            XB_SPIN(xb_ld(&bar[XB_XGEN(b.x)]) == gen, bar);
            __builtin_amdgcn_fence(__ATOMIC_ACQUIRE, "agent");
            asm volatile("s_waitcnt vmcnt(0)" ::: "memory");
        }
    }
    __syncthreads();
}

namespace pg8 {
typedef __bf16 bf16x2_t __attribute__((ext_vector_type(2)));
DI unsigned pk2(float lo, float hi) { f32x2v v = {lo, hi}; bf16x2_t b = __builtin_convertvector(v, bf16x2_t); return __builtin_bit_cast(unsigned, b); }
DI u32x4 pk8(f32x4 v0, f32x4 v1) { u32x4 w; w.x = pk2(v0[0], v0[1]); w.y = pk2(v0[2], v0[3]); w.z = pk2(v1[0], v1[1]); w.w = pk2(v1[2], v1[3]); return w; }

DI unsigned dpp_ror8(unsigned v) { return (unsigned)__builtin_amdgcn_mov_dpp((int)v, 0x128, 0xf, 0xf, false); }
DI void store_rows16(unsigned char* rowp, size_t ldb, u32x4 P0, u32x4 P1, int fr) {
    const bool hi = fr >= 8;
    const u32x4 give = hi ? P0 : P1;
    u32x4 recv; recv.x = dpp_ror8(give.x); recv.y = dpp_ror8(give.y); recv.z = dpp_ror8(give.z); recv.w = dpp_ror8(give.w);
    unsigned char* pa = rowp + (size_t)(fr & 7) * ldb + (hi ? 16 : 0);
    *(u32x4*)pa = hi ? recv : P0;
    *(u32x4*)(pa + 8 * ldb) = hi ? P1 : recv;
}
struct EpiInProj {
    static constexpr int PERM = 2;
    bf16* P1; float* vstat; const float* bias;
    DI void operator()(const f32x4 (&acc)[2][2][4][2], const Unit& u, int wr, int wc, int fr, int fq) const {
        const int rg0 = u.pm * BM + wr * 64;
        const int bcol0 = u.pn * BM + wc * 64 + 16 * fq;
        f32x4 bv[2][2];
#pragma unroll
        for (int bj = 0; bj < 2; ++bj)
#pragma unroll
            for (int n = 0; n < 2; ++n) bv[bj][n] = *(const f32x4*)(bias + bcol0 + 8 * bj + 4 * n);
        if (u.pn < 8) {
            bf16* base = P1 + u.pn * 128 + wc * 32 + 8 * fq;
#pragma unroll
            for (int ai = 0; ai < 2; ++ai)
#pragma unroll
                for (int m = 0; m < 4; ++m) {
                    f32x4 u0 = gelu4(acc[ai][0][m][0] + bv[0][0]), u1 = gelu4(acc[ai][0][m][1] + bv[0][1]);
                    const f32x4 g0 = sigmoid4(acc[ai][1][m][0] + bv[1][0]), g1 = sigmoid4(acc[ai][1][m][1] + bv[1][1]);
                    u0 = u0 * g0; u1 = u1 * g1;
                    *(u32x4*)(base + (size_t)(rg0 + ai * HALF + m * 16 + fr) * D) = pk8(u0, u1);
                }
        } else {
            const int t = (u.pn - 8) >> 2, colt = ((u.pn - 8) & 3) * BM;
            bf16* base = P1 + (size_t)(t + 1) * T * D + colt + wc * 64 + 16 * fq;
#pragma unroll
            for (int ai = 0; ai < 2; ++ai)
#pragma unroll
                for (int m = 0; m < 4; ++m) {
                    float s1 = 0.f, s2 = 0.f; u32x4 P[2];
#pragma unroll
                    for (int bj = 0; bj < 2; ++bj) {
                        f32x4 v0 = acc[ai][bj][m][0] + bv[bj][0], v1 = acc[ai][bj][m][1] + bv[bj][1];
                        if (t == 0) { v0 = gelu4(v0); v1 = gelu4(v1);
                            s1 += (v0[0] + v0[1]) + (v0[2] + v0[3]) + (v1[0] + v1[1]) + (v1[2] + v1[3]);
                            s2 += (v0[0] * v0[0] + v0[1] * v0[1]) + (v0[2] * v0[2] + v0[3] * v0[3]) + (v1[0] * v1[0] + v1[1] * v1[1]) + (v1[2] * v1[2] + v1[3] * v1[3]); }
                        else if (t == 1) { v0 = v0 * (QSCALE * LOG2E); v1 = v1 * (QSCALE * LOG2E); }
                        else if (t == 4) { v0 = sigmoid4(v0); v1 = sigmoid4(v1); }
                        P[bj] = pk8(v0, v1);
                    }
                    store_rows16((unsigned char*)(base + (size_t)(rg0 + ai * HALF + m * 16) * D), (size_t)D * 2, P[0], P[1], fr);
                    if (t == 0) {
                        s1 += __shfl_xor(s1, 16); s1 += __shfl_xor(s1, 32); s2 += __shfl_xor(s2, 16); s2 += __shfl_xor(s2, 32);
                        if (fq == 0) *(f32x2v*)(vstat + ((size_t)(rg0 + ai * HALF + m * 16 + fr) * 16 + (u.pn - 8) * 4 + wc) * 2) = (f32x2v){s1, s2};
                    }
                }
        }
    }
};
struct EpiBf16S {
    static constexpr int PERM = 2;
    bf16* O; int ldc; float scale;
    DI void operator()(const f32x4 (&acc)[2][2][4][2], const Unit& u, int wr, int wc, int fr, int fq) const {
        const int rg0 = u.pm * BM + wr * 64, col0 = u.pn * BM + wc * 64 + 16 * fq;
#pragma unroll
        for (int ai = 0; ai < 2; ++ai)
#pragma unroll
            for (int m = 0; m < 4; ++m)
                store_rows16((unsigned char*)(O + (size_t)(rg0 + ai * HALF + m * 16) * ldc + col0), (size_t)ldc * 2,
                             pk8(acc[ai][0][m][0] * scale, acc[ai][0][m][1] * scale), pk8(acc[ai][1][m][0] * scale, acc[ai][1][m][1] * scale), fr);
    }
};
template <bool LNIN> struct EpiResF32 {
    static constexpr int PERM = 0;
    float* out; const float* res; const float* xstat; const float* g; const float* b;
    DI void operator()(const f32x4 (&acc)[2][2][4][2], const Unit& u, int wr, int wc, int fr, int fq) const {
        const int col0 = u.pn * BM + wc * 32 + 4 * fq;
        f32x4 gv[2][2], bv[2][2];
        if (LNIN) {
#pragma unroll
            for (int bj = 0; bj < 2; ++bj)
#pragma unroll
                for (int n = 0; n < 2; ++n) { gv[bj][n] = *(const f32x4*)(g + col0 + bj * HALF + n * 16); bv[bj][n] = *(const f32x4*)(b + col0 + bj * HALF + n * 16); }
        }
#pragma unroll
        for (int ai = 0; ai < 2; ++ai)
#pragma unroll
            for (int m = 0; m < 4; ++m) {
                const int rg = u.pm * BM + ai * HALF + wr * 64 + m * 16, row = rg + fr; const size_t off = (size_t)row * D + col0;
                f32x2v st = (f32x2v){0.f, 1.f}; if (LNIN) st = *(const f32x2v*)(xstat + 2 * (size_t)row);
#pragma unroll
                for (int bj = 0; bj < 2; ++bj) { f32x4 o[2];
#pragma unroll
                    for (int n = 0; n < 2; ++n) { f32x4 r = *(const f32x4*)(res + off + bj * HALF + n * 16);
                        if (LNIN) r = (r - st.x) * st.y * gv[bj][n] + bv[bj][n];
                        o[n] = r * ALPHA + acc[ai][bj][m][n]; }
                    const bool hi = fr >= 8; const f32x4 give = hi ? o[0] : o[1];
                    u32x4 gi = __builtin_bit_cast(u32x4, give), rc; rc.x = dpp_ror8(gi.x); rc.y = dpp_ror8(gi.y); rc.z = dpp_ror8(gi.z); rc.w = dpp_ror8(gi.w);
                    const f32x4 recv = __builtin_bit_cast(f32x4, rc);
                    float* pa = out + (size_t)(rg + (fr & 7)) * D + col0 + bj * HALF + (hi ? 16 : 0);
                    *(f32x4*)pa = hi ? recv : o[0];
                    *(f32x4*)(pa + 8 * D) = hi ? o[1] : recv; }
                if (m & 1) asm volatile("" ::: "memory");
            }
    }
};
template <bool LNIN> struct EpiResB16 {
    static constexpr int PERM = 2;
    bf16* out; const float* resf; const bf16* resb; const float* xstat; const float* g; const float* b;
    DI void operator()(const f32x4 (&acc)[2][2][4][2], const Unit& u, int wr, int wc, int fr, int fq) const {
        const int col0 = u.pn * BM + wc * 64 + 16 * fq;
        f32x4 gv[2][2], bv[2][2];
        if (LNIN) {
#pragma unroll
            for (int bj = 0; bj < 2; ++bj)
#pragma unroll
                for (int n = 0; n < 2; ++n) { gv[bj][n] = *(const f32x4*)(g + col0 + 8 * bj + 4 * n); bv[bj][n] = *(const f32x4*)(b + col0 + 8 * bj + 4 * n); }
        }
#pragma unroll
        for (int ai = 0; ai < 2; ++ai)
#pragma unroll
            for (int m = 0; m < 4; ++m) {
                const int rg = u.pm * BM + ai * HALF + wr * 64 + m * 16, row = rg + fr; const size_t off = (size_t)row * D + col0;
                f32x4 rr[2][2];
                if (LNIN) { const f32x2v st = *(const f32x2v*)(xstat + 2 * (size_t)row);
#pragma unroll
                    for (int bj = 0; bj < 2; ++bj)
#pragma unroll
                        for (int n = 0; n < 2; ++n) rr[bj][n] = (*(const f32x4*)(resf + off + 8 * bj + 4 * n) - st.x) * st.y * gv[bj][n] + bv[bj][n];
                } else {
#pragma unroll
                    for (int bj = 0; bj < 2; ++bj) { const u32x4 x = *(const u32x4*)(resb + off + 8 * bj);
                        rr[bj][0] = (f32x4){bflo(x.x), bfhi(x.x), bflo(x.y), bfhi(x.y)}; rr[bj][1] = (f32x4){bflo(x.z), bfhi(x.z), bflo(x.w), bfhi(x.w)}; } }
                store_rows16((unsigned char*)(out + (size_t)rg * D + col0), (size_t)D * 2,
                             pk8(rr[0][0] * ALPHA + acc[ai][0][m][0], rr[0][1] * ALPHA + acc[ai][0][m][1]), pk8(rr[1][0] * ALPHA + acc[ai][1][m][0], rr[1][1] * ALPHA + acc[ai][1][m][1]), fr);
                if (m & 1) asm volatile("" ::: "memory");
            }
    }
};
constexpr int MO_BLKE = 128 * 1024, MO_RT = MO_BLKE + 640, MO_RW = MO_RT + 5 * 1024, MO_END = MO_RW + 5 * 1024;
static_assert(MO_END <= SCR_BYTES, "MoE LDS tables");
struct EpiGateUp {
    static constexpr int PERM = 1;
    bf16* H; const LAS unsigned char* lds;
    DI void operator()(const f32x4 (&acc)[2][2][4][2], const Unit& u, int wr, int wc, int fr, int fq) const {
        const int rl = wr * 64 + fr, row0 = u.pm * BM + rl, col0 = u.pn * 128 + wc * 32 + 8 * fq;
        float wv[2][4];
#pragma unroll
        for (int ai = 0; ai < 2; ++ai)
#pragma unroll
            for (int m = 0; m < 4; ++m) wv[ai][m] = (u.e < 64) ? *(const LAS float*)(lds + MO_RW + (u.ui * 256 + rl + ai * HALF + m * 16) * 4) : 1.0f;
#pragma unroll
        for (int ai = 0; ai < 2; ++ai)
#pragma unroll
            for (int m = 0; m < 4; ++m) {
                const f32x4 g0 = acc[ai][0][m][0], g1 = acc[ai][0][m][1];
                const f32x4 h0 = g0 * sigmoid4(g0) * acc[ai][1][m][0] * wv[ai][m], h1 = g1 * sigmoid4(g1) * acc[ai][1][m][1] * wv[ai][m];
                *(u32x4*)(H + (size_t)(row0 + ai * HALF + m * 16) * EH + col0) = pk8(h0, h1);
            }
    }
};
constexpr float Y8_SCALE = 32.0f, Y8_CLAMP = 440.0f;
DI unsigned pk4_fp8(f32x4 v) { v = v * Y8_SCALE;
    const float a = __builtin_fminf(__builtin_fmaxf(v[0], -Y8_CLAMP), Y8_CLAMP), b = __builtin_fminf(__builtin_fmaxf(v[1], -Y8_CLAMP), Y8_CLAMP), c = __builtin_fminf(__builtin_fmaxf(v[2], -Y8_CLAMP), Y8_CLAMP), d = __builtin_fminf(__builtin_fmaxf(v[3], -Y8_CLAMP), Y8_CLAMP);
    int p = __builtin_amdgcn_cvt_pk_fp8_f32(a, b, 0, false); p = __builtin_amdgcn_cvt_pk_fp8_f32(c, d, p, true); return (unsigned)p; }
struct EpiDown {
    static constexpr int PERM = 2;
    unsigned char* Y8; bf16* xb; int nostore;
    DI void operator()(const f32x4 (&acc)[2][2][4][2], const Unit& u, int wr, int wc, int fr, int fq) const {
        if (nostore) return;
        const int rl = wr * 64 + fr, col0 = u.pn * BM + wc * 64 + 16 * fq;
        if (u.e < 64) {
#pragma unroll
            for (int ai = 0; ai < 2; ++ai)
#pragma unroll
                for (int m = 0; m < 4; ++m) { const int r = rl + ai * HALF + m * 16;
                    u32x4 w; w.x = pk4_fp8(acc[ai][0][m][0]); w.y = pk4_fp8(acc[ai][0][m][1]); w.z = pk4_fp8(acc[ai][1][m][0]); w.w = pk4_fp8(acc[ai][1][m][1]);
                    __builtin_nontemporal_store(w, (u32x4*)(Y8 + ((size_t)u.pm * BM + r) * D + col0)); }
        } else {
#pragma unroll
            for (int ai = 0; ai < 2; ++ai) {
                u32x4 xr[4][2];
#pragma unroll
                for (int m = 0; m < 4; ++m)
#pragma unroll
                    for (int bj = 0; bj < 2; ++bj) xr[m][bj] = *(const u32x4*)(xb + ((size_t)(u.pm - SH_ROW0 / BM) * BM + rl + ai * HALF + m * 16) * D + col0 + 8 * bj);
#pragma unroll
                for (int m = 0; m < 4; ++m) { const size_t off = ((size_t)(u.pm - SH_ROW0 / BM) * BM + rl + ai * HALF + m * 16) * D + col0;
#pragma unroll
                    for (int bj = 0; bj < 2; ++bj) { const u32x4 x = xr[m][bj];
                        const f32x4 x0 = (f32x4){bflo(x.x), bfhi(x.x), bflo(x.y), bfhi(x.y)}, x1 = (f32x4){bflo(x.z), bfhi(x.z), bflo(x.w), bfhi(x.w)};
                        *(u32x4*)(xb + off + 8 * bj) = pk8(x0 * ALPHA + acc[ai][bj][m][0], x1 * ALPHA + acc[ai][bj][m][1]); } }
                asm volatile("" ::: "memory"); }
        }
    }
};
struct GateUpOrder {
    const char* X; const char* Wgu; const char* Wgus; const LAS unsigned char* lds; int nblk, G, c;
    DI bool next(int i, Unit& u) const {
        const int L = i * G + c; if (L >= (nblk + 64) * 2) return false;
        const int bl = L >> 1; u.pn = L & 1; u.ui = i;
        if (bl < nblk) { u.e = (int)__builtin_amdgcn_readfirstlane((int)*(const LAS unsigned char*)(lds + MO_BLKE + bl)); u.pm = bl; u.A = X; u.B = Wgu + ((size_t)u.e * 512 + u.pn * 256) * D * 2; }
        else { u.e = 64; u.pm = SH_ROW0 / BM + (bl - nblk); u.A = X + (size_t)(bl - nblk) * BM * D * 2; u.B = Wgus + (size_t)u.pn * 256 * D * 2; }
        return true;
    }
    DI void a_offs(const Unit& u, const int (&R)[2], const int (&C)[2], int K_, unsigned (&off)[2][2]) const {
        if (u.e < 64) {
#pragma unroll
            for (int h = 0; h < 2; ++h)
#pragma unroll
                for (int i = 0; i < 2; ++i) { const int tok = *(const LAS int*)(lds + MO_RT + (u.ui * 256 + h * HALF + R[i]) * 4); off[h][i] = (unsigned)(tok * K_ + C[i]) * 2u; }
        } else {
#pragma unroll
            for (int h = 0; h < 2; ++h)
#pragma unroll
                for (int i = 0; i < 2; ++i) off[h][i] = (unsigned)((h * HALF + R[i]) * K_ + C[i]) * 2u;
        }
    }
};
struct DownOrder {
    const char* H; const char* Wd; const char* Wds; const LAS unsigned char* lds; int lo, hi, nsh, G, c, hot;
    DI bool next(int i, Unit& u) const {
        const int L = i * G + c; if (L >= (hi - lo + nsh) * 4) return false;
        int bl = lo + (L >> 2); u.pn = L & 3; u.ui = i; if (hot) bl = lo + ((L >> 2) & 7);
        if (bl < hi) { u.e = (int)__builtin_amdgcn_readfirstlane((int)*(const LAS unsigned char*)(lds + MO_BLKE + bl)); u.pm = bl; u.B = Wd + ((size_t)u.e * D + u.pn * 256) * EH * 2; }
        else { u.e = 64; u.pm = SH_ROW0 / BM + (bl - hi); u.B = Wds + (size_t)u.pn * 256 * EH * 2; }
        u.A = H + (size_t)u.pm * BM * EH * 2;
        return true;
    }
    DI void a_offs(const Unit&, const int (&R)[2], const int (&C)[2], int K_, unsigned (&off)[2][2]) const {
#pragma unroll
        for (int h = 0; h < 2; ++h)
#pragma unroll
            for (int i = 0; i < 2; ++i) off[h][i] = (unsigned)((h * HALF + R[i]) * K_ + C[i]) * 2u;
    }
};
DI void moe_tables(LAS unsigned char* lds, const unsigned* blke, int nblk, const int* rowtok, const float* roww, bool gateup, int G, int c, int tid) {
    for (int b = tid; b < nblk; b += NTHREADS) *(LAS unsigned char*)(lds + MO_BLKE + b) = (unsigned char)__hip_atomic_load(blke + b, RLX_AGENT);
    if (gateup) {
#pragma unroll
        for (int i = 0; i < 5; ++i) { const int L = i * G + c, bl = L >> 1;
            if (bl < nblk && tid < 256) { *(LAS int*)(lds + MO_RT + (i * 256 + tid) * 4) = __hip_atomic_load(rowtok + (size_t)bl * 256 + tid, RLX_AGENT);
                                          *(LAS float*)(lds + MO_RW + (i * 256 + tid) * 4) = __hip_atomic_load(roww + (size_t)bl * 256 + tid, RLX_AGENT); } }
    }
    __syncthreads();
}
}

struct Frame {
    LAS unsigned char* lds;
    unsigned* ctl;
    unsigned char* ws; float* out;
    int tid, lane, wave, vcu, G;
};
DI unsigned short f2bf1(float x) { return (unsigned short)(pg8::pk2(x, x) & 0xffffu); }

template <class RowMap>
DI void transpose_item(const float* W, int N, bf16* WT, int Kd, RowMap rm, LAS float* scr, int kb, int nb, int lane) {
    const int k0 = 64 * kb, n0 = 32 * nb;
#pragma unroll 8
    for (int i = 0; i < 32; ++i) { const int kk = 2 * i + (lane >> 5); scr[kk * 33 + (lane & 31)] = W[(size_t)(k0 + kk) * N + n0 + (lane & 31)]; }
    LDS_WAIT(); asm volatile("" ::: "memory");
    const int c = lane & 7;
#pragma unroll
    for (int j = 0; j < 4; ++j) { const int n = (lane >> 3) + 8 * j; const LAS float* s = scr + (8 * c) * 33 + n;
        u32x4 o; o.x = pg8::pk2(s[0 * 33], s[1 * 33]); o.y = pg8::pk2(s[2 * 33], s[3 * 33]); o.z = pg8::pk2(s[4 * 33], s[5 * 33]); o.w = pg8::pk2(s[6 * 33], s[7 * 33]);
        *(u32x4*)(WT + (size_t)rm(n0 + n) * Kd + k0 + 8 * c) = o; }
    LDS_WAIT(); asm volatile("" ::: "memory");
}
struct RmIdent { int off; DI int operator()(int n) const { return off + n; } };
struct RmInProj { DI int operator()(int n) const { const int seg = n >> 10, w = n & 1023;
    return seg == 0 ? ((w >> 7) * 256 + ((w & 127) >> 3) * 16 + (w & 7)) : seg == 5 ? ((w >> 7) * 256 + ((w & 127) >> 3) * 16 + 8 + (w & 7)) : seg == 6 ? 6144 + w : 1024 + n; } };
struct RmGateUp { int up; DI int operator()(int n) const { return (n >> 7) * 256 + up * 128 + (n & 127); } };
DI int inproj_dest(int n) { return RmInProj()(n); }

template <bool NT = false> DI void row_stats(const float* xrow, int lane, f32x4 (&v)[4], float& mean, float& rstd) {
    const f32x4* xr = (const f32x4*)xrow + lane; float s = 0.f;
#pragma unroll
    for (int j = 0; j < 4; ++j) { v[j] = NT ? __builtin_nontemporal_load(xr + 64 * j) : xr[64 * j]; s += (v[j][0] + v[j][1]) + (v[j][2] + v[j][3]); }
    mean = wave_sum(s) * (1.f / D); float s2 = 0.f;
#pragma unroll
    for (int j = 0; j < 4; ++j) { const f32x4 d = v[j] - mean; s2 += (d[0] * d[0] + d[1] * d[1]) + (d[2] * d[2] + d[3] * d[3]); }
    rstd = 1.f / sqrtf(wave_sum(s2) * (1.f / D) + LN_EPS);
}

DI void row_stats_b16(const bf16* xrow, int lane, f32x4 (&v)[4], float& mean, float& rstd) {
    const u32x2* xr = (const u32x2*)xrow + lane; float s = 0.f;
#pragma unroll
    for (int j = 0; j < 4; ++j) { const u32x2 x = xr[64 * j]; v[j] = (f32x4){bflo(x.x), bfhi(x.x), bflo(x.y), bfhi(x.y)}; s += (v[j][0] + v[j][1]) + (v[j][2] + v[j][3]); }
    mean = wave_sum(s) * (1.f / D); float s2 = 0.f;
#pragma unroll
    for (int j = 0; j < 4; ++j) { const f32x4 d = v[j] - mean; s2 += (d[0] * d[0] + d[1] * d[1]) + (d[2] * d[2] + d[3] * d[3]); }
    rstd = 1.f / sqrtf(wave_sum(s2) * (1.f / D) + LN_EPS);
}
DI void p0_prologue(Frame& F, const float* const* in) {
    LAS float* scr = (LAS float*)(F.lds + F.wave * 16384);
    const int gw = F.vcu * NWAVES + F.wave, NGW = F.G * NWAVES, lane = F.lane;
    unsigned char* ws = F.ws;
    constexpr int I_IN = 16 * (INW / 32), I_OUT = 16 * 32, I_Q = 16 * 16, I_KV = 16 * 32, I_O = 8 * 32, I_SG = 16 * 8, I_SD = 4 * 32;
    constexpr int NITEMS = I_IN + I_OUT + I_Q + I_KV + I_O + 2 * I_SG + I_SD;
    for (int it = gw; it < NITEMS; it += NGW) {
        int r = it;
        if (r < I_IN) { transpose_item(in[4], INW, (bf16*)(ws + WS_WIN), D, RmInProj(), scr, r / (INW / 32), r % (INW / 32), lane); continue; } r -= I_IN;
        if (r < I_OUT) { transpose_item(in[10], D, (bf16*)(ws + WS_WOUT), D, RmIdent{0}, scr, r / 32, r % 32, lane); continue; } r -= I_OUT;
        if (r < I_Q) { transpose_item(in[13], MEMW, (bf16*)(ws + WS_WQ), D, RmIdent{0}, scr, r / 16, r % 16, lane); continue; } r -= I_Q;
        if (r < I_KV) { transpose_item(in[14], 2 * MEMW, (bf16*)(ws + WS_WKV), D, RmIdent{0}, scr, r / 32, r % 32, lane); continue; } r -= I_KV;
        if (r < I_O) { transpose_item(in[15], D, (bf16*)(ws + WS_WO), MEMW, RmIdent{0}, scr, r / 32, r % 32, lane); continue; } r -= I_O;
        if (r < I_SG) { transpose_item(in[23], EH, (bf16*)(ws + WS_WGUS), D, RmGateUp{0}, scr, r / 8, r % 8, lane); continue; } r -= I_SG;
        if (r < I_SG) { transpose_item(in[24], EH, (bf16*)(ws + WS_WGUS), D, RmGateUp{1}, scr, r / 8, r % 8, lane); continue; } r -= I_SG;
        transpose_item(in[25], D, (bf16*)(ws + WS_WDS), EH, RmIdent{0}, scr, r / 32, r % 32, lane);
    }
    const int gt = F.vcu * NTHREADS + F.tid, NGT = F.G * NTHREADS;
    { const float* wr = in[18]; bf16* hi = (bf16*)(ws + WS_WRHI); bf16* lo = (bf16*)(ws + WS_WRLO);
      for (int idx = gt; idx < D * NEXP; idx += NGT) { const int k = idx >> 6, e = idx & 63; const float w = wr[idx]; const unsigned short h = f2bf1(w); hi[e * D + k] = h; lo[e * D + k] = f2bf1(w - bf2f(h)); } }
    { const float* wsp = in[8]; bf16* o = (bf16*)(ws + WS_WSP);
      for (int idx = gt; idx < 8 * 128 * 128; idx += NGT) { const int s = idx & 127, t = (idx >> 7) & 127; o[idx] = (s <= t) ? f2bf1(wsp[idx]) : (unsigned short)0; } }
    { const float* bi = in[5]; float* o = (float*)(ws + WS_BPERM);
      for (int idx = gt; idx < INW; idx += NGT) o[inproj_dest(idx)] = bi[idx]; }
    { const f32x4* m4 = (const f32x4*)in[1]; u32x2* o = (u32x2*)(ws + WS_MEMB);
      for (int idx = gt; idx < NBATCH * MEMLEN * D / 4; idx += NGT) { const f32x4 v = m4[idx]; o[idx] = (u32x2){pg8::pk2(v[0], v[1]), pg8::pk2(v[2], v[3])}; } }
    { const float* x = in[0]; const float* g = in[2]; const float* b = in[3]; bf16* X0b = (bf16*)F.out; float* xstat = (float*)(ws + WS_XSTAT);
      f32x4 gv[4], bv[4];
#pragma unroll
      for (int j = 0; j < 4; ++j) { gv[j] = ((const f32x4*)g)[lane + 64 * j]; bv[j] = ((const f32x4*)b)[lane + 64 * j]; }
      for (int m = gw; m < T; m += NGW) { f32x4 v[4]; float mean, rstd; row_stats<true>(x + (size_t)m * D, lane, v, mean, rstd);
          u32x2* o8 = (u32x2*)(X0b + (size_t)m * D) + lane;
#pragma unroll
          for (int j = 0; j < 4; ++j) { const f32x4 y = (v[j] - mean) * rstd * gv[j] + bv[j]; o8[64 * j] = (u32x2){pg8::pk2(y[0], y[1]), pg8::pk2(y[2], y[3])}; }
          if (lane == 0) *(f32x2*)(xstat + 2 * (size_t)m) = (f32x2){mean, rstd}; } }
}
struct CvtItem { const float* W; bf16* WT; int N, Kd, mode, kb, nb; };
DI CvtItem cvt_decode(const float* const* in, unsigned char* ws, int it) {
    const int e = it / 384; int r = it % 384; CvtItem c;
    if (r < 256) { const int up = r >> 7; r &= 127; c.W = in[20 + up] + (size_t)e * D * EH; c.N = EH; c.WT = (bf16*)(ws + WS_WGU) + (size_t)e * 512 * D; c.Kd = D; c.mode = up; c.kb = r >> 3; c.nb = r & 7; }
    else { r -= 256; c.W = in[22] + (size_t)e * EH * D; c.N = D; c.WT = (bf16*)(ws + WS_WD) + (size_t)e * D * EH; c.Kd = EH; c.mode = 2; c.kb = r >> 5; c.nb = r & 31; }
    return c;
}
DI void cvt_load(const CvtItem& c, int lane, f32x4 (&v)[8]) {
#pragma unroll
    for (int i = 0; i < 8; ++i) v[i] = __builtin_nontemporal_load((const f32x4*)(c.W + (size_t)(64 * c.kb + (lane >> 3) + 8 * i) * c.N + 32 * c.nb + 4 * (lane & 7)));
}
DI void cvt_finish(const CvtItem& c, int lane, const f32x4 (&v)[8], LAS float* scr) {
#pragma unroll
    for (int i = 0; i < 8; ++i) { LAS float* d = scr + ((lane >> 3) + 8 * i) * 33 + 4 * (lane & 7); d[0] = v[i][0]; d[1] = v[i][1]; d[2] = v[i][2]; d[3] = v[i][3]; }
    LDS_WAIT(); asm volatile("" ::: "memory");
    const int cc = lane & 7;
#pragma unroll
    for (int j = 0; j < 4; ++j) { const int n = 32 * c.nb + (lane >> 3) + 8 * j; const LAS float* sp = scr + (8 * cc) * 33 + (lane >> 3) + 8 * j;
        const int drow = (c.mode == 2) ? n : ((n >> 7) * 256 + c.mode * 128 + (n & 127));
        u32x4 o; o.x = pg8::pk2(sp[0 * 33], sp[1 * 33]); o.y = pg8::pk2(sp[2 * 33], sp[3 * 33]); o.z = pg8::pk2(sp[4 * 33], sp[5 * 33]); o.w = pg8::pk2(sp[6 * 33], sp[7 * 33]);
        *(u32x4*)(c.WT + (size_t)drow * c.Kd + 64 * c.kb + 8 * cc) = o; }
    LDS_WAIT(); asm volatile("" ::: "memory");
}
DI void expert_convert(Frame& F, const float* const* in, int worker, int nworkers, int item_lo, int item_hi) {
    LAS float* scr = (LAS float*)(F.lds + F.wave * 16384);
    const int lane = F.lane, stride = nworkers * NWAVES;
    int it = item_lo + worker * NWAVES + F.wave;
    if (it >= item_hi) return;
    CvtItem cur = cvt_decode(in, F.ws, it); f32x4 v[8]; cvt_load(cur, lane, v);
    for (;;) {
        const int nx = it + stride; const bool has = nx < item_hi;
        CvtItem nxt = cur; f32x4 vn[8];
        if (has) { nxt = cvt_decode(in, F.ws, nx); cvt_load(nxt, lane, vn); }
        cvt_finish(cur, lane, v, scr);
        if (!has) break;
        cur = nxt; it = nx;
#pragma unroll
        for (int i = 0; i < 8; ++i) v[i] = vn[i];
    }
}

constexpr int MX_BUF = 32768, MX_STAT = 4 * MX_BUF, MX_FLG = MX_STAT + 1024, MX_FLG2 = MX_FLG + 64, MX_END = MX_FLG2 + 64;
static_assert(MX_END <= SCR_BYTES, "mixer LDS");
constexpr float MX_EXIT2 = SB_EXIT * LOG2E;
typedef short v4i16_t __attribute__((ext_vector_type(4)));
DI bf16x8 mk_frag(f32x4 e0, f32x4 e1) { const u32x4 w = pg8::pk8(e0, e1); return __builtin_bit_cast(bf16x8, w); }
DI bf16x8 ld_split8(const LAS unsigned char* p) {
    const s16x4 lo = *(const LAS s16x4*)p, hi = *(const LAS s16x4*)(p + 32);
    return (bf16x8){lo[0], lo[1], lo[2], lo[3], hi[0], hi[1], hi[2], hi[3]};
}
DI void glds16(const void* gsrc, unsigned lds_dst) { unsigned keep;
    asm volatile("s_mov_b32 %0, m0\n\ts_mov_b32 m0, %2\n\ts_nop 0\n\tglobal_load_lds_dwordx4 %1, off\n\ts_mov_b32 m0, %0" : "=&s"(keep) : "v"(gsrc), "s"(lds_dst) : "memory"); }
DI void mx_dma(LAS unsigned char* buf, const bf16* src, int w, int lane) {
#pragma unroll
    for (int i = 0; i < 4; ++i) { const int pc = 4 * w + i, row = 4 * pc + (lane >> 4), cpos = lane & 15;
        glds16((const char*)src + (size_t)row * (D * 2) + ((cpos ^ (row & 15)) * 16), (unsigned)__builtin_amdgcn_readfirstlane((unsigned)(uintptr_t)(buf + pc * 1024))); }
}
DI bf16x8 mx_tr(const LAS unsigned char* buf, int sA, int sB, int d0, int r) {
    const int ra = sA + (r >> 2), rb = sB + (r >> 2), ch = (d0 >> 3) + ((r & 3) >> 1), bo = 8 * (r & 1);
    const s16x4 lo = __builtin_bit_cast(s16x4, __builtin_amdgcn_ds_read_tr16_b64_v4i16((LAS v4i16_t*)(buf + ra * 256 + ((ch ^ (ra & 15)) * 16) + bo)));
    const s16x4 hi = __builtin_bit_cast(s16x4, __builtin_amdgcn_ds_read_tr16_b64_v4i16((LAS v4i16_t*)(buf + rb * 256 + ((ch ^ (rb & 15)) * 16) + bo)));
    return (bf16x8){lo[0], lo[1], lo[2], lo[3], hi[0], hi[1], hi[2], hi[3]};
}
DI void sb_scores(const LAS unsigned char* kbuf, const bf16x8 (&qf)[4], bool diag, int tq, float carry, int r, int q, const bf16x8& UE, const bf16x8& UO, const bf16x8& ONES, bf16x8 (&af)[4], float& tot_out) {
    f32x4 z[8];
#pragma unroll
    for (int st = 0; st < 8; ++st) { z[st] = (f32x4){0.f, 0.f, 0.f, 0.f};
#pragma unroll
        for (int kk = 0; kk < 4; ++kk) { const bf16x8 kf = *(const LAS bf16x8*)(kbuf + (16 * st + r) * 256 + (((4 * kk + q) ^ r) * 16));
            z[st] = __builtin_amdgcn_mfma_f32_16x16x32_bf16(kf, qf[kk], z[st], 0, 0, 0); }
        if (st & 1) __builtin_amdgcn_sched_barrier(0); }
    f32x4 ls[8];
#pragma unroll
    for (int st = 0; st < 8; ++st)
#pragma unroll
        for (int e = 0; e < 4; ++e) { const float zz = z[st][e]; const float sp = fmaxf(zz, 0.f) + fast_log2(1.0f + fast_exp2(-fabsf(zz)));
            const bool msk = diag && (16 * st + 4 * q + e >= tq);
            ls[st][e] = msk ? 0.f : -sp; z[st][e] = msk ? -1e30f : zz - sp; }
    bf16x8 lf[4];
#pragma unroll
    for (int p = 0; p < 4; ++p) lf[p] = mk_frag(ls[2 * p], ls[2 * p + 1]);
    f32x4 tot = (f32x4){0.f, 0.f, 0.f, 0.f};
#pragma unroll
    for (int p = 0; p < 4; ++p) tot = __builtin_amdgcn_mfma_f32_16x16x32_bf16(ONES, lf[p], tot, 0, 0, 0);
#pragma unroll
    for (int p = 0; p < 4; ++p) {
        f32x4 s0 = (f32x4){0.f, 0.f, 0.f, 0.f}, s1 = (f32x4){0.f, 0.f, 0.f, 0.f};
        s0 = __builtin_amdgcn_mfma_f32_16x16x32_bf16(UE, lf[p], s0, 0, 0, 0);
        s1 = __builtin_amdgcn_mfma_f32_16x16x32_bf16(UO, lf[p], s1, 0, 0, 0);
#pragma unroll
        for (int p2 = p + 1; p2 < 4; ++p2) { s0 = __builtin_amdgcn_mfma_f32_16x16x32_bf16(ONES, lf[p2], s0, 0, 0, 0); s1 = __builtin_amdgcn_mfma_f32_16x16x32_bf16(ONES, lf[p2], s1, 0, 0, 0); }
        f32x4 a0, a1;
#pragma unroll
        for (int e = 0; e < 4; ++e) { a0[e] = fast_exp2(z[2 * p][e] + s0[e] + carry); a1[e] = fast_exp2(z[2 * p + 1][e] + s1[e] + carry); }
        af[p] = mk_frag(a0, a1);
    }
    tot_out = tot[0];
}
DI void sb_pv(const LAS unsigned char* vbuf, const bf16x8 (&af)[4], f32x4 (&yb)[8], int r, int q) {
#pragma unroll
    for (int dt = 0; dt < 8; ++dt)
#pragma unroll
        for (int p = 0; p < 4; ++p) { const bf16x8 vf = mx_tr(vbuf, 32 * p + 4 * q, 32 * p + 16 + 4 * q, 16 * dt, r);
            yb[dt] = __builtin_amdgcn_mfma_f32_16x16x32_bf16(vf, af[p], yb[dt], 0, 0, 0);
            if (p == 3 && (dt & 1)) __builtin_amdgcn_sched_barrier(0); }
}
#define MX_WAIT_BAR(n) asm volatile("s_waitcnt vmcnt(" #n ") lgkmcnt(0)\n\ts_barrier" ::: "memory")
DI void mix_phase(Frame& F, const float* const* in) {
    LAS unsigned char* lds = F.lds; unsigned char* ws = F.ws;
    const int tid = F.tid, lane = F.lane, w = F.wave, r = lane & 15, q = lane >> 4;
    const bf16* UG = (const bf16*)(ws + WS_UG); const bf16* VA = (const bf16*)(ws + WS_VA); const bf16* Qg = (const bf16*)(ws + WS_Q);
    const bf16* Kg = (const bf16*)(ws + WS_K); const bf16* Vg = (const bf16*)(ws + WS_V); const bf16* GB = (const bf16*)(ws + WS_GB);
    const float* vstat = (const float*)(ws + WS_VSTAT); const bf16* WSP = (const bf16*)(ws + WS_WSP); bf16* MG = (bf16*)(ws + WS_MERGED);
    const float* lnvg = in[6]; const float* lnvb = in[7]; const float* bsp = in[9];
    LAS unsigned char* B0 = lds; LAS unsigned char* B1 = lds + MX_BUF; LAS unsigned char* B2 = lds + 2 * MX_BUF; LAS unsigned char* B3 = lds + 3 * MX_BUF;
    bf16x8 UE, UO, ONES;
#pragma unroll
    for (int jj = 0; jj < 8; ++jj) { ONES[jj] = (short)0x3F80;
        UE[jj] = (jj < 4) ? ((4 * q + jj > r) ? (short)0x3F80 : (short)0) : (short)0x3F80;
        UO[jj] = (jj < 4) ? (short)0 : ((4 * q + jj - 4 > r) ? (short)0x3F80 : (short)0); }
    const int NU = NBATCH * 16 * 8;
    int un = F.vcu;
    if (un >= NU) return;
#define MX_DEC(u_, b_, i_, j_) const int j_ = (u_) & 7, i_ = ((u_) >> 3) & 15, b_ = (u_) >> 7
    bf16x8 qf[4];
    { MX_DEC(un, b, i, j); const int ip = i > 0 ? i - 1 : 0;
      mx_dma(B0, Kg + (size_t)(b * SEQ + 128 * i) * D + 128 * j, w, lane);
      mx_dma(B2, Kg + (size_t)(b * SEQ + 128 * ip) * D + 128 * j, w, lane);
      mx_dma(B3, Vg + (size_t)(b * SEQ + 128 * ip) * D + 128 * j, w, lane);
#pragma unroll
      for (int kk = 0; kk < 4; ++kk) qf[kk] = *(const bf16x8*)(Qg + (size_t)(b * SEQ + 128 * i + 16 * w + r) * D + 128 * j + 32 * kk + 8 * q); }
    for (; un < NU; un += F.G) {
        MX_DEC(un, b, i, j);
        const int t0 = b * SEQ + 128 * i, c0 = 128 * j, tq = 16 * w + r;
        const int unn = (un + F.G < NU) ? un + F.G : un;
        MX_DEC(unn, bn, in_, jn); const int ipn = in_ > 0 ? in_ - 1 : 0;
        f32x4 yb[8];
#pragma unroll
        for (int dt = 0; dt < 8; ++dt) yb[dt] = (f32x4){0.f, 0.f, 0.f, 0.f};
        float carry = 0.f, tot; bf16x8 af[4];
        MX_WAIT_BAR(0);
        asm volatile("" : "+v"(qf[0]), "+v"(qf[1]), "+v"(qf[2]), "+v"(qf[3]));
        mx_dma(B1, Vg + (size_t)t0 * D + c0, w, lane);
        sb_scores(B0, qf, true, tq, 0.f, r, q, UE, UO, ONES, af, tot);
        MX_WAIT_BAR(0);
        mx_dma(B0, Kg + (size_t)(bn * SEQ + 128 * in_) * D + 128 * jn, w, lane);
        sb_pv(B1, af, yb, r, q);
        carry += tot;
        MX_WAIT_BAR(4);
        mx_dma(B1, VA + (size_t)t0 * D + c0, w, lane);
        const bool wlive = (i > 0) && (wave_max(carry) >= MX_EXIT2);
        if (wlive) { sb_scores(B2, qf, false, tq, carry, r, q, UE, UO, ONES, af, tot);
            const float wm = wave_max(carry + tot); if (lane == 0) *(LAS float*)(lds + MX_FLG + w * 4) = wm; }
        else if (i > 0) { if (lane == 0) *(LAS float*)(lds + MX_FLG + w * 4) = -1e30f; }
        MX_WAIT_BAR(4);
        mx_dma(B2, Kg + (size_t)(bn * SEQ + 128 * ipn) * D + 128 * jn, w, lane);
        if (wlive) { sb_pv(B3, af, yb, r, q); carry += tot; }
        if (i > 1) {
            float gm = -1e30f;
#pragma unroll
            for (int k = 0; k < 8; ++k) gm = fmaxf(gm, *(const LAS float*)(lds + MX_FLG + k * 4));
            if (gm >= MX_EXIT2) {
                for (int kb = i - 2; kb >= 0; --kb) {
                    MX_WAIT_BAR(0);
                    mx_dma(B2, Kg + (size_t)(b * SEQ + 128 * kb) * D + c0, w, lane); mx_dma(B3, Vg + (size_t)(b * SEQ + 128 * kb) * D + c0, w, lane);
                    MX_WAIT_BAR(0);
                    if (wave_max(carry) >= MX_EXIT2) { sb_scores(B2, qf, false, tq, carry, r, q, UE, UO, ONES, af, tot); sb_pv(B3, af, yb, r, q); carry += tot; }
                    const float wm = wave_max(carry); if (lane == 0) *(LAS float*)(lds + MX_FLG2 + w * 4) = wm;
                    MX_WAIT_BAR(0);
                    float g2 = -1e30f;
#pragma unroll
                    for (int k = 0; k < 8; ++k) g2 = fmaxf(g2, *(const LAS float*)(lds + MX_FLG2 + k * 4));
                    if (g2 < MX_EXIT2) break;
                }
                MX_WAIT_BAR(0);
                mx_dma(B2, Kg + (size_t)(bn * SEQ + 128 * ipn) * D + 128 * jn, w, lane);
            }
        }
        { f32x2 sp4[4];
#pragma unroll
          for (int k = 0; k < 4; ++k) sp4[k] = *((const f32x2*)vstat + (size_t)(t0 + (tid >> 2)) * 16 + 4 * (tid & 3) + k);
          float s1 = (sp4[0][0] + sp4[1][0]) + (sp4[2][0] + sp4[3][0]), s2 = (sp4[0][1] + sp4[1][1]) + (sp4[2][1] + sp4[3][1]);
          s1 += __shfl_xor(s1, 1); s1 += __shfl_xor(s1, 2); s2 += __shfl_xor(s2, 1); s2 += __shfl_xor(s2, 2);
          const float mean = s1 * (1.f / D), var = s2 * (1.f / D) - mean * mean;
          if ((tid & 3) == 0) *(LAS f32x2*)(lds + MX_STAT + (tid >> 2) * 8) = (f32x2){mean, 1.f / sqrtf(fmaxf(var, 0.f) + LN_EPS)}; }
        MX_WAIT_BAR(4);
        mx_dma(B3, Vg + (size_t)(bn * SEQ + 128 * ipn) * D + 128 * jn, w, lane);
        bf16x8 qn[4];
#pragma unroll
        for (int kk = 0; kk < 4; ++kk) qn[kk] = *(const bf16x8*)(Qg + (size_t)(bn * SEQ + 128 * in_ + 16 * w + r) * D + 128 * jn + 32 * kk + 8 * q);
        {
          f32x4 ya[8];
#pragma unroll
          for (int dt = 0; dt < 8; ++dt) ya[dt] = (f32x4){0.f, 0.f, 0.f, 0.f};
          float c1 = 0.f, c2 = 0.f;
          const int nks = (w >> 1) + 1;
          for (int ks = 0; ks < nks; ++ks) {
              const u32x4 wr4 = *(const u32x4*)(WSP + ((size_t)j * 128 + tq) * 128 + 32 * ks + 8 * q);
              float wv[8] = {bflo(wr4.x), bfhi(wr4.x), bflo(wr4.y), bfhi(wr4.y), bflo(wr4.z), bfhi(wr4.z), bflo(wr4.w), bfhi(wr4.w)}; float wp[8];
#pragma unroll
              for (int e = 0; e < 8; ++e) { const f32x2 st = *(const LAS f32x2*)(lds + MX_STAT + (32 * ks + 8 * q + e) * 8); wp[e] = wv[e] * st[1]; c2 += wv[e]; }
              const u32x4 wq = pg8::pk8((f32x4){wp[0], wp[1], wp[2], wp[3]}, (f32x4){wp[4], wp[5], wp[6], wp[7]});
              const float wb[8] = {bflo(wq.x), bfhi(wq.x), bflo(wq.y), bfhi(wq.y), bflo(wq.z), bfhi(wq.z), bflo(wq.w), bfhi(wq.w)};
#pragma unroll
              for (int e = 0; e < 8; ++e) { const f32x2 st = *(const LAS f32x2*)(lds + MX_STAT + (32 * ks + 8 * q + e) * 8); c1 += wb[e] * st[0]; }
              const bf16x8 wf = __builtin_bit_cast(bf16x8, wq);
#pragma unroll
              for (int dt = 0; dt < 8; ++dt) { const bf16x8 vf = mx_tr(B1, 32 * ks + 8 * q, 32 * ks + 8 * q + 4, 16 * dt, r);
                  ya[dt] = __builtin_amdgcn_mfma_f32_16x16x32_bf16(vf, wf, ya[dt], 0, 0, 0); }
          }
          c1 += __shfl_xor(c1, 16); c1 += __shfl_xor(c1, 32); c2 += __shfl_xor(c2, 16); c2 += __shfl_xor(c2, 32);
          const float bs = bsp[j * 128 + tq]; const size_t rowoff = (size_t)(t0 + tq) * D + c0 + 4 * q;
#pragma unroll
          for (int dt = 0; dt < 8; ++dt) { const u32x2 ug = *(const u32x2*)(UG + rowoff + 16 * dt), gb = *(const u32x2*)(GB + rowoff + 16 * dt);
              const f32x4 g4 = *(const f32x4*)(lnvg + c0 + 16 * dt + 4 * q), b4 = *(const f32x4*)(lnvb + c0 + 16 * dt + 4 * q);
              const f32x4 u4 = (f32x4){bflo(ug.x), bfhi(ug.x), bflo(ug.y), bfhi(ug.y)}, gq = (f32x4){bflo(gb.x), bfhi(gb.x), bflo(gb.y), bfhi(gb.y)};
              const f32x4 mixed = g4 * (ya[dt] - c1) + b4 * c2 + bs;
              const f32x4 o = u4 * mixed + gq * yb[dt];
              *(u32x2*)(MG + rowoff + 16 * dt) = (u32x2){pg8::pk2(o[0], o[1]), pg8::pk2(o[2], o[3])}; } }
#pragma unroll
        for (int kk = 0; kk < 4; ++kk) qf[kk] = qn[kk];
    }
    MX_WAIT_BAR(0);
#undef MX_DEC
}
#undef MX_WAIT_BAR

DI void ln1_phase(Frame& F, const float* const* in) {
    const int gw = F.vcu * NWAVES + F.wave, NGW = F.G * NWAVES, lane = F.lane;
    const bf16* Y1 = (const bf16*)(F.ws + WS_Y1); bf16* X1b = (bf16*)(F.ws + WS_X1B);
    f32x4 gv[4], bv[4];
#pragma unroll
    for (int j = 0; j < 4; ++j) { gv[j] = ((const f32x4*)in[11])[lane + 64 * j]; bv[j] = ((const f32x4*)in[12])[lane + 64 * j]; }
    for (int m = gw; m < T; m += NGW) { f32x4 v[4]; float mean, rstd; row_stats_b16(Y1 + (size_t)m * D, lane, v, mean, rstd);
        u32x2* ob = (u32x2*)(X1b + (size_t)m * D) + lane;
#pragma unroll
        for (int j = 0; j < 4; ++j) { const f32x4 y = (v[j] - mean) * rstd * gv[j] + bv[j]; ob[64 * j] = (u32x2){pg8::pk2(y[0], y[1]), pg8::pk2(y[2], y[3])}; } }
}

DI void memattn_phase(Frame& F, int first, int stride) {
    LAS unsigned char* lds = F.lds; unsigned char* ws = F.ws;
    const int lane = F.lane, w = F.wave, r = lane & 15, q = lane >> 4;
    const bf16* Qm = (const bf16*)(ws + WS_QM); const bf16* KV = (const bf16*)(ws + WS_KVM); bf16* Om = (bf16*)(ws + WS_OM);
    for (int su = first; su < NBATCH * 4 * 8; su += stride) {
        const int qc = su & 7, h = (su >> 3) & 3, b = su >> 5;
        mx_dma(lds, KV + (size_t)(b * MEMLEN) * D + h * 128, w, lane); mx_dma(lds + MX_BUF, KV + (size_t)(b * MEMLEN + 128) * D + h * 128, w, lane);
        mx_dma(lds + 2 * MX_BUF, KV + (size_t)(b * MEMLEN) * D + MEMW + h * 128, w, lane); mx_dma(lds + 3 * MX_BUF, KV + (size_t)(b * MEMLEN + 128) * D + MEMW + h * 128, w, lane);
        bf16x8 qf[4];
#pragma unroll
        for (int kk = 0; kk < 4; ++kk) qf[kk] = *(const bf16x8*)(Qm + ((size_t)b * SEQ + 256 * qc + 16 * w + r) * MEMW + h * 128 + 32 * kk + 8 * q);
        asm volatile("s_waitcnt vmcnt(0) lgkmcnt(0)\n\ts_barrier" ::: "memory");
        for (int c = 0; c < 2; ++c) {
            const size_t trow = (size_t)b * SEQ + 256 * qc + 128 * c + 16 * w + r;
            if (c == 1) {
#pragma unroll
                for (int kk = 0; kk < 4; ++kk) qf[kk] = *(const bf16x8*)(Qm + trow * MEMW + h * 128 + 32 * kk + 8 * q); }
            f32x4 z[16];
#pragma unroll
            for (int st = 0; st < 16; ++st) { z[st] = (f32x4){0.f, 0.f, 0.f, 0.f};
#pragma unroll
                for (int kk = 0; kk < 4; ++kk) { const bf16x8 kf = *(const LAS bf16x8*)(lds + (st >> 3) * MX_BUF + (16 * (st & 7) + r) * 256 + (((4 * kk + q) ^ r) * 16));
                    z[st] = __builtin_amdgcn_mfma_f32_16x16x32_bf16(kf, qf[kk], z[st], 0, 0, 0); }
                if (st & 1) __builtin_amdgcn_sched_barrier(0); }
            float mx = -1e30f;
#pragma unroll
            for (int st = 0; st < 16; ++st) mx = fmaxf(mx, fmaxf(fmaxf(z[st][0], z[st][1]), fmaxf(z[st][2], z[st][3])));
            mx = fmaxf(mx, __shfl_xor(mx, 16)); mx = fmaxf(mx, __shfl_xor(mx, 32));
            float sum = 0.f;
#pragma unroll
            for (int st = 0; st < 16; ++st)
#pragma unroll
                for (int e = 0; e < 4; ++e) { const float pp = fast_exp2((z[st][e] - mx) * LOG2E); z[st][e] = pp; sum += pp; }
            sum += __shfl_xor(sum, 16); sum += __shfl_xor(sum, 32);
            const float inv = 1.0f / sum;
            f32x4 o[8];
#pragma unroll
            for (int dt = 0; dt < 8; ++dt) o[dt] = (f32x4){0.f, 0.f, 0.f, 0.f};
#pragma unroll
            for (int p = 0; p < 8; ++p) { const bf16x8 pf = mk_frag(z[2 * p], z[2 * p + 1]);
#pragma unroll
                for (int dt = 0; dt < 8; ++dt) { const bf16x8 vf = mx_tr(lds + (2 + (p >> 2)) * MX_BUF, 32 * (p & 3) + 4 * q, 32 * (p & 3) + 16 + 4 * q, 16 * dt, r);
                    o[dt] = __builtin_amdgcn_mfma_f32_16x16x32_bf16(vf, pf, o[dt], 0, 0, 0); }
                __builtin_amdgcn_sched_barrier(0); }
#pragma unroll
            for (int dt = 0; dt < 8; ++dt) { const f32x4 v = o[dt] * inv;
                *(u32x2*)(Om + trow * MEMW + h * 128 + 16 * dt + 4 * q) = (u32x2){pg8::pk2(v[0], v[1]), pg8::pk2(v[2], v[3])}; }
        }
        asm volatile("s_waitcnt lgkmcnt(0)\n\ts_barrier" ::: "memory");
    }
}

constexpr int RT_XRS = 2064;
constexpr int RT_XH = 0, RT_XL = 16 * RT_XRS, RT_PART = 2 * 16 * RT_XRS, RT_SC = RT_PART + 8 * 16 * 64 * 4, RT_SEL = RT_SC + 16 * 64 * 4, RT_HIST = RT_SEL + 16 * 64 * 4, RT_END = RT_HIST + 256;
static_assert(RT_END <= SCR_BYTES, "router LDS");
DI float grp8_max(float v) { v = fmaxf(v, __shfl_xor(v, 1)); v = fmaxf(v, __shfl_xor(v, 2)); v = fmaxf(v, __shfl_xor(v, 4)); return v; }
DI float rdlane(float v, int l) { return __uint_as_float(__builtin_amdgcn_readlane(__float_as_uint(v), l)); }
DI void route_phase(Frame& F, const float* const* in, unsigned* gcount) {
    LAS unsigned char* lds = F.lds; unsigned char* ws = F.ws;
    const int tid = F.tid, lane = F.lane, w = F.wave, r = lane & 15, q = lane >> 4;
    const bf16* Y2 = (const bf16*)F.out; bf16* X2b = (bf16*)(ws + WS_X2B);
    const bf16* WRH = (const bf16*)(ws + WS_WRHI); const bf16* WRL = (const bf16*)(ws + WS_WRLO);
    unsigned* TK = (unsigned*)(ws + WS_TK); float* TKW = (float*)(ws + WS_TKW); unsigned* WGB = (unsigned*)(ws + WS_WGBASE);
    LAS unsigned* HIST = (LAS unsigned*)(lds + RT_HIST);
    if (tid < 64) HIST[tid] = 0u;
    const float rb = in[19][lane];
    f32x4 gv[4], bv[4];
#pragma unroll
    for (int j = 0; j < 4; ++j) { gv[j] = ((const f32x4*)in[16])[lane + 64 * j]; bv[j] = ((const f32x4*)in[17])[lane + 64 * j]; }
    bf16x8 bh[4][4], bl[4][4];
#pragma unroll
    for (int kk = 0; kk < 4; ++kk)
#pragma unroll
        for (int nt = 0; nt < 4; ++nt) { const size_t o = (size_t)(16 * nt + r) * D + 128 * w + 32 * kk + 8 * q; bh[kk][nt] = *(const bf16x8*)(WRH + o); bl[kk][nt] = *(const bf16x8*)(WRL + o); }
    u32x2 va[4], vb[4];
    { const int tl0 = F.vcu; if (tl0 < T / 16) {
#pragma unroll
        for (int j = 0; j < 4; ++j) { va[j] = ((const u32x2*)(Y2 + ((size_t)16 * tl0 + 2 * w) * D))[lane + 64 * j]; vb[j] = ((const u32x2*)(Y2 + ((size_t)16 * tl0 + 2 * w + 1) * D))[lane + 64 * j]; } } }
    __syncthreads();
    for (int tl = F.vcu; tl < T / 16; tl += F.G) {
#pragma unroll
        for (int rr = 0; rr < 2; ++rr) { const int lr = 2 * w + rr; const size_t m = (size_t)16 * tl + lr;
            f32x4 v[4]; float s = 0.f;
#pragma unroll
            for (int j = 0; j < 4; ++j) { const u32x2 x = rr ? vb[j] : va[j]; v[j] = (f32x4){bflo(x.x), bfhi(x.x), bflo(x.y), bfhi(x.y)}; s += (v[j][0] + v[j][1]) + (v[j][2] + v[j][3]); }
            const float mean = wave_sum(s) * (1.f / D); float s2 = 0.f;
#pragma unroll
            for (int j = 0; j < 4; ++j) { const f32x4 d = v[j] - mean; s2 += (d[0] * d[0] + d[1] * d[1]) + (d[2] * d[2] + d[3] * d[3]); }
            const float rstd = 1.f / sqrtf(wave_sum(s2) * (1.f / D) + LN_EPS);
            u32x2* ob = (u32x2*)(X2b + m * D) + lane;
#pragma unroll
            for (int j = 0; j < 4; ++j) { const f32x4 y = (v[j] - mean) * rstd * gv[j] + bv[j];
                const u32x2 hi = (u32x2){pg8::pk2(y[0], y[1]), pg8::pk2(y[2], y[3])}; ob[64 * j] = hi;
                const f32x4 rs = (f32x4){y[0] - bflo(hi.x), y[1] - bfhi(hi.x), y[2] - bflo(hi.y), y[3] - bfhi(hi.y)};
                *(LAS u32x2*)(lds + RT_XH + lr * RT_XRS + (4 * lane + 256 * j) * 2) = hi;
                *(LAS u32x2*)(lds + RT_XL + lr * RT_XRS + (4 * lane + 256 * j) * 2) = (u32x2){pg8::pk2(rs[0], rs[1]), pg8::pk2(rs[2], rs[3])}; } }
        { const int tn = tl + F.G; if (tn < T / 16) {
#pragma unroll
            for (int j = 0; j < 4; ++j) { va[j] = ((const u32x2*)(Y2 + ((size_t)16 * tn + 2 * w) * D))[lane + 64 * j]; vb[j] = ((const u32x2*)(Y2 + ((size_t)16 * tn + 2 * w + 1) * D))[lane + 64 * j]; } } }
        __syncthreads();
        { f32x4 acc[4];
#pragma unroll
          for (int nt = 0; nt < 4; ++nt) acc[nt] = (f32x4){0.f, 0.f, 0.f, 0.f};
#pragma unroll
          for (int kk = 0; kk < 4; ++kk) { const int k0 = 128 * w + 32 * kk + 8 * q;
              const bf16x8 ah = *(const LAS bf16x8*)(lds + RT_XH + r * RT_XRS + k0 * 2), al = *(const LAS bf16x8*)(lds + RT_XL + r * RT_XRS + k0 * 2);
#pragma unroll
              for (int nt = 0; nt < 4; ++nt) {
                  acc[nt] = __builtin_amdgcn_mfma_f32_16x16x32_bf16(ah, bh[kk][nt], acc[nt], 0, 0, 0);
                  acc[nt] = __builtin_amdgcn_mfma_f32_16x16x32_bf16(al, bh[kk][nt], acc[nt], 0, 0, 0);
                  acc[nt] = __builtin_amdgcn_mfma_f32_16x16x32_bf16(ah, bl[kk][nt], acc[nt], 0, 0, 0); } }
#pragma unroll
          for (int nt = 0; nt < 4; ++nt)
#pragma unroll
              for (int e = 0; e < 4; ++e) *(LAS float*)(lds + RT_PART + ((w * 16 + 4 * q + e) * 64 + 16 * nt + r) * 4) = acc[nt][e]; }
        __syncthreads();
#pragma unroll
        for (int rr = 0; rr < 2; ++rr) { const int lt = 2 * w + rr; const size_t tok = (size_t)16 * tl + lt;
            float lg = 0.f;
#pragma unroll
            for (int k = 0; k < 8; ++k) lg += *(const LAS float*)(lds + RT_PART + ((k * 16 + lt) * 64 + lane) * 4);
            const float sc = 1.0f / (1.0f + __expf(-lg)); const float sel = sc + rb;
            const int g = lane >> 3;
            const float m1 = grp8_max(sel);
            const unsigned long long bal = __ballot(sel == m1);
            const unsigned gb = (unsigned)(bal >> (8 * g)) & 0xffu; const int first = 8 * g + __builtin_ctz(gb);
            const float m2 = grp8_max(lane == first ? -1e30f : sel);
            const float gs = m1 + m2;
            int grank = 0;
#pragma unroll
            for (int g2 = 0; g2 < 8; ++g2) { const float v = rdlane(gs, 8 * g2); grank += ((v > gs) || (v == gs && g2 < g)) ? 1 : 0; }
            const float val = (grank < 4) ? sel : -1e30f;
            int rank = 0;
#pragma unroll
            for (int e2 = 0; e2 < 64; ++e2) { const float v = rdlane(val, e2); rank += ((v > val) || (v == val && e2 < lane)) ? 1 : 0; }
            const bool chosen = rank < 8;
            const unsigned long long cm = __ballot(chosen);
            const float wsum = wave_sum(chosen ? sc : 0.f);
            if (chosen) { const int kidx = __builtin_popcountll(cm & ((1ull << lane) - 1ull));
                const unsigned lrk = __hip_atomic_fetch_add(&HIST[lane], 1u, __ATOMIC_RELAXED, __HIP_MEMORY_SCOPE_WORKGROUP);
                TK[tok * 8 + kidx] = (unsigned)lane | (lrk << 8); TKW[tok * 8 + kidx] = sc * (ROUTED_SCALE / wsum); }
        }
        __syncthreads();
    }
    if (tid < 64) { const unsigned cnt = HIST[tid]; const unsigned base = __hip_atomic_fetch_add(gcount + tid, cnt, RLX_AGENT); WGB[F.vcu * 64 + tid] = base; }
}

DI void slots_phase(Frame& F) {
    LAS unsigned char* lds = F.lds; unsigned char* ws = F.ws; const int tid = F.tid;
    LAS unsigned* CNT = (LAS unsigned*)lds; LAS unsigned* PS = CNT + 64;
    int* ROWTOK = (int*)(ws + WS_ROWTOK); float* ROWW = (float*)(ws + WS_ROWW); unsigned* SLOT = (unsigned*)(ws + WS_SLOT);
    const unsigned* TK = (const unsigned*)(ws + WS_TK); const float* TKW = (const float*)(ws + WS_TKW); const unsigned* WGB = (const unsigned*)(ws + WS_WGBASE);
    if (tid < 64) CNT[tid] = __hip_atomic_load(F.ctl + CW_GCOUNT + tid, RLX_AGENT);
    __syncthreads();
    if (tid == 0) { unsigned run = 0u; for (int e = 0; e < 64; ++e) { PS[e] = run; run += (CNT[e] + 255u) & ~255u; } PS[64] = run; }
    __syncthreads();
    const unsigned nblk = PS[64] >> 8;
    if (F.vcu == 0) {
        if (tid == 0) { __hip_atomic_store(F.ctl + CW_HDR, nblk, RLX_AGENT); __hip_atomic_store(F.ctl + CW_HDR + 1, (nblk + 1u) >> 1, RLX_AGENT); }
        for (unsigned bl = tid; bl < nblk; bl += NTHREADS) { unsigned e = 0; for (int k = 1; k < 64; ++k) e += (PS[k] <= bl * 256u) ? 1u : 0u; __hip_atomic_store(F.ctl + CW_BLKE + bl, e, RLX_AGENT); }
    }
    for (int e = F.vcu; e < 64; e += F.G) { const unsigned lo = PS[e] + CNT[e], hi = PS[e + 1]; for (unsigned s = lo + tid; s < hi; s += NTHREADS) { ROWTOK[s] = 0; ROWW[s] = 0.f; } }
    for (int tl = F.vcu; tl < T / 16; tl += F.G) {
        if (tid < 128) { const size_t a = (size_t)16 * 8 * tl + tid; const unsigned pk = TK[a], e = pk & 0xffu, lrk = pk >> 8;
            const unsigned slot = PS[e] + WGB[F.vcu * 64 + e] + lrk; ROWTOK[slot] = (int)(a >> 3); ROWW[slot] = TKW[a]; SLOT[a] = slot; }
    }
}

DI void dec8(unsigned w, float (&o)[4]) { const f32x2 a = __builtin_amdgcn_cvt_pk_f32_fp8((int)w, false), b = __builtin_amdgcn_cvt_pk_f32_fp8((int)w, true); o[0] = a[0]; o[1] = a[1]; o[2] = b[0]; o[3] = b[1]; }
DI void combine_phase(Frame& F, const float* const* in) {
    const int gw = F.vcu * NWAVES + F.wave, NGW = F.G * NWAVES, lane = F.lane;
    const unsigned* SLOT = (const unsigned*)(F.ws + WS_SLOT); const unsigned char* Y8 = (const unsigned char*)(F.ws + WS_YH); const bf16* base = (const bf16*)(F.ws + WS_X2B); float* out = F.out;
    f32x4 gv[4], bv[4];
#pragma unroll
    for (int j = 0; j < 4; ++j) { gv[j] = *(const f32x4*)(in[26] + 16 * lane + 4 * j); bv[j] = *(const f32x4*)(in[27] + 16 * lane + 4 * j); }
    for (int m0 = gw; m0 < T; m0 += 2 * NGW) {
        u32x4 yr[2][8]; u32x4 bs[2][2];
#pragma unroll
        for (int t2 = 0; t2 < 2; ++t2) { const int m = m0 + t2 * NGW; const int mm = (m < T) ? m : m0;
            unsigned sl[8];
#pragma unroll
            for (int k = 0; k < 8; ++k) sl[k] = __builtin_amdgcn_readfirstlane(__hip_atomic_load(SLOT + (size_t)mm * 8 + k, RLX_AGENT));
            bs[t2][0] = *(const u32x4*)(base + (size_t)mm * D + 16 * lane); bs[t2][1] = *(const u32x4*)(base + (size_t)mm * D + 16 * lane + 8);
#pragma unroll
            for (int k = 0; k < 8; ++k) yr[t2][k] = *(const u32x4*)(Y8 + (size_t)sl[k] * D + 16 * lane);
        }
#pragma unroll
        for (int t2 = 0; t2 < 2; ++t2) { const int m = m0 + t2 * NGW; if (m >= T) continue;
            float a[16];
#pragma unroll
            for (int c = 0; c < 16; ++c) a[c] = 0.f;
#pragma unroll
            for (int k = 0; k < 8; ++k) { const u32x4 y = yr[t2][k]; float d[4];
                dec8(y.x, d); a[0] += d[0]; a[1] += d[1]; a[2] += d[2]; a[3] += d[3];
                dec8(y.y, d); a[4] += d[0]; a[5] += d[1]; a[6] += d[2]; a[7] += d[3];
                dec8(y.z, d); a[8] += d[0]; a[9] += d[1]; a[10] += d[2]; a[11] += d[3];
                dec8(y.w, d); a[12] += d[0]; a[13] += d[1]; a[14] += d[2]; a[15] += d[3]; }
            f32x4 v[4];
#pragma unroll
            for (int h = 0; h < 2; ++h) { const u32x4 x = bs[t2][h];
                v[2 * h] = (f32x4){bflo(x.x), bfhi(x.x), bflo(x.y), bfhi(x.y)} + (f32x4){a[8 * h], a[8 * h + 1], a[8 * h + 2], a[8 * h + 3]} * (1.0f / pg8::Y8_SCALE);
                v[2 * h + 1] = (f32x4){bflo(x.z), bfhi(x.z), bflo(x.w), bfhi(x.w)} + (f32x4){a[8 * h + 4], a[8 * h + 5], a[8 * h + 6], a[8 * h + 7]} * (1.0f / pg8::Y8_SCALE); }
            float s = 0.f;
#pragma unroll
            for (int j = 0; j < 4; ++j) s += (v[j][0] + v[j][1]) + (v[j][2] + v[j][3]);
            const float mean = wave_sum(s) * (1.f / D); float s2 = 0.f;
#pragma unroll
            for (int j = 0; j < 4; ++j) { const f32x4 d = v[j] - mean; s2 += (d[0] * d[0] + d[1] * d[1]) + (d[2] * d[2] + d[3] * d[3]); }
            const float rstd = 1.f / sqrtf(wave_sum(s2) * (1.f / D) + LN_EPS);
#pragma unroll
            for (int j = 0; j < 4; ++j) *(f32x4*)(out + (size_t)m * D + 16 * lane + 4 * j) = (v[j] - mean) * rstd * gv[j] + bv[j];
        }
    }
}

DI void stagger(const Frame& F, unsigned ticks) {
    if (F.vcu & 1) { const unsigned long long t0 = __builtin_amdgcn_s_memrealtime(); while (__builtin_amdgcn_s_memrealtime() - t0 < ticks) __builtin_amdgcn_s_sleep(8); }
}
#ifndef STAG_DOWN
#define STAG_DOWN 350
#endif
constexpr int NPHASE = 13;
constexpr int CVT_A = 12288;
constexpr int N_LAUNCHES = MK_N_LAUNCHES;
static_assert(N_LAUNCHES == 1 || N_LAUNCHES == NPHASE, "MK_N_LAUNCHES: 1 (one dispatch) or 13 (one dispatch per phase)");
struct Args { const float* in[28]; float* out; unsigned char* ws; int ph_lo, ph_hi; };
static_assert(sizeof(Args) == 28 * 8 + 8 + 8 + 8, "Args has no padding");

__global__ void __launch_bounds__(NTHREADS, 2) fwd_kernel(Args args) {
    extern __shared__ __attribute__((aligned(16))) unsigned char lds_raw[];
    Frame F;
    F.lds = (LAS unsigned char*)lds_raw;
    volatile LAS unsigned* MISC = (volatile LAS unsigned*)(F.lds + MISC_OFF);
    F.tid = threadIdx.x; F.lane = F.tid & 63; F.wave = __builtin_amdgcn_readfirstlane(F.tid >> 6);
    F.G = gridDim.x; { const int bx = blockIdx.x; F.vcu = (F.G % 8 == 0) ? (bx % 8) * (F.G / 8) + bx / 8 : bx; }
    F.ws = args.ws; F.ctl = (unsigned*)(args.ws + WS_CTL); F.out = args.out;
    unsigned char* ws = args.ws;
    for (int u = F.tid; u < (LDS_BYTES - MISC_OFF) / 4; u += NTHREADS) ((LAS unsigned*)(F.lds + MISC_OFF))[u] = 0u;
    __syncthreads();
    XcdBarrier bar; bar.bar = F.ctl + CW_BAR; bar.x = 0; bar.st = nullptr;
    if (N_LAUNCHES == 1) bar = xcd_barrier_post(F.ctl + CW_BAR, MISC + 8);
#define GRID_BAR() do { if (N_LAUNCHES == 1) xcd_barrier(bar); } while (0)
    const int lo = args.ph_lo, hi = args.ph_hi;
#ifndef PHASE_MASK
#define PHASE_MASK 0x1fff
#endif
#define IN(k) (((PHASE_MASK >> (k)) & 1) && lo <= (k) && (k) < hi)
#ifndef REPEAT_MASK
#define REPEAT_MASK 0
#endif
#ifndef DOWN_PROBE
#define DOWN_PROBE 0
#endif
#define REP(k) (((REPEAT_MASK >> (k)) & 1) ? 2 : 1)
#define SEAM(k) do { if (IN(k) && IN((k) + 1)) GRID_BAR(); } while (0)
    const float* const* in = args.in;

    for (int rep_ = 0; rep_ < (IN(0) ? REP(0) : 0); ++rep_) { if (rep_) GRID_BAR(); p0_prologue(F, in); SEAM(0); }
    for (int rep_ = 0; rep_ < (IN(1) ? REP(1) : 0); ++rep_) { if (rep_) GRID_BAR();
        pg8::DenseOrder S; S.init((const bf16*)F.out, (const bf16*)(ws + WS_WIN), T, INW, D, F.G, (int)blockIdx.x);
        pg8::EpiInProj E{(bf16*)(ws + WS_P1), (float*)(ws + WS_VSTAT), (const float*)(ws + WS_BPERM)};
        pg8::gemm_phase<pg8::EpiInProj, pg8::DenseOrder, true>(F.lds, D, S, E);
        SEAM(1);
    }
    for (int rep_ = 0; rep_ < (IN(2) ? REP(2) : 0); ++rep_) { if (rep_) GRID_BAR(); mix_phase(F, in); SEAM(2); }
    for (int rep_ = 0; rep_ < (IN(3) ? REP(3) : 0); ++rep_) { if (rep_) GRID_BAR();
        pg8::DenseOrder S; S.init((const bf16*)(ws + WS_MERGED), (const bf16*)(ws + WS_WOUT), T, D, D, F.G, (int)blockIdx.x);
        pg8::EpiResB16<true> E{(bf16*)(ws + WS_Y1), in[0], nullptr, (const float*)(ws + WS_XSTAT), in[2], in[3]};
        pg8::gemm_phase<pg8::EpiResB16<true>, pg8::DenseOrder, false>(F.lds, D, S, E);
        SEAM(3);
    }
    for (int rep_ = 0; rep_ < (IN(4) ? REP(4) : 0); ++rep_) { if (rep_) GRID_BAR(); ln1_phase(F, in); SEAM(4); }
    for (int rep_ = 0; rep_ < (IN(5) ? REP(5) : 0); ++rep_) { if (rep_) GRID_BAR();
        if (F.G == 256) { if ((int)blockIdx.x >= 160) expert_convert(F, in, (int)blockIdx.x - 160, 96, 0, CVT_A); }
        else expert_convert(F, in, F.vcu, F.G, 0, NEXP * 384);
        __syncthreads();
        { pg8::DenseOrder S; S.init((const bf16*)(ws + WS_X1B), (const bf16*)(ws + WS_WQ), T, MEMW, D, F.G, (int)blockIdx.x);
          pg8::EpiBf16S E{(bf16*)(ws + WS_QM), MEMW, QSCALE};
          pg8::gemm_phase<pg8::EpiBf16S, pg8::DenseOrder, false>(F.lds, D, S, E); }
        { const int c2 = ((int)blockIdx.x + F.G - 128 % F.G) % F.G;
          pg8::DenseOrder S; S.init((const bf16*)(ws + WS_MEMB), (const bf16*)(ws + WS_WKV), NBATCH * MEMLEN, 2 * MEMW, D, F.G, c2);
          pg8::EpiBf16S E{(bf16*)(ws + WS_KVM), 2 * MEMW, 1.0f};
          pg8::gemm_phase<pg8::EpiBf16S, pg8::DenseOrder, false>(F.lds, D, S, E); }
        SEAM(5);
    }
    for (int rep_ = 0; rep_ < (IN(6) ? REP(6) : 0); ++rep_) { if (rep_) GRID_BAR();
        if (F.G == 256) { if (F.vcu & 1) expert_convert(F, in, F.vcu >> 1, 128, CVT_A, NEXP * 384); else memattn_phase(F, F.vcu >> 1, 128); }
        else memattn_phase(F, F.vcu, F.G);
        SEAM(6); }
    for (int rep_ = 0; rep_ < (IN(7) ? REP(7) : 0); ++rep_) { if (rep_) GRID_BAR();
        pg8::DenseOrder S; S.init((const bf16*)(ws + WS_OM), (const bf16*)(ws + WS_WO), T, D, MEMW, F.G, (int)blockIdx.x);
        pg8::EpiResB16<false> E{(bf16*)F.out, nullptr, (const bf16*)(ws + WS_X1B), nullptr, nullptr, nullptr};
        pg8::gemm_phase<pg8::EpiResB16<false>, pg8::DenseOrder, false>(F.lds, MEMW, S, E);
        SEAM(7);
    }
    for (int rep_ = 0; rep_ < (IN(8) ? REP(8) : 0); ++rep_) { if (rep_) GRID_BAR(); route_phase(F, in, F.ctl + ((rep_ + 1 < REP(8)) ? 2048 : CW_GCOUNT)); SEAM(8); }
    for (int rep_ = 0; rep_ < (IN(9) ? REP(9) : 0); ++rep_) { if (rep_) GRID_BAR(); slots_phase(F); SEAM(9); }
    for (int rep_ = 0; rep_ < (IN(10) ? REP(10) : 0); ++rep_) { if (rep_) GRID_BAR();
        const int nblk = (int)__builtin_amdgcn_readfirstlane(__hip_atomic_load(F.ctl + CW_HDR, RLX_AGENT));
        pg8::moe_tables(F.lds, F.ctl + CW_BLKE, nblk, (const int*)(ws + WS_ROWTOK), (const float*)(ws + WS_ROWW), true, F.G, F.vcu, F.tid);
        pg8::GateUpOrder S{(const char*)(ws + WS_X2B), (const char*)(ws + WS_WGU), (const char*)(ws + WS_WGUS), F.lds, nblk, F.G, F.vcu};
        pg8::EpiGateUp E{(bf16*)(ws + WS_H), F.lds};
        pg8::gemm_phase<pg8::EpiGateUp, pg8::GateUpOrder, true>(F.lds, D, S, E);
        SEAM(10);
    }
    for (int rep_ = 0; rep_ < (IN(11) ? REP(11) : 0); ++rep_) { if (rep_) GRID_BAR();
        const int nblk = (int)__builtin_amdgcn_readfirstlane(__hip_atomic_load(F.ctl + CW_HDR, RLX_AGENT));
        pg8::moe_tables(F.lds, F.ctl + CW_BLKE, nblk, nullptr, nullptr, false, F.G, F.vcu, F.tid);
        pg8::DownOrder S{(const char*)(ws + WS_H), (const char*)(ws + WS_WD), (const char*)(ws + WS_WDS), F.lds, 0, nblk, 64, F.G, F.vcu, 0};
        pg8::EpiDown E{(unsigned char*)(ws + WS_YH), (bf16*)(ws + WS_X2B), 0};
        pg8::gemm_phase<pg8::EpiDown, pg8::DownOrder, true>(F.lds, EH, S, E);
        SEAM(11);
    }
    if (IN(12)) { combine_phase(F, in); }
#undef IN
#undef SEAM
#undef GRID_BAR
}

extern "C" void kernel_launch(void* const* d_in, const int* in_sizes, int n_in, void* d_out, int out_size, void* d_ws, size_t ws_size, hipStream_t stream) {
    static int grid = 0;
    if (grid == 0) {
        if (n_in != 28 || in_sizes[0] != T * D || out_size != T * D || ws_size < WS_END) { fprintf(stderr, "kernel_launch: unexpected shapes / workspace (n_in %d, ws %zu < %zu)\n", n_in, ws_size, (size_t)WS_END); grid = -1; return; }
        int dev = 0, cus = 0, per_cu = 0;
        if (hipGetDevice(&dev) != hipSuccess || hipDeviceGetAttribute(&cus, hipDeviceAttributeMultiprocessorCount, dev) != hipSuccess) { grid = -1; return; }
        if (hipFuncSetAttribute((const void*)fwd_kernel, hipFuncAttributeMaxDynamicSharedMemorySize, LDS_BYTES) != hipSuccess) { fprintf(stderr, "kernel_launch: hipFuncSetAttribute failed\n"); grid = -1; return; }
        if (hipOccupancyMaxActiveBlocksPerMultiprocessor(&per_cu, (const void*)fwd_kernel, NTHREADS, LDS_BYTES) != hipSuccess || per_cu < 1) { fprintf(stderr, "kernel_launch: occupancy query reports %d\n", per_cu); }
        (void)hipGetLastError();
        grid = cus;
    }
    if (grid < 0) return;
    if (hipMemsetAsync((char*)d_ws + WS_CTL, 0, CTL_ZERO_BYTES, stream) != hipSuccess) return;
    Args a{};
    for (int i = 0; i < 28; ++i) a.in[i] = (const float*)d_in[i];
    a.out = (float*)d_out; a.ws = (unsigned char*)d_ws;
    for (int li = 0; li < N_LAUNCHES; ++li) {
        a.ph_lo = (N_LAUNCHES == 1) ? 0 : li; a.ph_hi = (N_LAUNCHES == 1) ? NPHASE : li + 1;
        hipLaunchKernelGGL(fwd_kernel, dim3(grid), dim3(NTHREADS), LDS_BYTES, stream, a);
        if (hipPeekAtLastError() != hipSuccess) { fprintf(stderr, "kernel_launch: launch %d failed\n", li); break; }
    }
}
```

```cpp
#include <hip/hip_runtime.h>
#include <cstdio>
#include <cstdint>

#ifndef MK_N_LAUNCHES
#define MK_N_LAUNCHES 1
#endif

#define GAS __attribute__((address_space(1)))
#define LAS __attribute__((address_space(3)))
typedef unsigned short bf16;
typedef short bf16x8 __attribute__((ext_vector_type(8)));
typedef short s16x4 __attribute__((ext_vector_type(4)));
typedef float f32x4 __attribute__((ext_vector_type(4)));
typedef float f32x2 __attribute__((ext_vector_type(2)));
typedef unsigned u32x4 __attribute__((ext_vector_type(4)));
typedef unsigned u32x2 __attribute__((ext_vector_type(2)));
#define RLX_AGENT __ATOMIC_RELAXED, __HIP_MEMORY_SCOPE_AGENT
#define DI __device__ __forceinline__

constexpr int T = 16384, D = 1024, NBATCH = 8, SEQ = 2048, MEMLEN = 256, INW = 7168;
constexpr int NEXP = 64, TOPK = 8, EH = 256, MEMW = 512;
constexpr float LN_EPS = 1e-5f;
constexpr float ALPHA = 1.189207115002721f;
constexpr float QSCALE = 0.08838834764831845f;
constexpr float ROUTED_SCALE = 2.5f;
constexpr float LOG2E = 1.4426950408889634f, LN2 = 0.6931471805599453f;
constexpr float SB_EXIT = -30.0f;
constexpr int NWAVES = 8, NTHREADS = 512;
constexpr int MAXBLK = 576;
constexpr int SH_ROW0 = MAXBLK * 256;

constexpr size_t MiB = 1u << 20;
constexpr size_t WS_CTL = 0, CTL_ZERO_BYTES = 32 * 1024;
constexpr size_t WS_WRHI = 1 * MiB, WS_WRLO = WS_WRHI + 128 * 1024, WS_WSP = WS_WRLO + 128 * 1024, WS_BPERM = WS_WSP + 256 * 1024, WS_XSTAT = WS_BPERM + 32 * 1024;
constexpr size_t WS_ROWTOK = 2 * MiB, WS_ROWW = WS_ROWTOK + 576 * 1024, WS_SLOT = WS_ROWW + 576 * 1024;
constexpr size_t WS_WIN = 4 * MiB, WS_WOUT = 18 * MiB, WS_WQ = 20 * MiB, WS_WKV = 21 * MiB, WS_WO = 23 * MiB, WS_MEMB = 24 * MiB;
constexpr size_t WS_P1 = 29 * MiB;
constexpr size_t WS_UG = WS_P1, WS_VA = WS_P1 + 32 * MiB, WS_Q = WS_P1 + 64 * MiB, WS_K = WS_P1 + 96 * MiB, WS_V = WS_P1 + 128 * MiB, WS_GB = WS_P1 + 160 * MiB;
constexpr size_t WS_VSTAT = 221 * MiB;
constexpr size_t WS_MERGED = 228 * MiB;
constexpr size_t WS_Y1 = 29 * MiB;
constexpr size_t WS_X1F = 93 * MiB, WS_X1B = 157 * MiB;
constexpr size_t WS_QM = 189 * MiB, WS_KVM = 205 * MiB, WS_OM = 209 * MiB;
constexpr size_t WS_WGU = 29 * MiB;
constexpr size_t WS_H = 148 * MiB;
constexpr size_t WS_X2B = 228 * MiB;
constexpr size_t WS_WD = 260 * MiB;
constexpr size_t WS_WGUS = 293 * MiB, WS_WDS = 294 * MiB;
constexpr size_t WS_TK = 295 * MiB, WS_TKW = WS_TK + 512 * 1024, WS_WGBASE = WS_TKW + 512 * 1024;
constexpr size_t WS_YH = 4 * MiB;
constexpr size_t WS_END = 297 * MiB;
static_assert(WS_XSTAT + (size_t)T * 8 <= WS_ROWTOK && WS_SLOT + (size_t)T * 8 * 4 <= WS_WIN && WS_MEMB + 4 * MiB <= WS_P1, "ws map 1");
static_assert(WS_GB + 32 * MiB <= WS_VSTAT && WS_VSTAT + 2 * MiB <= WS_MERGED && WS_H + (size_t)(SH_ROW0 + T) * 512 <= WS_X2B && WS_X2B + 32 * MiB <= WS_WD, "ws map 2");
static_assert(WS_WD + (size_t)64 * 1024 * 256 * 2 <= WS_WGUS && WS_YH + (size_t)288 * 256 * 2048 <= WS_H && WS_WGBASE + 256 * 64 * 4 <= WS_END, "ws map 3");
constexpr int CW_TMO = 0, CW_CODE = 1;
constexpr int CW_GCOUNT = 64;
constexpr int CW_HDR = 192;
constexpr int CW_BLKE = 256;
constexpr int CW_BAR = 4096;

constexpr int SCR_BYTES = 140 * 1024;
constexpr int MISC_OFF = SCR_BYTES;
constexpr int LDS_BYTES = 144 * 1024;

DI unsigned cvt_pk_bf16(float lo, float hi) { unsigned r; asm volatile("v_cvt_pk_bf16_f32 %0, %1, %2" : "=v"(r) : "v"(lo), "v"(hi)); return r; }
DI float bf2f(unsigned short h) { return __uint_as_float((unsigned)h << 16); }
DI float bflo(unsigned w) { return __uint_as_float(w << 16); }
DI float bfhi(unsigned w) { return __uint_as_float(w & 0xffff0000u); }
DI float fast_exp2(float x) { return __builtin_amdgcn_exp2f(x); }
DI float fast_log2(float x) { return __builtin_amdgcn_logf(x); }
DI float fast_rcp(float x) { return __builtin_amdgcn_rcpf(x); }
DI float sigmoidf_(float x) { return fast_rcp(1.0f + fast_exp2(-x * LOG2E)); }
template <int CTRL, int ROWMASK> DI float dpp_f(float v, float fill) { return __uint_as_float((unsigned)__builtin_amdgcn_update_dpp((int)__float_as_uint(fill), (int)__float_as_uint(v), CTRL, ROWMASK, 0xf, false)); }
DI float wave_sum(float v) {
    v += dpp_f<0x111, 0xf>(v, 0.f); v += dpp_f<0x112, 0xf>(v, 0.f); v += dpp_f<0x114, 0xf>(v, 0.f); v += dpp_f<0x118, 0xf>(v, 0.f);
    v += dpp_f<0x142, 0xa>(v, 0.f); v += dpp_f<0x143, 0xc>(v, 0.f);
    return __uint_as_float(__builtin_amdgcn_readlane(__float_as_uint(v), 63));
}
DI float wave_max(float v) {
#pragma unroll
    for (int o = 1; o < 64; o <<= 1) v = fmaxf(v, __shfl_xor(v, o));
    return v;
}
#define LDS_WAIT() asm volatile("s_waitcnt lgkmcnt(0)" ::: "memory")
#define VM_WAIT() asm volatile("s_waitcnt vmcnt(0)" ::: "memory")

namespace pg8 {
constexpr int BM = 256, BK = 64, HALF = 128, HTB = HALF * BK * 2, STAGE_BYTES = 8 * HTB, NXCD = 8, WGM = 8;
__host__ __device__ __forceinline__ int lds_byte(int r, int c) { const int st = (r >> 4) * 2 + (c >> 5), rr = r & 15, cc = c & 31, ob = rr * 64 + cc * 2; return st * 1024 + (ob ^ (((ob >> 9) & 1) << 5)); }
__host__ __device__ __forceinline__ void stage_rc(int b, int& R, int& C) { const int st = b / 1024, sb = b % 1024, swz = sb ^ (((sb >> 9) & 1) << 5); R = (st >> 1) * 16 + swz / 64; C = (st & 1) * 32 + (swz % 64) / 2; }
__host__ __device__ __forceinline__ int perm32(int rho) { const int n = rho >> 4, i = rho & 15; return 8 * (i >> 2) + 4 * n + (i & 3); }

struct Unit { int pm, pn, e, ui; const char* A; const char* B; };

typedef float f32x2v __attribute__((ext_vector_type(2)));
DI f32x2v gelu_pk(f32x2v v) {
    const f32x2v av = __builtin_elementwise_abs(v), d = av * 0.2316418882f + 1.0f;
    f32x2v t; t.x = __builtin_amdgcn_rcpf(d.x); t.y = __builtin_amdgcn_rcpf(d.y);
    f32x2v q = t * 0.5307027145f + (-0.7265760135f); q = q * t + 0.7107068705f; q = q * t + (-0.142248368f); q = q * t + 0.127414796f; q = q * t;
    const f32x2v s = (v * v) * (-0.72134752044f);
    f32x2v e; e.x = __builtin_amdgcn_exp2f(s.x); e.y = __builtin_amdgcn_exp2f(s.y);
    const f32x2v m = v * (q * e), r = v - m;
    f32x2v o; o.x = v.x < 0.f ? m.x : r.x; o.y = v.y < 0.f ? m.y : r.y; return o;
}
DI f32x4 gelu4(f32x4 v) { const f32x2v a = gelu_pk((f32x2v){v[0], v[1]}), b = gelu_pk((f32x2v){v[2], v[3]}); return (f32x4){a.x, a.y, b.x, b.y}; }
DI f32x4 sigmoid4(f32x4 v) { return (f32x4){sigmoidf_(v[0]), sigmoidf_(v[1]), sigmoidf_(v[2]), sigmoidf_(v[3])}; }
DI u32x4 pack8(f32x4 v0, f32x4 v1) { u32x4 w; w.x = cvt_pk_bf16(v0[0], v0[1]); w.y = cvt_pk_bf16(v0[2], v0[3]); w.z = cvt_pk_bf16(v1[0], v1[1]); w.w = cvt_pk_bf16(v1[2], v1[3]); return w; }

template <class Epi, class Sched, bool ALIGN_EPI>
DI void gemm_phase(LAS unsigned char* lds, const int K, const Sched& S, const Epi& E) {
    const int tid = threadIdx.x, wid = __builtin_amdgcn_readfirstlane(tid >> 6), lane = tid & 63, wr = wid >> 2, wc = wid & 3, fr = lane & 15, fq = lane >> 4;
    const int nt = K / BK;
    int Rr[2], Cc[2]; unsigned voffB[2], voffB1[2];
#pragma unroll
    for (int i = 0; i < 2; ++i) { int R, C; stage_rc(tid * 16 + i * 8192, R, C); Rr[i] = R; Cc[i] = C;
        if (Epi::PERM == 2) { const int w0 = 64 * (R >> 5) + 16 * ((R & 15) >> 2) + 4 * ((R >> 4) & 1) + (R & 3); voffB[i] = (unsigned)(w0 * K + C) * 2u; voffB1[i] = (unsigned)((w0 + 8) * K + C) * 2u; }
        else { const int Rb = Epi::PERM ? ((R & ~31) + perm32(R & 31)) : R; voffB[i] = (unsigned)(Rb * K + C) * 2u; voffB1[i] = (unsigned)((Rb + HALF) * K + C) * 2u; } }
    const size_t kstep = (size_t)(BK * 2);
    const unsigned ldsw = (unsigned)wid * 1024u;
    const int aoff = lds_byte(wr * 64 + fr, fq * 8), boff = lds_byte(wc * 32 + fr, fq * 8);
#define PG8_SA(b, h) (((b) * 2 + (h)) * HTB)
#define PG8_SB(b, h) ((4 + (b) * 2 + (h)) * HTB)
#define PG8_STAGE_B(bufoff, gbase) do { _Pragma("unroll") for (int _i = 0; _i < 2; ++_i) \
        __builtin_amdgcn_global_load_lds((const unsigned*)((const char*)(gbase) + voffB[_i]), (LAS unsigned*)(lds + (bufoff) + ldsw + _i * 8192), 16, 0, 0); } while (0)
#define PG8_STAGE_B1(bufoff, gbase) do { _Pragma("unroll") for (int _i = 0; _i < 2; ++_i) \
        __builtin_amdgcn_global_load_lds((const unsigned*)((const char*)(gbase) + voffB1[_i]), (LAS unsigned*)(lds + (bufoff) + ldsw + _i * 8192), 16, 0, 0); } while (0)
#define PG8_STAGE_A(bufoff, gbase, o0, o1) do { \
        __builtin_amdgcn_global_load_lds((const unsigned*)((const char*)(gbase) + (o0)), (LAS unsigned*)(lds + (bufoff) + ldsw), 16, 0, 0); \
        __builtin_amdgcn_global_load_lds((const unsigned*)((const char*)(gbase) + (o1)), (LAS unsigned*)(lds + (bufoff) + ldsw + 8192), 16, 0, 0); } while (0)
#define PG8_LDA(dst, b, h) do { _Pragma("unroll") for (int m = 0; m < 4; ++m) _Pragma("unroll") for (int k = 0; k < 2; ++k) dst[m][k] = *(const LAS bf16x8*)(lds + PG8_SA(b, h) + aoff + m * 2048 + k * 1024); } while (0)
#define PG8_LDB(dst, b, h) do { _Pragma("unroll") for (int n = 0; n < 2; ++n) _Pragma("unroll") for (int k = 0; k < 2; ++k) dst[n][k] = *(const LAS bf16x8*)(lds + PG8_SB(b, h) + boff + n * 2048 + k * 1024); } while (0)
#define PG8_MMA(ai, bj, At, Bt) do { __builtin_amdgcn_s_setprio(1); _Pragma("unroll") for (int m = 0; m < 4; ++m) _Pragma("unroll") for (int n = 0; n < 2; ++n) _Pragma("unroll") for (int k = 0; k < 2; ++k) \
        acc[ai][bj][m][n] = __builtin_amdgcn_mfma_f32_16x16x32_bf16(Bt[n][k], At[m][k], acc[ai][bj][m][n], 0, 0, 0); __builtin_amdgcn_s_setprio(0); } while (0)
#define PG8_WAIT_V(n) asm volatile("s_waitcnt vmcnt(" #n ")" ::: "memory")
#define PG8_WAIT_L(n) asm volatile("s_waitcnt lgkmcnt(" #n ")" ::: "memory")
#define PG8_BAR __builtin_amdgcn_s_barrier()
#define PG8_SCHED __builtin_amdgcn_sched_barrier(0)
    Unit cur, nxt; int ui = 0;
    if (!S.next(0, cur)) return;
    unsigned oc[2][2], on[2][2];
    S.a_offs(cur, Rr, Cc, K, oc);
    f32x4 acc[2][2][4][2];
#pragma unroll
    for (int a = 0; a < 2; ++a)
#pragma unroll
        for (int b = 0; b < 2; ++b)
#pragma unroll
            for (int m = 0; m < 4; ++m)
#pragma unroll
                for (int n = 0; n < 2; ++n) acc[a][b][m][n] = (f32x4){0.f, 0.f, 0.f, 0.f};
    bf16x8 At[4][2], B0[2][2], B1[2][2];
    const char* cA = cur.A; const char* cB = cur.B;
    PG8_STAGE_B(PG8_SB(0, 0), cB); PG8_STAGE_B1(PG8_SB(0, 1), cB); PG8_STAGE_A(PG8_SA(0, 0), cA, oc[0][0], oc[0][1]); PG8_STAGE_A(PG8_SA(0, 1), cA, oc[1][0], oc[1][1]);
    if (wr == 1) PG8_BAR;
    PG8_WAIT_V(2); PG8_BAR;
    PG8_STAGE_B(PG8_SB(1, 0), cB + kstep); PG8_STAGE_A(PG8_SA(1, 0), cA + kstep, oc[0][0], oc[0][1]); PG8_STAGE_B1(PG8_SB(1, 1), cB + kstep);
    PG8_WAIT_V(6); PG8_BAR;
    for (;;) {
        const bool has_next = S.next(ui + 1, nxt);
        const char* nA = has_next ? nxt.A : cA; const char* nB = has_next ? nxt.B : cB;
        if (has_next) S.a_offs(nxt, Rr, Cc, K, on);
        else {
#pragma unroll
            for (int h = 0; h < 2; ++h)
#pragma unroll
                for (int i = 0; i < 2; ++i) on[h][i] = oc[h][i]; }
#pragma unroll 1
        for (int t = 0; t < nt; t += 2) {
            const bool last = (t == nt - 2);
            const char* a1 = cA + (size_t)(t + 1) * kstep;
            const char* a2 = last ? nA : cA + (size_t)(t + 2) * kstep; const char* b2 = last ? nB : cB + (size_t)(t + 2) * kstep;
            const char* a3 = a2 + kstep; const char* b3 = b2 + kstep;
            const unsigned x00 = last ? on[0][0] : oc[0][0], x01 = last ? on[0][1] : oc[0][1], x10 = last ? on[1][0] : oc[1][0], x11 = last ? on[1][1] : oc[1][1];
            PG8_LDB(B0, 0, 0); PG8_LDB(B1, 0, 1); PG8_SCHED; PG8_LDA(At, 0, 0); PG8_STAGE_A(PG8_SA(1, 1), a1, oc[1][0], oc[1][1]);
            PG8_WAIT_V(8); PG8_WAIT_L(0); PG8_BAR; PG8_MMA(0, 0, At, B0); PG8_MMA(0, 1, At, B1); PG8_BAR; PG8_SCHED;
            PG8_LDA(At, 0, 1); PG8_STAGE_B(PG8_SB(0, 0), b2); PG8_STAGE_B1(PG8_SB(0, 1), b2); PG8_STAGE_A(PG8_SA(0, 0), a2, x00, x01);
            PG8_WAIT_V(8); PG8_WAIT_L(0); PG8_BAR; PG8_MMA(1, 0, At, B0); PG8_MMA(1, 1, At, B1); PG8_BAR; PG8_SCHED;
            PG8_LDB(B0, 1, 0); PG8_LDB(B1, 1, 1); PG8_SCHED; PG8_LDA(At, 1, 0); PG8_STAGE_A(PG8_SA(0, 1), a2, x10, x11);
            PG8_WAIT_V(8); PG8_WAIT_L(0); PG8_BAR; PG8_MMA(0, 0, At, B0); PG8_MMA(0, 1, At, B1); PG8_BAR; PG8_SCHED;
            PG8_LDA(At, 1, 1); PG8_STAGE_B(PG8_SB(1, 0), b3); PG8_STAGE_B1(PG8_SB(1, 1), b3); PG8_STAGE_A(PG8_SA(1, 0), a3, x00, x01);
            PG8_WAIT_V(8); PG8_WAIT_L(0); PG8_BAR; PG8_MMA(1, 0, At, B0); PG8_MMA(1, 1, At, B1); PG8_BAR; PG8_SCHED;
        }
        if constexpr (ALIGN_EPI) { if (wr == 0) PG8_BAR; }
        E(acc, cur, wr, wc, fr, fq);
        if (!has_next) break;
#pragma unroll
        for (int a = 0; a < 2; ++a)
#pragma unroll
            for (int b = 0; b < 2; ++b)
#pragma unroll
                for (int m = 0; m < 4; ++m)
#pragma unroll
                    for (int n = 0; n < 2; ++n) acc[a][b][m][n] = (f32x4){0.f, 0.f, 0.f, 0.f};
        cur = nxt; cA = nA; cB = nB; ++ui;
#pragma unroll
        for (int h = 0; h < 2; ++h)
#pragma unroll
            for (int i = 0; i < 2; ++i) oc[h][i] = on[h][i];
        if constexpr (ALIGN_EPI) { if (wr == 1) PG8_BAR; }
    }
    PG8_WAIT_V(0);
    if constexpr (!ALIGN_EPI) { if (wr == 0) PG8_BAR; }
    PG8_BAR;
#undef PG8_SA
#undef PG8_SB
#undef PG8_STAGE_A
#undef PG8_STAGE_B
#undef PG8_STAGE_B1
#undef PG8_LDA
#undef PG8_LDB
#undef PG8_MMA
#undef PG8_WAIT_V
#undef PG8_WAIT_L
#undef PG8_BAR
#undef PG8_SCHED
}

struct DenseOrder {
    const char* A; const char* Bt; int K, nM, nN, nwg, G, c;
    DI void init(const bf16* A_, const bf16* Bt_, int M, int N, int K_, int G_, int c_) { A = (const char*)A_; Bt = (const char*)Bt_; K = K_; nM = M / BM; nN = N / BM; nwg = nM * nN; G = G_; c = c_; }
    DI bool next(int i, Unit& u) const {
        const long L = (long)i * G + c; if (L >= nwg) return false;
        int wgid = (int)L; { const int q = nwg / NXCD, r = nwg % NXCD, xcd = wgid % NXCD, off = wgid / NXCD; wgid = (xcd < r ? xcd * (q + 1) : r * (q + 1) + (xcd - r) * q) + off; }
        const int nig = WGM * nN, gid = wgid / nig, fm = gid * WGM, gsz = (nM - fm) < WGM ? (nM - fm) : WGM;
        u.pm = fm + ((wgid % nig) % gsz); u.pn = (wgid % nig) / gsz; u.e = 0; u.ui = i;
        u.A = A + (size_t)u.pm * BM * K * 2; u.B = Bt + (size_t)u.pn * BM * K * 2; return true;
    }
    DI void a_offs(const Unit&, const int (&R)[2], const int (&C)[2], int K_, unsigned (&off)[2][2]) const {
#pragma unroll
        for (int h = 0; h < 2; ++h)
#pragma unroll
            for (int i = 0; i < 2; ++i) off[h][i] = (unsigned)((h * HALF + R[i]) * K_ + C[i]) * 2u;
    }
};
}

#define XB_TMO      128
#define XB_XCNT(j)  (256  + 64 * (j))
#define XB_XSUB(j)  (1280 + 64 * (j))
#define XB_XGEN(j)  (2304 + 64 * (j))
#define XB_TOP      3328
#define XB_TOPGEN   3392
#define XCD_BAR_WORDS 3456
#define XB_SPIN_CAP (1u << 18)
DI unsigned xb_ld(unsigned* p)              { return __hip_atomic_load(p, __ATOMIC_RELAXED, __HIP_MEMORY_SCOPE_AGENT); }
DI unsigned xb_add(unsigned* p, unsigned v) { return __hip_atomic_fetch_add(p, v, __ATOMIC_RELAXED, __HIP_MEMORY_SCOPE_AGENT); }
DI unsigned xb_xcc_id() { return (unsigned)__builtin_amdgcn_s_getreg((3 << 11) | 20) & 0xFu; }
#define XB_SPIN(cond, bar) do { unsigned _sp = 0; while (cond) { __builtin_amdgcn_s_sleep(1); \
    if ((++_sp & 255u) == 0u) { if (xb_ld(&(bar)[XB_TMO])) break; if (_sp > XB_SPIN_CAP) { atomicAdd(&(bar)[XB_TMO], 1u); break; } } } } while (0)
struct XcdBarrier { unsigned* bar; unsigned x; volatile LAS unsigned* st; };
DI XcdBarrier xcd_barrier_post(unsigned* bar, volatile LAS unsigned* st) {
    XcdBarrier b; b.bar = bar; b.x = xb_xcc_id(); b.st = st;
    if (threadIdx.x == 0) (void)xb_add(&bar[XB_XCNT(b.x)], 1u);
    return b;
}
DI void xcd_barrier_complete(unsigned* bar, unsigned x, unsigned& nloc, unsigned& nx) {
    const unsigned G = gridDim.x * gridDim.y * gridDim.z;
    unsigned sum, cnt, mine, sp = 0u;
    for (;;) {
        sum = 0u; cnt = 0u; mine = 0u;
#pragma unroll
        for (unsigned j = 0; j < 16; ++j) { const unsigned c = xb_ld(&bar[XB_XCNT(j)]); sum += c; cnt += (c > 0u) ? 1u : 0u; mine = (j == x) ? c : mine; }
        if (sum == G) break;
        __builtin_amdgcn_s_sleep(1);
        if ((++sp & 255u) == 0u) { if (xb_ld(&bar[XB_TMO])) break; if (sp > XB_SPIN_CAP) { atomicAdd(&bar[XB_TMO], 1u); break; } }
    }
    nloc = mine > 0u ? mine : 1u; nx = cnt > 0u ? cnt : 1u;
}
DI void xcd_barrier(const XcdBarrier& b) {
    asm volatile("s_waitcnt vmcnt(0)" ::: "memory");
    __syncthreads();
    if (threadIdx.x == 0) {
        unsigned* bar = b.bar;
        __builtin_amdgcn_s_waitcnt(0);
        unsigned nloc = b.st[0], nx = b.st[1];
        if (nloc == 0u) { xcd_barrier_complete(bar, b.x, nloc, nx); b.st[0] = nloc; b.st[1] = nx; }
        const unsigned old = xb_add(&bar[XB_XSUB(b.x)], 1u);
        const unsigned gen = old / nloc;
        if (old + 1u == (gen + 1u) * nloc) {
            __builtin_amdgcn_fence(__ATOMIC_RELEASE, "agent");
            asm volatile("s_waitcnt vmcnt(0)" ::: "memory");
            const unsigned og = xb_add(&bar[XB_TOP], 1u);
            const unsigned tg = og / nx;
            if (og + 1u == (tg + 1u) * nx) xb_add(&bar[XB_TOPGEN], 1u);
            else XB_SPIN(xb_ld(&bar[XB_TOPGEN]) == tg, bar);
            __builtin_amdgcn_fence(__ATOMIC_ACQUIRE, "agent");
            xb_add(&bar[XB_XGEN(b.x)], 1u);
            asm volatile("s_waitcnt vmcnt(0)" ::: "memory");
        } else {
            XB_SPIN(xb_ld(&bar[XB_XGEN(b.x)]) == gen, bar);
            __builtin_amdgcn_fence(__ATOMIC_ACQUIRE, "agent");
            asm volatile("s_waitcnt vmcnt(0)" ::: "memory");
        }
    }
    __syncthreads();
}

namespace pg8 {
typedef __bf16 bf16x2_t __attribute__((ext_vector_type(2)));
DI unsigned pk2(float lo, float hi) { f32x2v v = {lo, hi}; bf16x2_t b = __builtin_convertvector(v, bf16x2_t); return __builtin_bit_cast(unsigned, b); }
DI u32x4 pk8(f32x4 v0, f32x4 v1) { u32x4 w; w.x = pk2(v0[0], v0[1]); w.y = pk2(v0[2], v0[3]); w.z = pk2(v1[0], v1[1]); w.w = pk2(v1[2], v1[3]); return w; }

DI unsigned dpp_ror8(unsigned v) { return (unsigned)__builtin_amdgcn_mov_dpp((int)v, 0x128, 0xf, 0xf, false); }
DI void store_rows16(unsigned char* rowp, size_t ldb, u32x4 P0, u32x4 P1, int fr) {
    const bool hi = fr >= 8;
    const u32x4 give = hi ? P0 : P1;
    u32x4 recv; recv.x = dpp_ror8(give.x); recv.y = dpp_ror8(give.y); recv.z = dpp_ror8(give.z); recv.w = dpp_ror8(give.w);
    unsigned char* pa = rowp + (size_t)(fr & 7) * ldb + (hi ? 16 : 0);
    *(u32x4*)pa = hi ? recv : P0;
    *(u32x4*)(pa + 8 * ldb) = hi ? P1 : recv;
}
struct EpiInProj {
    static constexpr int PERM = 2;
    bf16* P1; float* vstat; const float* bias;
    DI void operator()(const f32x4 (&acc)[2][2][4][2], const Unit& u, int wr, int wc, int fr, int fq) const {
        const int rg0 = u.pm * BM + wr * 64;
        const int bcol0 = u.pn * BM + wc * 64 + 16 * fq;
        f32x4 bv[2][2];
#pragma unroll
        for (int bj = 0; bj < 2; ++bj)
#pragma unroll
            for (int n = 0; n < 2; ++n) bv[bj][n] = *(const f32x4*)(bias + bcol0 + 8 * bj + 4 * n);
        if (u.pn < 8) {
            bf16* base = P1 + u.pn * 128 + wc * 32 + 8 * fq;
#pragma unroll
            for (int ai = 0; ai < 2; ++ai)
#pragma unroll
                for (int m = 0; m < 4; ++m) {
                    f32x4 u0 = gelu4(acc[ai][0][m][0] + bv[0][0]), u1 = gelu4(acc[ai][0][m][1] + bv[0][1]);
                    const f32x4 g0 = sigmoid4(acc[ai][1][m][0] + bv[1][0]), g1 = sigmoid4(acc[ai][1][m][1] + bv[1][1]);
                    u0 = u0 * g0; u1 = u1 * g1;
                    *(u32x4*)(base + (size_t)(rg0 + ai * HALF + m * 16 + fr) * D) = pk8(u0, u1);
                }
        } else {
            const int t = (u.pn - 8) >> 2, colt = ((u.pn - 8) & 3) * BM;
            bf16* base = P1 + (size_t)(t + 1) * T * D + colt + wc * 64 + 16 * fq;
#pragma unroll
            for (int ai = 0; ai < 2; ++ai)
#pragma unroll
                for (int m = 0; m < 4; ++m) {
                    float s1 = 0.f, s2 = 0.f; u32x4 P[2];
#pragma unroll
                    for (int bj = 0; bj < 2; ++bj) {
                        f32x4 v0 = acc[ai][bj][m][0] + bv[bj][0], v1 = acc[ai][bj][m][1] + bv[bj][1];
                        if (t == 0) { v0 = gelu4(v0); v1 = gelu4(v1);
                            s1 += (v0[0] + v0[1]) + (v0[2] + v0[3]) + (v1[0] + v1[1]) + (v1[2] + v1[3]);
                            s2 += (v0[0] * v0[0] + v0[1] * v0[1]) + (v0[2] * v0[2] + v0[3] * v0[3]) + (v1[0] * v1[0] + v1[1] * v1[1]) + (v1[2] * v1[2] + v1[3] * v1[3]); }
                        else if (t == 1) { v0 = v0 * (QSCALE * LOG2E); v1 = v1 * (QSCALE * LOG2E); }
                        else if (t == 4) { v0 = sigmoid4(v0); v1 = sigmoid4(v1); }
                        P[bj] = pk8(v0, v1);
                    }
                    store_rows16((unsigned char*)(base + (size_t)(rg0 + ai * HALF + m * 16) * D), (size_t)D * 2, P[0], P[1], fr);
                    if (t == 0) {
                        s1 += __shfl_xor(s1, 16); s1 += __shfl_xor(s1, 32); s2 += __shfl_xor(s2, 16); s2 += __shfl_xor(s2, 32);
                        if (fq == 0) *(f32x2v*)(vstat + ((size_t)(rg0 + ai * HALF + m * 16 + fr) * 16 + (u.pn - 8) * 4 + wc) * 2) = (f32x2v){s1, s2};
                    }
                }
        }
    }
};
struct EpiBf16S {
    static constexpr int PERM = 2;
    bf16* O; int ldc; float scale;
    DI void operator()(const f32x4 (&acc)[2][2][4][2], const Unit& u, int wr, int wc, int fr, int fq) const {
        const int rg0 = u.pm * BM + wr * 64, col0 = u.pn * BM + wc * 64 + 16 * fq;
#pragma unroll
        for (int ai = 0; ai < 2; ++ai)
#pragma unroll
            for (int m = 0; m < 4; ++m)
                store_rows16((unsigned char*)(O + (size_t)(rg0 + ai * HALF + m * 16) * ldc + col0), (size_t)ldc * 2,
                             pk8(acc[ai][0][m][0] * scale, acc[ai][0][m][1] * scale), pk8(acc[ai][1][m][0] * scale, acc[ai][1][m][1] * scale), fr);
    }
};
template <bool LNIN> struct EpiResF32 {
    static constexpr int PERM = 0;
    float* out; const float* res; const float* xstat; const float* g; const float* b;
    DI void operator()(const f32x4 (&acc)[2][2][4][2], const Unit& u, int wr, int wc, int fr, int fq) const {
        const int col0 = u.pn * BM + wc * 32 + 4 * fq;
        f32x4 gv[2][2], bv[2][2];
        if (LNIN) {
#pragma unroll
            for (int bj = 0; bj < 2; ++bj)
#pragma unroll
                for (int n = 0; n < 2; ++n) { gv[bj][n] = *(const f32x4*)(g + col0 + bj * HALF + n * 16); bv[bj][n] = *(const f32x4*)(b + col0 + bj * HALF + n * 16); }
        }
#pragma unroll
        for (int ai = 0; ai < 2; ++ai)
#pragma unroll
            for (int m = 0; m < 4; ++m) {
                const int rg = u.pm * BM + ai * HALF + wr * 64 + m * 16, row = rg + fr; const size_t off = (size_t)row * D + col0;
                f32x2v st = (f32x2v){0.f, 1.f}; if (LNIN) st = *(const f32x2v*)(xstat + 2 * (size_t)row);
#pragma unroll
                for (int bj = 0; bj < 2; ++bj) { f32x4 o[2];
#pragma unroll
                    for (int n = 0; n < 2; ++n) { f32x4 r = *(const f32x4*)(res + off + bj * HALF + n * 16);
                        if (LNIN) r = (r - st.x) * st.y * gv[bj][n] + bv[bj][n];
                        o[n] = r * ALPHA + acc[ai][bj][m][n]; }
                    const bool hi = fr >= 8; const f32x4 give = hi ? o[0] : o[1];
                    u32x4 gi = __builtin_bit_cast(u32x4, give), rc; rc.x = dpp_ror8(gi.x); rc.y = dpp_ror8(gi.y); rc.z = dpp_ror8(gi.z); rc.w = dpp_ror8(gi.w);
                    const f32x4 recv = __builtin_bit_cast(f32x4, rc);
                    float* pa = out + (size_t)(rg + (fr & 7)) * D + col0 + bj * HALF + (hi ? 16 : 0);
                    *(f32x4*)pa = hi ? recv : o[0];
                    *(f32x4*)(pa + 8 * D) = hi ? o[1] : recv; }
                if (m & 1) asm volatile("" ::: "memory");
            }
    }
};
template <bool LNIN> struct EpiResB16 {
    static constexpr int PERM = 2;
    bf16* out; const float* resf; const bf16* resb; const float* xstat; const float* g; const float* b;
    DI void operator()(const f32x4 (&acc)[2][2][4][2], const Unit& u, int wr, int wc, int fr, int fq) const {
        const int col0 = u.pn * BM + wc * 64 + 16 * fq;
        f32x4 gv[2][2], bv[2][2];
        if (LNIN) {
#pragma unroll
            for (int bj = 0; bj < 2; ++bj)
#pragma unroll
                for (int n = 0; n < 2; ++n) { gv[bj][n] = *(const f32x4*)(g + col0 + 8 * bj + 4 * n); bv[bj][n] = *(const f32x4*)(b + col0 + 8 * bj + 4 * n); }
        }
#pragma unroll
        for (int ai = 0; ai < 2; ++ai)
#pragma unroll
            for (int m = 0; m < 4; ++m) {
                const int rg = u.pm * BM + ai * HALF + wr * 64 + m * 16, row = rg + fr; const size_t off = (size_t)row * D + col0;
                f32x4 rr[2][2];
                if (LNIN) { const f32x2v st = *(const f32x2v*)(xstat + 2 * (size_t)row);
#pragma unroll
                    for (int bj = 0; bj < 2; ++bj)
#pragma unroll
                        for (int n = 0; n < 2; ++n) rr[bj][n] = (*(const f32x4*)(resf + off + 8 * bj + 4 * n) - st.x) * st.y * gv[bj][n] + bv[bj][n];
                } else {
#pragma unroll
                    for (int bj = 0; bj < 2; ++bj) { const u32x4 x = *(const u32x4*)(resb + off + 8 * bj);
                        rr[bj][0] = (f32x4){bflo(x.x), bfhi(x.x), bflo(x.y), bfhi(x.y)}; rr[bj][1] = (f32x4){bflo(x.z), bfhi(x.z), bflo(x.w), bfhi(x.w)}; } }
                store_rows16((unsigned char*)(out + (size_t)rg * D + col0), (size_t)D * 2,
                             pk8(rr[0][0] * ALPHA + acc[ai][0][m][0], rr[0][1] * ALPHA + acc[ai][0][m][1]), pk8(rr[1][0] * ALPHA + acc[ai][1][m][0], rr[1][1] * ALPHA + acc[ai][1][m][1]), fr);
                if (m & 1) asm volatile("" ::: "memory");
            }
    }
};
constexpr int MO_BLKE = 128 * 1024, MO_RT = MO_BLKE + 640, MO_RW = MO_RT + 5 * 1024, MO_END = MO_RW + 5 * 1024;
static_assert(MO_END <= SCR_BYTES, "MoE LDS tables");
struct EpiGateUp {
    static constexpr int PERM = 1;
    bf16* H; const LAS unsigned char* lds;
    DI void operator()(const f32x4 (&acc)[2][2][4][2], const Unit& u, int wr, int wc, int fr, int fq) const {
        const int rl = wr * 64 + fr, row0 = u.pm * BM + rl, col0 = u.pn * 128 + wc * 32 + 8 * fq;
        float wv[2][4];
#pragma unroll
        for (int ai = 0; ai < 2; ++ai)
#pragma unroll
            for (int m = 0; m < 4; ++m) wv[ai][m] = (u.e < 64) ? *(const LAS float*)(lds + MO_RW + (u.ui * 256 + rl + ai * HALF + m * 16) * 4) : 1.0f;
#pragma unroll
        for (int ai = 0; ai < 2; ++ai)
#pragma unroll
            for (int m = 0; m < 4; ++m) {
                const f32x4 g0 = acc[ai][0][m][0], g1 = acc[ai][0][m][1];
                const f32x4 h0 = g0 * sigmoid4(g0) * acc[ai][1][m][0] * wv[ai][m], h1 = g1 * sigmoid4(g1) * acc[ai][1][m][1] * wv[ai][m];
                *(u32x4*)(H + (size_t)(row0 + ai * HALF + m * 16) * EH + col0) = pk8(h0, h1);
            }
    }
};
constexpr float Y8_SCALE = 32.0f, Y8_CLAMP = 440.0f;
DI unsigned pk4_fp8(f32x4 v) { v = v * Y8_SCALE;
    const float a = __builtin_fminf(__builtin_fmaxf(v[0], -Y8_CLAMP), Y8_CLAMP), b = __builtin_fminf(__builtin_fmaxf(v[1], -Y8_CLAMP), Y8_CLAMP), c = __builtin_fminf(__builtin_fmaxf(v[2], -Y8_CLAMP), Y8_CLAMP), d = __builtin_fminf(__builtin_fmaxf(v[3], -Y8_CLAMP), Y8_CLAMP);
    int p = __builtin_amdgcn_cvt_pk_fp8_f32(a, b, 0, false); p = __builtin_amdgcn_cvt_pk_fp8_f32(c, d, p, true); return (unsigned)p; }
struct EpiDown {
    static constexpr int PERM = 2;
    unsigned char* Y8; bf16* xb; int nostore;
    DI void operator()(const f32x4 (&acc)[2][2][4][2], const Unit& u, int wr, int wc, int fr, int fq) const {
        if (nostore) return;
        const int rl = wr * 64 + fr, col0 = u.pn * BM + wc * 64 + 16 * fq;
        if (u.e < 64) {
#pragma unroll
            for (int ai = 0; ai < 2; ++ai)
#pragma unroll
                for (int m = 0; m < 4; ++m) { const int r = rl + ai * HALF + m * 16;
                    u32x4 w; w.x = pk4_fp8(acc[ai][0][m][0]); w.y = pk4_fp8(acc[ai][0][m][1]); w.z = pk4_fp8(acc[ai][1][m][0]); w.w = pk4_fp8(acc[ai][1][m][1]);
                    __builtin_nontemporal_store(w, (u32x4*)(Y8 + ((size_t)u.pm * BM + r) * D + col0)); }
        } else {
#pragma unroll
            for (int ai = 0; ai < 2; ++ai) {
                u32x4 xr[4][2];
#pragma unroll
                for (int m = 0; m < 4; ++m)
#pragma unroll
                    for (int bj = 0; bj < 2; ++bj) xr[m][bj] = *(const u32x4*)(xb + ((size_t)(u.pm - SH_ROW0 / BM) * BM + rl + ai * HALF + m * 16) * D + col0 + 8 * bj);
#pragma unroll
                for (int m = 0; m < 4; ++m) { const size_t off = ((size_t)(u.pm - SH_ROW0 / BM) * BM + rl + ai * HALF + m * 16) * D + col0;
#pragma unroll
                    for (int bj = 0; bj < 2; ++bj) { const u32x4 x = xr[m][bj];
                        const f32x4 x0 = (f32x4){bflo(x.x), bfhi(x.x), bflo(x.y), bfhi(x.y)}, x1 = (f32x4){bflo(x.z), bfhi(x.z), bflo(x.w), bfhi(x.w)};
                        *(u32x4*)(xb + off + 8 * bj) = pk8(x0 * ALPHA + acc[ai][bj][m][0], x1 * ALPHA + acc[ai][bj][m][1]); } }
                asm volatile("" ::: "memory"); }
        }
    }
};
struct GateUpOrder {
    const char* X; const char* Wgu; const char* Wgus; const LAS unsigned char* lds; int nblk, G, c;
    DI bool next(int i, Unit& u) const {
        const int L = i * G + c; if (L >= (nblk + 64) * 2) return false;
        const int bl = L >> 1; u.pn = L & 1; u.ui = i;
        if (bl < nblk) { u.e = (int)__builtin_amdgcn_readfirstlane((int)*(const LAS unsigned char*)(lds + MO_BLKE + bl)); u.pm = bl; u.A = X; u.B = Wgu + ((size_t)u.e * 512 + u.pn * 256) * D * 2; }
        else { u.e = 64; u.pm = SH_ROW0 / BM + (bl - nblk); u.A = X + (size_t)(bl - nblk) * BM * D * 2; u.B = Wgus + (size_t)u.pn * 256 * D * 2; }
        return true;
    }
    DI void a_offs(const Unit& u, const int (&R)[2], const int (&C)[2], int K_, unsigned (&off)[2][2]) const {
        if (u.e < 64) {
#pragma unroll
            for (int h = 0; h < 2; ++h)
#pragma unroll
                for (int i = 0; i < 2; ++i) { const int tok = *(const LAS int*)(lds + MO_RT + (u.ui * 256 + h * HALF + R[i]) * 4); off[h][i] = (unsigned)(tok * K_ + C[i]) * 2u; }
        } else {
#pragma unroll
            for (int h = 0; h < 2; ++h)
#pragma unroll
                for (int i = 0; i < 2; ++i) off[h][i] = (unsigned)((h * HALF + R[i]) * K_ + C[i]) * 2u;
        }
    }
};
struct DownOrder {
    const char* H; const char* Wd; const char* Wds; const LAS unsigned char* lds; int lo, hi, nsh, G, c, hot;
    DI bool next(int i, Unit& u) const {
        const int L = i * G + c; if (L >= (hi - lo + nsh) * 4) return false;
        int bl = lo + (L >> 2); u.pn = L & 3; u.ui = i; if (hot) bl = lo + ((L >> 2) & 7);
        if (bl < hi) { u.e = (int)__builtin_amdgcn_readfirstlane((int)*(const LAS unsigned char*)(lds + MO_BLKE + bl)); u.pm = bl; u.B = Wd + ((size_t)u.e * D + u.pn * 256) * EH * 2; }
        else { u.e = 64; u.pm = SH_ROW0 / BM + (bl - hi); u.B = Wds + (size_t)u.pn * 256 * EH * 2; }
        u.A = H + (size_t)u.pm * BM * EH * 2;
        return true;
    }
    DI void a_offs(const Unit&, const int (&R)[2], const int (&C)[2], int K_, unsigned (&off)[2][2]) const {
#pragma unroll
        for (int h = 0; h < 2; ++h)
#pragma unroll
            for (int i = 0; i < 2; ++i) off[h][i] = (unsigned)((h * HALF + R[i]) * K_ + C[i]) * 2u;
    }
};
DI void moe_tables(LAS unsigned char* lds, const unsigned* blke, int nblk, const int* rowtok, const float* roww, bool gateup, int G, int c, int tid) {
    for (int b = tid; b < nblk; b += NTHREADS) *(LAS unsigned char*)(lds + MO_BLKE + b) = (unsigned char)__hip_atomic_load(blke + b, RLX_AGENT);
    if (gateup) {
#pragma unroll
        for (int i = 0; i < 5; ++i) { const int L = i * G + c, bl = L >> 1;
            if (bl < nblk && tid < 256) { *(LAS int*)(lds + MO_RT + (i * 256 + tid) * 4) = __hip_atomic_load(rowtok + (size_t)bl * 256 + tid, RLX_AGENT);
                                          *(LAS float*)(lds + MO_RW + (i * 256 + tid) * 4) = __hip_atomic_load(roww + (size_t)bl * 256 + tid, RLX_AGENT); } }
    }
    __syncthreads();
}
}

struct Frame {
    LAS unsigned char* lds;
    unsigned* ctl;
    unsigned char* ws; float* out;
    int tid, lane, wave, vcu, G;
};
DI unsigned short f2bf1(float x) { return (unsigned short)(pg8::pk2(x, x) & 0xffffu); }

template <class RowMap>
DI void transpose_item(const float* W, int N, bf16* WT, int Kd, RowMap rm, LAS float* scr, int kb, int nb, int lane) {
    const int k0 = 64 * kb, n0 = 32 * nb;
#pragma unroll 8
    for (int i = 0; i < 32; ++i) { const int kk = 2 * i + (lane >> 5); scr[kk * 33 + (lane & 31)] = W[(size_t)(k0 + kk) * N + n0 + (lane & 31)]; }
    LDS_WAIT(); asm volatile("" ::: "memory");
    const int c = lane & 7;
#pragma unroll
    for (int j = 0; j < 4; ++j) { const int n = (lane >> 3) + 8 * j; const LAS float* s = scr + (8 * c) * 33 + n;
        u32x4 o; o.x = pg8::pk2(s[0 * 33], s[1 * 33]); o.y = pg8::pk2(s[2 * 33], s[3 * 33]); o.z = pg8::pk2(s[4 * 33], s[5 * 33]); o.w = pg8::pk2(s[6 * 33], s[7 * 33]);
        *(u32x4*)(WT + (size_t)rm(n0 + n) * Kd + k0 + 8 * c) = o; }
    LDS_WAIT(); asm volatile("" ::: "memory");
}
struct RmIdent { int off; DI int operator()(int n) const { return off + n; } };
struct RmInProj { DI int operator()(int n) const { const int seg = n >> 10, w = n & 1023;
    return seg == 0 ? ((w >> 7) * 256 + ((w & 127) >> 3) * 16 + (w & 7)) : seg == 5 ? ((w >> 7) * 256 + ((w & 127) >> 3) * 16 + 8 + (w & 7)) : seg == 6 ? 6144 + w : 1024 + n; } };
struct RmGateUp { int up; DI int operator()(int n) const { return (n >> 7) * 256 + up * 128 + (n & 127); } };
DI int inproj_dest(int n) { return RmInProj()(n); }

struct CvtItem { const float* W; bf16* WT; int N, Kd, mode, kb, nb; };
DI CvtItem cvt_decode(const float* const* in, unsigned char* ws, int it) {
    const int e = it / 384; int r = it % 384; CvtItem c;
    if (r < 256) { const int up = r >> 7; r &= 127; c.W = in[20 + up] + (size_t)e * D * EH; c.N = EH; c.WT = (bf16*)(ws + WS_WGU) + (size_t)e * 512 * D; c.Kd = D; c.mode = up; c.kb = r >> 3; c.nb = r & 7; }
    else { r -= 256; c.W = in[22] + (size_t)e * EH * D; c.N = D; c.WT = (bf16*)(ws + WS_WD) + (size_t)e * D * EH; c.Kd = EH; c.mode = 2; c.kb = r >> 5; c.nb = r & 31; }
    return c;
}
DI void cvt_load(const CvtItem& c, int lane, f32x4 (&v)[8]) {
#pragma unroll
    for (int i = 0; i < 8; ++i) v[i] = __builtin_nontemporal_load((const f32x4*)(c.W + (size_t)(64 * c.kb + (lane >> 3) + 8 * i) * c.N + 32 * c.nb + 4 * (lane & 7)));
}
DI void cvt_finish(const CvtItem& c, int lane, const f32x4 (&v)[8], LAS float* scr) {
#pragma unroll
    for (int i = 0; i < 8; ++i) { LAS float* d = scr + ((lane >> 3) + 8 * i) * 33 + 4 * (lane & 7); d[0] = v[i][0]; d[1] = v[i][1]; d[2] = v[i][2]; d[3] = v[i][3]; }
    LDS_WAIT(); asm volatile("" ::: "memory");
    const int cc = lane & 7;
#pragma unroll
    for (int j = 0; j < 4; ++j) { const int n = 32 * c.nb + (lane >> 3) + 8 * j; const LAS float* sp = scr + (8 * cc) * 33 + (lane >> 3) + 8 * j;
        const int drow = (c.mode == 2) ? n : (c.mode == 3) ? RmInProj()(n) : ((n >> 7) * 256 + c.mode * 128 + (n & 127));
        u32x4 o; o.x = pg8::pk2(sp[0 * 33], sp[1 * 33]); o.y = pg8::pk2(sp[2 * 33], sp[3 * 33]); o.z = pg8::pk2(sp[4 * 33], sp[5 * 33]); o.w = pg8::pk2(sp[6 * 33], sp[7 * 33]);
        *(u32x4*)(c.WT + (size_t)drow * c.Kd + 64 * c.kb + 8 * cc) = o; }
    LDS_WAIT(); asm volatile("" ::: "memory");
}
constexpr int P0_I_IN = 16 * (INW / 32), P0_I_OUT = 16 * 32, P0_I_Q = 16 * 16, P0_I_KV = 16 * 32, P0_I_O = 8 * 32, P0_I_SG = 16 * 8, P0_I_SD = 4 * 32;
constexpr int P0_NITEMS = P0_I_IN + P0_I_OUT + P0_I_Q + P0_I_KV + P0_I_O + 2 * P0_I_SG + P0_I_SD;
DI CvtItem p0_decode(const float* const* in, unsigned char* ws, int it) {
    int r = it; CvtItem c;
    if (r < P0_I_IN) { c.W = in[4]; c.N = INW; c.WT = (bf16*)(ws + WS_WIN); c.Kd = D; c.mode = 3; c.kb = r / (INW / 32); c.nb = r % (INW / 32); return c; } r -= P0_I_IN;
    if (r < P0_I_OUT) { c.W = in[10]; c.N = D; c.WT = (bf16*)(ws + WS_WOUT); c.Kd = D; c.mode = 2; c.kb = r / 32; c.nb = r % 32; return c; } r -= P0_I_OUT;
    if (r < P0_I_Q) { c.W = in[13]; c.N = MEMW; c.WT = (bf16*)(ws + WS_WQ); c.Kd = D; c.mode = 2; c.kb = r / 16; c.nb = r % 16; return c; } r -= P0_I_Q;
    if (r < P0_I_KV) { c.W = in[14]; c.N = 2 * MEMW; c.WT = (bf16*)(ws + WS_WKV); c.Kd = D; c.mode = 2; c.kb = r / 32; c.nb = r % 32; return c; } r -= P0_I_KV;
    if (r < P0_I_O) { c.W = in[15]; c.N = D; c.WT = (bf16*)(ws + WS_WO); c.Kd = MEMW; c.mode = 2; c.kb = r / 32; c.nb = r % 32; return c; } r -= P0_I_O;
    if (r < 2 * P0_I_SG) { const int up = r / P0_I_SG; r %= P0_I_SG; c.W = in[23 + up]; c.N = EH; c.WT = (bf16*)(ws + WS_WGUS); c.Kd = D; c.mode = up; c.kb = r / 8; c.nb = r % 8; return c; } r -= 2 * P0_I_SG;
    c.W = in[25]; c.N = D; c.WT = (bf16*)(ws + WS_WDS); c.Kd = EH; c.mode = 2; c.kb = r / 32; c.nb = r % 32; return c;
}
DI void p0_convert(Frame& F, const float* const* in) {
    LAS float* scr = (LAS float*)(F.lds + F.wave * 16384);
    const int lane = F.lane, stride = F.G * NWAVES;
    int it = F.vcu * NWAVES + F.wave;
    if (it >= P0_NITEMS) return;
    CvtItem cur = p0_decode(in, F.ws, it); f32x4 v[8]; cvt_load(cur, lane, v);
    for (;;) {
        const int nx = it + stride; const bool has = nx < P0_NITEMS;
        CvtItem nxt = cur; f32x4 vn[8];
        if (has) { nxt = p0_decode(in, F.ws, nx); cvt_load(nxt, lane, vn); }
        cvt_finish(cur, lane, v, scr);
        if (!has) break;
        cur = nxt; it = nx;
#pragma unroll
        for (int i = 0; i < 8; ++i) v[i] = vn[i];
    }
}
DI void expert_convert(Frame& F, const float* const* in, int worker, int nworkers, int item_lo, int item_hi) {
    LAS float* scr = (LAS float*)(F.lds + F.wave * 16384);
    const int lane = F.lane, stride = nworkers * NWAVES;
    int it = item_lo + worker * NWAVES + F.wave;
    if (it >= item_hi) return;
    CvtItem cur = cvt_decode(in, F.ws, it); f32x4 v[8]; cvt_load(cur, lane, v);
    for (;;) {
        const int nx = it + stride; const bool has = nx < item_hi;
        CvtItem nxt = cur; f32x4 vn[8];
        if (has) { nxt = cvt_decode(in, F.ws, nx); cvt_load(nxt, lane, vn); }
        cvt_finish(cur, lane, v, scr);
        if (!has) break;
        cur = nxt; it = nx;
#pragma unroll
        for (int i = 0; i < 8; ++i) v[i] = vn[i];
    }
}

template <bool NT = false> DI void row_stats(const float* xrow, int lane, f32x4 (&v)[4], float& mean, float& rstd) {
    const f32x4* xr = (const f32x4*)xrow + lane; float s = 0.f;
#pragma unroll
    for (int j = 0; j < 4; ++j) { v[j] = NT ? __builtin_nontemporal_load(xr + 64 * j) : xr[64 * j]; s += (v[j][0] + v[j][1]) + (v[j][2] + v[j][3]); }
    mean = wave_sum(s) * (1.f / D); float s2 = 0.f;
#pragma unroll
    for (int j = 0; j < 4; ++j) { const f32x4 d = v[j] - mean; s2 += (d[0] * d[0] + d[1] * d[1]) + (d[2] * d[2] + d[3] * d[3]); }
    rstd = 1.f / sqrtf(wave_sum(s2) * (1.f / D) + LN_EPS);
}

DI void row_stats_b16(const bf16* xrow, int lane, f32x4 (&v)[4], float& mean, float& rstd) {
    const u32x2* xr = (const u32x2*)xrow + lane; float s = 0.f;
#pragma unroll
    for (int j = 0; j < 4; ++j) { const u32x2 x = xr[64 * j]; v[j] = (f32x4){bflo(x.x), bfhi(x.x), bflo(x.y), bfhi(x.y)}; s += (v[j][0] + v[j][1]) + (v[j][2] + v[j][3]); }
    mean = wave_sum(s) * (1.f / D); float s2 = 0.f;
#pragma unroll
    for (int j = 0; j < 4; ++j) { const f32x4 d = v[j] - mean; s2 += (d[0] * d[0] + d[1] * d[1]) + (d[2] * d[2] + d[3] * d[3]); }
    rstd = 1.f / sqrtf(wave_sum(s2) * (1.f / D) + LN_EPS);
}
DI void p0_prologue(Frame& F, const float* const* in) {
    const int gw = F.vcu * NWAVES + F.wave, NGW = F.G * NWAVES, lane = F.lane;
    unsigned char* ws = F.ws;
    p0_convert(F, in);
    const int gt = F.vcu * NTHREADS + F.tid, NGT = F.G * NTHREADS;
    { const float* wr = in[18]; bf16* hi = (bf16*)(ws + WS_WRHI); bf16* lo = (bf16*)(ws + WS_WRLO);
      for (int idx = gt; idx < D * NEXP; idx += NGT) { const int k = idx >> 6, e = idx & 63; const float w = wr[idx]; const unsigned short h = f2bf1(w); hi[e * D + k] = h; lo[e * D + k] = f2bf1(w - bf2f(h)); } }
    { const float* wsp = in[8]; bf16* o = (bf16*)(ws + WS_WSP);
      for (int idx = gt; idx < 8 * 128 * 128; idx += NGT) { const int s = idx & 127, t = (idx >> 7) & 127; o[idx] = (s <= t) ? f2bf1(wsp[idx]) : (unsigned short)0; } }
    { const float* bi = in[5]; float* o = (float*)(ws + WS_BPERM);
      for (int idx = gt; idx < INW; idx += NGT) o[inproj_dest(idx)] = bi[idx]; }
    { const f32x4* m4 = (const f32x4*)in[1]; u32x2* o = (u32x2*)(ws + WS_MEMB);
      for (int idx = gt; idx < NBATCH * MEMLEN * D / 4; idx += NGT) { const f32x4 v = m4[idx]; o[idx] = (u32x2){pg8::pk2(v[0], v[1]), pg8::pk2(v[2], v[3])}; } }
    { const float* x = in[0]; const float* g = in[2]; const float* b = in[3]; bf16* X0b = (bf16*)F.out; float* xstat = (float*)(ws + WS_XSTAT);
      f32x4 gv[4], bv[4];
#pragma unroll
      for (int j = 0; j < 4; ++j) { gv[j] = ((const f32x4*)g)[lane + 64 * j]; bv[j] = ((const f32x4*)b)[lane + 64 * j]; }
      for (int m = gw; m < T; m += NGW) { f32x4 v[4]; float mean, rstd; row_stats<true>(x + (size_t)m * D, lane, v, mean, rstd);
          u32x2* o8 = (u32x2*)(X0b + (size_t)m * D) + lane;
#pragma unroll
          for (int j = 0; j < 4; ++j) { const f32x4 y = (v[j] - mean) * rstd * gv[j] + bv[j]; o8[64 * j] = (u32x2){pg8::pk2(y[0], y[1]), pg8::pk2(y[2], y[3])}; }
          if (lane == 0) *(f32x2*)(xstat + 2 * (size_t)m) = (f32x2){mean, rstd}; } }
}
constexpr int MX_BUF = 32768, MX_STAT = 4 * MX_BUF, MX_FLG = MX_STAT + 1024, MX_FLG2 = MX_FLG + 64, MX_END = MX_FLG2 + 64;
static_assert(MX_END <= SCR_BYTES, "mixer LDS");
constexpr float MX_EXIT2 = SB_EXIT * LOG2E;
typedef short v4i16_t __attribute__((ext_vector_type(4)));
DI bf16x8 mk_frag(f32x4 e0, f32x4 e1) { const u32x4 w = pg8::pk8(e0, e1); return __builtin_bit_cast(bf16x8, w); }
DI bf16x8 ld_split8(const LAS unsigned char* p) {
    const s16x4 lo = *(const LAS s16x4*)p, hi = *(const LAS s16x4*)(p + 32);
    return (bf16x8){lo[0], lo[1], lo[2], lo[3], hi[0], hi[1], hi[2], hi[3]};
}
DI void glds16(const void* gsrc, unsigned lds_dst) { unsigned keep;
    asm volatile("s_mov_b32 %0, m0\n\ts_mov_b32 m0, %2\n\ts_nop 0\n\tglobal_load_lds_dwordx4 %1, off\n\ts_mov_b32 m0, %0" : "=&s"(keep) : "v"(gsrc), "s"(lds_dst) : "memory"); }
DI void mx_dma(LAS unsigned char* buf, const bf16* src, int w, int lane) {
#pragma unroll
    for (int i = 0; i < 4; ++i) { const int pc = 4 * w + i, row = 4 * pc + (lane >> 4), cpos = lane & 15;
        glds16((const char*)src + (size_t)row * (D * 2) + ((cpos ^ (row & 15)) * 16), (unsigned)__builtin_amdgcn_readfirstlane((unsigned)(uintptr_t)(buf + pc * 1024))); }
}
DI bf16x8 mx_tr(const LAS unsigned char* buf, int sA, int sB, int d0, int r) {
    const int ra = sA + (r >> 2), rb = sB + (r >> 2), ch = (d0 >> 3) + ((r & 3) >> 1), bo = 8 * (r & 1);
    const s16x4 lo = __builtin_bit_cast(s16x4, __builtin_amdgcn_ds_read_tr16_b64_v4i16((LAS v4i16_t*)(buf + ra * 256 + ((ch ^ (ra & 15)) * 16) + bo)));
    const s16x4 hi = __builtin_bit_cast(s16x4, __builtin_amdgcn_ds_read_tr16_b64_v4i16((LAS v4i16_t*)(buf + rb * 256 + ((ch ^ (rb & 15)) * 16) + bo)));
    return (bf16x8){lo[0], lo[1], lo[2], lo[3], hi[0], hi[1], hi[2], hi[3]};
}
DI void sb_scores(const LAS unsigned char* kbuf, const bf16x8 (&qf)[4], bool diag, int tq, float carry, int r, int q, const bf16x8& UE, const bf16x8& UO, const bf16x8& ONES, bf16x8 (&af)[4], float& tot_out) {
    f32x4 z[8];
#pragma unroll
    for (int st = 0; st < 8; ++st) { z[st] = (f32x4){0.f, 0.f, 0.f, 0.f};
#pragma unroll
        for (int kk = 0; kk < 4; ++kk) { const bf16x8 kf = *(const LAS bf16x8*)(kbuf + (16 * st + r) * 256 + (((4 * kk + q) ^ r) * 16));
            z[st] = __builtin_amdgcn_mfma_f32_16x16x32_bf16(kf, qf[kk], z[st], 0, 0, 0); }
        if (st & 1) __builtin_amdgcn_sched_barrier(0); }
    f32x4 ls[8];
#pragma unroll
    for (int st = 0; st < 8; ++st)
#pragma unroll
        for (int e = 0; e < 4; ++e) { const float zz = z[st][e]; const float sp = fmaxf(zz, 0.f) + fast_log2(1.0f + fast_exp2(-fabsf(zz)));
            const bool msk = diag && (16 * st + 4 * q + e >= tq);
            ls[st][e] = msk ? 0.f : -sp; z[st][e] = msk ? -1e30f : zz - sp; }
    bf16x8 lf[4];
#pragma unroll
    for (int p = 0; p < 4; ++p) lf[p] = mk_frag(ls[2 * p], ls[2 * p + 1]);
    f32x4 tot = (f32x4){0.f, 0.f, 0.f, 0.f};
#pragma unroll
    for (int p = 0; p < 4; ++p) tot = __builtin_amdgcn_mfma_f32_16x16x32_bf16(ONES, lf[p], tot, 0, 0, 0);
#pragma unroll
    for (int p = 0; p < 4; ++p) {
        f32x4 s0 = (f32x4){0.f, 0.f, 0.f, 0.f}, s1 = (f32x4){0.f, 0.f, 0.f, 0.f};
        s0 = __builtin_amdgcn_mfma_f32_16x16x32_bf16(UE, lf[p], s0, 0, 0, 0);
        s1 = __builtin_amdgcn_mfma_f32_16x16x32_bf16(UO, lf[p], s1, 0, 0, 0);
#pragma unroll
        for (int p2 = p + 1; p2 < 4; ++p2) { s0 = __builtin_amdgcn_mfma_f32_16x16x32_bf16(ONES, lf[p2], s0, 0, 0, 0); s1 = __builtin_amdgcn_mfma_f32_16x16x32_bf16(ONES, lf[p2], s1, 0, 0, 0); }
        f32x4 a0, a1;
#pragma unroll
        for (int e = 0; e < 4; ++e) { a0[e] = fast_exp2(z[2 * p][e] + s0[e] + carry); a1[e] = fast_exp2(z[2 * p + 1][e] + s1[e] + carry); }
        af[p] = mk_frag(a0, a1);
    }
    tot_out = tot[0];
}
DI void sb_pv(const LAS unsigned char* vbuf, const bf16x8 (&af)[4], f32x4 (&yb)[8], int r, int q) {
#pragma unroll
    for (int dt = 0; dt < 8; ++dt)
#pragma unroll
        for (int p = 0; p < 4; ++p) { const bf16x8 vf = mx_tr(vbuf, 32 * p + 4 * q, 32 * p + 16 + 4 * q, 16 * dt, r);
            yb[dt] = __builtin_amdgcn_mfma_f32_16x16x32_bf16(vf, af[p], yb[dt], 0, 0, 0);
            if (p == 3 && (dt & 1)) __builtin_amdgcn_sched_barrier(0); }
}
#define MX_WAIT_BAR(n) asm volatile("s_waitcnt vmcnt(" #n ") lgkmcnt(0)\n\ts_barrier" ::: "memory")
DI void mix_phase(Frame& F, const float* const* in) {
    LAS unsigned char* lds = F.lds; unsigned char* ws = F.ws;
    const int tid = F.tid, lane = F.lane, w = F.wave, r = lane & 15, q = lane >> 4;
    const bf16* UG = (const bf16*)(ws + WS_UG); const bf16* VA = (const bf16*)(ws + WS_VA); const bf16* Qg = (const bf16*)(ws + WS_Q);
    const bf16* Kg = (const bf16*)(ws + WS_K); const bf16* Vg = (const bf16*)(ws + WS_V); const bf16* GB = (const bf16*)(ws + WS_GB);
    const float* vstat = (const float*)(ws + WS_VSTAT); const bf16* WSP = (const bf16*)(ws + WS_WSP); bf16* MG = (bf16*)(ws + WS_MERGED);
    const float* lnvg = in[6]; const float* lnvb = in[7]; const float* bsp = in[9];
    LAS unsigned char* B0 = lds; LAS unsigned char* B1 = lds + MX_BUF; LAS unsigned char* B2 = lds + 2 * MX_BUF; LAS unsigned char* B3 = lds + 3 * MX_BUF;
    bf16x8 UE, UO, ONES;
#pragma unroll
    for (int jj = 0; jj < 8; ++jj) { ONES[jj] = (short)0x3F80;
        UE[jj] = (jj < 4) ? ((4 * q + jj > r) ? (short)0x3F80 : (short)0) : (short)0x3F80;
        UO[jj] = (jj < 4) ? (short)0 : ((4 * q + jj - 4 > r) ? (short)0x3F80 : (short)0); }
    const int NU = NBATCH * 16 * 8;
    int un = F.vcu;
    if (un >= NU) return;
#define MX_DEC(u_, b_, i_, j_) const int j_ = (u_) & 7, i_ = ((u_) >> 3) & 15, b_ = (u_) >> 7
    bf16x8 qf[4];
    { MX_DEC(un, b, i, j); const int ip = i > 0 ? i - 1 : 0;
      mx_dma(B0, Kg + (size_t)(b * SEQ + 128 * i) * D + 128 * j, w, lane);
      mx_dma(B2, Kg + (size_t)(b * SEQ + 128 * ip) * D + 128 * j, w, lane);
      mx_dma(B3, Vg + (size_t)(b * SEQ + 128 * ip) * D + 128 * j, w, lane);
#pragma unroll
      for (int kk = 0; kk < 4; ++kk) qf[kk] = *(const bf16x8*)(Qg + (size_t)(b * SEQ + 128 * i + 16 * w + r) * D + 128 * j + 32 * kk + 8 * q); }
    for (; un < NU; un += F.G) {
        MX_DEC(un, b, i, j);
        const int t0 = b * SEQ + 128 * i, c0 = 128 * j, tq = 16 * w + r;
        const int unn = (un + F.G < NU) ? un + F.G : un;
        MX_DEC(unn, bn, in_, jn); const int ipn = in_ > 0 ? in_ - 1 : 0;
        f32x4 yb[8];
#pragma unroll
        for (int dt = 0; dt < 8; ++dt) yb[dt] = (f32x4){0.f, 0.f, 0.f, 0.f};
        float carry = 0.f, tot; bf16x8 af[4];
        MX_WAIT_BAR(0);
        asm volatile("" : "+v"(qf[0]), "+v"(qf[1]), "+v"(qf[2]), "+v"(qf[3]));
        mx_dma(B1, Vg + (size_t)t0 * D + c0, w, lane);
        sb_scores(B0, qf, true, tq, 0.f, r, q, UE, UO, ONES, af, tot);
        MX_WAIT_BAR(0);
        mx_dma(B0, Kg + (size_t)(bn * SEQ + 128 * in_) * D + 128 * jn, w, lane);
        sb_pv(B1, af, yb, r, q);
        carry += tot;
        MX_WAIT_BAR(4);
        mx_dma(B1, VA + (size_t)t0 * D + c0, w, lane);
        const bool wlive = (i > 0) && (wave_max(carry) >= MX_EXIT2);
        if (wlive) { sb_scores(B2, qf, false, tq, carry, r, q, UE, UO, ONES, af, tot);
            const float wm = wave_max(carry + tot); if (lane == 0) *(LAS float*)(lds + MX_FLG + w * 4) = wm; }
        else if (i > 0) { if (lane == 0) *(LAS float*)(lds + MX_FLG + w * 4) = -1e30f; }
        MX_WAIT_BAR(4);
        mx_dma(B2, Kg + (size_t)(bn * SEQ + 128 * ipn) * D + 128 * jn, w, lane);
        if (wlive) { sb_pv(B3, af, yb, r, q); carry += tot; }
        if (i > 1) {
            float gm = -1e30f;
#pragma unroll
            for (int k = 0; k < 8; ++k) gm = fmaxf(gm, *(const LAS float*)(lds + MX_FLG + k * 4));
            if (gm >= MX_EXIT2) {
                for (int kb = i - 2; kb >= 0; --kb) {
                    MX_WAIT_BAR(0);
                    mx_dma(B2, Kg + (size_t)(b * SEQ + 128 * kb) * D + c0, w, lane); mx_dma(B3, Vg + (size_t)(b * SEQ + 128 * kb) * D + c0, w, lane);
                    MX_WAIT_BAR(0);
                    if (wave_max(carry) >= MX_EXIT2) { sb_scores(B2, qf, false, tq, carry, r, q, UE, UO, ONES, af, tot); sb_pv(B3, af, yb, r, q); carry += tot; }
                    const float wm = wave_max(carry); if (lane == 0) *(LAS float*)(lds + MX_FLG2 + w * 4) = wm;
                    MX_WAIT_BAR(0);
                    float g2 = -1e30f;
#pragma unroll
                    for (int k = 0; k < 8; ++k) g2 = fmaxf(g2, *(const LAS float*)(lds + MX_FLG2 + k * 4));
                    if (g2 < MX_EXIT2) break;
                }
                MX_WAIT_BAR(0);
                mx_dma(B2, Kg + (size_t)(bn * SEQ + 128 * ipn) * D + 128 * jn, w, lane);
            }
        }
        { f32x2 sp4[4];
#pragma unroll
          for (int k = 0; k < 4; ++k) sp4[k] = *((const f32x2*)vstat + (size_t)(t0 + (tid >> 2)) * 16 + 4 * (tid & 3) + k);
          float s1 = (sp4[0][0] + sp4[1][0]) + (sp4[2][0] + sp4[3][0]), s2 = (sp4[0][1] + sp4[1][1]) + (sp4[2][1] + sp4[3][1]);
          s1 += __shfl_xor(s1, 1); s1 += __shfl_xor(s1, 2); s2 += __shfl_xor(s2, 1); s2 += __shfl_xor(s2, 2);
          const float mean = s1 * (1.f / D), var = s2 * (1.f / D) - mean * mean;
          if ((tid & 3) == 0) *(LAS f32x2*)(lds + MX_STAT + (tid >> 2) * 8) = (f32x2){mean, 1.f / sqrtf(fmaxf(var, 0.f) + LN_EPS)}; }
        MX_WAIT_BAR(4);
        mx_dma(B3, Vg + (size_t)(bn * SEQ + 128 * ipn) * D + 128 * jn, w, lane);
        bf16x8 qn[4];
#pragma unroll
        for (int kk = 0; kk < 4; ++kk) qn[kk] = *(const bf16x8*)(Qg + (size_t)(bn * SEQ + 128 * in_ + 16 * w + r) * D + 128 * jn + 32 * kk + 8 * q);
        {
          f32x4 ya[8];
#pragma unroll
          for (int dt = 0; dt < 8; ++dt) ya[dt] = (f32x4){0.f, 0.f, 0.f, 0.f};
          float c1 = 0.f, c2 = 0.f;
          const int nks = (w >> 1) + 1;
          for (int ks = 0; ks < nks; ++ks) {
              const u32x4 wr4 = *(const u32x4*)(WSP + ((size_t)j * 128 + tq) * 128 + 32 * ks + 8 * q);
              float wv[8] = {bflo(wr4.x), bfhi(wr4.x), bflo(wr4.y), bfhi(wr4.y), bflo(wr4.z), bfhi(wr4.z), bflo(wr4.w), bfhi(wr4.w)}; float wp[8];
#pragma unroll
              for (int e = 0; e < 8; ++e) { const f32x2 st = *(const LAS f32x2*)(lds + MX_STAT + (32 * ks + 8 * q + e) * 8); wp[e] = wv[e] * st[1]; c2 += wv[e]; }
              const u32x4 wq = pg8::pk8((f32x4){wp[0], wp[1], wp[2], wp[3]}, (f32x4){wp[4], wp[5], wp[6], wp[7]});
              const float wb[8] = {bflo(wq.x), bfhi(wq.x), bflo(wq.y), bfhi(wq.y), bflo(wq.z), bfhi(wq.z), bflo(wq.w), bfhi(wq.w)};
#pragma unroll
              for (int e = 0; e < 8; ++e) { const f32x2 st = *(const LAS f32x2*)(lds + MX_STAT + (32 * ks + 8 * q + e) * 8); c1 += wb[e] * st[0]; }
              const bf16x8 wf = __builtin_bit_cast(bf16x8, wq);
#pragma unroll
              for (int dt = 0; dt < 8; ++dt) { const bf16x8 vf = mx_tr(B1, 32 * ks + 8 * q, 32 * ks + 8 * q + 4, 16 * dt, r);
                  ya[dt] = __builtin_amdgcn_mfma_f32_16x16x32_bf16(vf, wf, ya[dt], 0, 0, 0); }
          }
          c1 += __shfl_xor(c1, 16); c1 += __shfl_xor(c1, 32); c2 += __shfl_xor(c2, 16); c2 += __shfl_xor(c2, 32);
          const float bs = bsp[j * 128 + tq]; const size_t rowoff = (size_t)(t0 + tq) * D + c0 + 4 * q;
#pragma unroll
          for (int dt = 0; dt < 8; ++dt) { const u32x2 ug = *(const u32x2*)(UG + rowoff + 16 * dt), gb = *(const u32x2*)(GB + rowoff + 16 * dt);
              const f32x4 g4 = *(const f32x4*)(lnvg + c0 + 16 * dt + 4 * q), b4 = *(const f32x4*)(lnvb + c0 + 16 * dt + 4 * q);
              const f32x4 u4 = (f32x4){bflo(ug.x), bfhi(ug.x), bflo(ug.y), bfhi(ug.y)}, gq = (f32x4){bflo(gb.x), bfhi(gb.x), bflo(gb.y), bfhi(gb.y)};
              const f32x4 mixed = g4 * (ya[dt] - c1) + b4 * c2 + bs;
              const f32x4 o = u4 * mixed + gq * yb[dt];
              *(u32x2*)(MG + rowoff + 16 * dt) = (u32x2){pg8::pk2(o[0], o[1]), pg8::pk2(o[2], o[3])}; } }
#pragma unroll
        for (int kk = 0; kk < 4; ++kk) qf[kk] = qn[kk];
    }
    MX_WAIT_BAR(0);
#undef MX_DEC
}
#undef MX_WAIT_BAR

DI void ln1_phase(Frame& F, const float* const* in) {
    const int gw = F.vcu * NWAVES + F.wave, NGW = F.G * NWAVES, lane = F.lane;
    const bf16* Y1 = (const bf16*)(F.ws + WS_Y1); bf16* X1b = (bf16*)(F.ws + WS_X1B);
    f32x4 gv[4], bv[4];
#pragma unroll
    for (int j = 0; j < 4; ++j) { gv[j] = ((const f32x4*)in[11])[lane + 64 * j]; bv[j] = ((const f32x4*)in[12])[lane + 64 * j]; }
    for (int m = gw; m < T; m += NGW) { f32x4 v[4]; float mean, rstd; row_stats_b16(Y1 + (size_t)m * D, lane, v, mean, rstd);
        u32x2* ob = (u32x2*)(X1b + (size_t)m * D) + lane;
#pragma unroll
        for (int j = 0; j < 4; ++j) { const f32x4 y = (v[j] - mean) * rstd * gv[j] + bv[j]; ob[64 * j] = (u32x2){pg8::pk2(y[0], y[1]), pg8::pk2(y[2], y[3])}; } }
}

DI void memattn_phase(Frame& F, int first, int stride) {
    LAS unsigned char* lds = F.lds; unsigned char* ws = F.ws;
    const int lane = F.lane, w = F.wave, r = lane & 15, q = lane >> 4;
    const bf16* Qm = (const bf16*)(ws + WS_QM); const bf16* KV = (const bf16*)(ws + WS_KVM); bf16* Om = (bf16*)(ws + WS_OM);
    for (int su = first; su < NBATCH * 4 * 8; su += stride) {
        const int qc = su & 7, h = (su >> 3) & 3, b = su >> 5;
        mx_dma(lds, KV + (size_t)(b * MEMLEN) * D + h * 128, w, lane); mx_dma(lds + MX_BUF, KV + (size_t)(b * MEMLEN + 128) * D + h * 128, w, lane);
        mx_dma(lds + 2 * MX_BUF, KV + (size_t)(b * MEMLEN) * D + MEMW + h * 128, w, lane); mx_dma(lds + 3 * MX_BUF, KV + (size_t)(b * MEMLEN + 128) * D + MEMW + h * 128, w, lane);
        bf16x8 qf[4];
#pragma unroll
        for (int kk = 0; kk < 4; ++kk) qf[kk] = *(const bf16x8*)(Qm + ((size_t)b * SEQ + 256 * qc + 16 * w + r) * MEMW + h * 128 + 32 * kk + 8 * q);
        asm volatile("s_waitcnt vmcnt(0) lgkmcnt(0)\n\ts_barrier" ::: "memory");
        for (int c = 0; c < 2; ++c) {
            const size_t trow = (size_t)b * SEQ + 256 * qc + 128 * c + 16 * w + r;
            if (c == 1) {
#pragma unroll
                for (int kk = 0; kk < 4; ++kk) qf[kk] = *(const bf16x8*)(Qm + trow * MEMW + h * 128 + 32 * kk + 8 * q); }
            f32x4 z[16];
#pragma unroll
            for (int st = 0; st < 16; ++st) { z[st] = (f32x4){0.f, 0.f, 0.f, 0.f};
#pragma unroll
                for (int kk = 0; kk < 4; ++kk) { const bf16x8 kf = *(const LAS bf16x8*)(lds + (st >> 3) * MX_BUF + (16 * (st & 7) + r) * 256 + (((4 * kk + q) ^ r) * 16));
                    z[st] = __builtin_amdgcn_mfma_f32_16x16x32_bf16(kf, qf[kk], z[st], 0, 0, 0); }
                if (st & 1) __builtin_amdgcn_sched_barrier(0); }
            float mx = -1e30f;
#pragma unroll
            for (int st = 0; st < 16; ++st) mx = fmaxf(mx, fmaxf(fmaxf(z[st][0], z[st][1]), fmaxf(z[st][2], z[st][3])));
            mx = fmaxf(mx, __shfl_xor(mx, 16)); mx = fmaxf(mx, __shfl_xor(mx, 32));
            float sum = 0.f;
#pragma unroll
            for (int st = 0; st < 16; ++st)
#pragma unroll
                for (int e = 0; e < 4; ++e) { const float pp = fast_exp2((z[st][e] - mx) * LOG2E); z[st][e] = pp; sum += pp; }
            sum += __shfl_xor(sum, 16); sum += __shfl_xor(sum, 32);
            const float inv = 1.0f / sum;
            f32x4 o[8];
#pragma unroll
            for (int dt = 0; dt < 8; ++dt) o[dt] = (f32x4){0.f, 0.f, 0.f, 0.f};
#pragma unroll
            for (int p = 0; p < 8; ++p) { const bf16x8 pf = mk_frag(z[2 * p], z[2 * p + 1]);
#pragma unroll
                for (int dt = 0; dt < 8; ++dt) { const bf16x8 vf = mx_tr(lds + (2 + (p >> 2)) * MX_BUF, 32 * (p & 3) + 4 * q, 32 * (p & 3) + 16 + 4 * q, 16 * dt, r);
                    o[dt] = __builtin_amdgcn_mfma_f32_16x16x32_bf16(vf, pf, o[dt], 0, 0, 0); }
                __builtin_amdgcn_sched_barrier(0); }
#pragma unroll
            for (int dt = 0; dt < 8; ++dt) { const f32x4 v = o[dt] * inv;
                *(u32x2*)(Om + trow * MEMW + h * 128 + 16 * dt + 4 * q) = (u32x2){pg8::pk2(v[0], v[1]), pg8::pk2(v[2], v[3])}; }
        }
        asm volatile("s_waitcnt lgkmcnt(0)\n\ts_barrier" ::: "memory");
    }
}

constexpr int RT_XRS = 2064;
constexpr int RT_XH = 0, RT_XL = 16 * RT_XRS, RT_PART = 2 * 16 * RT_XRS, RT_SC = RT_PART + 8 * 16 * 64 * 4, RT_SEL = RT_SC + 16 * 64 * 4, RT_HIST = RT_SEL + 16 * 64 * 4, RT_END = RT_HIST + 256;
static_assert(RT_END <= SCR_BYTES, "router LDS");
DI float grp8_max(float v) { v = fmaxf(v, __shfl_xor(v, 1)); v = fmaxf(v, __shfl_xor(v, 2)); v = fmaxf(v, __shfl_xor(v, 4)); return v; }
DI float rdlane(float v, int l) { return __uint_as_float(__builtin_amdgcn_readlane(__float_as_uint(v), l)); }
DI void route_phase(Frame& F, const float* const* in, unsigned* gcount) {
    LAS unsigned char* lds = F.lds; unsigned char* ws = F.ws;
    const int tid = F.tid, lane = F.lane, w = F.wave, r = lane & 15, q = lane >> 4;
    const bf16* Y2 = (const bf16*)F.out; bf16* X2b = (bf16*)(ws + WS_X2B);
    const bf16* WRH = (const bf16*)(ws + WS_WRHI); const bf16* WRL = (const bf16*)(ws + WS_WRLO);
    unsigned* TK = (unsigned*)(ws + WS_TK); float* TKW = (float*)(ws + WS_TKW); unsigned* WGB = (unsigned*)(ws + WS_WGBASE);
    LAS unsigned* HIST = (LAS unsigned*)(lds + RT_HIST);
    if (tid < 64) HIST[tid] = 0u;
    const float rb = in[19][lane];
    f32x4 gv[4], bv[4];
#pragma unroll
    for (int j = 0; j < 4; ++j) { gv[j] = ((const f32x4*)in[16])[lane + 64 * j]; bv[j] = ((const f32x4*)in[17])[lane + 64 * j]; }
    bf16x8 bh[4][4], bl[4][4];
#pragma unroll
    for (int kk = 0; kk < 4; ++kk)
#pragma unroll
        for (int nt = 0; nt < 4; ++nt) { const size_t o = (size_t)(16 * nt + r) * D + 128 * w + 32 * kk + 8 * q; bh[kk][nt] = *(const bf16x8*)(WRH + o); bl[kk][nt] = *(const bf16x8*)(WRL + o); }
    u32x2 va[4], vb[4];
    { const int tl0 = F.vcu; if (tl0 < T / 16) {
#pragma unroll
        for (int j = 0; j < 4; ++j) { va[j] = ((const u32x2*)(Y2 + ((size_t)16 * tl0 + 2 * w) * D))[lane + 64 * j]; vb[j] = ((const u32x2*)(Y2 + ((size_t)16 * tl0 + 2 * w + 1) * D))[lane + 64 * j]; } } }
    __syncthreads();
    for (int tl = F.vcu; tl < T / 16; tl += F.G) {
#pragma unroll
        for (int rr = 0; rr < 2; ++rr) { const int lr = 2 * w + rr; const size_t m = (size_t)16 * tl + lr;
            f32x4 v[4]; float s = 0.f;
#pragma unroll
            for (int j = 0; j < 4; ++j) { const u32x2 x = rr ? vb[j] : va[j]; v[j] = (f32x4){bflo(x.x), bfhi(x.x), bflo(x.y), bfhi(x.y)}; s += (v[j][0] + v[j][1]) + (v[j][2] + v[j][3]); }
            const float mean = wave_sum(s) * (1.f / D); float s2 = 0.f;
#pragma unroll
            for (int j = 0; j < 4; ++j) { const f32x4 d = v[j] - mean; s2 += (d[0] * d[0] + d[1] * d[1]) + (d[2] * d[2] + d[3] * d[3]); }
            const float rstd = 1.f / sqrtf(wave_sum(s2) * (1.f / D) + LN_EPS);
            u32x2* ob = (u32x2*)(X2b + m * D) + lane;
#pragma unroll
            for (int j = 0; j < 4; ++j) { const f32x4 y = (v[j] - mean) * rstd * gv[j] + bv[j];
                const u32x2 hi = (u32x2){pg8::pk2(y[0], y[1]), pg8::pk2(y[2], y[3])}; ob[64 * j] = hi;
                const f32x4 rs = (f32x4){y[0] - bflo(hi.x), y[1] - bfhi(hi.x), y[2] - bflo(hi.y), y[3] - bfhi(hi.y)};
                *(LAS u32x2*)(lds + RT_XH + lr * RT_XRS + (4 * lane + 256 * j) * 2) = hi;
                *(LAS u32x2*)(lds + RT_XL + lr * RT_XRS + (4 * lane + 256 * j) * 2) = (u32x2){pg8::pk2(rs[0], rs[1]), pg8::pk2(rs[2], rs[3])}; } }
        { const int tn = tl + F.G; if (tn < T / 16) {
#pragma unroll
            for (int j = 0; j < 4; ++j) { va[j] = ((const u32x2*)(Y2 + ((size_t)16 * tn + 2 * w) * D))[lane + 64 * j]; vb[j] = ((const u32x2*)(Y2 + ((size_t)16 * tn + 2 * w + 1) * D))[lane + 64 * j]; } } }
        __syncthreads();
        { f32x4 acc[4];
#pragma unroll
          for (int nt = 0; nt < 4; ++nt) acc[nt] = (f32x4){0.f, 0.f, 0.f, 0.f};
#pragma unroll
          for (int kk = 0; kk < 4; ++kk) { const int k0 = 128 * w + 32 * kk + 8 * q;
              const bf16x8 ah = *(const LAS bf16x8*)(lds + RT_XH + r * RT_XRS + k0 * 2), al = *(const LAS bf16x8*)(lds + RT_XL + r * RT_XRS + k0 * 2);
#pragma unroll
              for (int nt = 0; nt < 4; ++nt) {
                  acc[nt] = __builtin_amdgcn_mfma_f32_16x16x32_bf16(ah, bh[kk][nt], acc[nt], 0, 0, 0);
                  acc[nt] = __builtin_amdgcn_mfma_f32_16x16x32_bf16(al, bh[kk][nt], acc[nt], 0, 0, 0);
                  acc[nt] = __builtin_amdgcn_mfma_f32_16x16x32_bf16(ah, bl[kk][nt], acc[nt], 0, 0, 0); } }
#pragma unroll
          for (int nt = 0; nt < 4; ++nt)
#pragma unroll
              for (int e = 0; e < 4; ++e) *(LAS float*)(lds + RT_PART + ((w * 16 + 4 * q + e) * 64 + 16 * nt + r) * 4) = acc[nt][e]; }
        __syncthreads();
#pragma unroll
        for (int rr = 0; rr < 2; ++rr) { const int lt = 2 * w + rr; const size_t tok = (size_t)16 * tl + lt;
            float lg = 0.f;
#pragma unroll
            for (int k = 0; k < 8; ++k) lg += *(const LAS float*)(lds + RT_PART + ((k * 16 + lt) * 64 + lane) * 4);
            const float sc = 1.0f / (1.0f + __expf(-lg)); const float sel = sc + rb;
            const int g = lane >> 3;
            const float m1 = grp8_max(sel);
            const unsigned long long bal = __ballot(sel == m1);
            const unsigned gb = (unsigned)(bal >> (8 * g)) & 0xffu; const int first = 8 * g + __builtin_ctz(gb);
            const float m2 = grp8_max(lane == first ? -1e30f : sel);
            const float gs = m1 + m2;
            int grank = 0;
#pragma unroll
            for (int g2 = 0; g2 < 8; ++g2) { const float v = rdlane(gs, 8 * g2); grank += ((v > gs) || (v == gs && g2 < g)) ? 1 : 0; }
            const float val = (grank < 4) ? sel : -1e30f;
            int rank = 0;
#pragma unroll
            for (int e2 = 0; e2 < 64; ++e2) { const float v = rdlane(val, e2); rank += ((v > val) || (v == val && e2 < lane)) ? 1 : 0; }
            const bool chosen = rank < 8;
            const unsigned long long cm = __ballot(chosen);
            const float wsum = wave_sum(chosen ? sc : 0.f);
            if (chosen) { const int kidx = __builtin_popcountll(cm & ((1ull << lane) - 1ull));
                const unsigned lrk = __hip_atomic_fetch_add(&HIST[lane], 1u, __ATOMIC_RELAXED, __HIP_MEMORY_SCOPE_WORKGROUP);
                TK[tok * 8 + kidx] = (unsigned)lane | (lrk << 8); TKW[tok * 8 + kidx] = sc * (ROUTED_SCALE / wsum); }
        }
        __syncthreads();
    }
    if (tid < 64) { const unsigned cnt = HIST[tid]; const unsigned base = __hip_atomic_fetch_add(gcount + tid, cnt, RLX_AGENT); WGB[F.vcu * 64 + tid] = base; }
}

DI void slots_phase(Frame& F) {
    LAS unsigned char* lds = F.lds; unsigned char* ws = F.ws; const int tid = F.tid;
    LAS unsigned* CNT = (LAS unsigned*)lds; LAS unsigned* PS = CNT + 64;
    int* ROWTOK = (int*)(ws + WS_ROWTOK); float* ROWW = (float*)(ws + WS_ROWW); unsigned* SLOT = (unsigned*)(ws + WS_SLOT);
    const unsigned* TK = (const unsigned*)(ws + WS_TK); const float* TKW = (const float*)(ws + WS_TKW); const unsigned* WGB = (const unsigned*)(ws + WS_WGBASE);
    if (tid < 64) CNT[tid] = __hip_atomic_load(F.ctl + CW_GCOUNT + tid, RLX_AGENT);
    __syncthreads();
    if (tid == 0) { unsigned run = 0u; for (int e = 0; e < 64; ++e) { PS[e] = run; run += (CNT[e] + 255u) & ~255u; } PS[64] = run; }
    __syncthreads();
    const unsigned nblk = PS[64] >> 8;
    if (F.vcu == 0) {
        if (tid == 0) { __hip_atomic_store(F.ctl + CW_HDR, nblk, RLX_AGENT); __hip_atomic_store(F.ctl + CW_HDR + 1, (nblk + 1u) >> 1, RLX_AGENT); }
        for (unsigned bl = tid; bl < nblk; bl += NTHREADS) { unsigned e = 0; for (int k = 1; k < 64; ++k) e += (PS[k] <= bl * 256u) ? 1u : 0u; __hip_atomic_store(F.ctl + CW_BLKE + bl, e, RLX_AGENT); }
    }
    for (int e = F.vcu; e < 64; e += F.G) { const unsigned lo = PS[e] + CNT[e], hi = PS[e + 1]; for (unsigned s = lo + tid; s < hi; s += NTHREADS) { ROWTOK[s] = 0; ROWW[s] = 0.f; } }
    for (int tl = F.vcu; tl < T / 16; tl += F.G) {
        if (tid < 128) { const size_t a = (size_t)16 * 8 * tl + tid; const unsigned pk = TK[a], e = pk & 0xffu, lrk = pk >> 8;
            const unsigned slot = PS[e] + WGB[F.vcu * 64 + e] + lrk; ROWTOK[slot] = (int)(a >> 3); ROWW[slot] = TKW[a]; SLOT[a] = slot; }
    }
}

DI void dec8(unsigned w, float (&o)[4]) { const f32x2 a = __builtin_amdgcn_cvt_pk_f32_fp8((int)w, false), b = __builtin_amdgcn_cvt_pk_f32_fp8((int)w, true); o[0] = a[0]; o[1] = a[1]; o[2] = b[0]; o[3] = b[1]; }
DI void combine_phase(Frame& F, const float* const* in) {
    const int gw = F.vcu * NWAVES + F.wave, NGW = F.G * NWAVES, lane = F.lane;
    const unsigned* SLOT = (const unsigned*)(F.ws + WS_SLOT); const unsigned char* Y8 = (const unsigned char*)(F.ws + WS_YH); const bf16* base = (const bf16*)(F.ws + WS_X2B); float* out = F.out;
    f32x4 gv[4], bv[4];
#pragma unroll
    for (int j = 0; j < 4; ++j) { gv[j] = *(const f32x4*)(in[26] + 16 * lane + 4 * j); bv[j] = *(const f32x4*)(in[27] + 16 * lane + 4 * j); }
    for (int m0 = gw; m0 < T; m0 += 2 * NGW) {
        u32x4 yr[2][8]; u32x4 bs[2][2];
#pragma unroll
        for (int t2 = 0; t2 < 2; ++t2) { const int m = m0 + t2 * NGW; const int mm = (m < T) ? m : m0;
            unsigned sl[8];
#pragma unroll
            for (int k = 0; k < 8; ++k) sl[k] = __builtin_amdgcn_readfirstlane(__hip_atomic_load(SLOT + (size_t)mm * 8 + k, RLX_AGENT));
            bs[t2][0] = *(const u32x4*)(base + (size_t)mm * D + 16 * lane); bs[t2][1] = *(const u32x4*)(base + (size_t)mm * D + 16 * lane + 8);
#pragma unroll
            for (int k = 0; k < 8; ++k) yr[t2][k] = *(const u32x4*)(Y8 + (size_t)sl[k] * D + 16 * lane);
        }
#pragma unroll
        for (int t2 = 0; t2 < 2; ++t2) { const int m = m0 + t2 * NGW; if (m >= T) continue;
            float a[16];
#pragma unroll
            for (int c = 0; c < 16; ++c) a[c] = 0.f;
#pragma unroll
            for (int k = 0; k < 8; ++k) { const u32x4 y = yr[t2][k]; float d[4];
                dec8(y.x, d); a[0] += d[0]; a[1] += d[1]; a[2] += d[2]; a[3] += d[3];
                dec8(y.y, d); a[4] += d[0]; a[5] += d[1]; a[6] += d[2]; a[7] += d[3];
                dec8(y.z, d); a[8] += d[0]; a[9] += d[1]; a[10] += d[2]; a[11] += d[3];
                dec8(y.w, d); a[12] += d[0]; a[13] += d[1]; a[14] += d[2]; a[15] += d[3]; }
            f32x4 v[4];
#pragma unroll
            for (int h = 0; h < 2; ++h) { const u32x4 x = bs[t2][h];
                v[2 * h] = (f32x4){bflo(x.x), bfhi(x.x), bflo(x.y), bfhi(x.y)} + (f32x4){a[8 * h], a[8 * h + 1], a[8 * h + 2], a[8 * h + 3]} * (1.0f / pg8::Y8_SCALE);
                v[2 * h + 1] = (f32x4){bflo(x.z), bfhi(x.z), bflo(x.w), bfhi(x.w)} + (f32x4){a[8 * h + 4], a[8 * h + 5], a[8 * h + 6], a[8 * h + 7]} * (1.0f / pg8::Y8_SCALE); }
            float s = 0.f;
#pragma unroll
            for (int j = 0; j < 4; ++j) s += (v[j][0] + v[j][1]) + (v[j][2] + v[j][3]);
            const float mean = wave_sum(s) * (1.f / D); float s2 = 0.f;
#pragma unroll
            for (int j = 0; j < 4; ++j) { const f32x4 d = v[j] - mean; s2 += (d[0] * d[0] + d[1] * d[1]) + (d[2] * d[2] + d[3] * d[3]); }
            const float rstd = 1.f / sqrtf(wave_sum(s2) * (1.f / D) + LN_EPS);
#pragma unroll
            for (int j = 0; j < 4; ++j) *(f32x4*)(out + (size_t)m * D + 16 * lane + 4 * j) = (v[j] - mean) * rstd * gv[j] + bv[j];
        }
    }
}

DI void stagger(const Frame& F, unsigned ticks) {
    if (F.vcu & 1) { const unsigned long long t0 = __builtin_amdgcn_s_memrealtime(); while (__builtin_amdgcn_s_memrealtime() - t0 < ticks) __builtin_amdgcn_s_sleep(8); }
}
#ifndef STAG_DOWN
#define STAG_DOWN 350
#endif
constexpr int NPHASE = 13;
constexpr int CVT_A = 12288;
constexpr int N_LAUNCHES = MK_N_LAUNCHES;
static_assert(N_LAUNCHES == 1 || N_LAUNCHES == NPHASE, "MK_N_LAUNCHES: 1 (one dispatch) or 13 (one dispatch per phase)");
struct Args { const float* in[28]; float* out; unsigned char* ws; int ph_lo, ph_hi; };
static_assert(sizeof(Args) == 28 * 8 + 8 + 8 + 8, "Args has no padding");

__global__ void __launch_bounds__(NTHREADS, 2) fwd_kernel(Args args) {
    extern __shared__ __attribute__((aligned(16))) unsigned char lds_raw[];
    Frame F;
    F.lds = (LAS unsigned char*)lds_raw;
    volatile LAS unsigned* MISC = (volatile LAS unsigned*)(F.lds + MISC_OFF);
    F.tid = threadIdx.x; F.lane = F.tid & 63; F.wave = __builtin_amdgcn_readfirstlane(F.tid >> 6);
    F.G = gridDim.x; { const int bx = blockIdx.x; F.vcu = (F.G % 8 == 0) ? (bx % 8) * (F.G / 8) + bx / 8 : bx; }
    F.ws = args.ws; F.ctl = (unsigned*)(args.ws + WS_CTL); F.out = args.out;
    unsigned char* ws = args.ws;
    for (int u = F.tid; u < (LDS_BYTES - MISC_OFF) / 4; u += NTHREADS) ((LAS unsigned*)(F.lds + MISC_OFF))[u] = 0u;
    __syncthreads();
    XcdBarrier bar; bar.bar = F.ctl + CW_BAR; bar.x = 0; bar.st = nullptr;
    if (N_LAUNCHES == 1) bar = xcd_barrier_post(F.ctl + CW_BAR, MISC + 8);
#define GRID_BAR() do { if (N_LAUNCHES == 1) xcd_barrier(bar); } while (0)
    const int lo = args.ph_lo, hi = args.ph_hi;
#ifndef PHASE_MASK
#define PHASE_MASK 0x1fff
#endif
#define IN(k) (((PHASE_MASK >> (k)) & 1) && lo <= (k) && (k) < hi)
#ifndef REPEAT_MASK
#define REPEAT_MASK 0
#endif
#ifndef DOWN_PROBE
#define DOWN_PROBE 0
#endif
#define REP(k) (((REPEAT_MASK >> (k)) & 1) ? 2 : 1)
#define SEAM(k) do { if (IN(k) && IN((k) + 1)) GRID_BAR(); } while (0)
    const float* const* in = args.in;

    for (int rep_ = 0; rep_ < (IN(0) ? REP(0) : 0); ++rep_) { if (rep_) GRID_BAR(); p0_prologue(F, in); SEAM(0); }
    for (int rep_ = 0; rep_ < (IN(1) ? REP(1) : 0); ++rep_) { if (rep_) GRID_BAR();
        pg8::DenseOrder S; S.init((const bf16*)F.out, (const bf16*)(ws + WS_WIN), T, INW, D, F.G, (int)blockIdx.x);
        pg8::EpiInProj E{(bf16*)(ws + WS_P1), (float*)(ws + WS_VSTAT), (const float*)(ws + WS_BPERM)};
        pg8::gemm_phase<pg8::EpiInProj, pg8::DenseOrder, true>(F.lds, D, S, E);
        SEAM(1);
    }
    for (int rep_ = 0; rep_ < (IN(2) ? REP(2) : 0); ++rep_) { if (rep_) GRID_BAR(); mix_phase(F, in); SEAM(2); }
    for (int rep_ = 0; rep_ < (IN(3) ? REP(3) : 0); ++rep_) { if (rep_) GRID_BAR();
        pg8::DenseOrder S; S.init((const bf16*)(ws + WS_MERGED), (const bf16*)(ws + WS_WOUT), T, D, D, F.G, (int)blockIdx.x);
        pg8::EpiResB16<true> E{(bf16*)(ws + WS_Y1), in[0], nullptr, (const float*)(ws + WS_XSTAT), in[2], in[3]};
        pg8::gemm_phase<pg8::EpiResB16<true>, pg8::DenseOrder, false>(F.lds, D, S, E);
        SEAM(3);
    }
    for (int rep_ = 0; rep_ < (IN(4) ? REP(4) : 0); ++rep_) { if (rep_) GRID_BAR(); ln1_phase(F, in); SEAM(4); }
    for (int rep_ = 0; rep_ < (IN(5) ? REP(5) : 0); ++rep_) { if (rep_) GRID_BAR();
        if (F.G == 256) { if ((int)blockIdx.x >= 160) expert_convert(F, in, (int)blockIdx.x - 160, 96, 0, CVT_A); }
        else expert_convert(F, in, F.vcu, F.G, 0, NEXP * 384);
        __syncthreads();
        { pg8::DenseOrder S; S.init((const bf16*)(ws + WS_X1B), (const bf16*)(ws + WS_WQ), T, MEMW, D, F.G, (int)blockIdx.x);
          pg8::EpiBf16S E{(bf16*)(ws + WS_QM), MEMW, QSCALE};
          pg8::gemm_phase<pg8::EpiBf16S, pg8::DenseOrder, false>(F.lds, D, S, E); }
        { const int c2 = ((int)blockIdx.x + F.G - 128 % F.G) % F.G;
          pg8::DenseOrder S; S.init((const bf16*)(ws + WS_MEMB), (const bf16*)(ws + WS_WKV), NBATCH * MEMLEN, 2 * MEMW, D, F.G, c2);
          pg8::EpiBf16S E{(bf16*)(ws + WS_KVM), 2 * MEMW, 1.0f};
          pg8::gemm_phase<pg8::EpiBf16S, pg8::DenseOrder, false>(F.lds, D, S, E); }
        SEAM(5);
    }
    for (int rep_ = 0; rep_ < (IN(6) ? REP(6) : 0); ++rep_) { if (rep_) GRID_BAR();
        if (F.G == 256) { if (F.vcu & 1) expert_convert(F, in, F.vcu >> 1, 128, CVT_A, NEXP * 384); else memattn_phase(F, F.vcu >> 1, 128); }
        else memattn_phase(F, F.vcu, F.G);
        SEAM(6); }
    for (int rep_ = 0; rep_ < (IN(7) ? REP(7) : 0); ++rep_) { if (rep_) GRID_BAR();
        pg8::DenseOrder S; S.init((const bf16*)(ws + WS_OM), (const bf16*)(ws + WS_WO), T, D, MEMW, F.G, (int)blockIdx.x);
        pg8::EpiResB16<false> E{(bf16*)F.out, nullptr, (const bf16*)(ws + WS_X1B), nullptr, nullptr, nullptr};
        pg8::gemm_phase<pg8::EpiResB16<false>, pg8::DenseOrder, false>(F.lds, MEMW, S, E);
        SEAM(7);
    }
    for (int rep_ = 0; rep_ < (IN(8) ? REP(8) : 0); ++rep_) { if (rep_) GRID_BAR(); route_phase(F, in, F.ctl + ((rep_ + 1 < REP(8)) ? 2048 : CW_GCOUNT)); SEAM(8); }
    for (int rep_ = 0; rep_ < (IN(9) ? REP(9) : 0); ++rep_) { if (rep_) GRID_BAR(); slots_phase(F); SEAM(9); }
    for (int rep_ = 0; rep_ < (IN(10) ? REP(10) : 0); ++rep_) { if (rep_) GRID_BAR();
        const int nblk = (int)__builtin_amdgcn_readfirstlane(__hip_atomic_load(F.ctl + CW_HDR, RLX_AGENT));
        pg8::moe_tables(F.lds, F.ctl + CW_BLKE, nblk, (const int*)(ws + WS_ROWTOK), (const float*)(ws + WS_ROWW), true, F.G, F.vcu, F.tid);
        pg8::GateUpOrder S{(const char*)(ws + WS_X2B), (const char*)(ws + WS_WGU), (const char*)(ws + WS_WGUS), F.lds, nblk, F.G, F.vcu};
        pg8::EpiGateUp E{(bf16*)(ws + WS_H), F.lds};
        pg8::gemm_phase<pg8::EpiGateUp, pg8::GateUpOrder, true>(F.lds, D, S, E);
        SEAM(10);
    }
    for (int rep_ = 0; rep_ < (IN(11) ? REP(11) : 0); ++rep_) { if (rep_) GRID_BAR();
        const int nblk = (int)__builtin_amdgcn_readfirstlane(__hip_atomic_load(F.ctl + CW_HDR, RLX_AGENT));
        pg8::moe_tables(F.lds, F.ctl + CW_BLKE, nblk, nullptr, nullptr, false, F.G, F.vcu, F.tid);
        pg8::DownOrder S{(const char*)(ws + WS_H), (const char*)(ws + WS_WD), (const char*)(ws + WS_WDS), F.lds, 0, nblk, 64, F.G, F.vcu, 0};
        pg8::EpiDown E{(unsigned char*)(ws + WS_YH), (bf16*)(ws + WS_X2B), 0};
        pg8::gemm_phase<pg8::EpiDown, pg8::DownOrder, true>(F.lds, EH, S, E);
        SEAM(11);
    }
    if (IN(12)) { combine_phase(F, in); }
#undef IN
#undef SEAM
#undef GRID_BAR
}

extern "C" void kernel_launch(void* const* d_in, const int* in_sizes, int n_in, void* d_out, int out_size, void* d_ws, size_t ws_size, hipStream_t stream) {
    static int grid = 0;
    if (grid == 0) {
        if (n_in != 28 || in_sizes[0] != T * D || out_size != T * D || ws_size < WS_END) { fprintf(stderr, "kernel_launch: unexpected shapes / workspace (n_in %d, ws %zu < %zu)\n", n_in, ws_size, (size_t)WS_END); grid = -1; return; }
        int dev = 0, cus = 0, per_cu = 0;
        if (hipGetDevice(&dev) != hipSuccess || hipDeviceGetAttribute(&cus, hipDeviceAttributeMultiprocessorCount, dev) != hipSuccess) { grid = -1; return; }
        if (hipFuncSetAttribute((const void*)fwd_kernel, hipFuncAttributeMaxDynamicSharedMemorySize, LDS_BYTES) != hipSuccess) { fprintf(stderr, "kernel_launch: hipFuncSetAttribute failed\n"); grid = -1; return; }
        if (hipOccupancyMaxActiveBlocksPerMultiprocessor(&per_cu, (const void*)fwd_kernel, NTHREADS, LDS_BYTES) != hipSuccess || per_cu < 1) { fprintf(stderr, "kernel_launch: occupancy query reports %d\n", per_cu); }
        (void)hipGetLastError();
        grid = cus;
    }
    if (grid < 0) return;
    if (hipMemsetAsync((char*)d_ws + WS_CTL, 0, CTL_ZERO_BYTES, stream) != hipSuccess) return;
    Args a{};
    for (int i = 0; i < 28; ++i) a.in[i] = (const float*)d_in[i];
    a.out = (float*)d_out; a.ws = (unsigned char*)d_ws;
    for (int li = 0; li < N_LAUNCHES; ++li) {
        a.ph_lo = (N_LAUNCHES == 1) ? 0 : li; a.ph_hi = (N_LAUNCHES == 1) ? NPHASE : li + 1;
        hipLaunchKernelGGL(fwd_kernel, dim3(grid), dim3(NTHREADS), LDS_BYTES, stream, a);
        if (hipPeekAtLastError() != hipSuccess) { fprintf(stderr, "kernel_launch: launch %d failed\n", li); break; }
    }
}
```

```cpp
#include <hip/hip_runtime.h>
#include <cstdio>
#include <cstdint>

#ifndef MK_N_LAUNCHES
#define MK_N_LAUNCHES 1
#endif

#define GAS __attribute__((address_space(1)))
#define LAS __attribute__((address_space(3)))
typedef unsigned short bf16;
typedef short bf16x8 __attribute__((ext_vector_type(8)));
typedef short s16x4 __attribute__((ext_vector_type(4)));
typedef float f32x4 __attribute__((ext_vector_type(4)));
typedef float f32x2 __attribute__((ext_vector_type(2)));
typedef unsigned u32x4 __attribute__((ext_vector_type(4)));
typedef unsigned u32x2 __attribute__((ext_vector_type(2)));
#define RLX_AGENT __ATOMIC_RELAXED, __HIP_MEMORY_SCOPE_AGENT
#define DI __device__ __forceinline__

constexpr int T = 16384, D = 1024, NBATCH = 8, SEQ = 2048, MEMLEN = 256, INW = 7168;
constexpr int NEXP = 64, TOPK = 8, EH = 256, MEMW = 512;
constexpr float LN_EPS = 1e-5f;
constexpr float ALPHA = 1.189207115002721f;
constexpr float QSCALE = 0.08838834764831845f;
constexpr float ROUTED_SCALE = 2.5f;
constexpr float LOG2E = 1.4426950408889634f, LN2 = 0.6931471805599453f;
constexpr float SB_EXIT = -30.0f;
constexpr int NWAVES = 8, NTHREADS = 512;
constexpr int MAXBLK = 576;
constexpr int SH_ROW0 = MAXBLK * 256;

constexpr size_t MiB = 1u << 20;
constexpr size_t WS_CTL = 0, CTL_ZERO_BYTES = 32 * 1024;
constexpr size_t WS_WRHI = 1 * MiB, WS_WRLO = WS_WRHI + 128 * 1024, WS_WSP = WS_WRLO + 128 * 1024, WS_BPERM = WS_WSP + 256 * 1024, WS_XSTAT = WS_BPERM + 32 * 1024;
constexpr size_t WS_ROWTOK = 2 * MiB, WS_ROWW = WS_ROWTOK + 576 * 1024, WS_SLOT = WS_ROWW + 576 * 1024;
constexpr size_t WS_WIN = 4 * MiB, WS_WOUT = 18 * MiB, WS_WQ = 20 * MiB, WS_WKV = 21 * MiB, WS_WO = 23 * MiB, WS_MEMB = 24 * MiB;
constexpr size_t WS_P1 = 29 * MiB;
constexpr size_t WS_UG = WS_P1, WS_VA = WS_P1 + 32 * MiB, WS_Q = WS_P1 + 64 * MiB, WS_K = WS_P1 + 96 * MiB, WS_V = WS_P1 + 128 * MiB, WS_GB = WS_P1 + 160 * MiB;
constexpr size_t WS_VSTAT = 221 * MiB;
constexpr size_t WS_MERGED = 228 * MiB;
constexpr size_t WS_Y1 = 29 * MiB;
constexpr size_t WS_X1F = 93 * MiB, WS_X1B = 157 * MiB;
constexpr size_t WS_QM = 189 * MiB, WS_KVM = 205 * MiB, WS_OM = 209 * MiB;
constexpr size_t WS_WGU = 29 * MiB;
constexpr size_t WS_H = 148 * MiB;
constexpr size_t WS_X2B = 228 * MiB;
constexpr size_t WS_WD = 260 * MiB;
constexpr size_t WS_WGUS = 293 * MiB, WS_WDS = 294 * MiB;
constexpr size_t WS_TK = 295 * MiB, WS_TKW = WS_TK + 512 * 1024, WS_WGBASE = WS_TKW + 512 * 1024;
constexpr size_t WS_YH = 4 * MiB;
constexpr size_t WS_END = 297 * MiB;
static_assert(WS_XSTAT + (size_t)T * 8 <= WS_ROWTOK && WS_SLOT + (size_t)T * 8 * 4 <= WS_WIN && WS_MEMB + 4 * MiB <= WS_P1, "ws map 1");
static_assert(WS_GB + 32 * MiB <= WS_VSTAT && WS_VSTAT + 2 * MiB <= WS_MERGED && WS_H + (size_t)(SH_ROW0 + T) * 512 <= WS_X2B && WS_X2B + 32 * MiB <= WS_WD, "ws map 2");
static_assert(WS_WD + (size_t)64 * 1024 * 256 * 2 <= WS_WGUS && WS_YH + (size_t)288 * 256 * 2048 <= WS_H && WS_WGBASE + 256 * 64 * 4 <= WS_END, "ws map 3");
constexpr int CW_TMO = 0, CW_CODE = 1;
constexpr int CW_GCOUNT = 64;
constexpr int CW_HDR = 192;
constexpr int CW_BLKE = 256;
constexpr int CW_BAR = 4096;

constexpr int SCR_BYTES = 140 * 1024;
constexpr int MISC_OFF = SCR_BYTES;
constexpr int LDS_BYTES = 144 * 1024;

DI unsigned cvt_pk_bf16(float lo, float hi) { unsigned r; asm volatile("v_cvt_pk_bf16_f32 %0, %1, %2" : "=v"(r) : "v"(lo), "v"(hi)); return r; }
DI float bf2f(unsigned short h) { return __uint_as_float((unsigned)h << 16); }
DI float bflo(unsigned w) { return __uint_as_float(w << 16); }
DI float bfhi(unsigned w) { return __uint_as_float(w & 0xffff0000u); }
DI float fast_exp2(float x) { return __builtin_amdgcn_exp2f(x); }
DI float fast_log2(float x) { return __builtin_amdgcn_logf(x); }
DI float fast_rcp(float x) { return __builtin_amdgcn_rcpf(x); }
DI float sigmoidf_(float x) { return fast_rcp(1.0f + fast_exp2(-x * LOG2E)); }
template <int CTRL, int ROWMASK> DI float dpp_f(float v, float fill) { return __uint_as_float((unsigned)__builtin_amdgcn_update_dpp((int)__float_as_uint(fill), (int)__float_as_uint(v), CTRL, ROWMASK, 0xf, false)); }
DI float wave_sum(float v) {
    v += dpp_f<0x111, 0xf>(v, 0.f); v += dpp_f<0x112, 0xf>(v, 0.f); v += dpp_f<0x114, 0xf>(v, 0.f); v += dpp_f<0x118, 0xf>(v, 0.f);
    v += dpp_f<0x142, 0xa>(v, 0.f); v += dpp_f<0x143, 0xc>(v, 0.f);
    return __uint_as_float(__builtin_amdgcn_readlane(__float_as_uint(v), 63));
}
DI float wave_max(float v) {
#pragma unroll
    for (int o = 1; o < 64; o <<= 1) v = fmaxf(v, __shfl_xor(v, o));
    return v;
}
#define LDS_WAIT() asm volatile("s_waitcnt lgkmcnt(0)" ::: "memory")
#define VM_WAIT() asm volatile("s_waitcnt vmcnt(0)" ::: "memory")

namespace pg8 {
constexpr int BM = 256, BK = 64, HALF = 128, HTB = HALF * BK * 2, STAGE_BYTES = 8 * HTB, NXCD = 8, WGM = 8;
__host__ __device__ __forceinline__ int lds_byte(int r, int c) { const int st = (r >> 4) * 2 + (c >> 5), rr = r & 15, cc = c & 31, ob = rr * 64 + cc * 2; return st * 1024 + (ob ^ (((ob >> 9) & 1) << 5)); }
__host__ __device__ __forceinline__ void stage_rc(int b, int& R, int& C) { const int st = b / 1024, sb = b % 1024, swz = sb ^ (((sb >> 9) & 1) << 5); R = (st >> 1) * 16 + swz / 64; C = (st & 1) * 32 + (swz % 64) / 2; }
__host__ __device__ __forceinline__ int perm32(int rho) { const int n = rho >> 4, i = rho & 15; return 8 * (i >> 2) + 4 * n + (i & 3); }

struct Unit { int pm, pn, e, ui; const char* A; const char* B; };

typedef float f32x2v __attribute__((ext_vector_type(2)));
DI f32x2v gelu_pk(f32x2v v) {
    const f32x2v av = __builtin_elementwise_abs(v), d = av * 0.2316418882f + 1.0f;
    f32x2v t; t.x = __builtin_amdgcn_rcpf(d.x); t.y = __builtin_amdgcn_rcpf(d.y);
    f32x2v q = t * 0.5307027145f + (-0.7265760135f); q = q * t + 0.7107068705f; q = q * t + (-0.142248368f); q = q * t + 0.127414796f; q = q * t;
    const f32x2v s = (v * v) * (-0.72134752044f);
    f32x2v e; e.x = __builtin_amdgcn_exp2f(s.x); e.y = __builtin_amdgcn_exp2f(s.y);
    const f32x2v m = v * (q * e), r = v - m;
    f32x2v o; o.x = v.x < 0.f ? m.x : r.x; o.y = v.y < 0.f ? m.y : r.y; return o;
}
DI f32x4 gelu4(f32x4 v) { const f32x2v a = gelu_pk((f32x2v){v[0], v[1]}), b = gelu_pk((f32x2v){v[2], v[3]}); return (f32x4){a.x, a.y, b.x, b.y}; }
DI f32x4 sigmoid4(f32x4 v) { return (f32x4){sigmoidf_(v[0]), sigmoidf_(v[1]), sigmoidf_(v[2]), sigmoidf_(v[3])}; }
DI u32x4 pack8(f32x4 v0, f32x4 v1) { u32x4 w; w.x = cvt_pk_bf16(v0[0], v0[1]); w.y = cvt_pk_bf16(v0[2], v0[3]); w.z = cvt_pk_bf16(v1[0], v1[1]); w.w = cvt_pk_bf16(v1[2], v1[3]); return w; }

template <class Epi, class Sched, bool ALIGN_EPI>
DI void gemm_phase(LAS unsigned char* lds, const int K, const Sched& S, const Epi& E) {
    const int tid = threadIdx.x, wid = __builtin_amdgcn_readfirstlane(tid >> 6), lane = tid & 63, wr = wid >> 2, wc = wid & 3, fr = lane & 15, fq = lane >> 4;
    const int nt = K / BK;
    int Rr[2], Cc[2]; unsigned voffB[2], voffB1[2];
#pragma unroll
    for (int i = 0; i < 2; ++i) { int R, C; stage_rc(tid * 16 + i * 8192, R, C); Rr[i] = R; Cc[i] = C;
        if (Epi::PERM == 2) { const int w0 = 64 * (R >> 5) + 16 * ((R & 15) >> 2) + 4 * ((R >> 4) & 1) + (R & 3); voffB[i] = (unsigned)(w0 * K + C) * 2u; voffB1[i] = (unsigned)((w0 + 8) * K + C) * 2u; }
        else { const int Rb = Epi::PERM ? ((R & ~31) + perm32(R & 31)) : R; voffB[i] = (unsigned)(Rb * K + C) * 2u; voffB1[i] = (unsigned)((Rb + HALF) * K + C) * 2u; } }
    const size_t kstep = (size_t)(BK * 2);
    const unsigned ldsw = (unsigned)wid * 1024u;
    const int aoff = lds_byte(wr * 64 + fr, fq * 8), boff = lds_byte(wc * 32 + fr, fq * 8);
#define PG8_SA(b, h) (((b) * 2 + (h)) * HTB)
#define PG8_SB(b, h) ((4 + (b) * 2 + (h)) * HTB)
#define PG8_STAGE_B(bufoff, gbase) do { _Pragma("unroll") for (int _i = 0; _i < 2; ++_i) \
        __builtin_amdgcn_global_load_lds((const unsigned*)((const char*)(gbase) + voffB[_i]), (LAS unsigned*)(lds + (bufoff) + ldsw + _i * 8192), 16, 0, 0); } while (0)
#define PG8_STAGE_B1(bufoff, gbase) do { _Pragma("unroll") for (int _i = 0; _i < 2; ++_i) \
        __builtin_amdgcn_global_load_lds((const unsigned*)((const char*)(gbase) + voffB1[_i]), (LAS unsigned*)(lds + (bufoff) + ldsw + _i * 8192), 16, 0, 0); } while (0)
#define PG8_STAGE_A(bufoff, gbase, o0, o1) do { \
        __builtin_amdgcn_global_load_lds((const unsigned*)((const char*)(gbase) + (o0)), (LAS unsigned*)(lds + (bufoff) + ldsw), 16, 0, 0); \
        __builtin_amdgcn_global_load_lds((const unsigned*)((const char*)(gbase) + (o1)), (LAS unsigned*)(lds + (bufoff) + ldsw + 8192), 16, 0, 0); } while (0)
#define PG8_LDA(dst, b, h) do { _Pragma("unroll") for (int m = 0; m < 4; ++m) _Pragma("unroll") for (int k = 0; k < 2; ++k) dst[m][k] = *(const LAS bf16x8*)(lds + PG8_SA(b, h) + aoff + m * 2048 + k * 1024); } while (0)
#define PG8_LDB(dst, b, h) do { _Pragma("unroll") for (int n = 0; n < 2; ++n) _Pragma("unroll") for (int k = 0; k < 2; ++k) dst[n][k] = *(const LAS bf16x8*)(lds + PG8_SB(b, h) + boff + n * 2048 + k * 1024); } while (0)
#define PG8_MMA(ai, bj, At, Bt) do { __builtin_amdgcn_s_setprio(1); _Pragma("unroll") for (int m = 0; m < 4; ++m) _Pragma("unroll") for (int n = 0; n < 2; ++n) _Pragma("unroll") for (int k = 0; k < 2; ++k) \
        acc[ai][bj][m][n] = __builtin_amdgcn_mfma_f32_16x16x32_bf16(Bt[n][k], At[m][k], acc[ai][bj][m][n], 0, 0, 0); __builtin_amdgcn_s_setprio(0); } while (0)
#define PG8_WAIT_V(n) asm volatile("s_waitcnt vmcnt(" #n ")" ::: "memory")
#define PG8_WAIT_L(n) asm volatile("s_waitcnt lgkmcnt(" #n ")" ::: "memory")
#define PG8_BAR __builtin_amdgcn_s_barrier()
#define PG8_SCHED __builtin_amdgcn_sched_barrier(0)
    Unit cur, nxt; int ui = 0;
    if (!S.next(0, cur)) return;
    unsigned oc[2][2], on[2][2];
    S.a_offs(cur, Rr, Cc, K, oc);
    f32x4 acc[2][2][4][2];
#pragma unroll
    for (int a = 0; a < 2; ++a)
#pragma unroll
        for (int b = 0; b < 2; ++b)
#pragma unroll
            for (int m = 0; m < 4; ++m)
#pragma unroll
                for (int n = 0; n < 2; ++n) acc[a][b][m][n] = (f32x4){0.f, 0.f, 0.f, 0.f};
    bf16x8 At[4][2], B0[2][2], B1[2][2];
    const char* cA = cur.A; const char* cB = cur.B;
    PG8_STAGE_B(PG8_SB(0, 0), cB); PG8_STAGE_B1(PG8_SB(0, 1), cB); PG8_STAGE_A(PG8_SA(0, 0), cA, oc[0][0], oc[0][1]); PG8_STAGE_A(PG8_SA(0, 1), cA, oc[1][0], oc[1][1]);
    if (wr == 1) PG8_BAR;
    PG8_WAIT_V(2); PG8_BAR;
    PG8_STAGE_B(PG8_SB(1, 0), cB + kstep); PG8_STAGE_A(PG8_SA(1, 0), cA + kstep, oc[0][0], oc[0][1]); PG8_STAGE_B1(PG8_SB(1, 1), cB + kstep);
    PG8_WAIT_V(6); PG8_BAR;
    for (;;) {
        const bool has_next = S.next(ui + 1, nxt);
        const char* nA = has_next ? nxt.A : cA; const char* nB = has_next ? nxt.B : cB;
        if (has_next) S.a_offs(nxt, Rr, Cc, K, on);
        else {
#pragma unroll
            for (int h = 0; h < 2; ++h)
#pragma unroll
                for (int i = 0; i < 2; ++i) on[h][i] = oc[h][i]; }
#pragma unroll 1
        for (int t = 0; t < nt; t += 2) {
            const bool last = (t == nt - 2);
            const char* a1 = cA + (size_t)(t + 1) * kstep;
            const char* a2 = last ? nA : cA + (size_t)(t + 2) * kstep; const char* b2 = last ? nB : cB + (size_t)(t + 2) * kstep;
            const char* a3 = a2 + kstep; const char* b3 = b2 + kstep;
            const unsigned x00 = last ? on[0][0] : oc[0][0], x01 = last ? on[0][1] : oc[0][1], x10 = last ? on[1][0] : oc[1][0], x11 = last ? on[1][1] : oc[1][1];
            PG8_LDB(B0, 0, 0); PG8_LDB(B1, 0, 1); PG8_SCHED; PG8_LDA(At, 0, 0); PG8_STAGE_A(PG8_SA(1, 1), a1, oc[1][0], oc[1][1]);
            PG8_WAIT_V(8); PG8_WAIT_L(0); PG8_BAR; PG8_MMA(0, 0, At, B0); PG8_MMA(0, 1, At, B1); PG8_BAR; PG8_SCHED;
            PG8_LDA(At, 0, 1); PG8_STAGE_B(PG8_SB(0, 0), b2); PG8_STAGE_B1(PG8_SB(0, 1), b2); PG8_STAGE_A(PG8_SA(0, 0), a2, x00, x01);
            PG8_WAIT_V(8); PG8_WAIT_L(0); PG8_BAR; PG8_MMA(1, 0, At, B0); PG8_MMA(1, 1, At, B1); PG8_BAR; PG8_SCHED;
            PG8_LDB(B0, 1, 0); PG8_LDB(B1, 1, 1); PG8_SCHED; PG8_LDA(At, 1, 0); PG8_STAGE_A(PG8_SA(0, 1), a2, x10, x11);
            PG8_WAIT_V(8); PG8_WAIT_L(0); PG8_BAR; PG8_MMA(0, 0, At, B0); PG8_MMA(0, 1, At, B1); PG8_BAR; PG8_SCHED;
            PG8_LDA(At, 1, 1); PG8_STAGE_B(PG8_SB(1, 0), b3); PG8_STAGE_B1(PG8_SB(1, 1), b3); PG8_STAGE_A(PG8_SA(1, 0), a3, x00, x01);
            PG8_WAIT_V(8); PG8_WAIT_L(0); PG8_BAR; PG8_MMA(1, 0, At, B0); PG8_MMA(1, 1, At, B1); PG8_BAR; PG8_SCHED;
        }
        if constexpr (ALIGN_EPI) { if (wr == 0) PG8_BAR; }
        E(acc, cur, wr, wc, fr, fq);
        if (!has_next) break;
#pragma unroll
        for (int a = 0; a < 2; ++a)
#pragma unroll
            for (int b = 0; b < 2; ++b)
#pragma unroll
                for (int m = 0; m < 4; ++m)
#pragma unroll
                    for (int n = 0; n < 2; ++n) acc[a][b][m][n] = (f32x4){0.f, 0.f, 0.f, 0.f};
        cur = nxt; cA = nA; cB = nB; ++ui;
#pragma unroll
        for (int h = 0; h < 2; ++h)
#pragma unroll
            for (int i = 0; i < 2; ++i) oc[h][i] = on[h][i];
        if constexpr (ALIGN_EPI) { if (wr == 1) PG8_BAR; }
    }
    PG8_WAIT_V(0);
    if constexpr (!ALIGN_EPI) { if (wr == 0) PG8_BAR; }
    PG8_BAR;
#undef PG8_SA
#undef PG8_SB
#undef PG8_STAGE_A
#undef PG8_STAGE_B
#undef PG8_STAGE_B1
#undef PG8_LDA
#undef PG8_LDB
#undef PG8_MMA
#undef PG8_WAIT_V
#undef PG8_WAIT_L
#undef PG8_BAR
#undef PG8_SCHED
}

struct DenseOrder {
    const char* A; const char* Bt; int K, nM, nN, nwg, G, c;
    DI void init(const bf16* A_, const bf16* Bt_, int M, int N, int K_, int G_, int c_) { A = (const char*)A_; Bt = (const char*)Bt_; K = K_; nM = M / BM; nN = N / BM; nwg = nM * nN; G = G_; c = c_; }
    DI bool next(int i, Unit& u) const {
        const long L = (long)i * G + c; if (L >= nwg) return false;
        int wgid = (int)L; { const int q = nwg / NXCD, r = nwg % NXCD, xcd = wgid % NXCD, off = wgid / NXCD; wgid = (xcd < r ? xcd * (q + 1) : r * (q + 1) + (xcd - r) * q) + off; }
        const int nig = WGM * nN, gid = wgid / nig, fm = gid * WGM, gsz = (nM - fm) < WGM ? (nM - fm) : WGM;
        u.pm = fm + ((wgid % nig) % gsz); u.pn = (wgid % nig) / gsz; u.e = 0; u.ui = i;
        u.A = A + (size_t)u.pm * BM * K * 2; u.B = Bt + (size_t)u.pn * BM * K * 2; return true;
    }
    DI void a_offs(const Unit&, const int (&R)[2], const int (&C)[2], int K_, unsigned (&off)[2][2]) const {
#pragma unroll
        for (int h = 0; h < 2; ++h)
#pragma unroll
            for (int i = 0; i < 2; ++i) off[h][i] = (unsigned)((h * HALF + R[i]) * K_ + C[i]) * 2u;
    }
};
}

#define XB_TMO      128
#define XB_XCNT(j)  (256  + 64 * (j))
#define XB_XSUB(j)  (1280 + 64 * (j))
#define XB_XGEN(j)  (2304 + 64 * (j))
#define XB_TOP      3328
#define XB_TOPGEN   3392
#define XCD_BAR_WORDS 3456
#define XB_SPIN_CAP (1u << 18)
DI unsigned xb_ld(unsigned* p)              { return __hip_atomic_load(p, __ATOMIC_RELAXED, __HIP_MEMORY_SCOPE_AGENT); }
DI unsigned xb_add(unsigned* p, unsigned v) { return __hip_atomic_fetch_add(p, v, __ATOMIC_RELAXED, __HIP_MEMORY_SCOPE_AGENT); }
DI unsigned xb_xcc_id() { return (unsigned)__builtin_amdgcn_s_getreg((3 << 11) | 20) & 0xFu; }
#define XB_SPIN(cond, bar) do { unsigned _sp = 0; while (cond) { __builtin_amdgcn_s_sleep(1); \
    if ((++_sp & 255u) == 0u) { if (xb_ld(&(bar)[XB_TMO])) break; if (_sp > XB_SPIN_CAP) { atomicAdd(&(bar)[XB_TMO], 1u); break; } } } } while (0)
struct XcdBarrier { unsigned* bar; unsigned x; volatile LAS unsigned* st; };
DI XcdBarrier xcd_barrier_post(unsigned* bar, volatile LAS unsigned* st) {
    XcdBarrier b; b.bar = bar; b.x = xb_xcc_id(); b.st = st;
    if (threadIdx.x == 0) (void)xb_add(&bar[XB_XCNT(b.x)], 1u);
    return b;
}
DI void xcd_barrier_complete(unsigned* bar, unsigned x, unsigned& nloc, unsigned& nx) {
    const unsigned G = gridDim.x * gridDim.y * gridDim.z;
    unsigned sum, cnt, mine, sp = 0u;
    for (;;) {
        sum = 0u; cnt = 0u; mine = 0u;
#pragma unroll
        for (unsigned j = 0; j < 16; ++j) { const unsigned c = xb_ld(&bar[XB_XCNT(j)]); sum += c; cnt += (c > 0u) ? 1u : 0u; mine = (j == x) ? c : mine; }
        if (sum == G) break;
        __builtin_amdgcn_s_sleep(1);
        if ((++sp & 255u) == 0u) { if (xb_ld(&bar[XB_TMO])) break; if (sp > XB_SPIN_CAP) { atomicAdd(&bar[XB_TMO], 1u); break; } }
    }
    nloc = mine > 0u ? mine : 1u; nx = cnt > 0u ? cnt : 1u;
}
DI void xcd_barrier(const XcdBarrier& b) {
    asm volatile("s_waitcnt vmcnt(0)" ::: "memory");
    __syncthreads();
    if (threadIdx.x == 0) {
        unsigned* bar = b.bar;
        __builtin_amdgcn_s_waitcnt(0);
        unsigned nloc = b.st[0], nx = b.st[1];
        if (nloc == 0u) { xcd_barrier_complete(bar, b.x, nloc, nx); b.st[0] = nloc; b.st[1] = nx; }
        const unsigned old = xb_add(&bar[XB_XSUB(b.x)], 1u);
        const unsigned gen = old / nloc;
        if (old + 1u == (gen + 1u) * nloc) {
            __builtin_amdgcn_fence(__ATOMIC_RELEASE, "agent");
            asm volatile("s_waitcnt vmcnt(0)" ::: "memory");
            const unsigned og = xb_add(&bar[XB_TOP], 1u);
            const unsigned tg = og / nx;
            if (og + 1u == (tg + 1u) * nx) xb_add(&bar[XB_TOPGEN], 1u);
            else XB_SPIN(xb_ld(&bar[XB_TOPGEN]) == tg, bar);
            __builtin_amdgcn_fence(__ATOMIC_ACQUIRE, "agent");
            xb_add(&bar[XB_XGEN(b.x)], 1u);
            asm volatile("s_waitcnt vmcnt(0)" ::: "memory");
        } else {
            XB_SPIN(xb_ld(&bar[XB_XGEN(b.x)]) == gen, bar);
            __builtin_amdgcn_fence(__ATOMIC_ACQUIRE, "agent");
            asm volatile("s_waitcnt vmcnt(0)" ::: "memory");
        }
    }
    __syncthreads();
}

namespace pg8 {
typedef __bf16 bf16x2_t __attribute__((ext_vector_type(2)));
DI unsigned pk2(float lo, float hi) { f32x2v v = {lo, hi}; bf16x2_t b = __builtin_convertvector(v, bf16x2_t); return __builtin_bit_cast(unsigned, b); }
DI u32x4 pk8(f32x4 v0, f32x4 v1) { u32x4 w; w.x = pk2(v0[0], v0[1]); w.y = pk2(v0[2], v0[3]); w.z = pk2(v1[0], v1[1]); w.w = pk2(v1[2], v1[3]); return w; }

DI unsigned dpp_ror8(unsigned v) { return (unsigned)__builtin_amdgcn_mov_dpp((int)v, 0x128, 0xf, 0xf, false); }
DI void store_rows16(unsigned char* rowp, size_t ldb, u32x4 P0, u32x4 P1, int fr) {
    const bool hi = fr >= 8;
    const u32x4 give = hi ? P0 : P1;
    u32x4 recv; recv.x = dpp_ror8(give.x); recv.y = dpp_ror8(give.y); recv.z = dpp_ror8(give.z); recv.w = dpp_ror8(give.w);
    unsigned char* pa = rowp + (size_t)(fr & 7) * ldb + (hi ? 16 : 0);
    *(u32x4*)pa = hi ? recv : P0;
    *(u32x4*)(pa + 8 * ldb) = hi ? P1 : recv;
}
struct EpiInProj {
    static constexpr int PERM = 2;
    bf16* P1; float* vstat; const float* bias;
    DI void operator()(const f32x4 (&acc)[2][2][4][2], const Unit& u, int wr, int wc, int fr, int fq) const {
        const int rg0 = u.pm * BM + wr * 64;
        const int bcol0 = u.pn * BM + wc * 64 + 16 * fq;
        f32x4 bv[2][2];
#pragma unroll
        for (int bj = 0; bj < 2; ++bj)
#pragma unroll
            for (int n = 0; n < 2; ++n) bv[bj][n] = *(const f32x4*)(bias + bcol0 + 8 * bj + 4 * n);
        if (u.pn < 8) {
            bf16* base = P1 + u.pn * 128 + wc * 32 + 8 * fq;
#pragma unroll
            for (int ai = 0; ai < 2; ++ai)
#pragma unroll
                for (int m = 0; m < 4; ++m) {
                    f32x4 u0 = gelu4(acc[ai][0][m][0] + bv[0][0]), u1 = gelu4(acc[ai][0][m][1] + bv[0][1]);
                    const f32x4 g0 = sigmoid4(acc[ai][1][m][0] + bv[1][0]), g1 = sigmoid4(acc[ai][1][m][1] + bv[1][1]);
                    u0 = u0 * g0; u1 = u1 * g1;
                    *(u32x4*)(base + (size_t)(rg0 + ai * HALF + m * 16 + fr) * D) = pk8(u0, u1);
                }
        } else {
            const int t = (u.pn - 8) >> 2, colt = ((u.pn - 8) & 3) * BM;
            bf16* base = P1 + (size_t)(t + 1) * T * D + colt + wc * 64 + 16 * fq;
#pragma unroll
            for (int ai = 0; ai < 2; ++ai)
#pragma unroll
                for (int m = 0; m < 4; ++m) {
                    float s1 = 0.f, s2 = 0.f; u32x4 P[2];
#pragma unroll
                    for (int bj = 0; bj < 2; ++bj) {
                        f32x4 v0 = acc[ai][bj][m][0] + bv[bj][0], v1 = acc[ai][bj][m][1] + bv[bj][1];
                        if (t == 0) { v0 = gelu4(v0); v1 = gelu4(v1);
                            s1 += (v0[0] + v0[1]) + (v0[2] + v0[3]) + (v1[0] + v1[1]) + (v1[2] + v1[3]);
                            s2 += (v0[0] * v0[0] + v0[1] * v0[1]) + (v0[2] * v0[2] + v0[3] * v0[3]) + (v1[0] * v1[0] + v1[1] * v1[1]) + (v1[2] * v1[2] + v1[3] * v1[3]); }
                        else if (t == 1) { v0 = v0 * (QSCALE * LOG2E); v1 = v1 * (QSCALE * LOG2E); }
                        else if (t == 4) { v0 = sigmoid4(v0); v1 = sigmoid4(v1); }
                        P[bj] = pk8(v0, v1);
                    }
                    store_rows16((unsigned char*)(base + (size_t)(rg0 + ai * HALF + m * 16) * D), (size_t)D * 2, P[0], P[1], fr);
                    if (t == 0) {
                        s1 += __shfl_xor(s1, 16); s1 += __shfl_xor(s1, 32); s2 += __shfl_xor(s2, 16); s2 += __shfl_xor(s2, 32);
                        if (fq == 0) *(f32x2v*)(vstat + ((size_t)(rg0 + ai * HALF + m * 16 + fr) * 16 + (u.pn - 8) * 4 + wc) * 2) = (f32x2v){s1, s2};
                    }
                }
        }
    }
};
struct EpiBf16S {
    static constexpr int PERM = 2;
    bf16* O; int ldc; float scale;
    DI void operator()(const f32x4 (&acc)[2][2][4][2], const Unit& u, int wr, int wc, int fr, int fq) const {
        const int rg0 = u.pm * BM + wr * 64, col0 = u.pn * BM + wc * 64 + 16 * fq;
#pragma unroll
        for (int ai = 0; ai < 2; ++ai)
#pragma unroll
            for (int m = 0; m < 4; ++m)
                store_rows16((unsigned char*)(O + (size_t)(rg0 + ai * HALF + m * 16) * ldc + col0), (size_t)ldc * 2,
                             pk8(acc[ai][0][m][0] * scale, acc[ai][0][m][1] * scale), pk8(acc[ai][1][m][0] * scale, acc[ai][1][m][1] * scale), fr);
    }
};
template <bool LNIN> struct EpiResF32 {
    static constexpr int PERM = 0;
    float* out; const float* res; const float* xstat; const float* g; const float* b;
    DI void operator()(const f32x4 (&acc)[2][2][4][2], const Unit& u, int wr, int wc, int fr, int fq) const {
        const int col0 = u.pn * BM + wc * 32 + 4 * fq;
        f32x4 gv[2][2], bv[2][2];
        if (LNIN) {
#pragma unroll
            for (int bj = 0; bj < 2; ++bj)
#pragma unroll
                for (int n = 0; n < 2; ++n) { gv[bj][n] = *(const f32x4*)(g + col0 + bj * HALF + n * 16); bv[bj][n] = *(const f32x4*)(b + col0 + bj * HALF + n * 16); }
        }
#pragma unroll
        for (int ai = 0; ai < 2; ++ai)
#pragma unroll
            for (int m = 0; m < 4; ++m) {
                const int rg = u.pm * BM + ai * HALF + wr * 64 + m * 16, row = rg + fr; const size_t off = (size_t)row * D + col0;
                f32x2v st = (f32x2v){0.f, 1.f}; if (LNIN) st = *(const f32x2v*)(xstat + 2 * (size_t)row);
#pragma unroll
                for (int bj = 0; bj < 2; ++bj) { f32x4 o[2];
#pragma unroll
                    for (int n = 0; n < 2; ++n) { f32x4 r = *(const f32x4*)(res + off + bj * HALF + n * 16);
                        if (LNIN) r = (r - st.x) * st.y * gv[bj][n] + bv[bj][n];
                        o[n] = r * ALPHA + acc[ai][bj][m][n]; }
                    const bool hi = fr >= 8; const f32x4 give = hi ? o[0] : o[1];
                    u32x4 gi = __builtin_bit_cast(u32x4, give), rc; rc.x = dpp_ror8(gi.x); rc.y = dpp_ror8(gi.y); rc.z = dpp_ror8(gi.z); rc.w = dpp_ror8(gi.w);
                    const f32x4 recv = __builtin_bit_cast(f32x4, rc);
                    float* pa = out + (size_t)(rg + (fr & 7)) * D + col0 + bj * HALF + (hi ? 16 : 0);
                    *(f32x4*)pa = hi ? recv : o[0];
                    *(f32x4*)(pa + 8 * D) = hi ? o[1] : recv; }
                if (m & 1) asm volatile("" ::: "memory");
            }
    }
};
template <bool LNIN> struct EpiResB16 {
    static constexpr int PERM = 2;
    bf16* out; const float* resf; const bf16* resb; const float* xstat; const float* g; const float* b;
    DI void operator()(const f32x4 (&acc)[2][2][4][2], const Unit& u, int wr, int wc, int fr, int fq) const {
        const int col0 = u.pn * BM + wc * 64 + 16 * fq;
        f32x4 gv[2][2], bv[2][2];
        if (LNIN) {
#pragma unroll
            for (int bj = 0; bj < 2; ++bj)
#pragma unroll
                for (int n = 0; n < 2; ++n) { gv[bj][n] = *(const f32x4*)(g + col0 + 8 * bj + 4 * n); bv[bj][n] = *(const f32x4*)(b + col0 + 8 * bj + 4 * n); }
        }
#pragma unroll
        for (int ai = 0; ai < 2; ++ai)
#pragma unroll
            for (int m = 0; m < 4; ++m) {
                const int rg = u.pm * BM + ai * HALF + wr * 64 + m * 16, row = rg + fr; const size_t off = (size_t)row * D + col0;
                f32x4 rr[2][2];
                if (LNIN) { const f32x2v st = *(const f32x2v*)(xstat + 2 * (size_t)row);
#pragma unroll
                    for (int bj = 0; bj < 2; ++bj)
#pragma unroll
                        for (int n = 0; n < 2; ++n) rr[bj][n] = (*(const f32x4*)(resf + off + 8 * bj + 4 * n) - st.x) * st.y * gv[bj][n] + bv[bj][n];
                } else {
#pragma unroll
                    for (int bj = 0; bj < 2; ++bj) { const u32x4 x = *(const u32x4*)(resb + off + 8 * bj);
                        rr[bj][0] = (f32x4){bflo(x.x), bfhi(x.x), bflo(x.y), bfhi(x.y)}; rr[bj][1] = (f32x4){bflo(x.z), bfhi(x.z), bflo(x.w), bfhi(x.w)}; } }
                store_rows16((unsigned char*)(out + (size_t)rg * D + col0), (size_t)D * 2,
                             pk8(rr[0][0] * ALPHA + acc[ai][0][m][0], rr[0][1] * ALPHA + acc[ai][0][m][1]), pk8(rr[1][0] * ALPHA + acc[ai][1][m][0], rr[1][1] * ALPHA + acc[ai][1][m][1]), fr);
                if (m & 1) asm volatile("" ::: "memory");
            }
    }
};
constexpr int MO_BLKE = 128 * 1024, MO_RT = MO_BLKE + 640, MO_RW = MO_RT + 5 * 1024, MO_END = MO_RW + 5 * 1024;
static_assert(MO_END <= SCR_BYTES, "MoE LDS tables");
struct EpiGateUp {
    static constexpr int PERM = 1;
    bf16* H; const LAS unsigned char* lds;
    DI void operator()(const f32x4 (&acc)[2][2][4][2], const Unit& u, int wr, int wc, int fr, int fq) const {
        const int rl = wr * 64 + fr, row0 = u.pm * BM + rl, col0 = u.pn * 128 + wc * 32 + 8 * fq;
        float wv[2][4];
#pragma unroll
        for (int ai = 0; ai < 2; ++ai)
#pragma unroll
            for (int m = 0; m < 4; ++m) wv[ai][m] = (u.e < 64) ? *(const LAS float*)(lds + MO_RW + (u.ui * 256 + rl + ai * HALF + m * 16) * 4) : 1.0f;
#pragma unroll
        for (int ai = 0; ai < 2; ++ai)
#pragma unroll
            for (int m = 0; m < 4; ++m) {
                const f32x4 g0 = acc[ai][0][m][0], g1 = acc[ai][0][m][1];
                const f32x4 h0 = g0 * sigmoid4(g0) * acc[ai][1][m][0] * wv[ai][m], h1 = g1 * sigmoid4(g1) * acc[ai][1][m][1] * wv[ai][m];
                *(u32x4*)(H + (size_t)(row0 + ai * HALF + m * 16) * EH + col0) = pk8(h0, h1);
            }
    }
};
constexpr float Y8_SCALE = 32.0f, Y8_CLAMP = 440.0f;
DI unsigned pk4_fp8(f32x4 v) { v = v * Y8_SCALE;
    const float a = __builtin_fminf(__builtin_fmaxf(v[0], -Y8_CLAMP), Y8_CLAMP), b = __builtin_fminf(__builtin_fmaxf(v[1], -Y8_CLAMP), Y8_CLAMP), c = __builtin_fminf(__builtin_fmaxf(v[2], -Y8_CLAMP), Y8_CLAMP), d = __builtin_fminf(__builtin_fmaxf(v[3], -Y8_CLAMP), Y8_CLAMP);
    int p = __builtin_amdgcn_cvt_pk_fp8_f32(a, b, 0, false); p = __builtin_amdgcn_cvt_pk_fp8_f32(c, d, p, true); return (unsigned)p; }
struct EpiDown {
    static constexpr int PERM = 2;
    unsigned char* Y8; bf16* xb; int nostore;
    DI void operator()(const f32x4 (&acc)[2][2][4][2], const Unit& u, int wr, int wc, int fr, int fq) const {
        if (nostore) return;
        const int rl = wr * 64 + fr, col0 = u.pn * BM + wc * 64 + 16 * fq;
        if (u.e < 64) {
#pragma unroll
            for (int ai = 0; ai < 2; ++ai)
#pragma unroll
                for (int m = 0; m < 4; ++m) { const int r = rl + ai * HALF + m * 16;
                    u32x4 w; w.x = pk4_fp8(acc[ai][0][m][0]); w.y = pk4_fp8(acc[ai][0][m][1]); w.z = pk4_fp8(acc[ai][1][m][0]); w.w = pk4_fp8(acc[ai][1][m][1]);
                    __builtin_nontemporal_store(w, (u32x4*)(Y8 + ((size_t)u.pm * BM + r) * D + col0)); }
        } else {
#pragma unroll
            for (int ai = 0; ai < 2; ++ai) {
                u32x4 xr[4][2];
#pragma unroll
                for (int m = 0; m < 4; ++m)
#pragma unroll
                    for (int bj = 0; bj < 2; ++bj) xr[m][bj] = *(const u32x4*)(xb + ((size_t)(u.pm - SH_ROW0 / BM) * BM + rl + ai * HALF + m * 16) * D + col0 + 8 * bj);
#pragma unroll
                for (int m = 0; m < 4; ++m) { const size_t off = ((size_t)(u.pm - SH_ROW0 / BM) * BM + rl + ai * HALF + m * 16) * D + col0;
#pragma unroll
                    for (int bj = 0; bj < 2; ++bj) { const u32x4 x = xr[m][bj];
                        const f32x4 x0 = (f32x4){bflo(x.x), bfhi(x.x), bflo(x.y), bfhi(x.y)}, x1 = (f32x4){bflo(x.z), bfhi(x.z), bflo(x.w), bfhi(x.w)};
                        *(u32x4*)(xb + off + 8 * bj) = pk8(x0 * ALPHA + acc[ai][bj][m][0], x1 * ALPHA + acc[ai][bj][m][1]); } }
                asm volatile("" ::: "memory"); }
        }
    }
};
struct GateUpOrder {
    const char* X; const char* Wgu; const char* Wgus; const LAS unsigned char* lds; int nblk, G, c;
    DI bool next(int i, Unit& u) const {
        const int L = i * G + c; if (L >= (nblk + 64) * 2) return false;
        const int bl = L >> 1; u.pn = L & 1; u.ui = i;
        if (bl < nblk) { u.e = (int)__builtin_amdgcn_readfirstlane((int)*(const LAS unsigned char*)(lds + MO_BLKE + bl)); u.pm = bl; u.A = X; u.B = Wgu + ((size_t)u.e * 512 + u.pn * 256) * D * 2; }
        else { u.e = 64; u.pm = SH_ROW0 / BM + (bl - nblk); u.A = X + (size_t)(bl - nblk) * BM * D * 2; u.B = Wgus + (size_t)u.pn * 256 * D * 2; }
        return true;
    }
    DI void a_offs(const Unit& u, const int (&R)[2], const int (&C)[2], int K_, unsigned (&off)[2][2]) const {
        if (u.e < 64) {
#pragma unroll
            for (int h = 0; h < 2; ++h)
#pragma unroll
                for (int i = 0; i < 2; ++i) { const int tok = *(const LAS int*)(lds + MO_RT + (u.ui * 256 + h * HALF + R[i]) * 4); off[h][i] = (unsigned)(tok * K_ + C[i]) * 2u; }
        } else {
#pragma unroll
            for (int h = 0; h < 2; ++h)
#pragma unroll
                for (int i = 0; i < 2; ++i) off[h][i] = (unsigned)((h * HALF + R[i]) * K_ + C[i]) * 2u;
        }
    }
};
struct DownOrder {
    const char* H; const char* Wd; const char* Wds; const LAS unsigned char* lds; int lo, hi, nsh, G, c, hot;
    DI bool next(int i, Unit& u) const {
        const int L = i * G + c; if (L >= (hi - lo + nsh) * 4) return false;
        int bl = lo + (L >> 2); u.pn = L & 3; u.ui = i; if (hot) bl = lo + ((L >> 2) & 7);
        if (bl < hi) { u.e = (int)__builtin_amdgcn_readfirstlane((int)*(const LAS unsigned char*)(lds + MO_BLKE + bl)); u.pm = bl; u.B = Wd + ((size_t)u.e * D + u.pn * 256) * EH * 2; }
        else { u.e = 64; u.pm = SH_ROW0 / BM + (bl - hi); u.B = Wds + (size_t)u.pn * 256 * EH * 2; }
        u.A = H + (size_t)u.pm * BM * EH * 2;
        return true;
    }
    DI void a_offs(const Unit&, const int (&R)[2], const int (&C)[2], int K_, unsigned (&off)[2][2]) const {
#pragma unroll
        for (int h = 0; h < 2; ++h)
#pragma unroll
            for (int i = 0; i < 2; ++i) off[h][i] = (unsigned)((h * HALF + R[i]) * K_ + C[i]) * 2u;
    }
};
DI void moe_tables(LAS unsigned char* lds, const unsigned* blke, int nblk, const int* rowtok, const float* roww, bool gateup, int G, int c, int tid) {
    for (int b = tid; b < nblk; b += NTHREADS) *(LAS unsigned char*)(lds + MO_BLKE + b) = (unsigned char)__hip_atomic_load(blke + b, RLX_AGENT);
    if (gateup) {
#pragma unroll
        for (int i = 0; i < 5; ++i) { const int L = i * G + c, bl = L >> 1;
            if (bl < nblk && tid < 256) { *(LAS int*)(lds + MO_RT + (i * 256 + tid) * 4) = __hip_atomic_load(rowtok + (size_t)bl * 256 + tid, RLX_AGENT);
                                          *(LAS float*)(lds + MO_RW + (i * 256 + tid) * 4) = __hip_atomic_load(roww + (size_t)bl * 256 + tid, RLX_AGENT); } }
    }
    __syncthreads();
}
}

struct Frame {
    LAS unsigned char* lds;
    unsigned* ctl;
    unsigned char* ws; float* out;
    int tid, lane, wave, vcu, G;
};
DI unsigned short f2bf1(float x) { return (unsigned short)(pg8::pk2(x, x) & 0xffffu); }

template <class RowMap>
DI void transpose_item(const float* W, int N, bf16* WT, int Kd, RowMap rm, LAS float* scr, int kb, int nb, int lane) {
    const int k0 = 64 * kb, n0 = 32 * nb;
#pragma unroll 8
    for (int i = 0; i < 32; ++i) { const int kk = 2 * i + (lane >> 5); scr[kk * 33 + (lane & 31)] = W[(size_t)(k0 + kk) * N + n0 + (lane & 31)]; }
    LDS_WAIT(); asm volatile("" ::: "memory");
    const int c = lane & 7;
#pragma unroll
    for (int j = 0; j < 4; ++j) { const int n = (lane >> 3) + 8 * j; const LAS float* s = scr + (8 * c) * 33 + n;
        u32x4 o; o.x = pg8::pk2(s[0 * 33], s[1 * 33]); o.y = pg8::pk2(s[2 * 33], s[3 * 33]); o.z = pg8::pk2(s[4 * 33], s[5 * 33]); o.w = pg8::pk2(s[6 * 33], s[7 * 33]);
        *(u32x4*)(WT + (size_t)rm(n0 + n) * Kd + k0 + 8 * c) = o; }
    LDS_WAIT(); asm volatile("" ::: "memory");
}
struct RmIdent { int off; DI int operator()(int n) const { return off + n; } };
struct RmInProj { DI int operator()(int n) const { const int seg = n >> 10, w = n & 1023;
    return seg == 0 ? ((w >> 7) * 256 + ((w & 127) >> 3) * 16 + (w & 7)) : seg == 5 ? ((w >> 7) * 256 + ((w & 127) >> 3) * 16 + 8 + (w & 7)) : seg == 6 ? 6144 + w : 1024 + n; } };
struct RmGateUp { int up; DI int operator()(int n) const { return (n >> 7) * 256 + up * 128 + (n & 127); } };
DI int inproj_dest(int n) { return RmInProj()(n); }

struct CvtItem { const float* W; bf16* WT; int N, Kd, mode, kb, nb; };
DI CvtItem cvt_decode(const float* const* in, unsigned char* ws, int it) {
    const int e = it / 384; int r = it % 384; CvtItem c;
    if (r < 256) { const int up = r >> 7; r &= 127; c.W = in[20 + up] + (size_t)e * D * EH; c.N = EH; c.WT = (bf16*)(ws + WS_WGU) + (size_t)e * 512 * D; c.Kd = D; c.mode = up; c.kb = r >> 3; c.nb = r & 7; }
    else { r -= 256; c.W = in[22] + (size_t)e * EH * D; c.N = D; c.WT = (bf16*)(ws + WS_WD) + (size_t)e * D * EH; c.Kd = EH; c.mode = 2; c.kb = r >> 5; c.nb = r & 31; }
    return c;
}
DI void cvt_load(const CvtItem& c, int lane, f32x4 (&v)[8]) {
#pragma unroll
    for (int i = 0; i < 8; ++i) v[i] = __builtin_nontemporal_load((const f32x4*)(c.W + (size_t)(64 * c.kb + (lane >> 3) + 8 * i) * c.N + 32 * c.nb + 4 * (lane & 7)));
}
DI void cvt_finish(const CvtItem& c, int lane, const f32x4 (&v)[8], LAS float* scr) {
#pragma unroll
    for (int i = 0; i < 8; ++i) { LAS float* d = scr + ((lane >> 3) + 8 * i) * 33 + 4 * (lane & 7); d[0] = v[i][0]; d[1] = v[i][1]; d[2] = v[i][2]; d[3] = v[i][3]; }
    LDS_WAIT(); asm volatile("" ::: "memory");
    const int cc = lane & 7;
#pragma unroll
    for (int j = 0; j < 4; ++j) { const int n = 32 * c.nb + (lane >> 3) + 8 * j; const LAS float* sp = scr + (8 * cc) * 33 + (lane >> 3) + 8 * j;
        const int drow = (c.mode == 2) ? n : (c.mode == 3) ? RmInProj()(n) : ((n >> 7) * 256 + c.mode * 128 + (n & 127));
        u32x4 o; o.x = pg8::pk2(sp[0 * 33], sp[1 * 33]); o.y = pg8::pk2(sp[2 * 33], sp[3 * 33]); o.z = pg8::pk2(sp[4 * 33], sp[5 * 33]); o.w = pg8::pk2(sp[6 * 33], sp[7 * 33]);
        *(u32x4*)(c.WT + (size_t)drow * c.Kd + 64 * c.kb + 8 * cc) = o; }
    LDS_WAIT(); asm volatile("" ::: "memory");
}
constexpr int P0_I_IN = 16 * (INW / 32), P0_I_OUT = 16 * 32, P0_I_Q = 16 * 16, P0_I_KV = 16 * 32, P0_I_O = 8 * 32, P0_I_SG = 16 * 8, P0_I_SD = 4 * 32;
constexpr int P0_NITEMS = P0_I_IN + P0_I_OUT + P0_I_Q + P0_I_KV + P0_I_O + 2 * P0_I_SG + P0_I_SD;
DI CvtItem p0_decode(const float* const* in, unsigned char* ws, int it) {
    int r = it; CvtItem c;
    if (r < P0_I_IN) { c.W = in[4]; c.N = INW; c.WT = (bf16*)(ws + WS_WIN); c.Kd = D; c.mode = 3; c.kb = r / (INW / 32); c.nb = r % (INW / 32); return c; } r -= P0_I_IN;
    if (r < P0_I_OUT) { c.W = in[10]; c.N = D; c.WT = (bf16*)(ws + WS_WOUT); c.Kd = D; c.mode = 2; c.kb = r / 32; c.nb = r % 32; return c; } r -= P0_I_OUT;
    if (r < P0_I_Q) { c.W = in[13]; c.N = MEMW; c.WT = (bf16*)(ws + WS_WQ); c.Kd = D; c.mode = 2; c.kb = r / 16; c.nb = r % 16; return c; } r -= P0_I_Q;
    if (r < P0_I_KV) { c.W = in[14]; c.N = 2 * MEMW; c.WT = (bf16*)(ws + WS_WKV); c.Kd = D; c.mode = 2; c.kb = r / 32; c.nb = r % 32; return c; } r -= P0_I_KV;
    if (r < P0_I_O) { c.W = in[15]; c.N = D; c.WT = (bf16*)(ws + WS_WO); c.Kd = MEMW; c.mode = 2; c.kb = r / 32; c.nb = r % 32; return c; } r -= P0_I_O;
    if (r < 2 * P0_I_SG) { const int up = r / P0_I_SG; r %= P0_I_SG; c.W = in[23 + up]; c.N = EH; c.WT = (bf16*)(ws + WS_WGUS); c.Kd = D; c.mode = up; c.kb = r / 8; c.nb = r % 8; return c; } r -= 2 * P0_I_SG;
    c.W = in[25]; c.N = D; c.WT = (bf16*)(ws + WS_WDS); c.Kd = EH; c.mode = 2; c.kb = r / 32; c.nb = r % 32; return c;
}
DI void p0_convert(Frame& F, const float* const* in) {
    LAS float* scr = (LAS float*)(F.lds + F.wave * 16384);
    const int lane = F.lane, stride = F.G * NWAVES;
    int it = F.vcu * NWAVES + F.wave;
    if (it >= P0_NITEMS) return;
    CvtItem cur = p0_decode(in, F.ws, it); f32x4 v[8]; cvt_load(cur, lane, v);
    for (;;) {
        const int nx = it + stride; const bool has = nx < P0_NITEMS;
        CvtItem nxt = cur; f32x4 vn[8];
        if (has) { nxt = p0_decode(in, F.ws, nx); cvt_load(nxt, lane, vn); }
        cvt_finish(cur, lane, v, scr);
        if (!has) break;
        cur = nxt; it = nx;
#pragma unroll
        for (int i = 0; i < 8; ++i) v[i] = vn[i];
    }
}
DI void expert_convert(Frame& F, const float* const* in, int worker, int nworkers, int item_lo, int item_hi) {
    LAS float* scr = (LAS float*)(F.lds + F.wave * 16384);
    const int lane = F.lane, stride = nworkers * NWAVES;
    int it = item_lo + worker * NWAVES + F.wave;
    if (it >= item_hi) return;
    CvtItem cur = cvt_decode(in, F.ws, it); f32x4 v[8]; cvt_load(cur, lane, v);
    for (;;) {
        const int nx = it + stride; const bool has = nx < item_hi;
        CvtItem nxt = cur; f32x4 vn[8];
        if (has) { nxt = cvt_decode(in, F.ws, nx); cvt_load(nxt, lane, vn); }
        cvt_finish(cur, lane, v, scr);
        if (!has) break;
        cur = nxt; it = nx;
#pragma unroll
        for (int i = 0; i < 8; ++i) v[i] = vn[i];
    }
}

template <bool NT = false> DI void row_stats(const float* xrow, int lane, f32x4 (&v)[4], float& mean, float& rstd) {
    const f32x4* xr = (const f32x4*)xrow + lane; float s = 0.f;
#pragma unroll
    for (int j = 0; j < 4; ++j) { v[j] = NT ? __builtin_nontemporal_load(xr + 64 * j) : xr[64 * j]; s += (v[j][0] + v[j][1]) + (v[j][2] + v[j][3]); }
    mean = wave_sum(s) * (1.f / D); float s2 = 0.f;
#pragma unroll
    for (int j = 0; j < 4; ++j) { const f32x4 d = v[j] - mean; s2 += (d[0] * d[0] + d[1] * d[1]) + (d[2] * d[2] + d[3] * d[3]); }
    rstd = 1.f / sqrtf(wave_sum(s2) * (1.f / D) + LN_EPS);
}

DI void row_stats_b16(const bf16* xrow, int lane, f32x4 (&v)[4], float& mean, float& rstd) {
    const u32x2* xr = (const u32x2*)xrow + lane; float s = 0.f;
#pragma unroll
    for (int j = 0; j < 4; ++j) { const u32x2 x = xr[64 * j]; v[j] = (f32x4){bflo(x.x), bfhi(x.x), bflo(x.y), bfhi(x.y)}; s += (v[j][0] + v[j][1]) + (v[j][2] + v[j][3]); }
    mean = wave_sum(s) * (1.f / D); float s2 = 0.f;
#pragma unroll
    for (int j = 0; j < 4; ++j) { const f32x4 d = v[j] - mean; s2 += (d[0] * d[0] + d[1] * d[1]) + (d[2] * d[2] + d[3] * d[3]); }
    rstd = 1.f / sqrtf(wave_sum(s2) * (1.f / D) + LN_EPS);
}
DI void p0_prologue(Frame& F, const float* const* in) {
    const int gw = F.vcu * NWAVES + F.wave, NGW = F.G * NWAVES, lane = F.lane;
    unsigned char* ws = F.ws;
    p0_convert(F, in);
    const int gt = F.vcu * NTHREADS + F.tid, NGT = F.G * NTHREADS;
    { const float* wr = in[18]; bf16* hi = (bf16*)(ws + WS_WRHI); bf16* lo = (bf16*)(ws + WS_WRLO);
      for (int idx = gt; idx < D * NEXP; idx += NGT) { const int k = idx >> 6, e = idx & 63; const float w = wr[idx]; const unsigned short h = f2bf1(w); hi[e * D + k] = h; lo[e * D + k] = f2bf1(w - bf2f(h)); } }
    { const float* wsp = in[8]; bf16* o = (bf16*)(ws + WS_WSP);
      for (int idx = gt; idx < 8 * 128 * 128; idx += NGT) { const int s = idx & 127, t = (idx >> 7) & 127; o[idx] = (s <= t) ? f2bf1(wsp[idx]) : (unsigned short)0; } }
    { const float* bi = in[5]; float* o = (float*)(ws + WS_BPERM);
      for (int idx = gt; idx < INW; idx += NGT) o[inproj_dest(idx)] = bi[idx]; }
    { const f32x4* m4 = (const f32x4*)in[1]; u32x2* o = (u32x2*)(ws + WS_MEMB);
      for (int idx = gt; idx < NBATCH * MEMLEN * D / 4; idx += NGT) { const f32x4 v = m4[idx]; o[idx] = (u32x2){pg8::pk2(v[0], v[1]), pg8::pk2(v[2], v[3])}; } }
    { const float* x = in[0]; const float* g = in[2]; const float* b = in[3]; bf16* X0b = (bf16*)F.out; float* xstat = (float*)(ws + WS_XSTAT);
      f32x4 gv[4], bv[4];
#pragma unroll
      for (int j = 0; j < 4; ++j) { gv[j] = ((const f32x4*)g)[lane + 64 * j]; bv[j] = ((const f32x4*)b)[lane + 64 * j]; }
      for (int m = gw; m < T; m += NGW) { f32x4 v[4]; float mean, rstd; row_stats<true>(x + (size_t)m * D, lane, v, mean, rstd);
          u32x2* o8 = (u32x2*)(X0b + (size_t)m * D) + lane;
#pragma unroll
          for (int j = 0; j < 4; ++j) { const f32x4 y = (v[j] - mean) * rstd * gv[j] + bv[j]; o8[64 * j] = (u32x2){pg8::pk2(y[0], y[1]), pg8::pk2(y[2], y[3])}; }
          if (lane == 0) *(f32x2*)(xstat + 2 * (size_t)m) = (f32x2){mean, rstd}; } }
}
constexpr int MX_BUF = 32768, MX_STAT = 4 * MX_BUF, MX_FLG = MX_STAT + 1024, MX_FLG2 = MX_FLG + 64, MX_END = MX_FLG2 + 64;
static_assert(MX_END <= SCR_BYTES, "mixer LDS");
constexpr float MX_EXIT2 = SB_EXIT * LOG2E;
typedef short v4i16_t __attribute__((ext_vector_type(4)));
DI bf16x8 mk_frag(f32x4 e0, f32x4 e1) { const u32x4 w = pg8::pk8(e0, e1); return __builtin_bit_cast(bf16x8, w); }
DI bf16x8 ld_split8(const LAS unsigned char* p) {
    const s16x4 lo = *(const LAS s16x4*)p, hi = *(const LAS s16x4*)(p + 32);
    return (bf16x8){lo[0], lo[1], lo[2], lo[3], hi[0], hi[1], hi[2], hi[3]};
}
DI void glds16(const void* gsrc, unsigned lds_dst) { unsigned keep;
    asm volatile("s_mov_b32 %0, m0\n\ts_mov_b32 m0, %2\n\ts_nop 0\n\tglobal_load_lds_dwordx4 %1, off\n\ts_mov_b32 m0, %0" : "=&s"(keep) : "v"(gsrc), "s"(lds_dst) : "memory"); }
DI void mx_dma(LAS unsigned char* buf, const bf16* src, int w, int lane) {
#pragma unroll
    for (int i = 0; i < 4; ++i) { const int pc = 4 * w + i, row = 4 * pc + (lane >> 4), cpos = lane & 15;
        glds16((const char*)src + (size_t)row * (D * 2) + ((cpos ^ (row & 15)) * 16), (unsigned)__builtin_amdgcn_readfirstlane((unsigned)(uintptr_t)(buf + pc * 1024))); }
}
DI bf16x8 mx_tr(const LAS unsigned char* buf, int sA, int sB, int d0, int r) {
    const int ra = sA + (r >> 2), rb = sB + (r >> 2), ch = (d0 >> 3) + ((r & 3) >> 1), bo = 8 * (r & 1);
    const s16x4 lo = __builtin_bit_cast(s16x4, __builtin_amdgcn_ds_read_tr16_b64_v4i16((LAS v4i16_t*)(buf + ra * 256 + ((ch ^ (ra & 15)) * 16) + bo)));
    const s16x4 hi = __builtin_bit_cast(s16x4, __builtin_amdgcn_ds_read_tr16_b64_v4i16((LAS v4i16_t*)(buf + rb * 256 + ((ch ^ (rb & 15)) * 16) + bo)));
    return (bf16x8){lo[0], lo[1], lo[2], lo[3], hi[0], hi[1], hi[2], hi[3]};
}
DI void sb_scores(const LAS unsigned char* kbuf, const bf16x8 (&qf)[4], bool diag, int tq, float carry, int r, int q, const bf16x8& UE, const bf16x8& UO, const bf16x8& ONES, bf16x8 (&af)[4], float& tot_out) {
    f32x4 z[8];
#pragma unroll
    for (int st = 0; st < 8; ++st) { z[st] = (f32x4){0.f, 0.f, 0.f, 0.f};
#pragma unroll
        for (int kk = 0; kk < 4; ++kk) { const bf16x8 kf = *(const LAS bf16x8*)(kbuf + (16 * st + r) * 256 + (((4 * kk + q) ^ r) * 16));
            z[st] = __builtin_amdgcn_mfma_f32_16x16x32_bf16(kf, qf[kk], z[st], 0, 0, 0); }
        if (st & 1) __builtin_amdgcn_sched_barrier(0); }
    f32x4 ls[8];
#pragma unroll
    for (int st = 0; st < 8; ++st)
#pragma unroll
        for (int e = 0; e < 4; ++e) { const float zz = z[st][e]; const float sp = fmaxf(zz, 0.f) + fast_log2(1.0f + fast_exp2(-fabsf(zz)));
            const bool msk = diag && (16 * st + 4 * q + e >= tq);
            ls[st][e] = msk ? 0.f : -sp; z[st][e] = msk ? -1e30f : zz - sp; }
    bf16x8 lf[4];
#pragma unroll
    for (int p = 0; p < 4; ++p) lf[p] = mk_frag(ls[2 * p], ls[2 * p + 1]);
    f32x4 tot = (f32x4){0.f, 0.f, 0.f, 0.f};
#pragma unroll
    for (int p = 0; p < 4; ++p) tot = __builtin_amdgcn_mfma_f32_16x16x32_bf16(ONES, lf[p], tot, 0, 0, 0);
#pragma unroll
    for (int p = 0; p < 4; ++p) {
        f32x4 s0 = (f32x4){0.f, 0.f, 0.f, 0.f}, s1 = (f32x4){0.f, 0.f, 0.f, 0.f};
        s0 = __builtin_amdgcn_mfma_f32_16x16x32_bf16(UE, lf[p], s0, 0, 0, 0);
        s1 = __builtin_amdgcn_mfma_f32_16x16x32_bf16(UO, lf[p], s1, 0, 0, 0);
#pragma unroll
        for (int p2 = p + 1; p2 < 4; ++p2) { s0 = __builtin_amdgcn_mfma_f32_16x16x32_bf16(ONES, lf[p2], s0, 0, 0, 0); s1 = __builtin_amdgcn_mfma_f32_16x16x32_bf16(ONES, lf[p2], s1, 0, 0, 0); }
        f32x4 a0, a1;
#pragma unroll
        for (int e = 0; e < 4; ++e) { a0[e] = fast_exp2(z[2 * p][e] + s0[e] + carry); a1[e] = fast_exp2(z[2 * p + 1][e] + s1[e] + carry); }
        af[p] = mk_frag(a0, a1);
    }
    tot_out = tot[0];
}
DI void sb_pv(const LAS unsigned char* vbuf, const bf16x8 (&af)[4], f32x4 (&yb)[8], int r, int q) {
#pragma unroll
    for (int dt = 0; dt < 8; ++dt)
#pragma unroll
        for (int p = 0; p < 4; ++p) { const bf16x8 vf = mx_tr(vbuf, 32 * p + 4 * q, 32 * p + 16 + 4 * q, 16 * dt, r);
            yb[dt] = __builtin_amdgcn_mfma_f32_16x16x32_bf16(vf, af[p], yb[dt], 0, 0, 0);
            if (p == 3 && (dt & 1)) __builtin_amdgcn_sched_barrier(0); }
}
#define MX_WAIT_BAR(n) asm volatile("s_waitcnt vmcnt(" #n ") lgkmcnt(0)\n\ts_barrier" ::: "memory")
DI void mix_phase(Frame& F, const float* const* in) {
    LAS unsigned char* lds = F.lds; unsigned char* ws = F.ws;
    const int tid = F.tid, lane = F.lane, w = F.wave, r = lane & 15, q = lane >> 4;
    const bf16* UG = (const bf16*)(ws + WS_UG); const bf16* VA = (const bf16*)(ws + WS_VA); const bf16* Qg = (const bf16*)(ws + WS_Q);
    const bf16* Kg = (const bf16*)(ws + WS_K); const bf16* Vg = (const bf16*)(ws + WS_V); const bf16* GB = (const bf16*)(ws + WS_GB);
    const float* vstat = (const float*)(ws + WS_VSTAT); const bf16* WSP = (const bf16*)(ws + WS_WSP); bf16* MG = (bf16*)(ws + WS_MERGED);
    const float* lnvg = in[6]; const float* lnvb = in[7]; const float* bsp = in[9];
    LAS unsigned char* B0 = lds; LAS unsigned char* B1 = lds + MX_BUF; LAS unsigned char* B2 = lds + 2 * MX_BUF; LAS unsigned char* B3 = lds + 3 * MX_BUF;
    bf16x8 UE, UO, ONES;
#pragma unroll
    for (int jj = 0; jj < 8; ++jj) { ONES[jj] = (short)0x3F80;
        UE[jj] = (jj < 4) ? ((4 * q + jj > r) ? (short)0x3F80 : (short)0) : (short)0x3F80;
        UO[jj] = (jj < 4) ? (short)0 : ((4 * q + jj - 4 > r) ? (short)0x3F80 : (short)0); }
    const int NU = NBATCH * 16 * 8;
    int un = F.vcu;
    if (un >= NU) return;
#define MX_DEC(u_, b_, i_, j_) const int j_ = (u_) & 7, i_ = ((u_) >> 3) & 15, b_ = (u_) >> 7
    bf16x8 qf[4];
    { MX_DEC(un, b, i, j); const int ip = i > 0 ? i - 1 : 0;
      mx_dma(B0, Kg + (size_t)(b * SEQ + 128 * i) * D + 128 * j, w, lane);
      mx_dma(B2, Kg + (size_t)(b * SEQ + 128 * ip) * D + 128 * j, w, lane);
      mx_dma(B3, Vg + (size_t)(b * SEQ + 128 * ip) * D + 128 * j, w, lane);
#pragma unroll
      for (int kk = 0; kk < 4; ++kk) qf[kk] = *(const bf16x8*)(Qg + (size_t)(b * SEQ + 128 * i + 16 * w + r) * D + 128 * j + 32 * kk + 8 * q); }
    for (; un < NU; un += F.G) {
        MX_DEC(un, b, i, j);
        const int t0 = b * SEQ + 128 * i, c0 = 128 * j, tq = 16 * w + r;
        const int unn = (un + F.G < NU) ? un + F.G : un;
        MX_DEC(unn, bn, in_, jn); const int ipn = in_ > 0 ? in_ - 1 : 0;
        f32x4 yb[8];
#pragma unroll
        for (int dt = 0; dt < 8; ++dt) yb[dt] = (f32x4){0.f, 0.f, 0.f, 0.f};
        float carry = 0.f, tot; bf16x8 af[4];
        MX_WAIT_BAR(0);
        asm volatile("" : "+v"(qf[0]), "+v"(qf[1]), "+v"(qf[2]), "+v"(qf[3]));
        mx_dma(B1, Vg + (size_t)t0 * D + c0, w, lane);
        sb_scores(B0, qf, true, tq, 0.f, r, q, UE, UO, ONES, af, tot);
        MX_WAIT_BAR(0);
        mx_dma(B0, Kg + (size_t)(bn * SEQ + 128 * in_) * D + 128 * jn, w, lane);
        sb_pv(B1, af, yb, r, q);
        carry += tot;
        MX_WAIT_BAR(4);
        mx_dma(B1, VA + (size_t)t0 * D + c0, w, lane);
        const bool wlive = (i > 0) && (wave_max(carry) >= MX_EXIT2);
        if (wlive) { sb_scores(B2, qf, false, tq, carry, r, q, UE, UO, ONES, af, tot);
            const float wm = wave_max(carry + tot); if (lane == 0) *(LAS float*)(lds + MX_FLG + w * 4) = wm; }
        else if (i > 0) { if (lane == 0) *(LAS float*)(lds + MX_FLG + w * 4) = -1e30f; }
        MX_WAIT_BAR(4);
        mx_dma(B2, Kg + (size_t)(bn * SEQ + 128 * ipn) * D + 128 * jn, w, lane);
        if (wlive) { sb_pv(B3, af, yb, r, q); carry += tot; }
        if (i > 1) {
            float gm = -1e30f;
#pragma unroll
            for (int k = 0; k < 8; ++k) gm = fmaxf(gm, *(const LAS float*)(lds + MX_FLG + k * 4));
            if (gm >= MX_EXIT2) {
                for (int kb = i - 2; kb >= 0; --kb) {
                    MX_WAIT_BAR(0);
                    mx_dma(B2, Kg + (size_t)(b * SEQ + 128 * kb) * D + c0, w, lane); mx_dma(B3, Vg + (size_t)(b * SEQ + 128 * kb) * D + c0, w, lane);
                    MX_WAIT_BAR(0);
                    if (wave_max(carry) >= MX_EXIT2) { sb_scores(B2, qf, false, tq, carry, r, q, UE, UO, ONES, af, tot); sb_pv(B3, af, yb, r, q); carry += tot; }
                    const float wm = wave_max(carry); if (lane == 0) *(LAS float*)(lds + MX_FLG2 + w * 4) = wm;
                    MX_WAIT_BAR(0);
                    float g2 = -1e30f;
#pragma unroll
                    for (int k = 0; k < 8; ++k) g2 = fmaxf(g2, *(const LAS float*)(lds + MX_FLG2 + k * 4));
                    if (g2 < MX_EXIT2) break;
                }
                MX_WAIT_BAR(0);
                mx_dma(B2, Kg + (size_t)(bn * SEQ + 128 * ipn) * D + 128 * jn, w, lane);
            }
        }
        { f32x2 sp4[4];
#pragma unroll
          for (int k = 0; k < 4; ++k) sp4[k] = *((const f32x2*)vstat + (size_t)(t0 + (tid >> 2)) * 16 + 4 * (tid & 3) + k);
          float s1 = (sp4[0][0] + sp4[1][0]) + (sp4[2][0] + sp4[3][0]), s2 = (sp4[0][1] + sp4[1][1]) + (sp4[2][1] + sp4[3][1]);
          s1 += __shfl_xor(s1, 1); s1 += __shfl_xor(s1, 2); s2 += __shfl_xor(s2, 1); s2 += __shfl_xor(s2, 2);
          const float mean = s1 * (1.f / D), var = s2 * (1.f / D) - mean * mean;
          if ((tid & 3) == 0) *(LAS f32x2*)(lds + MX_STAT + (tid >> 2) * 8) = (f32x2){mean, 1.f / sqrtf(fmaxf(var, 0.f) + LN_EPS)}; }
        MX_WAIT_BAR(4);
        mx_dma(B3, Vg + (size_t)(bn * SEQ + 128 * ipn) * D + 128 * jn, w, lane);
        bf16x8 qn[4];
#pragma unroll
        for (int kk = 0; kk < 4; ++kk) qn[kk] = *(const bf16x8*)(Qg + (size_t)(bn * SEQ + 128 * in_ + 16 * w + r) * D + 128 * jn + 32 * kk + 8 * q);
        {
          f32x4 ya[8];
#pragma unroll
          for (int dt = 0; dt < 8; ++dt) ya[dt] = (f32x4){0.f, 0.f, 0.f, 0.f};
          float c1 = 0.f, c2 = 0.f;
          const int nks = (w >> 1) + 1;
          for (int ks = 0; ks < nks; ++ks) {
              const u32x4 wr4 = *(const u32x4*)(WSP + ((size_t)j * 128 + tq) * 128 + 32 * ks + 8 * q);
              float wv[8] = {bflo(wr4.x), bfhi(wr4.x), bflo(wr4.y), bfhi(wr4.y), bflo(wr4.z), bfhi(wr4.z), bflo(wr4.w), bfhi(wr4.w)}; float wp[8];
#pragma unroll
              for (int e = 0; e < 8; ++e) { const f32x2 st = *(const LAS f32x2*)(lds + MX_STAT + (32 * ks + 8 * q + e) * 8); wp[e] = wv[e] * st[1]; c2 += wv[e]; }
              const u32x4 wq = pg8::pk8((f32x4){wp[0], wp[1], wp[2], wp[3]}, (f32x4){wp[4], wp[5], wp[6], wp[7]});
              const float wb[8] = {bflo(wq.x), bfhi(wq.x), bflo(wq.y), bfhi(wq.y), bflo(wq.z), bfhi(wq.z), bflo(wq.w), bfhi(wq.w)};
#pragma unroll
              for (int e = 0; e < 8; ++e) { const f32x2 st = *(const LAS f32x2*)(lds + MX_STAT + (32 * ks + 8 * q + e) * 8); c1 += wb[e] * st[0]; }
              const bf16x8 wf = __builtin_bit_cast(bf16x8, wq);
#pragma unroll
              for (int dt = 0; dt < 8; ++dt) { const bf16x8 vf = mx_tr(B1, 32 * ks + 8 * q, 32 * ks + 8 * q + 4, 16 * dt, r);
                  ya[dt] = __builtin_amdgcn_mfma_f32_16x16x32_bf16(vf, wf, ya[dt], 0, 0, 0); }
          }
          c1 += __shfl_xor(c1, 16); c1 += __shfl_xor(c1, 32); c2 += __shfl_xor(c2, 16); c2 += __shfl_xor(c2, 32);
          const float bs = bsp[j * 128 + tq]; const size_t rowoff = (size_t)(t0 + tq) * D + c0 + 4 * q;
#pragma unroll
          for (int dt = 0; dt < 8; ++dt) { const u32x2 ug = *(const u32x2*)(UG + rowoff + 16 * dt), gb = *(const u32x2*)(GB + rowoff + 16 * dt);
              const f32x4 g4 = *(const f32x4*)(lnvg + c0 + 16 * dt + 4 * q), b4 = *(const f32x4*)(lnvb + c0 + 16 * dt + 4 * q);
              const f32x4 u4 = (f32x4){bflo(ug.x), bfhi(ug.x), bflo(ug.y), bfhi(ug.y)}, gq = (f32x4){bflo(gb.x), bfhi(gb.x), bflo(gb.y), bfhi(gb.y)};
              const f32x4 mixed = g4 * (ya[dt] - c1) + b4 * c2 + bs;
              const f32x4 o = u4 * mixed + gq * yb[dt];
              *(u32x2*)(MG + rowoff + 16 * dt) = (u32x2){pg8::pk2(o[0], o[1]), pg8::pk2(o[2], o[3])}; } }
#pragma unroll
        for (int kk = 0; kk < 4; ++kk) qf[kk] = qn[kk];
    }
    MX_WAIT_BAR(0);
#undef MX_DEC
}
#undef MX_WAIT_BAR

DI void ln1_phase(Frame& F, const float* const* in) {
    const int gw = F.vcu * NWAVES + F.wave, NGW = F.G * NWAVES, lane = F.lane;
    const bf16* Y1 = (const bf16*)(F.ws + WS_Y1); bf16* X1b = (bf16*)(F.ws + WS_X1B);
    f32x4 gv[4], bv[4];
#pragma unroll
    for (int j = 0; j < 4; ++j) { gv[j] = ((const f32x4*)in[11])[lane + 64 * j]; bv[j] = ((const f32x4*)in[12])[lane + 64 * j]; }
    for (int m = gw; m < T; m += NGW) { f32x4 v[4]; float mean, rstd; row_stats_b16(Y1 + (size_t)m * D, lane, v, mean, rstd);
        u32x2* ob = (u32x2*)(X1b + (size_t)m * D) + lane;
#pragma unroll
        for (int j = 0; j < 4; ++j) { const f32x4 y = (v[j] - mean) * rstd * gv[j] + bv[j]; ob[64 * j] = (u32x2){pg8::pk2(y[0], y[1]), pg8::pk2(y[2], y[3])}; } }
}

DI void memattn_phase(Frame& F, int first, int stride) {
    LAS unsigned char* lds = F.lds; unsigned char* ws = F.ws;
    const int lane = F.lane, w = F.wave, r = lane & 15, q = lane >> 4;
    const bf16* Qm = (const bf16*)(ws + WS_QM); const bf16* KV = (const bf16*)(ws + WS_KVM); bf16* Om = (bf16*)(ws + WS_OM);
    for (int su = first; su < NBATCH * 4 * 8; su += stride) {
        const int qc = su & 7, h = (su >> 3) & 3, b = su >> 5;
        mx_dma(lds, KV + (size_t)(b * MEMLEN) * D + h * 128, w, lane); mx_dma(lds + MX_BUF, KV + (size_t)(b * MEMLEN + 128) * D + h * 128, w, lane);
        mx_dma(lds + 2 * MX_BUF, KV + (size_t)(b * MEMLEN) * D + MEMW + h * 128, w, lane); mx_dma(lds + 3 * MX_BUF, KV + (size_t)(b * MEMLEN + 128) * D + MEMW + h * 128, w, lane);
        bf16x8 qf[4];
#pragma unroll
        for (int kk = 0; kk < 4; ++kk) qf[kk] = *(const bf16x8*)(Qm + ((size_t)b * SEQ + 256 * qc + 16 * w + r) * MEMW + h * 128 + 32 * kk + 8 * q);
        asm volatile("s_waitcnt vmcnt(0) lgkmcnt(0)\n\ts_barrier" ::: "memory");
        for (int c = 0; c < 2; ++c) {
            const size_t trow = (size_t)b * SEQ + 256 * qc + 128 * c + 16 * w + r;
            if (c == 1) {
#pragma unroll
                for (int kk = 0; kk < 4; ++kk) qf[kk] = *(const bf16x8*)(Qm + trow * MEMW + h * 128 + 32 * kk + 8 * q); }
            f32x4 z[16];
#pragma unroll
            for (int st = 0; st < 16; ++st) { z[st] = (f32x4){0.f, 0.f, 0.f, 0.f};
#pragma unroll
                for (int kk = 0; kk < 4; ++kk) { const bf16x8 kf = *(const LAS bf16x8*)(lds + (st >> 3) * MX_BUF + (16 * (st & 7) + r) * 256 + (((4 * kk + q) ^ r) * 16));
                    z[st] = __builtin_amdgcn_mfma_f32_16x16x32_bf16(kf, qf[kk], z[st], 0, 0, 0); }
                if (st & 1) __builtin_amdgcn_sched_barrier(0); }
            float mx = -1e30f;
#pragma unroll
            for (int st = 0; st < 16; ++st) mx = fmaxf(mx, fmaxf(fmaxf(z[st][0], z[st][1]), fmaxf(z[st][2], z[st][3])));
            mx = fmaxf(mx, __shfl_xor(mx, 16)); mx = fmaxf(mx, __shfl_xor(mx, 32));
            float sum = 0.f;
#pragma unroll
            for (int st = 0; st < 16; ++st)
#pragma unroll
                for (int e = 0; e < 4; ++e) { const float pp = fast_exp2((z[st][e] - mx) * LOG2E); z[st][e] = pp; sum += pp; }
            sum += __shfl_xor(sum, 16); sum += __shfl_xor(sum, 32);
            const float inv = 1.0f / sum;
            f32x4 o[8];
#pragma unroll
            for (int dt = 0; dt < 8; ++dt) o[dt] = (f32x4){0.f, 0.f, 0.f, 0.f};
#pragma unroll
            for (int p = 0; p < 8; ++p) { const bf16x8 pf = mk_frag(z[2 * p], z[2 * p + 1]);
#pragma unroll
                for (int dt = 0; dt < 8; ++dt) { const bf16x8 vf = mx_tr(lds + (2 + (p >> 2)) * MX_BUF, 32 * (p & 3) + 4 * q, 32 * (p & 3) + 16 + 4 * q, 16 * dt, r);
                    o[dt] = __builtin_amdgcn_mfma_f32_16x16x32_bf16(vf, pf, o[dt], 0, 0, 0); }
                __builtin_amdgcn_sched_barrier(0); }
#pragma unroll
            for (int dt = 0; dt < 8; ++dt) { const f32x4 v = o[dt] * inv;
                *(u32x2*)(Om + trow * MEMW + h * 128 + 16 * dt + 4 * q) = (u32x2){pg8::pk2(v[0], v[1]), pg8::pk2(v[2], v[3])}; }
        }
        asm volatile("s_waitcnt lgkmcnt(0)\n\ts_barrier" ::: "memory");
    }
}

constexpr int RT_XRS = 2064;
constexpr int RT_XH = 0, RT_XL = 16 * RT_XRS, RT_PART = 2 * 16 * RT_XRS, RT_SC = RT_PART + 8 * 16 * 64 * 4, RT_SEL = RT_SC + 16 * 64 * 4, RT_HIST = RT_SEL + 16 * 64 * 4, RT_END = RT_HIST + 256;
static_assert(RT_END <= SCR_BYTES, "router LDS");
DI float grp8_max(float v) {
    v = fmaxf(v, dpp_f<0xB1, 0xf>(v, v)); v = fmaxf(v, dpp_f<0x4E, 0xf>(v, v)); v = fmaxf(v, dpp_f<0x141, 0xf>(v, v)); return v; }
DI float wave_max_dpp(float v) {
    const float NI = -3.0e38f;
    v = fmaxf(v, dpp_f<0x111, 0xf>(v, NI)); v = fmaxf(v, dpp_f<0x112, 0xf>(v, NI)); v = fmaxf(v, dpp_f<0x114, 0xf>(v, NI)); v = fmaxf(v, dpp_f<0x118, 0xf>(v, NI));
    v = fmaxf(v, dpp_f<0x142, 0xa>(v, NI)); v = fmaxf(v, dpp_f<0x143, 0xc>(v, NI));
    return __uint_as_float(__builtin_amdgcn_readlane(__float_as_uint(v), 63));
}
DI float rdlane(float v, int l) { return __uint_as_float(__builtin_amdgcn_readlane(__float_as_uint(v), l)); }
DI void route_phase(Frame& F, const float* const* in, unsigned* gcount) {
    LAS unsigned char* lds = F.lds; unsigned char* ws = F.ws;
    const int tid = F.tid, lane = F.lane, w = F.wave, r = lane & 15, q = lane >> 4;
    const bf16* Y2 = (const bf16*)F.out; bf16* X2b = (bf16*)(ws + WS_X2B);
    const bf16* WRH = (const bf16*)(ws + WS_WRHI); const bf16* WRL = (const bf16*)(ws + WS_WRLO);
    unsigned* TK = (unsigned*)(ws + WS_TK); float* TKW = (float*)(ws + WS_TKW); unsigned* WGB = (unsigned*)(ws + WS_WGBASE);
    LAS unsigned* HIST = (LAS unsigned*)(lds + RT_HIST);
    if (tid < 64) HIST[tid] = 0u;
    const float rb = in[19][lane];
    f32x4 gv[4], bv[4];
#pragma unroll
    for (int j = 0; j < 4; ++j) { gv[j] = ((const f32x4*)in[16])[lane + 64 * j]; bv[j] = ((const f32x4*)in[17])[lane + 64 * j]; }
    bf16x8 bh[4][4], bl[4][4];
#pragma unroll
    for (int kk = 0; kk < 4; ++kk)
#pragma unroll
        for (int nt = 0; nt < 4; ++nt) { const size_t o = (size_t)(16 * nt + r) * D + 128 * w + 32 * kk + 8 * q; bh[kk][nt] = *(const bf16x8*)(WRH + o); bl[kk][nt] = *(const bf16x8*)(WRL + o); }
    u32x2 va[4], vb[4];
    { const int tl0 = F.vcu; if (tl0 < T / 16) {
#pragma unroll
        for (int j = 0; j < 4; ++j) { va[j] = ((const u32x2*)(Y2 + ((size_t)16 * tl0 + 2 * w) * D))[lane + 64 * j]; vb[j] = ((const u32x2*)(Y2 + ((size_t)16 * tl0 + 2 * w + 1) * D))[lane + 64 * j]; } } }
    __syncthreads();
    for (int tl = F.vcu; tl < T / 16; tl += F.G) {
#pragma unroll
        for (int rr = 0; rr < 2; ++rr) { const int lr = 2 * w + rr; const size_t m = (size_t)16 * tl + lr;
            f32x4 v[4]; float s = 0.f;
#pragma unroll
            for (int j = 0; j < 4; ++j) { const u32x2 x = rr ? vb[j] : va[j]; v[j] = (f32x4){bflo(x.x), bfhi(x.x), bflo(x.y), bfhi(x.y)}; s += (v[j][0] + v[j][1]) + (v[j][2] + v[j][3]); }
            const float mean = wave_sum(s) * (1.f / D); float s2 = 0.f;
#pragma unroll
            for (int j = 0; j < 4; ++j) { const f32x4 d = v[j] - mean; s2 += (d[0] * d[0] + d[1] * d[1]) + (d[2] * d[2] + d[3] * d[3]); }
            const float rstd = 1.f / sqrtf(wave_sum(s2) * (1.f / D) + LN_EPS);
            u32x2* ob = (u32x2*)(X2b + m * D) + lane;
#pragma unroll
            for (int j = 0; j < 4; ++j) { const f32x4 y = (v[j] - mean) * rstd * gv[j] + bv[j];
                const u32x2 hi = (u32x2){pg8::pk2(y[0], y[1]), pg8::pk2(y[2], y[3])}; ob[64 * j] = hi;
                const f32x4 rs = (f32x4){y[0] - bflo(hi.x), y[1] - bfhi(hi.x), y[2] - bflo(hi.y), y[3] - bfhi(hi.y)};
                *(LAS u32x2*)(lds + RT_XH + lr * RT_XRS + (4 * lane + 256 * j) * 2) = hi;
                *(LAS u32x2*)(lds + RT_XL + lr * RT_XRS + (4 * lane + 256 * j) * 2) = (u32x2){pg8::pk2(rs[0], rs[1]), pg8::pk2(rs[2], rs[3])}; } }
        { const int tn = tl + F.G; if (tn < T / 16) {
#pragma unroll
            for (int j = 0; j < 4; ++j) { va[j] = ((const u32x2*)(Y2 + ((size_t)16 * tn + 2 * w) * D))[lane + 64 * j]; vb[j] = ((const u32x2*)(Y2 + ((size_t)16 * tn + 2 * w + 1) * D))[lane + 64 * j]; } } }
        __syncthreads();
        { f32x4 acc[4];
#pragma unroll
          for (int nt = 0; nt < 4; ++nt) acc[nt] = (f32x4){0.f, 0.f, 0.f, 0.f};
#pragma unroll
          for (int kk = 0; kk < 4; ++kk) { const int k0 = 128 * w + 32 * kk + 8 * q;
              const bf16x8 ah = *(const LAS bf16x8*)(lds + RT_XH + r * RT_XRS + k0 * 2), al = *(const LAS bf16x8*)(lds + RT_XL + r * RT_XRS + k0 * 2);
#pragma unroll
              for (int nt = 0; nt < 4; ++nt) {
                  acc[nt] = __builtin_amdgcn_mfma_f32_16x16x32_bf16(ah, bh[kk][nt], acc[nt], 0, 0, 0);
                  acc[nt] = __builtin_amdgcn_mfma_f32_16x16x32_bf16(al, bh[kk][nt], acc[nt], 0, 0, 0);
                  acc[nt] = __builtin_amdgcn_mfma_f32_16x16x32_bf16(ah, bl[kk][nt], acc[nt], 0, 0, 0); } }
#pragma unroll
          for (int nt = 0; nt < 4; ++nt)
#pragma unroll
              for (int e = 0; e < 4; ++e) *(LAS float*)(lds + RT_PART + ((w * 16 + 4 * q + e) * 64 + 16 * nt + r) * 4) = acc[nt][e]; }
        __syncthreads();
#pragma unroll
        for (int rr = 0; rr < 2; ++rr) { const int lt = 2 * w + rr; const size_t tok = (size_t)16 * tl + lt;
            float lg = 0.f;
#pragma unroll
            for (int k = 0; k < 8; ++k) lg += *(const LAS float*)(lds + RT_PART + ((k * 16 + lt) * 64 + lane) * 4);
            const float sc = 1.0f / (1.0f + __expf(-lg)); const float sel = sc + rb;
            const int g = lane >> 3;
            const float m1 = grp8_max(sel);
            const unsigned long long bal = __ballot(sel == m1);
            const unsigned gb = (unsigned)(bal >> (8 * g)) & 0xffu; const int first = 8 * g + __builtin_ctz(gb);
            const float m2 = grp8_max(lane == first ? -1e30f : sel);
            const float gs = m1 + m2;
            int grank = 0;
#pragma unroll
            for (int g2 = 0; g2 < 8; ++g2) { const float v = rdlane(gs, 8 * g2); grank += ((v > gs) || (v == gs && g2 < g)) ? 1 : 0; }
            const float val = (grank < 4) ? sel : -1e30f;
            float cur = val; bool chosen = false;
#pragma unroll
            for (int it = 0; it < 8; ++it) { const float mxv = wave_max_dpp(cur); const unsigned long long hit = __ballot(cur == mxv);
                const int win = __builtin_ctzll(hit); const bool me = (lane == win); chosen = chosen || me; cur = me ? -3.0e38f : cur; }
            const unsigned long long cm = __ballot(chosen);
            const float wsum = wave_sum(chosen ? sc : 0.f);
            if (chosen) { const int kidx = __builtin_popcountll(cm & ((1ull << lane) - 1ull));
                const unsigned lrk = __hip_atomic_fetch_add(&HIST[lane], 1u, __ATOMIC_RELAXED, __HIP_MEMORY_SCOPE_WORKGROUP);
                TK[tok * 8 + kidx] = (unsigned)lane | (lrk << 8); TKW[tok * 8 + kidx] = sc * (ROUTED_SCALE / wsum); }
        }
        __syncthreads();
    }
    if (tid < 64) { const unsigned cnt = HIST[tid]; const unsigned base = __hip_atomic_fetch_add(gcount + tid, cnt, RLX_AGENT); WGB[F.vcu * 64 + tid] = base; }
}

DI void slots_phase(Frame& F) {
    LAS unsigned char* lds = F.lds; unsigned char* ws = F.ws; const int tid = F.tid;
    LAS unsigned* CNT = (LAS unsigned*)lds; LAS unsigned* PS = CNT + 64;
    int* ROWTOK = (int*)(ws + WS_ROWTOK); float* ROWW = (float*)(ws + WS_ROWW); unsigned* SLOT = (unsigned*)(ws + WS_SLOT);
    const unsigned* TK = (const unsigned*)(ws + WS_TK); const float* TKW = (const float*)(ws + WS_TKW); const unsigned* WGB = (const unsigned*)(ws + WS_WGBASE);
    if (tid < 64) CNT[tid] = __hip_atomic_load(F.ctl + CW_GCOUNT + tid, RLX_AGENT);
    __syncthreads();
    if (tid == 0) { unsigned run = 0u; for (int e = 0; e < 64; ++e) { PS[e] = run; run += (CNT[e] + 255u) & ~255u; } PS[64] = run; }
    __syncthreads();
    const unsigned nblk = PS[64] >> 8;
    if (F.vcu == 0) {
        if (tid == 0) { __hip_atomic_store(F.ctl + CW_HDR, nblk, RLX_AGENT); __hip_atomic_store(F.ctl + CW_HDR + 1, (nblk + 1u) >> 1, RLX_AGENT); }
        for (unsigned bl = tid; bl < nblk; bl += NTHREADS) { unsigned e = 0; for (int k = 1; k < 64; ++k) e += (PS[k] <= bl * 256u) ? 1u : 0u; __hip_atomic_store(F.ctl + CW_BLKE + bl, e, RLX_AGENT); }
    }
    for (int e = F.vcu; e < 64; e += F.G) { const unsigned lo = PS[e] + CNT[e], hi = PS[e + 1]; for (unsigned s = lo + tid; s < hi; s += NTHREADS) { ROWTOK[s] = 0; ROWW[s] = 0.f; } }
    for (int tl = F.vcu; tl < T / 16; tl += F.G) {
        if (tid < 128) { const size_t a = (size_t)16 * 8 * tl + tid; const unsigned pk = TK[a], e = pk & 0xffu, lrk = pk >> 8;
            const unsigned slot = PS[e] + WGB[F.vcu * 64 + e] + lrk; ROWTOK[slot] = (int)(a >> 3); ROWW[slot] = TKW[a]; SLOT[a] = slot; }
    }
}

DI void dec8(unsigned w, float (&o)[4]) { const f32x2 a = __builtin_amdgcn_cvt_pk_f32_fp8((int)w, false), b = __builtin_amdgcn_cvt_pk_f32_fp8((int)w, true); o[0] = a[0]; o[1] = a[1]; o[2] = b[0]; o[3] = b[1]; }
DI void combine_phase(Frame& F, const float* const* in) {
    const int gw = F.vcu * NWAVES + F.wave, NGW = F.G * NWAVES, lane = F.lane;
    const unsigned* SLOT = (const unsigned*)(F.ws + WS_SLOT); const unsigned char* Y8 = (const unsigned char*)(F.ws + WS_YH); const bf16* base = (const bf16*)(F.ws + WS_X2B); float* out = F.out;
    f32x4 gv[4], bv[4];
#pragma unroll
    for (int j = 0; j < 4; ++j) { gv[j] = *(const f32x4*)(in[26] + 16 * lane + 4 * j); bv[j] = *(const f32x4*)(in[27] + 16 * lane + 4 * j); }
    for (int m0 = gw; m0 < T; m0 += 2 * NGW) {
        u32x4 yr[2][8]; u32x4 bs[2][2];
#pragma unroll
        for (int t2 = 0; t2 < 2; ++t2) { const int m = m0 + t2 * NGW; const int mm = (m < T) ? m : m0;
            unsigned sl[8];
#pragma unroll
            for (int k = 0; k < 8; ++k) sl[k] = __builtin_amdgcn_readfirstlane(__hip_atomic_load(SLOT + (size_t)mm * 8 + k, RLX_AGENT));
            bs[t2][0] = *(const u32x4*)(base + (size_t)mm * D + 16 * lane); bs[t2][1] = *(const u32x4*)(base + (size_t)mm * D + 16 * lane + 8);
#pragma unroll
            for (int k = 0; k < 8; ++k) yr[t2][k] = *(const u32x4*)(Y8 + (size_t)sl[k] * D + 16 * lane);
        }
#pragma unroll
        for (int t2 = 0; t2 < 2; ++t2) { const int m = m0 + t2 * NGW; if (m >= T) continue;
            float a[16];
#pragma unroll
            for (int c = 0; c < 16; ++c) a[c] = 0.f;
#pragma unroll
            for (int k = 0; k < 8; ++k) { const u32x4 y = yr[t2][k]; float d[4];
                dec8(y.x, d); a[0] += d[0]; a[1] += d[1]; a[2] += d[2]; a[3] += d[3];
                dec8(y.y, d); a[4] += d[0]; a[5] += d[1]; a[6] += d[2]; a[7] += d[3];
                dec8(y.z, d); a[8] += d[0]; a[9] += d[1]; a[10] += d[2]; a[11] += d[3];
                dec8(y.w, d); a[12] += d[0]; a[13] += d[1]; a[14] += d[2]; a[15] += d[3]; }
            f32x4 v[4];
#pragma unroll
            for (int h = 0; h < 2; ++h) { const u32x4 x = bs[t2][h];
                v[2 * h] = (f32x4){bflo(x.x), bfhi(x.x), bflo(x.y), bfhi(x.y)} + (f32x4){a[8 * h], a[8 * h + 1], a[8 * h + 2], a[8 * h + 3]} * (1.0f / pg8::Y8_SCALE);
                v[2 * h + 1] = (f32x4){bflo(x.z), bfhi(x.z), bflo(x.w), bfhi(x.w)} + (f32x4){a[8 * h + 4], a[8 * h + 5], a[8 * h + 6], a[8 * h + 7]} * (1.0f / pg8::Y8_SCALE); }
            float s = 0.f;
#pragma unroll
            for (int j = 0; j < 4; ++j) s += (v[j][0] + v[j][1]) + (v[j][2] + v[j][3]);
            const float mean = wave_sum(s) * (1.f / D); float s2 = 0.f;
#pragma unroll
            for (int j = 0; j < 4; ++j) { const f32x4 d = v[j] - mean; s2 += (d[0] * d[0] + d[1] * d[1]) + (d[2] * d[2] + d[3] * d[3]); }
            const float rstd = 1.f / sqrtf(wave_sum(s2) * (1.f / D) + LN_EPS);
#pragma unroll
            for (int j = 0; j < 4; ++j) *(f32x4*)(out + (size_t)m * D + 16 * lane + 4 * j) = (v[j] - mean) * rstd * gv[j] + bv[j];
        }
    }
}

DI void stagger(const Frame& F, unsigned ticks) {
    if (F.vcu & 1) { const unsigned long long t0 = __builtin_amdgcn_s_memrealtime(); while (__builtin_amdgcn_s_memrealtime() - t0 < ticks) __builtin_amdgcn_s_sleep(8); }
}
#ifndef STAG_DOWN
#define STAG_DOWN 350
#endif
constexpr int NPHASE = 13;
constexpr int CVT_A = 12288;
constexpr int N_LAUNCHES = MK_N_LAUNCHES;
static_assert(N_LAUNCHES == 1 || N_LAUNCHES == NPHASE, "MK_N_LAUNCHES: 1 (one dispatch) or 13 (one dispatch per phase)");
struct Args { const float* in[28]; float* out; unsigned char* ws; int ph_lo, ph_hi; };
static_assert(sizeof(Args) == 28 * 8 + 8 + 8 + 8, "Args has no padding");

__global__ void __launch_bounds__(NTHREADS, 2) fwd_kernel(Args args) {
    extern __shared__ __attribute__((aligned(16))) unsigned char lds_raw[];
    Frame F;
    F.lds = (LAS unsigned char*)lds_raw;
    volatile LAS unsigned* MISC = (volatile LAS unsigned*)(F.lds + MISC_OFF);
    F.tid = threadIdx.x; F.lane = F.tid & 63; F.wave = __builtin_amdgcn_readfirstlane(F.tid >> 6);
    F.G = gridDim.x; { const int bx = blockIdx.x; F.vcu = (F.G % 8 == 0) ? (bx % 8) * (F.G / 8) + bx / 8 : bx; }
    F.ws = args.ws; F.ctl = (unsigned*)(args.ws + WS_CTL); F.out = args.out;
    unsigned char* ws = args.ws;
    for (int u = F.tid; u < (LDS_BYTES - MISC_OFF) / 4; u += NTHREADS) ((LAS unsigned*)(F.lds + MISC_OFF))[u] = 0u;
    __syncthreads();
    XcdBarrier bar; bar.bar = F.ctl + CW_BAR; bar.x = 0; bar.st = nullptr;
    if (N_LAUNCHES == 1) bar = xcd_barrier_post(F.ctl + CW_BAR, MISC + 8);
#define GRID_BAR() do { if (N_LAUNCHES == 1) xcd_barrier(bar); } while (0)
    const int lo = args.ph_lo, hi = args.ph_hi;
#ifndef PHASE_MASK
#define PHASE_MASK 0x1fff
#endif
#define IN(k) (((PHASE_MASK >> (k)) & 1) && lo <= (k) && (k) < hi)
#ifndef REPEAT_MASK
#define REPEAT_MASK 0
#endif
#ifndef DOWN_PROBE
#define DOWN_PROBE 0
#endif
#define REP(k) (((REPEAT_MASK >> (k)) & 1) ? 2 : 1)
#define SEAM(k) do { if (IN(k) && IN((k) + 1)) GRID_BAR(); } while (0)
    const float* const* in = args.in;

    for (int rep_ = 0; rep_ < (IN(0) ? REP(0) : 0); ++rep_) { if (rep_) GRID_BAR(); p0_prologue(F, in); SEAM(0); }
    for (int rep_ = 0; rep_ < (IN(1) ? REP(1) : 0); ++rep_) { if (rep_) GRID_BAR();
        pg8::DenseOrder S; S.init((const bf16*)F.out, (const bf16*)(ws + WS_WIN), T, INW, D, F.G, (int)blockIdx.x);
        pg8::EpiInProj E{(bf16*)(ws + WS_P1), (float*)(ws + WS_VSTAT), (const float*)(ws + WS_BPERM)};
        pg8::gemm_phase<pg8::EpiInProj, pg8::DenseOrder, true>(F.lds, D, S, E);
        SEAM(1);
    }
    for (int rep_ = 0; rep_ < (IN(2) ? REP(2) : 0); ++rep_) { if (rep_) GRID_BAR(); mix_phase(F, in); SEAM(2); }
    for (int rep_ = 0; rep_ < (IN(3) ? REP(3) : 0); ++rep_) { if (rep_) GRID_BAR();
        pg8::DenseOrder S; S.init((const bf16*)(ws + WS_MERGED), (const bf16*)(ws + WS_WOUT), T, D, D, F.G, (int)blockIdx.x);
        pg8::EpiResB16<true> E{(bf16*)(ws + WS_Y1), in[0], nullptr, (const float*)(ws + WS_XSTAT), in[2], in[3]};
        pg8::gemm_phase<pg8::EpiResB16<true>, pg8::DenseOrder, false>(F.lds, D, S, E);
        SEAM(3);
    }
    for (int rep_ = 0; rep_ < (IN(4) ? REP(4) : 0); ++rep_) { if (rep_) GRID_BAR(); ln1_phase(F, in); SEAM(4); }
    for (int rep_ = 0; rep_ < (IN(5) ? REP(5) : 0); ++rep_) { if (rep_) GRID_BAR();
        if (F.G == 256) { if ((int)blockIdx.x >= 160) expert_convert(F, in, (int)blockIdx.x - 160, 96, 0, CVT_A); }
        else expert_convert(F, in, F.vcu, F.G, 0, NEXP * 384);
        __syncthreads();
        { pg8::DenseOrder S; S.init((const bf16*)(ws + WS_X1B), (const bf16*)(ws + WS_WQ), T, MEMW, D, F.G, (int)blockIdx.x);
          pg8::EpiBf16S E{(bf16*)(ws + WS_QM), MEMW, QSCALE};
          pg8::gemm_phase<pg8::EpiBf16S, pg8::DenseOrder, false>(F.lds, D, S, E); }
        { const int c2 = ((int)blockIdx.x + F.G - 128 % F.G) % F.G;
          pg8::DenseOrder S; S.init((const bf16*)(ws + WS_MEMB), (const bf16*)(ws + WS_WKV), NBATCH * MEMLEN, 2 * MEMW, D, F.G, c2);
          pg8::EpiBf16S E{(bf16*)(ws + WS_KVM), 2 * MEMW, 1.0f};
          pg8::gemm_phase<pg8::EpiBf16S, pg8::DenseOrder, false>(F.lds, D, S, E); }
        SEAM(5);
    }
    for (int rep_ = 0; rep_ < (IN(6) ? REP(6) : 0); ++rep_) { if (rep_) GRID_BAR();
        if (F.G == 256) { if (F.vcu & 1) expert_convert(F, in, F.vcu >> 1, 128, CVT_A, NEXP * 384); else memattn_phase(F, F.vcu >> 1, 128); }
        else memattn_phase(F, F.vcu, F.G);
        SEAM(6); }
    for (int rep_ = 0; rep_ < (IN(7) ? REP(7) : 0); ++rep_) { if (rep_) GRID_BAR();
        pg8::DenseOrder S; S.init((const bf16*)(ws + WS_OM), (const bf16*)(ws + WS_WO), T, D, MEMW, F.G, (int)blockIdx.x);
        pg8::EpiResB16<false> E{(bf16*)F.out, nullptr, (const bf16*)(ws + WS_X1B), nullptr, nullptr, nullptr};
        pg8::gemm_phase<pg8::EpiResB16<false>, pg8::DenseOrder, false>(F.lds, MEMW, S, E);
        SEAM(7);
    }
    for (int rep_ = 0; rep_ < (IN(8) ? REP(8) : 0); ++rep_) { if (rep_) GRID_BAR(); route_phase(F, in, F.ctl + ((rep_ + 1 < REP(8)) ? 2048 : CW_GCOUNT)); SEAM(8); }
    for (int rep_ = 0; rep_ < (IN(9) ? REP(9) : 0); ++rep_) { if (rep_) GRID_BAR(); slots_phase(F); SEAM(9); }
    for (int rep_ = 0; rep_ < (IN(10) ? REP(10) : 0); ++rep_) { if (rep_) GRID_BAR();
        const int nblk = (int)__builtin_amdgcn_readfirstlane(__hip_atomic_load(F.ctl + CW_HDR, RLX_AGENT));
        pg8::moe_tables(F.lds, F.ctl + CW_BLKE, nblk, (const int*)(ws + WS_ROWTOK), (const float*)(ws + WS_ROWW), true, F.G, F.vcu, F.tid);
        pg8::GateUpOrder S{(const char*)(ws + WS_X2B), (const char*)(ws + WS_WGU), (const char*)(ws + WS_WGUS), F.lds, nblk, F.G, F.vcu};
        pg8::EpiGateUp E{(bf16*)(ws + WS_H), F.lds};
        pg8::gemm_phase<pg8::EpiGateUp, pg8::GateUpOrder, true>(F.lds, D, S, E);
        SEAM(10);
    }
    for (int rep_ = 0; rep_ < (IN(11) ? REP(11) : 0); ++rep_) { if (rep_) GRID_BAR();
        const int nblk = (int)__builtin_amdgcn_readfirstlane(__hip_atomic_load(F.ctl + CW_HDR, RLX_AGENT));
        pg8::moe_tables(F.lds, F.ctl + CW_BLKE, nblk, nullptr, nullptr, false, F.G, F.vcu, F.tid);
        pg8::DownOrder S{(const char*)(ws + WS_H), (const char*)(ws + WS_WD), (const char*)(ws + WS_WDS), F.lds, 0, nblk, 64, F.G, F.vcu, 0};
        pg8::EpiDown E{(unsigned char*)(ws + WS_YH), (bf16*)(ws + WS_X2B), 0};
        pg8::gemm_phase<pg8::EpiDown, pg8::DownOrder, true>(F.lds, EH, S, E);
        SEAM(11);
    }
    if (IN(12)) { combine_phase(F, in); }
#undef IN
#undef SEAM
#undef GRID_BAR
}

extern "C" void kernel_launch(void* const* d_in, const int* in_sizes, int n_in, void* d_out, int out_size, void* d_ws, size_t ws_size, hipStream_t stream) {
    static int grid = 0;
    if (grid == 0) {
        if (n_in != 28 || in_sizes[0] != T * D || out_size != T * D || ws_size < WS_END) { fprintf(stderr, "kernel_launch: unexpected shapes / workspace (n_in %d, ws %zu < %zu)\n", n_in, ws_size, (size_t)WS_END); grid = -1; return; }
        int dev = 0, cus = 0, per_cu = 0;
        if (hipGetDevice(&dev) != hipSuccess || hipDeviceGetAttribute(&cus, hipDeviceAttributeMultiprocessorCount, dev) != hipSuccess) { grid = -1; return; }
        if (hipFuncSetAttribute((const void*)fwd_kernel, hipFuncAttributeMaxDynamicSharedMemorySize, LDS_BYTES) != hipSuccess) { fprintf(stderr, "kernel_launch: hipFuncSetAttribute failed\n"); grid = -1; return; }
        if (hipOccupancyMaxActiveBlocksPerMultiprocessor(&per_cu, (const void*)fwd_kernel, NTHREADS, LDS_BYTES) != hipSuccess || per_cu < 1) { fprintf(stderr, "kernel_launch: occupancy query reports %d\n", per_cu); }
        (void)hipGetLastError();
        grid = cus;
    }
    if (grid < 0) return;
    if (hipMemsetAsync((char*)d_ws + WS_CTL, 0, CTL_ZERO_BYTES, stream) != hipSuccess) return;
    Args a{};
    for (int i = 0; i < 28; ++i) a.in[i] = (const float*)d_in[i];
    a.out = (float*)d_out; a.ws = (unsigned char*)d_ws;
    for (int li = 0; li < N_LAUNCHES; ++li) {
        a.ph_lo = (N_LAUNCHES == 1) ? 0 : li; a.ph_hi = (N_LAUNCHES == 1) ? NPHASE : li + 1;
        hipLaunchKernelGGL(fwd_kernel, dim3(grid), dim3(NTHREADS), LDS_BYTES, stream, a);
        if (hipPeekAtLastError() != hipSuccess) { fprintf(stderr, "kernel_launch: launch %d failed\n", li); break; }
    }
}
```

```cpp
#include <hip/hip_runtime.h>
#include <cstdio>
#include <cstdint>

#ifndef MK_N_LAUNCHES
#define MK_N_LAUNCHES 1
#endif

#define GAS __attribute__((address_space(1)))
#define LAS __attribute__((address_space(3)))
typedef unsigned short bf16;
typedef short bf16x8 __attribute__((ext_vector_type(8)));
typedef short s16x4 __attribute__((ext_vector_type(4)));
typedef float f32x4 __attribute__((ext_vector_type(4)));
typedef float f32x2 __attribute__((ext_vector_type(2)));
typedef unsigned u32x4 __attribute__((ext_vector_type(4)));
typedef unsigned u32x2 __attribute__((ext_vector_type(2)));
typedef long i64x2 __attribute__((ext_vector_type(2)));
#define RLX_AGENT __ATOMIC_RELAXED, __HIP_MEMORY_SCOPE_AGENT
#define DI __device__ __forceinline__

constexpr int T = 16384, D = 1024, NBATCH = 8, SEQ = 2048, MEMLEN = 256, INW = 7168;
constexpr int NEXP = 64, TOPK = 8, EH = 256, MEMW = 512;
constexpr float LN_EPS = 1e-5f;
constexpr float ALPHA = 1.189207115002721f;
constexpr float QSCALE = 0.08838834764831845f;
constexpr float ROUTED_SCALE = 2.5f;
constexpr float LOG2E = 1.4426950408889634f, LN2 = 0.6931471805599453f;
constexpr float SB_EXIT = -30.0f;
constexpr int NWAVES = 8, NTHREADS = 512;
constexpr int MAXBLK = 576;
constexpr int SH_ROW0 = MAXBLK * 256;

constexpr size_t MiB = 1u << 20;
constexpr size_t WS_CTL = 0, CTL_ZERO_BYTES = 32 * 1024;
constexpr size_t WS_WRHI = 1 * MiB, WS_WRLO = WS_WRHI + 128 * 1024, WS_WSP = WS_WRLO + 128 * 1024, WS_BPERM = WS_WSP + 256 * 1024, WS_XSTAT = WS_BPERM + 32 * 1024;
constexpr size_t WS_ROWTOK = 2 * MiB, WS_ROWW = WS_ROWTOK + 576 * 1024, WS_SLOT = WS_ROWW + 576 * 1024;
constexpr size_t WS_WIN = 4 * MiB, WS_WOUT = 18 * MiB, WS_WQ = 20 * MiB, WS_WKV = 21 * MiB, WS_WO = 23 * MiB, WS_MEMB = 24 * MiB;
constexpr size_t WS_P1 = 29 * MiB;
constexpr size_t WS_UG = WS_P1, WS_VA = WS_P1 + 32 * MiB, WS_Q = WS_P1 + 64 * MiB, WS_K = WS_P1 + 96 * MiB, WS_V = WS_P1 + 128 * MiB, WS_GB = WS_P1 + 160 * MiB;
constexpr size_t WS_VSTAT = 221 * MiB;
constexpr size_t WS_MERGED = 228 * MiB;
constexpr size_t WS_Y1 = 29 * MiB;
constexpr size_t WS_X1F = 93 * MiB, WS_X1B = 157 * MiB;
constexpr size_t WS_QM = 189 * MiB, WS_KVM = 205 * MiB, WS_OM = 209 * MiB;
constexpr size_t WS_WGU = 29 * MiB;
constexpr size_t WS_H = 148 * MiB;
constexpr size_t WS_X2B = 228 * MiB;
constexpr size_t WS_WD = 260 * MiB;
constexpr size_t WS_WGUS = 293 * MiB, WS_WDS = 294 * MiB;
constexpr size_t WS_TK = 295 * MiB, WS_TKW = WS_TK + 512 * 1024, WS_WGBASE = WS_TKW + 512 * 1024;
constexpr size_t WS_YH = 4 * MiB;
constexpr size_t WS_END = 297 * MiB;
static_assert(WS_XSTAT + (size_t)T * 8 <= WS_ROWTOK && WS_SLOT + (size_t)T * 8 * 4 <= WS_WIN && WS_MEMB + 4 * MiB <= WS_P1, "ws map 1");
static_assert(WS_GB + 32 * MiB <= WS_VSTAT && WS_VSTAT + 2 * MiB <= WS_MERGED && WS_H + (size_t)(SH_ROW0 + T) * 512 <= WS_X2B && WS_X2B + 32 * MiB <= WS_WD, "ws map 2");
static_assert(WS_WD + (size_t)64 * 1024 * 256 * 2 <= WS_WGUS && WS_YH + (size_t)288 * 256 * 2048 <= WS_H && WS_WGBASE + 256 * 64 * 4 <= WS_END, "ws map 3");
constexpr int CW_TMO = 0, CW_CODE = 1;
constexpr int CW_GCOUNT = 64;
constexpr int CW_HDR = 192;
constexpr int CW_BLKE = 256;
constexpr int CW_BAR = 4096;

constexpr int SCR_BYTES = 140 * 1024;
constexpr int MISC_OFF = SCR_BYTES;
constexpr int LDS_BYTES = 144 * 1024;

DI unsigned cvt_pk_bf16(float lo, float hi) { unsigned r; asm volatile("v_cvt_pk_bf16_f32 %0, %1, %2" : "=v"(r) : "v"(lo), "v"(hi)); return r; }
DI float bf2f(unsigned short h) { return __uint_as_float((unsigned)h << 16); }
DI float bflo(unsigned w) { return __uint_as_float(w << 16); }
DI float bfhi(unsigned w) { return __uint_as_float(w & 0xffff0000u); }
DI float fast_exp2(float x) { return __builtin_amdgcn_exp2f(x); }
DI float fast_log2(float x) { return __builtin_amdgcn_logf(x); }
DI float fast_rcp(float x) { return __builtin_amdgcn_rcpf(x); }
DI float sigmoidf_(float x) { return fast_rcp(1.0f + fast_exp2(-x * LOG2E)); }
template <int CTRL, int ROWMASK> DI float dpp_f(float v, float fill) { return __uint_as_float((unsigned)__builtin_amdgcn_update_dpp((int)__float_as_uint(fill), (int)__float_as_uint(v), CTRL, ROWMASK, 0xf, false)); }
DI float wave_sum(float v) {
    v += dpp_f<0x111, 0xf>(v, 0.f); v += dpp_f<0x112, 0xf>(v, 0.f); v += dpp_f<0x114, 0xf>(v, 0.f); v += dpp_f<0x118, 0xf>(v, 0.f);
    v += dpp_f<0x142, 0xa>(v, 0.f); v += dpp_f<0x143, 0xc>(v, 0.f);
    return __uint_as_float(__builtin_amdgcn_readlane(__float_as_uint(v), 63));
}
DI float wave_max(float v) {
#pragma unroll
    for (int o = 1; o < 64; o <<= 1) v = fmaxf(v, __shfl_xor(v, o));
    return v;
}
#define LDS_WAIT() asm volatile("s_waitcnt lgkmcnt(0)" ::: "memory")
#define VM_WAIT() asm volatile("s_waitcnt vmcnt(0)" ::: "memory")

namespace pg8 {
constexpr int BM = 256, BK = 64, HALF = 128, HTB = HALF * BK * 2, STAGE_BYTES = 8 * HTB, NXCD = 8, WGM = 8;
__host__ __device__ __forceinline__ int lds_byte(int r, int c) { const int st = (r >> 4) * 2 + (c >> 5), rr = r & 15, cc = c & 31, ob = rr * 64 + cc * 2; return st * 1024 + (ob ^ (((ob >> 9) & 1) << 5)); }
__host__ __device__ __forceinline__ void stage_rc(int b, int& R, int& C) { const int st = b / 1024, sb = b % 1024, swz = sb ^ (((sb >> 9) & 1) << 5); R = (st >> 1) * 16 + swz / 64; C = (st & 1) * 32 + (swz % 64) / 2; }
__host__ __device__ __forceinline__ int perm32(int rho) { const int n = rho >> 4, i = rho & 15; return 8 * (i >> 2) + 4 * n + (i & 3); }

struct Unit { int pm, pn, e, ui; const char* A; const char* B; };

typedef float f32x2v __attribute__((ext_vector_type(2)));
DI f32x2v gelu_pk(f32x2v v) {
    const f32x2v av = __builtin_elementwise_abs(v), d = av * 0.2316418882f + 1.0f;
    f32x2v t; t.x = __builtin_amdgcn_rcpf(d.x); t.y = __builtin_amdgcn_rcpf(d.y);
    f32x2v q = t * 0.5307027145f + (-0.7265760135f); q = q * t + 0.7107068705f; q = q * t + (-0.142248368f); q = q * t + 0.127414796f; q = q * t;
    const f32x2v s = (v * v) * (-0.72134752044f);
    f32x2v e; e.x = __builtin_amdgcn_exp2f(s.x); e.y = __builtin_amdgcn_exp2f(s.y);
    const f32x2v m = v * (q * e), r = v - m;
    f32x2v o; o.x = v.x < 0.f ? m.x : r.x; o.y = v.y < 0.f ? m.y : r.y; return o;
}
DI f32x4 gelu4(f32x4 v) { const f32x2v a = gelu_pk((f32x2v){v[0], v[1]}), b = gelu_pk((f32x2v){v[2], v[3]}); return (f32x4){a.x, a.y, b.x, b.y}; }
DI f32x4 sigmoid4(f32x4 v) { return (f32x4){sigmoidf_(v[0]), sigmoidf_(v[1]), sigmoidf_(v[2]), sigmoidf_(v[3])}; }
DI u32x4 pack8(f32x4 v0, f32x4 v1) { u32x4 w; w.x = cvt_pk_bf16(v0[0], v0[1]); w.y = cvt_pk_bf16(v0[2], v0[3]); w.z = cvt_pk_bf16(v1[0], v1[1]); w.w = cvt_pk_bf16(v1[2], v1[3]); return w; }

template <class Epi, class Sched, bool ALIGN_EPI, bool F8 = false>
DI void gemm_phase(LAS unsigned char* lds, const int K, const Sched& S, const Epi& E) {
    const int tid = threadIdx.x, wid = __builtin_amdgcn_readfirstlane(tid >> 6), lane = tid & 63, wr = wid >> 2, wc = wid & 3, fr = lane & 15, fq = lane >> 4;
    const int nt = K / BK;
    int Rr[2], Cc[2]; unsigned voffB[2], voffB1[2];
#pragma unroll
    for (int i = 0; i < 2; ++i) { int R, C; stage_rc(tid * 16 + i * 8192, R, C); Rr[i] = R; Cc[i] = C;
        if (Epi::PERM == 2) { const int w0 = 64 * (R >> 5) + 16 * ((R & 15) >> 2) + 4 * ((R >> 4) & 1) + (R & 3); voffB[i] = (unsigned)(w0 * K + C) * 2u; voffB1[i] = (unsigned)((w0 + 8) * K + C) * 2u; }
        else { const int Rb = Epi::PERM ? ((R & ~31) + perm32(R & 31)) : R; voffB[i] = (unsigned)(Rb * K + C) * 2u; voffB1[i] = (unsigned)((Rb + HALF) * K + C) * 2u; } }
    const size_t kstep = (size_t)(BK * 2);
    const unsigned ldsw = (unsigned)wid * 1024u;
    const int aoff = lds_byte(wr * 64 + fr, fq * 8), boff = lds_byte(wc * 32 + fr, fq * 8);
#define PG8_SA(b, h) (((b) * 2 + (h)) * HTB)
#define PG8_SB(b, h) ((4 + (b) * 2 + (h)) * HTB)
#define PG8_STAGE_B(bufoff, gbase) do { _Pragma("unroll") for (int _i = 0; _i < 2; ++_i) \
        __builtin_amdgcn_global_load_lds((const unsigned*)((const char*)(gbase) + voffB[_i]), (LAS unsigned*)(lds + (bufoff) + ldsw + _i * 8192), 16, 0, 0); } while (0)
#define PG8_STAGE_B1(bufoff, gbase) do { _Pragma("unroll") for (int _i = 0; _i < 2; ++_i) \
        __builtin_amdgcn_global_load_lds((const unsigned*)((const char*)(gbase) + voffB1[_i]), (LAS unsigned*)(lds + (bufoff) + ldsw + _i * 8192), 16, 0, 0); } while (0)
#define PG8_STAGE_A(bufoff, gbase, o0, o1) do { \
        __builtin_amdgcn_global_load_lds((const unsigned*)((const char*)(gbase) + (o0)), (LAS unsigned*)(lds + (bufoff) + ldsw), 16, 0, 0); \
        __builtin_amdgcn_global_load_lds((const unsigned*)((const char*)(gbase) + (o1)), (LAS unsigned*)(lds + (bufoff) + ldsw + 8192), 16, 0, 0); } while (0)
#define PG8_LDA(dst, b, h) do { _Pragma("unroll") for (int m = 0; m < 4; ++m) _Pragma("unroll") for (int k = 0; k < 2; ++k) dst[m][k] = *(const LAS bf16x8*)(lds + PG8_SA(b, h) + aoff + m * 2048 + k * 1024); } while (0)
#define PG8_LDB(dst, b, h) do { _Pragma("unroll") for (int n = 0; n < 2; ++n) _Pragma("unroll") for (int k = 0; k < 2; ++k) dst[n][k] = *(const LAS bf16x8*)(lds + PG8_SB(b, h) + boff + n * 2048 + k * 1024); } while (0)
#define PG8_MMA(ai, bj, At, Bt) do { __builtin_amdgcn_s_setprio(1); _Pragma("unroll") for (int m = 0; m < 4; ++m) _Pragma("unroll") for (int n = 0; n < 2; ++n) _Pragma("unroll") for (int k = 0; k < 2; ++k) { \
        if constexpr (F8) { const i64x2 b8_ = __builtin_bit_cast(i64x2, Bt[n][k]), a8_ = __builtin_bit_cast(i64x2, At[m][k]); \
            acc[ai][bj][m][n] = __builtin_amdgcn_mfma_f32_16x16x32_fp8_fp8(b8_[0], a8_[0], acc[ai][bj][m][n], 0, 0, 0); acc[ai][bj][m][n] = __builtin_amdgcn_mfma_f32_16x16x32_fp8_fp8(b8_[1], a8_[1], acc[ai][bj][m][n], 0, 0, 0); } \
        else acc[ai][bj][m][n] = __builtin_amdgcn_mfma_f32_16x16x32_bf16(Bt[n][k], At[m][k], acc[ai][bj][m][n], 0, 0, 0); } __builtin_amdgcn_s_setprio(0); } while (0)
#define PG8_WAIT_V(n) asm volatile("s_waitcnt vmcnt(" #n ")" ::: "memory")
#define PG8_WAIT_L(n) asm volatile("s_waitcnt lgkmcnt(" #n ")" ::: "memory")
#define PG8_BAR __builtin_amdgcn_s_barrier()
#define PG8_SCHED __builtin_amdgcn_sched_barrier(0)
    Unit cur, nxt; int ui = 0;
    if (!S.next(0, cur)) return;
    unsigned oc[2][2], on[2][2];
    S.a_offs(cur, Rr, Cc, K, oc);
    f32x4 acc[2][2][4][2];
#pragma unroll
    for (int a = 0; a < 2; ++a)
#pragma unroll
        for (int b = 0; b < 2; ++b)
#pragma unroll
            for (int m = 0; m < 4; ++m)
#pragma unroll
                for (int n = 0; n < 2; ++n) acc[a][b][m][n] = (f32x4){0.f, 0.f, 0.f, 0.f};
    bf16x8 At[4][2], B0[2][2], B1[2][2];
    const char* cA = cur.A; const char* cB = cur.B;
    PG8_STAGE_B(PG8_SB(0, 0), cB); PG8_STAGE_B1(PG8_SB(0, 1), cB); PG8_STAGE_A(PG8_SA(0, 0), cA, oc[0][0], oc[0][1]); PG8_STAGE_A(PG8_SA(0, 1), cA, oc[1][0], oc[1][1]);
    if (wr == 1) PG8_BAR;
    PG8_WAIT_V(2); PG8_BAR;
    PG8_STAGE_B(PG8_SB(1, 0), cB + kstep); PG8_STAGE_A(PG8_SA(1, 0), cA + kstep, oc[0][0], oc[0][1]); PG8_STAGE_B1(PG8_SB(1, 1), cB + kstep);
    PG8_WAIT_V(6); PG8_BAR;
    for (;;) {
        const bool has_next = S.next(ui + 1, nxt);
        const char* nA = has_next ? nxt.A : cA; const char* nB = has_next ? nxt.B : cB;
        if (has_next) S.a_offs(nxt, Rr, Cc, K, on);
        else {
#pragma unroll
            for (int h = 0; h < 2; ++h)
#pragma unroll
                for (int i = 0; i < 2; ++i) on[h][i] = oc[h][i]; }
#pragma unroll 1
        for (int t = 0; t < nt; t += 2) {
            const bool last = (t == nt - 2);
            const char* a1 = cA + (size_t)(t + 1) * kstep;
            const char* a2 = last ? nA : cA + (size_t)(t + 2) * kstep; const char* b2 = last ? nB : cB + (size_t)(t + 2) * kstep;
            const char* a3 = a2 + kstep; const char* b3 = b2 + kstep;
            const unsigned x00 = last ? on[0][0] : oc[0][0], x01 = last ? on[0][1] : oc[0][1], x10 = last ? on[1][0] : oc[1][0], x11 = last ? on[1][1] : oc[1][1];
            PG8_LDB(B0, 0, 0); PG8_LDB(B1, 0, 1); PG8_SCHED; PG8_LDA(At, 0, 0); PG8_STAGE_A(PG8_SA(1, 1), a1, oc[1][0], oc[1][1]);
            PG8_WAIT_V(8); PG8_WAIT_L(0); PG8_BAR; PG8_MMA(0, 0, At, B0); PG8_MMA(0, 1, At, B1); PG8_BAR; PG8_SCHED;
            PG8_LDA(At, 0, 1); PG8_STAGE_B(PG8_SB(0, 0), b2); PG8_STAGE_B1(PG8_SB(0, 1), b2); PG8_STAGE_A(PG8_SA(0, 0), a2, x00, x01);
            PG8_WAIT_V(8); PG8_WAIT_L(0); PG8_BAR; PG8_MMA(1, 0, At, B0); PG8_MMA(1, 1, At, B1); PG8_BAR; PG8_SCHED;
            PG8_LDB(B0, 1, 0); PG8_LDB(B1, 1, 1); PG8_SCHED; PG8_LDA(At, 1, 0); PG8_STAGE_A(PG8_SA(0, 1), a2, x10, x11);
            PG8_WAIT_V(8); PG8_WAIT_L(0); PG8_BAR; PG8_MMA(0, 0, At, B0); PG8_MMA(0, 1, At, B1); PG8_BAR; PG8_SCHED;
            PG8_LDA(At, 1, 1); PG8_STAGE_B(PG8_SB(1, 0), b3); PG8_STAGE_B1(PG8_SB(1, 1), b3); PG8_STAGE_A(PG8_SA(1, 0), a3, x00, x01);
            PG8_WAIT_V(8); PG8_WAIT_L(0); PG8_BAR; PG8_MMA(1, 0, At, B0); PG8_MMA(1, 1, At, B1); PG8_BAR; PG8_SCHED;
        }
        if constexpr (ALIGN_EPI) { if (wr == 0) PG8_BAR; }
        E(acc, cur, wr, wc, fr, fq);
        if (!has_next) break;
#pragma unroll
        for (int a = 0; a < 2; ++a)
#pragma unroll
            for (int b = 0; b < 2; ++b)
#pragma unroll
                for (int m = 0; m < 4; ++m)
#pragma unroll
                    for (int n = 0; n < 2; ++n) acc[a][b][m][n] = (f32x4){0.f, 0.f, 0.f, 0.f};
        cur = nxt; cA = nA; cB = nB; ++ui;
#pragma unroll
        for (int h = 0; h < 2; ++h)
#pragma unroll
            for (int i = 0; i < 2; ++i) oc[h][i] = on[h][i];
        if constexpr (ALIGN_EPI) { if (wr == 1) PG8_BAR; }
    }
    PG8_WAIT_V(0);
    if constexpr (!ALIGN_EPI) { if (wr == 0) PG8_BAR; }
    PG8_BAR;
#undef PG8_SA
#undef PG8_SB
#undef PG8_STAGE_A
#undef PG8_STAGE_B
#undef PG8_STAGE_B1
#undef PG8_LDA
#undef PG8_LDB
#undef PG8_MMA
#undef PG8_WAIT_V
#undef PG8_WAIT_L
#undef PG8_BAR
#undef PG8_SCHED
}

struct DenseOrder {
    const char* A; const char* Bt; int K, nM, nN, nwg, G, c;
    DI void init(const bf16* A_, const bf16* Bt_, int M, int N, int K_, int G_, int c_) { A = (const char*)A_; Bt = (const char*)Bt_; K = K_; nM = M / BM; nN = N / BM; nwg = nM * nN; G = G_; c = c_; }
    DI bool next(int i, Unit& u) const {
        const long L = (long)i * G + c; if (L >= nwg) return false;
        int wgid = (int)L; { const int q = nwg / NXCD, r = nwg % NXCD, xcd = wgid % NXCD, off = wgid / NXCD; wgid = (xcd < r ? xcd * (q + 1) : r * (q + 1) + (xcd - r) * q) + off; }
        const int nig = WGM * nN, gid = wgid / nig, fm = gid * WGM, gsz = (nM - fm) < WGM ? (nM - fm) : WGM;
        u.pm = fm + ((wgid % nig) % gsz); u.pn = (wgid % nig) / gsz; u.e = 0; u.ui = i;
        u.A = A + (size_t)u.pm * BM * K * 2; u.B = Bt + (size_t)u.pn * BM * K * 2; return true;
    }
    DI void a_offs(const Unit&, const int (&R)[2], const int (&C)[2], int K_, unsigned (&off)[2][2]) const {
#pragma unroll
        for (int h = 0; h < 2; ++h)
#pragma unroll
            for (int i = 0; i < 2; ++i) off[h][i] = (unsigned)((h * HALF + R[i]) * K_ + C[i]) * 2u;
    }
};
}

#define XB_TMO      128
#define XB_XCNT(j)  (256  + 64 * (j))
#define XB_XSUB(j)  (1280 + 64 * (j))
#define XB_XGEN(j)  (2304 + 64 * (j))
#define XB_TOP      3328
#define XB_TOPGEN   3392
#define XCD_BAR_WORDS 3456
#define XB_SPIN_CAP (1u << 18)
DI unsigned xb_ld(unsigned* p)              { return __hip_atomic_load(p, __ATOMIC_RELAXED, __HIP_MEMORY_SCOPE_AGENT); }
DI unsigned xb_add(unsigned* p, unsigned v) { return __hip_atomic_fetch_add(p, v, __ATOMIC_RELAXED, __HIP_MEMORY_SCOPE_AGENT); }
DI unsigned xb_xcc_id() { return (unsigned)__builtin_amdgcn_s_getreg((3 << 11) | 20) & 0xFu; }
#define XB_SPIN(cond, bar) do { unsigned _sp = 0; while (cond) { __builtin_amdgcn_s_sleep(1); \
    if ((++_sp & 255u) == 0u) { if (xb_ld(&(bar)[XB_TMO])) break; if (_sp > XB_SPIN_CAP) { atomicAdd(&(bar)[XB_TMO], 1u); break; } } } } while (0)
struct XcdBarrier { unsigned* bar; unsigned x; volatile LAS unsigned* st; };
DI XcdBarrier xcd_barrier_post(unsigned* bar, volatile LAS unsigned* st) {
    XcdBarrier b; b.bar = bar; b.x = xb_xcc_id(); b.st = st;
    if (threadIdx.x == 0) (void)xb_add(&bar[XB_XCNT(b.x)], 1u);
    return b;
}
DI void xcd_barrier_complete(unsigned* bar, unsigned x, unsigned& nloc, unsigned& nx) {
    const unsigned G = gridDim.x * gridDim.y * gridDim.z;
    unsigned sum, cnt, mine, sp = 0u;
    for (;;) {
        sum = 0u; cnt = 0u; mine = 0u;
#pragma unroll
        for (unsigned j = 0; j < 16; ++j) { const unsigned c = xb_ld(&bar[XB_XCNT(j)]); sum += c; cnt += (c > 0u) ? 1u : 0u; mine = (j == x) ? c : mine; }
        if (sum == G) break;
        __builtin_amdgcn_s_sleep(1);
        if ((++sp & 255u) == 0u) { if (xb_ld(&bar[XB_TMO])) break; if (sp > XB_SPIN_CAP) { atomicAdd(&bar[XB_TMO], 1u); break; } }
    }
    nloc = mine > 0u ? mine : 1u; nx = cnt > 0u ? cnt : 1u;
}
DI void xcd_barrier(const XcdBarrier& b) {
    asm volatile("s_waitcnt vmcnt(0)" ::: "memory");
    __syncthreads();
    if (threadIdx.x == 0) {
        unsigned* bar = b.bar;
        __builtin_amdgcn_s_waitcnt(0);
        unsigned nloc = b.st[0], nx = b.st[1];
        if (nloc == 0u) { xcd_barrier_complete(bar, b.x, nloc, nx); b.st[0] = nloc; b.st[1] = nx; }
        const unsigned old = xb_add(&bar[XB_XSUB(b.x)], 1u);
        const unsigned gen = old / nloc;
        if (old + 1u == (gen + 1u) * nloc) {
            __builtin_amdgcn_fence(__ATOMIC_RELEASE, "agent");
            asm volatile("s_waitcnt vmcnt(0)" ::: "memory");
            const unsigned og = xb_add(&bar[XB_TOP], 1u);
            const unsigned tg = og / nx;
            if (og + 1u == (tg + 1u) * nx) xb_add(&bar[XB_TOPGEN], 1u);
            else XB_SPIN(xb_ld(&bar[XB_TOPGEN]) == tg, bar);
            __builtin_amdgcn_fence(__ATOMIC_ACQUIRE, "agent");
            xb_add(&bar[XB_XGEN(b.x)], 1u);
            asm volatile("s_waitcnt vmcnt(0)" ::: "memory");
        } else {
            XB_SPIN(xb_ld(&bar[XB_XGEN(b.x)]) == gen, bar);
            __builtin_amdgcn_fence(__ATOMIC_ACQUIRE, "agent");
            asm volatile("s_waitcnt vmcnt(0)" ::: "memory");
        }
    }
    __syncthreads();
}

namespace pg8 {
typedef __bf16 bf16x2_t __attribute__((ext_vector_type(2)));
DI unsigned pk2(float lo, float hi) { f32x2v v = {lo, hi}; bf16x2_t b = __builtin_convertvector(v, bf16x2_t); return __builtin_bit_cast(unsigned, b); }
DI u32x4 pk8(f32x4 v0, f32x4 v1) { u32x4 w; w.x = pk2(v0[0], v0[1]); w.y = pk2(v0[2], v0[3]); w.z = pk2(v1[0], v1[1]); w.w = pk2(v1[2], v1[3]); return w; }

DI unsigned dpp_ror8(unsigned v) { return (unsigned)__builtin_amdgcn_mov_dpp((int)v, 0x128, 0xf, 0xf, false); }
DI void store_rows16(unsigned char* rowp, size_t ldb, u32x4 P0, u32x4 P1, int fr) {
    const bool hi = fr >= 8;
    const u32x4 give = hi ? P0 : P1;
    u32x4 recv; recv.x = dpp_ror8(give.x); recv.y = dpp_ror8(give.y); recv.z = dpp_ror8(give.z); recv.w = dpp_ror8(give.w);
    unsigned char* pa = rowp + (size_t)(fr & 7) * ldb + (hi ? 16 : 0);
    *(u32x4*)pa = hi ? recv : P0;
    *(u32x4*)(pa + 8 * ldb) = hi ? P1 : recv;
}
struct EpiInProj {
    static constexpr int PERM = 2;
    bf16* P1; float* vstat; const float* bias;
    DI void operator()(const f32x4 (&acc)[2][2][4][2], const Unit& u, int wr, int wc, int fr, int fq) const {
        const int rg0 = u.pm * BM + wr * 64;
        const int bcol0 = u.pn * BM + wc * 64 + 16 * fq;
        f32x4 bv[2][2];
#pragma unroll
        for (int bj = 0; bj < 2; ++bj)
#pragma unroll
            for (int n = 0; n < 2; ++n) bv[bj][n] = *(const f32x4*)(bias + bcol0 + 8 * bj + 4 * n);
        if (u.pn < 8) {
            bf16* base = P1 + u.pn * 128 + wc * 32 + 8 * fq;
#pragma unroll
            for (int ai = 0; ai < 2; ++ai)
#pragma unroll
                for (int m = 0; m < 4; ++m) {
                    f32x4 u0 = gelu4(acc[ai][0][m][0] + bv[0][0]), u1 = gelu4(acc[ai][0][m][1] + bv[0][1]);
                    const f32x4 g0 = sigmoid4(acc[ai][1][m][0] + bv[1][0]), g1 = sigmoid4(acc[ai][1][m][1] + bv[1][1]);
                    u0 = u0 * g0; u1 = u1 * g1;
                    *(u32x4*)(base + (size_t)(rg0 + ai * HALF + m * 16 + fr) * D) = pk8(u0, u1);
                }
        } else {
            const int t = (u.pn - 8) >> 2, colt = ((u.pn - 8) & 3) * BM;
            bf16* base = P1 + (size_t)(t + 1) * T * D + colt + wc * 64 + 16 * fq;
#pragma unroll
            for (int ai = 0; ai < 2; ++ai)
#pragma unroll
                for (int m = 0; m < 4; ++m) {
                    float s1 = 0.f, s2 = 0.f; u32x4 P[2];
#pragma unroll
                    for (int bj = 0; bj < 2; ++bj) {
                        f32x4 v0 = acc[ai][bj][m][0] + bv[bj][0], v1 = acc[ai][bj][m][1] + bv[bj][1];
                        if (t == 0) { v0 = gelu4(v0); v1 = gelu4(v1);
                            s1 += (v0[0] + v0[1]) + (v0[2] + v0[3]) + (v1[0] + v1[1]) + (v1[2] + v1[3]);
                            s2 += (v0[0] * v0[0] + v0[1] * v0[1]) + (v0[2] * v0[2] + v0[3] * v0[3]) + (v1[0] * v1[0] + v1[1] * v1[1]) + (v1[2] * v1[2] + v1[3] * v1[3]); }
                        else if (t == 1) { v0 = v0 * (QSCALE * LOG2E); v1 = v1 * (QSCALE * LOG2E); }
                        else if (t == 4) { v0 = sigmoid4(v0); v1 = sigmoid4(v1); }
                        P[bj] = pk8(v0, v1);
                    }
                    store_rows16((unsigned char*)(base + (size_t)(rg0 + ai * HALF + m * 16) * D), (size_t)D * 2, P[0], P[1], fr);
                    if (t == 0) {
                        s1 += __shfl_xor(s1, 16); s1 += __shfl_xor(s1, 32); s2 += __shfl_xor(s2, 16); s2 += __shfl_xor(s2, 32);
                        if (fq == 0) *(f32x2v*)(vstat + ((size_t)(rg0 + ai * HALF + m * 16 + fr) * 16 + (u.pn - 8) * 4 + wc) * 2) = (f32x2v){s1, s2};
                    }
                }
        }
    }
};
struct EpiBf16S {
    static constexpr int PERM = 2;
    bf16* O; int ldc; float scale;
    DI void operator()(const f32x4 (&acc)[2][2][4][2], const Unit& u, int wr, int wc, int fr, int fq) const {
        const int rg0 = u.pm * BM + wr * 64, col0 = u.pn * BM + wc * 64 + 16 * fq;
#pragma unroll
        for (int ai = 0; ai < 2; ++ai)
#pragma unroll
            for (int m = 0; m < 4; ++m)
                store_rows16((unsigned char*)(O + (size_t)(rg0 + ai * HALF + m * 16) * ldc + col0), (size_t)ldc * 2,
                             pk8(acc[ai][0][m][0] * scale, acc[ai][0][m][1] * scale), pk8(acc[ai][1][m][0] * scale, acc[ai][1][m][1] * scale), fr);
    }
};
template <bool LNIN> struct EpiResF32 {
    static constexpr int PERM = 0;
    float* out; const float* res; const float* xstat; const float* g; const float* b;
    DI void operator()(const f32x4 (&acc)[2][2][4][2], const Unit& u, int wr, int wc, int fr, int fq) const {
        const int col0 = u.pn * BM + wc * 32 + 4 * fq;
        f32x4 gv[2][2], bv[2][2];
        if (LNIN) {
#pragma unroll
            for (int bj = 0; bj < 2; ++bj)
#pragma unroll
                for (int n = 0; n < 2; ++n) { gv[bj][n] = *(const f32x4*)(g + col0 + bj * HALF + n * 16); bv[bj][n] = *(const f32x4*)(b + col0 + bj * HALF + n * 16); }
        }
#pragma unroll
        for (int ai = 0; ai < 2; ++ai)
#pragma unroll
            for (int m = 0; m < 4; ++m) {
                const int rg = u.pm * BM + ai * HALF + wr * 64 + m * 16, row = rg + fr; const size_t off = (size_t)row * D + col0;
                f32x2v st = (f32x2v){0.f, 1.f}; if (LNIN) st = *(const f32x2v*)(xstat + 2 * (size_t)row);
#pragma unroll
                for (int bj = 0; bj < 2; ++bj) { f32x4 o[2];
#pragma unroll
                    for (int n = 0; n < 2; ++n) { f32x4 r = *(const f32x4*)(res + off + bj * HALF + n * 16);
                        if (LNIN) r = (r - st.x) * st.y * gv[bj][n] + bv[bj][n];
                        o[n] = r * ALPHA + acc[ai][bj][m][n]; }
                    const bool hi = fr >= 8; const f32x4 give = hi ? o[0] : o[1];
                    u32x4 gi = __builtin_bit_cast(u32x4, give), rc; rc.x = dpp_ror8(gi.x); rc.y = dpp_ror8(gi.y); rc.z = dpp_ror8(gi.z); rc.w = dpp_ror8(gi.w);
                    const f32x4 recv = __builtin_bit_cast(f32x4, rc);
                    float* pa = out + (size_t)(rg + (fr & 7)) * D + col0 + bj * HALF + (hi ? 16 : 0);
                    *(f32x4*)pa = hi ? recv : o[0];
                    *(f32x4*)(pa + 8 * D) = hi ? o[1] : recv; }
                if (m & 1) asm volatile("" ::: "memory");
            }
    }
};
template <bool LNIN> struct EpiResB16 {
    static constexpr int PERM = 2;
    bf16* out; const float* resf; const bf16* resb; const float* xstat; const float* g; const float* b;
    DI void operator()(const f32x4 (&acc)[2][2][4][2], const Unit& u, int wr, int wc, int fr, int fq) const {
        const int col0 = u.pn * BM + wc * 64 + 16 * fq;
        f32x4 gv[2][2], bv[2][2];
        if (LNIN) {
#pragma unroll
            for (int bj = 0; bj < 2; ++bj)
#pragma unroll
                for (int n = 0; n < 2; ++n) { gv[bj][n] = *(const f32x4*)(g + col0 + 8 * bj + 4 * n); bv[bj][n] = *(const f32x4*)(b + col0 + 8 * bj + 4 * n); }
        }
#pragma unroll
        for (int ai = 0; ai < 2; ++ai)
#pragma unroll
            for (int m = 0; m < 4; ++m) {
                const int rg = u.pm * BM + ai * HALF + wr * 64 + m * 16, row = rg + fr; const size_t off = (size_t)row * D + col0;
                f32x4 rr[2][2];
                if (LNIN) { const f32x2v st = *(const f32x2v*)(xstat + 2 * (size_t)row);
#pragma unroll
                    for (int bj = 0; bj < 2; ++bj)
#pragma unroll
                        for (int n = 0; n < 2; ++n) rr[bj][n] = (*(const f32x4*)(resf + off + 8 * bj + 4 * n) - st.x) * st.y * gv[bj][n] + bv[bj][n];
                } else {
#pragma unroll
                    for (int bj = 0; bj < 2; ++bj) { const u32x4 x = *(const u32x4*)(resb + off + 8 * bj);
                        rr[bj][0] = (f32x4){bflo(x.x), bfhi(x.x), bflo(x.y), bfhi(x.y)}; rr[bj][1] = (f32x4){bflo(x.z), bfhi(x.z), bflo(x.w), bfhi(x.w)}; } }
                store_rows16((unsigned char*)(out + (size_t)rg * D + col0), (size_t)D * 2,
                             pk8(rr[0][0] * ALPHA + acc[ai][0][m][0], rr[0][1] * ALPHA + acc[ai][0][m][1]), pk8(rr[1][0] * ALPHA + acc[ai][1][m][0], rr[1][1] * ALPHA + acc[ai][1][m][1]), fr);
                if (m & 1) asm volatile("" ::: "memory");
            }
    }
};
constexpr float Y8_SCALE = 32.0f, Y8_CLAMP = 440.0f, H8_SCALE = 16.0f, W8_SCALE = 32.0f;
DI unsigned pk4_fp8s(f32x4 v, float sc) { v = v * sc;
    const float a = __builtin_fminf(__builtin_fmaxf(v[0], -Y8_CLAMP), Y8_CLAMP), b = __builtin_fminf(__builtin_fmaxf(v[1], -Y8_CLAMP), Y8_CLAMP), c = __builtin_fminf(__builtin_fmaxf(v[2], -Y8_CLAMP), Y8_CLAMP), d = __builtin_fminf(__builtin_fmaxf(v[3], -Y8_CLAMP), Y8_CLAMP);
    int p = __builtin_amdgcn_cvt_pk_fp8_f32(a, b, 0, false); p = __builtin_amdgcn_cvt_pk_fp8_f32(c, d, p, true); return (unsigned)p; }
DI unsigned pk4_fp8(f32x4 v) { return pk4_fp8s(v, Y8_SCALE); }
constexpr int MO_BLKE = 128 * 1024, MO_RT = MO_BLKE + 640, MO_RW = MO_RT + 5 * 1024, MO_END = MO_RW + 5 * 1024;
static_assert(MO_END <= SCR_BYTES, "MoE LDS tables");
struct EpiGateUp {
    static constexpr int PERM = 1;
    unsigned char* H; const LAS unsigned char* lds;
    DI void operator()(const f32x4 (&acc)[2][2][4][2], const Unit& u, int wr, int wc, int fr, int fq) const {
        const int rl = wr * 64 + fr, row0 = u.pm * BM + rl, col0 = u.pn * 128 + wc * 32 + 8 * fq;
        float wv[2][4];
#pragma unroll
        for (int ai = 0; ai < 2; ++ai)
#pragma unroll
            for (int m = 0; m < 4; ++m) wv[ai][m] = (u.e < 64) ? *(const LAS float*)(lds + MO_RW + (u.ui * 256 + rl + ai * HALF + m * 16) * 4) : 1.0f;
#pragma unroll
        for (int ai = 0; ai < 2; ++ai)
#pragma unroll
            for (int m = 0; m < 4; ++m) {
                const f32x4 g0 = acc[ai][0][m][0], g1 = acc[ai][0][m][1];
                const f32x4 h0 = g0 * sigmoid4(g0) * acc[ai][1][m][0] * wv[ai][m], h1 = g1 * sigmoid4(g1) * acc[ai][1][m][1] * wv[ai][m];
                *(u32x2*)(H + (size_t)(row0 + ai * HALF + m * 16) * EH + col0) = (u32x2){pk4_fp8s(h0, H8_SCALE), pk4_fp8s(h1, H8_SCALE)};
            }
    }
};
struct EpiDown {
    static constexpr int PERM = 2;
    unsigned char* Y8; bf16* xb; int nostore;
    DI void operator()(const f32x4 (&acc)[2][2][4][2], const Unit& u, int wr, int wc, int fr, int fq) const {
        if (nostore) return;
        const int rl = wr * 64 + fr, col0 = u.pn * BM + wc * 64 + 16 * fq;
        if (u.e < 64) {
#pragma unroll
            for (int ai = 0; ai < 2; ++ai)
#pragma unroll
                for (int m = 0; m < 4; ++m) { const int r = rl + ai * HALF + m * 16;
                    constexpr float RS = Y8_SCALE / (H8_SCALE * W8_SCALE);
                    u32x4 w; w.x = pk4_fp8s(acc[ai][0][m][0], RS); w.y = pk4_fp8s(acc[ai][0][m][1], RS); w.z = pk4_fp8s(acc[ai][1][m][0], RS); w.w = pk4_fp8s(acc[ai][1][m][1], RS);
                    __builtin_nontemporal_store(w, (u32x4*)(Y8 + ((size_t)u.pm * BM + r) * D + col0)); }
        } else {
#pragma unroll
            for (int ai = 0; ai < 2; ++ai) {
                u32x4 xr[4][2];
#pragma unroll
                for (int m = 0; m < 4; ++m)
#pragma unroll
                    for (int bj = 0; bj < 2; ++bj) xr[m][bj] = *(const u32x4*)(xb + ((size_t)(u.pm - SH_ROW0 / BM) * BM + rl + ai * HALF + m * 16) * D + col0 + 8 * bj);
#pragma unroll
                for (int m = 0; m < 4; ++m) { const size_t off = ((size_t)(u.pm - SH_ROW0 / BM) * BM + rl + ai * HALF + m * 16) * D + col0;
#pragma unroll
                    for (int bj = 0; bj < 2; ++bj) { const u32x4 x = xr[m][bj];
                        const f32x4 x0 = (f32x4){bflo(x.x), bfhi(x.x), bflo(x.y), bfhi(x.y)}, x1 = (f32x4){bflo(x.z), bfhi(x.z), bflo(x.w), bfhi(x.w)};
                        *(u32x4*)(xb + off + 8 * bj) = pk8(x0 * ALPHA + acc[ai][bj][m][0] * (1.0f / (H8_SCALE * W8_SCALE)), x1 * ALPHA + acc[ai][bj][m][1] * (1.0f / (H8_SCALE * W8_SCALE))); } }
                asm volatile("" ::: "memory"); }
        }
    }
};
struct GateUpOrder {
    const char* X; const char* Wgu; const char* Wgus; const LAS unsigned char* lds; int nblk, G, c;
    DI bool next(int i, Unit& u) const {
        const int L = i * G + c; if (L >= (nblk + 64) * 2) return false;
        const int bl = L >> 1; u.pn = L & 1; u.ui = i;
        if (bl < nblk) { u.e = (int)__builtin_amdgcn_readfirstlane((int)*(const LAS unsigned char*)(lds + MO_BLKE + bl)); u.pm = bl; u.A = X; u.B = Wgu + ((size_t)u.e * 512 + u.pn * 256) * D * 2; }
        else { u.e = 64; u.pm = SH_ROW0 / BM + (bl - nblk); u.A = X + (size_t)(bl - nblk) * BM * D * 2; u.B = Wgus + (size_t)u.pn * 256 * D * 2; }
        return true;
    }
    DI void a_offs(const Unit& u, const int (&R)[2], const int (&C)[2], int K_, unsigned (&off)[2][2]) const {
        if (u.e < 64) {
#pragma unroll
            for (int h = 0; h < 2; ++h)
#pragma unroll
                for (int i = 0; i < 2; ++i) { const int tok = *(const LAS int*)(lds + MO_RT + (u.ui * 256 + h * HALF + R[i]) * 4); off[h][i] = (unsigned)(tok * K_ + C[i]) * 2u; }
        } else {
#pragma unroll
            for (int h = 0; h < 2; ++h)
#pragma unroll
                for (int i = 0; i < 2; ++i) off[h][i] = (unsigned)((h * HALF + R[i]) * K_ + C[i]) * 2u;
        }
    }
};
struct DownOrder {
    const char* H; const char* Wd; const char* Wds; const LAS unsigned char* lds; int lo, hi, nsh, G, c, hot;
    DI bool next(int i, Unit& u) const {
        const int L = i * G + c; if (L >= (hi - lo + nsh) * 4) return false;
        int bl = lo + (L >> 2); u.pn = L & 3; u.ui = i; if (hot) bl = lo + ((L >> 2) & 7);
        if (bl < hi) { u.e = (int)__builtin_amdgcn_readfirstlane((int)*(const LAS unsigned char*)(lds + MO_BLKE + bl)); u.pm = bl; u.B = Wd + ((size_t)u.e * D + u.pn * 256) * EH; }
        else { u.e = 64; u.pm = SH_ROW0 / BM + (bl - hi); u.B = Wds + (size_t)u.pn * 256 * EH; }
        u.A = H + (size_t)u.pm * BM * EH;
        return true;
    }
    DI void a_offs(const Unit&, const int (&R)[2], const int (&C)[2], int K_, unsigned (&off)[2][2]) const {
#pragma unroll
        for (int h = 0; h < 2; ++h)
#pragma unroll
            for (int i = 0; i < 2; ++i) off[h][i] = (unsigned)((h * HALF + R[i]) * K_ + C[i]) * 2u;
    }
};
DI void moe_tables(LAS unsigned char* lds, const unsigned* blke, int nblk, const int* rowtok, const float* roww, bool gateup, int G, int c, int tid) {
    for (int b = tid; b < nblk; b += NTHREADS) *(LAS unsigned char*)(lds + MO_BLKE + b) = (unsigned char)__hip_atomic_load(blke + b, RLX_AGENT);
    if (gateup) {
#pragma unroll
        for (int i = 0; i < 5; ++i) { const int L = i * G + c, bl = L >> 1;
            if (bl < nblk && tid < 256) { *(LAS int*)(lds + MO_RT + (i * 256 + tid) * 4) = __hip_atomic_load(rowtok + (size_t)bl * 256 + tid, RLX_AGENT);
                                          *(LAS float*)(lds + MO_RW + (i * 256 + tid) * 4) = __hip_atomic_load(roww + (size_t)bl * 256 + tid, RLX_AGENT); } }
    }
    __syncthreads();
}
}

struct Frame {
    LAS unsigned char* lds;
    unsigned* ctl;
    unsigned char* ws; float* out;
    int tid, lane, wave, vcu, G;
};
DI unsigned short f2bf1(float x) { return (unsigned short)(pg8::pk2(x, x) & 0xffffu); }

template <class RowMap>
DI void transpose_item(const float* W, int N, bf16* WT, int Kd, RowMap rm, LAS float* scr, int kb, int nb, int lane) {
    const int k0 = 64 * kb, n0 = 32 * nb;
#pragma unroll 8
    for (int i = 0; i < 32; ++i) { const int kk = 2 * i + (lane >> 5); scr[kk * 33 + (lane & 31)] = W[(size_t)(k0 + kk) * N + n0 + (lane & 31)]; }
    LDS_WAIT(); asm volatile("" ::: "memory");
    const int c = lane & 7;
#pragma unroll
    for (int j = 0; j < 4; ++j) { const int n = (lane >> 3) + 8 * j; const LAS float* s = scr + (8 * c) * 33 + n;
        u32x4 o; o.x = pg8::pk2(s[0 * 33], s[1 * 33]); o.y = pg8::pk2(s[2 * 33], s[3 * 33]); o.z = pg8::pk2(s[4 * 33], s[5 * 33]); o.w = pg8::pk2(s[6 * 33], s[7 * 33]);
        *(u32x4*)(WT + (size_t)rm(n0 + n) * Kd + k0 + 8 * c) = o; }
    LDS_WAIT(); asm volatile("" ::: "memory");
}
struct RmIdent { int off; DI int operator()(int n) const { return off + n; } };
struct RmInProj { DI int operator()(int n) const { const int seg = n >> 10, w = n & 1023;
    return seg == 0 ? ((w >> 7) * 256 + ((w & 127) >> 3) * 16 + (w & 7)) : seg == 5 ? ((w >> 7) * 256 + ((w & 127) >> 3) * 16 + 8 + (w & 7)) : seg == 6 ? 6144 + w : 1024 + n; } };
struct RmGateUp { int up; DI int operator()(int n) const { return (n >> 7) * 256 + up * 128 + (n & 127); } };
DI int inproj_dest(int n) { return RmInProj()(n); }

struct CvtItem { const float* W; bf16* WT; int N, Kd, mode, kb, nb; };
DI CvtItem cvt_decode(const float* const* in, unsigned char* ws, int it) {
    const int e = it / 384; int r = it % 384; CvtItem c;
    if (r < 256) { const int up = r >> 7; r &= 127; c.W = in[20 + up] + (size_t)e * D * EH; c.N = EH; c.WT = (bf16*)(ws + WS_WGU) + (size_t)e * 512 * D; c.Kd = D; c.mode = up; c.kb = r >> 3; c.nb = r & 7; }
    else { r -= 256; c.W = in[22] + (size_t)e * EH * D; c.N = D; c.WT = (bf16*)(ws + WS_WD + (size_t)e * D * EH); c.Kd = EH; c.mode = 4; c.kb = r >> 5; c.nb = r & 31; }
    return c;
}
DI void cvt_load(const CvtItem& c, int lane, f32x4 (&v)[8]) {
#pragma unroll
    for (int i = 0; i < 8; ++i) v[i] = __builtin_nontemporal_load((const f32x4*)(c.W + (size_t)(64 * c.kb + (lane >> 3) + 8 * i) * c.N + 32 * c.nb + 4 * (lane & 7)));
}
DI void cvt_finish(const CvtItem& c, int lane, const f32x4 (&v)[8], LAS float* scr) {
#pragma unroll
    for (int i = 0; i < 8; ++i) { LAS float* d = scr + ((lane >> 3) + 8 * i) * 33 + 4 * (lane & 7); d[0] = v[i][0]; d[1] = v[i][1]; d[2] = v[i][2]; d[3] = v[i][3]; }
    LDS_WAIT(); asm volatile("" ::: "memory");
    const int cc = lane & 7;
#pragma unroll
    for (int j = 0; j < 4; ++j) { const int n = 32 * c.nb + (lane >> 3) + 8 * j; const LAS float* sp = scr + (8 * cc) * 33 + (lane >> 3) + 8 * j;
        if (c.mode == 4) {
            *(u32x2*)((unsigned char*)c.WT + (size_t)n * c.Kd + 64 * c.kb + 8 * cc) = (u32x2){pg8::pk4_fp8s((f32x4){sp[0 * 33], sp[1 * 33], sp[2 * 33], sp[3 * 33]}, pg8::W8_SCALE), pg8::pk4_fp8s((f32x4){sp[4 * 33], sp[5 * 33], sp[6 * 33], sp[7 * 33]}, pg8::W8_SCALE)};
            continue; }
        const int drow = (c.mode == 2) ? n : (c.mode == 3) ? RmInProj()(n) : ((n >> 7) * 256 + c.mode * 128 + (n & 127));
        u32x4 o; o.x = pg8::pk2(sp[0 * 33], sp[1 * 33]); o.y = pg8::pk2(sp[2 * 33], sp[3 * 33]); o.z = pg8::pk2(sp[4 * 33], sp[5 * 33]); o.w = pg8::pk2(sp[6 * 33], sp[7 * 33]);
        *(u32x4*)(c.WT + (size_t)drow * c.Kd + 64 * c.kb + 8 * cc) = o; }
    LDS_WAIT(); asm volatile("" ::: "memory");
}
constexpr int P0_I_IN = 16 * (INW / 32), P0_I_OUT = 16 * 32, P0_I_Q = 16 * 16, P0_I_KV = 16 * 32, P0_I_O = 8 * 32, P0_I_SG = 16 * 8, P0_I_SD = 4 * 32;
constexpr int P0_NITEMS = P0_I_IN + P0_I_OUT + P0_I_Q + P0_I_KV + P0_I_O + 2 * P0_I_SG + P0_I_SD;
DI CvtItem p0_decode(const float* const* in, unsigned char* ws, int it) {
    int r = it; CvtItem c;
    if (r < P0_I_IN) { c.W = in[4]; c.N = INW; c.WT = (bf16*)(ws + WS_WIN); c.Kd = D; c.mode = 3; c.kb = r / (INW / 32); c.nb = r % (INW / 32); return c; } r -= P0_I_IN;
    if (r < P0_I_OUT) { c.W = in[10]; c.N = D; c.WT = (bf16*)(ws + WS_WOUT); c.Kd = D; c.mode = 2; c.kb = r / 32; c.nb = r % 32; return c; } r -= P0_I_OUT;
    if (r < P0_I_Q) { c.W = in[13]; c.N = MEMW; c.WT = (bf16*)(ws + WS_WQ); c.Kd = D; c.mode = 2; c.kb = r / 16; c.nb = r % 16; return c; } r -= P0_I_Q;
    if (r < P0_I_KV) { c.W = in[14]; c.N = 2 * MEMW; c.WT = (bf16*)(ws + WS_WKV); c.Kd = D; c.mode = 2; c.kb = r / 32; c.nb = r % 32; return c; } r -= P0_I_KV;
    if (r < P0_I_O) { c.W = in[15]; c.N = D; c.WT = (bf16*)(ws + WS_WO); c.Kd = MEMW; c.mode = 2; c.kb = r / 32; c.nb = r % 32; return c; } r -= P0_I_O;
    if (r < 2 * P0_I_SG) { const int up = r / P0_I_SG; r %= P0_I_SG; c.W = in[23 + up]; c.N = EH; c.WT = (bf16*)(ws + WS_WGUS); c.Kd = D; c.mode = up; c.kb = r / 8; c.nb = r % 8; return c; } r -= 2 * P0_I_SG;
    c.W = in[25]; c.N = D; c.WT = (bf16*)(ws + WS_WDS); c.Kd = EH; c.mode = 4; c.kb = r / 32; c.nb = r % 32; return c;
}
DI void p0_convert(Frame& F, const float* const* in) {
    LAS float* scr = (LAS float*)(F.lds + F.wave * 16384);
    const int lane = F.lane, stride = F.G * NWAVES;
    int it = F.vcu * NWAVES + F.wave;
    if (it >= P0_NITEMS) return;
    CvtItem cur = p0_decode(in, F.ws, it); f32x4 v[8]; cvt_load(cur, lane, v);
    for (;;) {
        const int nx = it + stride; const bool has = nx < P0_NITEMS;
        CvtItem nxt = cur; f32x4 vn[8];
        if (has) { nxt = p0_decode(in, F.ws, nx); cvt_load(nxt, lane, vn); }
        cvt_finish(cur, lane, v, scr);
        if (!has) break;
        cur = nxt; it = nx;
#pragma unroll
        for (int i = 0; i < 8; ++i) v[i] = vn[i];
    }
}
DI void expert_convert(Frame& F, const float* const* in, int worker, int nworkers, int item_lo, int item_hi) {
    LAS float* scr = (LAS float*)(F.lds + F.wave * 16384);
    const int lane = F.lane, stride = nworkers * NWAVES;
    int it = item_lo + worker * NWAVES + F.wave;
    if (it >= item_hi) return;
    CvtItem cur = cvt_decode(in, F.ws, it); f32x4 v[8]; cvt_load(cur, lane, v);
    for (;;) {
        const int nx = it + stride; const bool has = nx < item_hi;
        CvtItem nxt = cur; f32x4 vn[8];
        if (has) { nxt = cvt_decode(in, F.ws, nx); cvt_load(nxt, lane, vn); }
        cvt_finish(cur, lane, v, scr);
        if (!has) break;
        cur = nxt; it = nx;
#pragma unroll
        for (int i = 0; i < 8; ++i) v[i] = vn[i];
    }
}

template <bool NT = false> DI void row_stats(const float* xrow, int lane, f32x4 (&v)[4], float& mean, float& rstd) {
    const f32x4* xr = (const f32x4*)xrow + lane; float s = 0.f;
#pragma unroll
    for (int j = 0; j < 4; ++j) { v[j] = NT ? __builtin_nontemporal_load(xr + 64 * j) : xr[64 * j]; s += (v[j][0] + v[j][1]) + (v[j][2] + v[j][3]); }
    mean = wave_sum(s) * (1.f / D); float s2 = 0.f;
#pragma unroll
    for (int j = 0; j < 4; ++j) { const f32x4 d = v[j] - mean; s2 += (d[0] * d[0] + d[1] * d[1]) + (d[2] * d[2] + d[3] * d[3]); }
    rstd = 1.f / sqrtf(wave_sum(s2) * (1.f / D) + LN_EPS);
}

DI void row_stats_b16(const bf16* xrow, int lane, f32x4 (&v)[4], float& mean, float& rstd) {
    const u32x2* xr = (const u32x2*)xrow + lane; float s = 0.f;
#pragma unroll
    for (int j = 0; j < 4; ++j) { const u32x2 x = xr[64 * j]; v[j] = (f32x4){bflo(x.x), bfhi(x.x), bflo(x.y), bfhi(x.y)}; s += (v[j][0] + v[j][1]) + (v[j][2] + v[j][3]); }
    mean = wave_sum(s) * (1.f / D); float s2 = 0.f;
#pragma unroll
    for (int j = 0; j < 4; ++j) { const f32x4 d = v[j] - mean; s2 += (d[0] * d[0] + d[1] * d[1]) + (d[2] * d[2] + d[3] * d[3]); }
    rstd = 1.f / sqrtf(wave_sum(s2) * (1.f / D) + LN_EPS);
}
DI void p0_prologue(Frame& F, const float* const* in) {
    const int gw = F.vcu * NWAVES + F.wave, NGW = F.G * NWAVES, lane = F.lane;
    unsigned char* ws = F.ws;
    p0_convert(F, in);
    const int gt = F.vcu * NTHREADS + F.tid, NGT = F.G * NTHREADS;
    { const float* wr = in[18]; bf16* hi = (bf16*)(ws + WS_WRHI); bf16* lo = (bf16*)(ws + WS_WRLO);
      for (int idx = gt; idx < D * NEXP; idx += NGT) { const int k = idx >> 6, e = idx & 63; const float w = wr[idx]; const unsigned short h = f2bf1(w); hi[e * D + k] = h; lo[e * D + k] = f2bf1(w - bf2f(h)); } }
    { const float* wsp = in[8]; bf16* o = (bf16*)(ws + WS_WSP);
      for (int idx = gt; idx < 8 * 128 * 128; idx += NGT) { const int s = idx & 127, t = (idx >> 7) & 127; o[idx] = (s <= t) ? f2bf1(wsp[idx]) : (unsigned short)0; } }
    { const float* bi = in[5]; float* o = (float*)(ws + WS_BPERM);
      for (int idx = gt; idx < INW; idx += NGT) o[inproj_dest(idx)] = bi[idx]; }
    { const f32x4* m4 = (const f32x4*)in[1]; u32x2* o = (u32x2*)(ws + WS_MEMB);
      for (int idx = gt; idx < NBATCH * MEMLEN * D / 4; idx += NGT) { const f32x4 v = m4[idx]; o[idx] = (u32x2){pg8::pk2(v[0], v[1]), pg8::pk2(v[2], v[3])}; } }
    { const float* x = in[0]; const float* g = in[2]; const float* b = in[3]; bf16* X0b = (bf16*)F.out; float* xstat = (float*)(ws + WS_XSTAT);
      f32x4 gv[4], bv[4];
#pragma unroll
      for (int j = 0; j < 4; ++j) { gv[j] = ((const f32x4*)g)[lane + 64 * j]; bv[j] = ((const f32x4*)b)[lane + 64 * j]; }
      for (int m = gw; m < T; m += NGW) { f32x4 v[4]; float mean, rstd; row_stats<true>(x + (size_t)m * D, lane, v, mean, rstd);
          u32x2* o8 = (u32x2*)(X0b + (size_t)m * D) + lane;
#pragma unroll
          for (int j = 0; j < 4; ++j) { const f32x4 y = (v[j] - mean) * rstd * gv[j] + bv[j]; o8[64 * j] = (u32x2){pg8::pk2(y[0], y[1]), pg8::pk2(y[2], y[3])}; }
          if (lane == 0) *(f32x2*)(xstat + 2 * (size_t)m) = (f32x2){mean, rstd}; } }
}
constexpr int MX_BUF = 32768, MX_STAT = 4 * MX_BUF, MX_FLG = MX_STAT + 1024, MX_FLG2 = MX_FLG + 64, MX_END = MX_FLG2 + 64;
static_assert(MX_END <= SCR_BYTES, "mixer LDS");
constexpr float MX_EXIT2 = SB_EXIT * LOG2E;
typedef short v4i16_t __attribute__((ext_vector_type(4)));
DI bf16x8 mk_frag(f32x4 e0, f32x4 e1) { const u32x4 w = pg8::pk8(e0, e1); return __builtin_bit_cast(bf16x8, w); }
DI bf16x8 ld_split8(const LAS unsigned char* p) {
    const s16x4 lo = *(const LAS s16x4*)p, hi = *(const LAS s16x4*)(p + 32);
    return (bf16x8){lo[0], lo[1], lo[2], lo[3], hi[0], hi[1], hi[2], hi[3]};
}
DI void glds16(const void* gsrc, unsigned lds_dst) { unsigned keep;
    asm volatile("s_mov_b32 %0, m0\n\ts_mov_b32 m0, %2\n\ts_nop 0\n\tglobal_load_lds_dwordx4 %1, off\n\ts_mov_b32 m0, %0" : "=&s"(keep) : "v"(gsrc), "s"(lds_dst) : "memory"); }
DI void mx_dma(LAS unsigned char* buf, const bf16* src, int w, int lane) {
#pragma unroll
    for (int i = 0; i < 4; ++i) { const int pc = 4 * w + i, row = 4 * pc + (lane >> 4), cpos = lane & 15;
        glds16((const char*)src + (size_t)row * (D * 2) + ((cpos ^ (row & 15)) * 16), (unsigned)__builtin_amdgcn_readfirstlane((unsigned)(uintptr_t)(buf + pc * 1024))); }
}
DI bf16x8 mx_tr(const LAS unsigned char* buf, int sA, int sB, int d0, int r) {
    const int ra = sA + (r >> 2), rb = sB + (r >> 2), ch = (d0 >> 3) + ((r & 3) >> 1), bo = 8 * (r & 1);
    const s16x4 lo = __builtin_bit_cast(s16x4, __builtin_amdgcn_ds_read_tr16_b64_v4i16((LAS v4i16_t*)(buf + ra * 256 + ((ch ^ (ra & 15)) * 16) + bo)));
    const s16x4 hi = __builtin_bit_cast(s16x4, __builtin_amdgcn_ds_read_tr16_b64_v4i16((LAS v4i16_t*)(buf + rb * 256 + ((ch ^ (rb & 15)) * 16) + bo)));
    return (bf16x8){lo[0], lo[1], lo[2], lo[3], hi[0], hi[1], hi[2], hi[3]};
}
DI void sb_scores(const LAS unsigned char* kbuf, const bf16x8 (&qf)[4], bool diag, int tq, float carry, int r, int q, const bf16x8& UE, const bf16x8& UO, const bf16x8& ONES, bf16x8 (&af)[4], float& tot_out) {
    f32x4 z[8];
#pragma unroll
    for (int st = 0; st < 8; ++st) { z[st] = (f32x4){0.f, 0.f, 0.f, 0.f};
#pragma unroll
        for (int kk = 0; kk < 4; ++kk) { const bf16x8 kf = *(const LAS bf16x8*)(kbuf + (16 * st + r) * 256 + (((4 * kk + q) ^ r) * 16));
            z[st] = __builtin_amdgcn_mfma_f32_16x16x32_bf16(kf, qf[kk], z[st], 0, 0, 0); }
        if (st & 1) __builtin_amdgcn_sched_barrier(0); }
    f32x4 ls[8];
#pragma unroll
    for (int st = 0; st < 8; ++st)
#pragma unroll
        for (int e = 0; e < 4; ++e) { const float zz = z[st][e]; const float sp = fmaxf(zz, 0.f) + fast_log2(1.0f + fast_exp2(-fabsf(zz)));
            const bool msk = diag && (16 * st + 4 * q + e >= tq);
            ls[st][e] = msk ? 0.f : -sp; z[st][e] = msk ? -1e30f : zz - sp; }
    bf16x8 lf[4];
#pragma unroll
    for (int p = 0; p < 4; ++p) lf[p] = mk_frag(ls[2 * p], ls[2 * p + 1]);
    f32x4 tot = (f32x4){0.f, 0.f, 0.f, 0.f};
#pragma unroll
    for (int p = 0; p < 4; ++p) tot = __builtin_amdgcn_mfma_f32_16x16x32_bf16(ONES, lf[p], tot, 0, 0, 0);
#pragma unroll
    for (int p = 0; p < 4; ++p) {
        f32x4 s0 = (f32x4){0.f, 0.f, 0.f, 0.f}, s1 = (f32x4){0.f, 0.f, 0.f, 0.f};
        s0 = __builtin_amdgcn_mfma_f32_16x16x32_bf16(UE, lf[p], s0, 0, 0, 0);
        s1 = __builtin_amdgcn_mfma_f32_16x16x32_bf16(UO, lf[p], s1, 0, 0, 0);
#pragma unroll
        for (int p2 = p + 1; p2 < 4; ++p2) { s0 = __builtin_amdgcn_mfma_f32_16x16x32_bf16(ONES, lf[p2], s0, 0, 0, 0); s1 = __builtin_amdgcn_mfma_f32_16x16x32_bf16(ONES, lf[p2], s1, 0, 0, 0); }
        f32x4 a0, a1;
#pragma unroll
        for (int e = 0; e < 4; ++e) { a0[e] = fast_exp2(z[2 * p][e] + s0[e] + carry); a1[e] = fast_exp2(z[2 * p + 1][e] + s1[e] + carry); }
        af[p] = mk_frag(a0, a1);
    }
    tot_out = tot[0];
}
DI void sb_pv(const LAS unsigned char* vbuf, const bf16x8 (&af)[4], f32x4 (&yb)[8], int r, int q) {
#pragma unroll
    for (int dt = 0; dt < 8; ++dt)
#pragma unroll
        for (int p = 0; p < 4; ++p) { const bf16x8 vf = mx_tr(vbuf, 32 * p + 4 * q, 32 * p + 16 + 4 * q, 16 * dt, r);
            yb[dt] = __builtin_amdgcn_mfma_f32_16x16x32_bf16(vf, af[p], yb[dt], 0, 0, 0);
            if (p == 3 && (dt & 1)) __builtin_amdgcn_sched_barrier(0); }
}
#define MX_WAIT_BAR(n) asm volatile("s_waitcnt vmcnt(" #n ") lgkmcnt(0)\n\ts_barrier" ::: "memory")
DI void mix_phase(Frame& F, const float* const* in) {
    LAS unsigned char* lds = F.lds; unsigned char* ws = F.ws;
    const int tid = F.tid, lane = F.lane, w = F.wave, r = lane & 15, q = lane >> 4;
    const bf16* UG = (const bf16*)(ws + WS_UG); const bf16* VA = (const bf16*)(ws + WS_VA); const bf16* Qg = (const bf16*)(ws + WS_Q);
    const bf16* Kg = (const bf16*)(ws + WS_K); const bf16* Vg = (const bf16*)(ws + WS_V); const bf16* GB = (const bf16*)(ws + WS_GB);
    const float* vstat = (const float*)(ws + WS_VSTAT); const bf16* WSP = (const bf16*)(ws + WS_WSP); bf16* MG = (bf16*)(ws + WS_MERGED);
    const float* lnvg = in[6]; const float* lnvb = in[7]; const float* bsp = in[9];
    LAS unsigned char* B0 = lds; LAS unsigned char* B1 = lds + MX_BUF; LAS unsigned char* B2 = lds + 2 * MX_BUF; LAS unsigned char* B3 = lds + 3 * MX_BUF;
    bf16x8 UE, UO, ONES;
#pragma unroll
    for (int jj = 0; jj < 8; ++jj) { ONES[jj] = (short)0x3F80;
        UE[jj] = (jj < 4) ? ((4 * q + jj > r) ? (short)0x3F80 : (short)0) : (short)0x3F80;
        UO[jj] = (jj < 4) ? (short)0 : ((4 * q + jj - 4 > r) ? (short)0x3F80 : (short)0); }
    const int NU = NBATCH * 16 * 8;
    int un = F.vcu;
    if (un >= NU) return;
#define MX_DEC(u_, b_, i_, j_) const int j_ = (u_) & 7, i_ = ((u_) >> 3) & 15, b_ = (u_) >> 7
    bf16x8 qf[4];
    { MX_DEC(un, b, i, j); const int ip = i > 0 ? i - 1 : 0;
      mx_dma(B0, Kg + (size_t)(b * SEQ + 128 * i) * D + 128 * j, w, lane);
      mx_dma(B2, Kg + (size_t)(b * SEQ + 128 * ip) * D + 128 * j, w, lane);
      mx_dma(B3, Vg + (size_t)(b * SEQ + 128 * ip) * D + 128 * j, w, lane);
#pragma unroll
      for (int kk = 0; kk < 4; ++kk) qf[kk] = *(const bf16x8*)(Qg + (size_t)(b * SEQ + 128 * i + 16 * w + r) * D + 128 * j + 32 * kk + 8 * q); }
    for (; un < NU; un += F.G) {
        MX_DEC(un, b, i, j);
        const int t0 = b * SEQ + 128 * i, c0 = 128 * j, tq = 16 * w + r;
        const int unn = (un + F.G < NU) ? un + F.G : un;
        MX_DEC(unn, bn, in_, jn); const int ipn = in_ > 0 ? in_ - 1 : 0;
        f32x4 yb[8];
#pragma unroll
        for (int dt = 0; dt < 8; ++dt) yb[dt] = (f32x4){0.f, 0.f, 0.f, 0.f};
        float carry = 0.f, tot; bf16x8 af[4];
        MX_WAIT_BAR(0);
        asm volatile("" : "+v"(qf[0]), "+v"(qf[1]), "+v"(qf[2]), "+v"(qf[3]));
        mx_dma(B1, Vg + (size_t)t0 * D + c0, w, lane);
        sb_scores(B0, qf, true, tq, 0.f, r, q, UE, UO, ONES, af, tot);
        MX_WAIT_BAR(0);
        mx_dma(B0, Kg + (size_t)(bn * SEQ + 128 * in_) * D + 128 * jn, w, lane);
        sb_pv(B1, af, yb, r, q);
        carry += tot;
        MX_WAIT_BAR(4);
        mx_dma(B1, VA + (size_t)t0 * D + c0, w, lane);
        const bool wlive = (i > 0) && (wave_max(carry) >= MX_EXIT2);
        if (wlive) { sb_scores(B2, qf, false, tq, carry, r, q, UE, UO, ONES, af, tot);
            const float wm = wave_max(carry + tot); if (lane == 0) *(LAS float*)(lds + MX_FLG + w * 4) = wm; }
        else if (i > 0) { if (lane == 0) *(LAS float*)(lds + MX_FLG + w * 4) = -1e30f; }
        MX_WAIT_BAR(4);
        mx_dma(B2, Kg + (size_t)(bn * SEQ + 128 * ipn) * D + 128 * jn, w, lane);
        if (wlive) { sb_pv(B3, af, yb, r, q); carry += tot; }
        if (i > 1) {
            float gm = -1e30f;
#pragma unroll
            for (int k = 0; k < 8; ++k) gm = fmaxf(gm, *(const LAS float*)(lds + MX_FLG + k * 4));
            if (gm >= MX_EXIT2) {
                for (int kb = i - 2; kb >= 0; --kb) {
                    MX_WAIT_BAR(0);
                    mx_dma(B2, Kg + (size_t)(b * SEQ + 128 * kb) * D + c0, w, lane); mx_dma(B3, Vg + (size_t)(b * SEQ + 128 * kb) * D + c0, w, lane);
                    MX_WAIT_BAR(0);
                    if (wave_max(carry) >= MX_EXIT2) { sb_scores(B2, qf, false, tq, carry, r, q, UE, UO, ONES, af, tot); sb_pv(B3, af, yb, r, q); carry += tot; }
                    const float wm = wave_max(carry); if (lane == 0) *(LAS float*)(lds + MX_FLG2 + w * 4) = wm;
                    MX_WAIT_BAR(0);
                    float g2 = -1e30f;
#pragma unroll
                    for (int k = 0; k < 8; ++k) g2 = fmaxf(g2, *(const LAS float*)(lds + MX_FLG2 + k * 4));
                    if (g2 < MX_EXIT2) break;
                }
                MX_WAIT_BAR(0);
                mx_dma(B2, Kg + (size_t)(bn * SEQ + 128 * ipn) * D + 128 * jn, w, lane);
            }
        }
        { f32x2 sp4[4];
#pragma unroll
          for (int k = 0; k < 4; ++k) sp4[k] = *((const f32x2*)vstat + (size_t)(t0 + (tid >> 2)) * 16 + 4 * (tid & 3) + k);
          float s1 = (sp4[0][0] + sp4[1][0]) + (sp4[2][0] + sp4[3][0]), s2 = (sp4[0][1] + sp4[1][1]) + (sp4[2][1] + sp4[3][1]);
          s1 += __shfl_xor(s1, 1); s1 += __shfl_xor(s1, 2); s2 += __shfl_xor(s2, 1); s2 += __shfl_xor(s2, 2);
          const float mean = s1 * (1.f / D), var = s2 * (1.f / D) - mean * mean;
          if ((tid & 3) == 0) *(LAS f32x2*)(lds + MX_STAT + (tid >> 2) * 8) = (f32x2){mean, 1.f / sqrtf(fmaxf(var, 0.f) + LN_EPS)}; }
        MX_WAIT_BAR(4);
        mx_dma(B3, Vg + (size_t)(bn * SEQ + 128 * ipn) * D + 128 * jn, w, lane);
        bf16x8 qn[4];
#pragma unroll
        for (int kk = 0; kk < 4; ++kk) qn[kk] = *(const bf16x8*)(Qg + (size_t)(bn * SEQ + 128 * in_ + 16 * w + r) * D + 128 * jn + 32 * kk + 8 * q);
        {
          f32x4 ya[8];
#pragma unroll
          for (int dt = 0; dt < 8; ++dt) ya[dt] = (f32x4){0.f, 0.f, 0.f, 0.f};
          float c1 = 0.f, c2 = 0.f;
          const int nks = (w >> 1) + 1;
          for (int ks = 0; ks < nks; ++ks) {
              const u32x4 wr4 = *(const u32x4*)(WSP + ((size_t)j * 128 + tq) * 128 + 32 * ks + 8 * q);
              float wv[8] = {bflo(wr4.x), bfhi(wr4.x), bflo(wr4.y), bfhi(wr4.y), bflo(wr4.z), bfhi(wr4.z), bflo(wr4.w), bfhi(wr4.w)}; float wp[8];
#pragma unroll
              for (int e = 0; e < 8; ++e) { const f32x2 st = *(const LAS f32x2*)(lds + MX_STAT + (32 * ks + 8 * q + e) * 8); wp[e] = wv[e] * st[1]; c2 += wv[e]; }
              const u32x4 wq = pg8::pk8((f32x4){wp[0], wp[1], wp[2], wp[3]}, (f32x4){wp[4], wp[5], wp[6], wp[7]});
              const float wb[8] = {bflo(wq.x), bfhi(wq.x), bflo(wq.y), bfhi(wq.y), bflo(wq.z), bfhi(wq.z), bflo(wq.w), bfhi(wq.w)};
#pragma unroll
              for (int e = 0; e < 8; ++e) { const f32x2 st = *(const LAS f32x2*)(lds + MX_STAT + (32 * ks + 8 * q + e) * 8); c1 += wb[e] * st[0]; }
              const bf16x8 wf = __builtin_bit_cast(bf16x8, wq);
#pragma unroll
              for (int dt = 0; dt < 8; ++dt) { const bf16x8 vf = mx_tr(B1, 32 * ks + 8 * q, 32 * ks + 8 * q + 4, 16 * dt, r);
                  ya[dt] = __builtin_amdgcn_mfma_f32_16x16x32_bf16(vf, wf, ya[dt], 0, 0, 0); }
          }
          c1 += __shfl_xor(c1, 16); c1 += __shfl_xor(c1, 32); c2 += __shfl_xor(c2, 16); c2 += __shfl_xor(c2, 32);
          const float bs = bsp[j * 128 + tq]; const size_t rowoff = (size_t)(t0 + tq) * D + c0 + 4 * q;
#pragma unroll
          for (int dt = 0; dt < 8; ++dt) { const u32x2 ug = *(const u32x2*)(UG + rowoff + 16 * dt), gb = *(const u32x2*)(GB + rowoff + 16 * dt);
              const f32x4 g4 = *(const f32x4*)(lnvg + c0 + 16 * dt + 4 * q), b4 = *(const f32x4*)(lnvb + c0 + 16 * dt + 4 * q);
              const f32x4 u4 = (f32x4){bflo(ug.x), bfhi(ug.x), bflo(ug.y), bfhi(ug.y)}, gq = (f32x4){bflo(gb.x), bfhi(gb.x), bflo(gb.y), bfhi(gb.y)};
              const f32x4 mixed = g4 * (ya[dt] - c1) + b4 * c2 + bs;
              const f32x4 o = u4 * mixed + gq * yb[dt];
              *(u32x2*)(MG + rowoff + 16 * dt) = (u32x2){pg8::pk2(o[0], o[1]), pg8::pk2(o[2], o[3])}; } }
#pragma unroll
        for (int kk = 0; kk < 4; ++kk) qf[kk] = qn[kk];
    }
    MX_WAIT_BAR(0);
#undef MX_DEC
}
#undef MX_WAIT_BAR

DI void ln1_phase(Frame& F, const float* const* in) {
    const int gw = F.vcu * NWAVES + F.wave, NGW = F.G * NWAVES, lane = F.lane;
    const bf16* Y1 = (const bf16*)(F.ws + WS_Y1); bf16* X1b = (bf16*)(F.ws + WS_X1B);
    f32x4 gv[4], bv[4];
#pragma unroll
    for (int j = 0; j < 4; ++j) { gv[j] = ((const f32x4*)in[11])[lane + 64 * j]; bv[j] = ((const f32x4*)in[12])[lane + 64 * j]; }
    for (int m = gw; m < T; m += NGW) { f32x4 v[4]; float mean, rstd; row_stats_b16(Y1 + (size_t)m * D, lane, v, mean, rstd);
        u32x2* ob = (u32x2*)(X1b + (size_t)m * D) + lane;
#pragma unroll
        for (int j = 0; j < 4; ++j) { const f32x4 y = (v[j] - mean) * rstd * gv[j] + bv[j]; ob[64 * j] = (u32x2){pg8::pk2(y[0], y[1]), pg8::pk2(y[2], y[3])}; } }
}

DI void memattn_phase(Frame& F, int first, int stride) {
    LAS unsigned char* lds = F.lds; unsigned char* ws = F.ws;
    const int lane = F.lane, w = F.wave, r = lane & 15, q = lane >> 4;
    const bf16* Qm = (const bf16*)(ws + WS_QM); const bf16* KV = (const bf16*)(ws + WS_KVM); bf16* Om = (bf16*)(ws + WS_OM);
    for (int su = first; su < NBATCH * 4 * 8; su += stride) {
        const int qc = su & 7, h = (su >> 3) & 3, b = su >> 5;
        mx_dma(lds, KV + (size_t)(b * MEMLEN) * D + h * 128, w, lane); mx_dma(lds + MX_BUF, KV + (size_t)(b * MEMLEN + 128) * D + h * 128, w, lane);
        mx_dma(lds + 2 * MX_BUF, KV + (size_t)(b * MEMLEN) * D + MEMW + h * 128, w, lane); mx_dma(lds + 3 * MX_BUF, KV + (size_t)(b * MEMLEN + 128) * D + MEMW + h * 128, w, lane);
        bf16x8 qf[4];
#pragma unroll
        for (int kk = 0; kk < 4; ++kk) qf[kk] = *(const bf16x8*)(Qm + ((size_t)b * SEQ + 256 * qc + 16 * w + r) * MEMW + h * 128 + 32 * kk + 8 * q);
        asm volatile("s_waitcnt vmcnt(0) lgkmcnt(0)\n\ts_barrier" ::: "memory");
        for (int c = 0; c < 2; ++c) {
            const size_t trow = (size_t)b * SEQ + 256 * qc + 128 * c + 16 * w + r;
            if (c == 1) {
#pragma unroll
                for (int kk = 0; kk < 4; ++kk) qf[kk] = *(const bf16x8*)(Qm + trow * MEMW + h * 128 + 32 * kk + 8 * q); }
            f32x4 z[16];
#pragma unroll
            for (int st = 0; st < 16; ++st) { z[st] = (f32x4){0.f, 0.f, 0.f, 0.f};
#pragma unroll
                for (int kk = 0; kk < 4; ++kk) { const bf16x8 kf = *(const LAS bf16x8*)(lds + (st >> 3) * MX_BUF + (16 * (st & 7) + r) * 256 + (((4 * kk + q) ^ r) * 16));
                    z[st] = __builtin_amdgcn_mfma_f32_16x16x32_bf16(kf, qf[kk], z[st], 0, 0, 0); }
                if (st & 1) __builtin_amdgcn_sched_barrier(0); }
            float mx = -1e30f;
#pragma unroll
            for (int st = 0; st < 16; ++st) mx = fmaxf(mx, fmaxf(fmaxf(z[st][0], z[st][1]), fmaxf(z[st][2], z[st][3])));
            mx = fmaxf(mx, __shfl_xor(mx, 16)); mx = fmaxf(mx, __shfl_xor(mx, 32));
            float sum = 0.f;
#pragma unroll
            for (int st = 0; st < 16; ++st)
#pragma unroll
                for (int e = 0; e < 4; ++e) { const float pp = fast_exp2((z[st][e] - mx) * LOG2E); z[st][e] = pp; sum += pp; }
            sum += __shfl_xor(sum, 16); sum += __shfl_xor(sum, 32);
            const float inv = 1.0f / sum;
            f32x4 o[8];
#pragma unroll
            for (int dt = 0; dt < 8; ++dt) o[dt] = (f32x4){0.f, 0.f, 0.f, 0.f};
#pragma unroll
            for (int p = 0; p < 8; ++p) { const bf16x8 pf = mk_frag(z[2 * p], z[2 * p + 1]);
#pragma unroll
                for (int dt = 0; dt < 8; ++dt) { const bf16x8 vf = mx_tr(lds + (2 + (p >> 2)) * MX_BUF, 32 * (p & 3) + 4 * q, 32 * (p & 3) + 16 + 4 * q, 16 * dt, r);
                    o[dt] = __builtin_amdgcn_mfma_f32_16x16x32_bf16(vf, pf, o[dt], 0, 0, 0); }
                __builtin_amdgcn_sched_barrier(0); }
#pragma unroll
            for (int dt = 0; dt < 8; ++dt) { const f32x4 v = o[dt] * inv;
                *(u32x2*)(Om + trow * MEMW + h * 128 + 16 * dt + 4 * q) = (u32x2){pg8::pk2(v[0], v[1]), pg8::pk2(v[2], v[3])}; }
        }
        asm volatile("s_waitcnt lgkmcnt(0)\n\ts_barrier" ::: "memory");
    }
}

constexpr int RT_XRS = 2064;
constexpr int RT_XH = 0, RT_XL = 16 * RT_XRS, RT_PART = 2 * 16 * RT_XRS, RT_SC = RT_PART + 8 * 16 * 64 * 4, RT_SEL = RT_SC + 16 * 64 * 4, RT_HIST = RT_SEL + 16 * 64 * 4, RT_END = RT_HIST + 256;
static_assert(RT_END <= SCR_BYTES, "router LDS");
DI float grp8_max(float v) {
    v = fmaxf(v, dpp_f<0xB1, 0xf>(v, v)); v = fmaxf(v, dpp_f<0x4E, 0xf>(v, v)); v = fmaxf(v, dpp_f<0x141, 0xf>(v, v)); return v; }
DI float wave_max_dpp(float v) {
    const float NI = -3.0e38f;
    v = fmaxf(v, dpp_f<0x111, 0xf>(v, NI)); v = fmaxf(v, dpp_f<0x112, 0xf>(v, NI)); v = fmaxf(v, dpp_f<0x114, 0xf>(v, NI)); v = fmaxf(v, dpp_f<0x118, 0xf>(v, NI));
    v = fmaxf(v, dpp_f<0x142, 0xa>(v, NI)); v = fmaxf(v, dpp_f<0x143, 0xc>(v, NI));
    return __uint_as_float(__builtin_amdgcn_readlane(__float_as_uint(v), 63));
}
DI float rdlane(float v, int l) { return __uint_as_float(__builtin_amdgcn_readlane(__float_as_uint(v), l)); }
DI void route_phase(Frame& F, const float* const* in, unsigned* gcount) {
    LAS unsigned char* lds = F.lds; unsigned char* ws = F.ws;
    const int tid = F.tid, lane = F.lane, w = F.wave, r = lane & 15, q = lane >> 4;
    const bf16* Y2 = (const bf16*)F.out; bf16* X2b = (bf16*)(ws + WS_X2B);
    const bf16* WRH = (const bf16*)(ws + WS_WRHI); const bf16* WRL = (const bf16*)(ws + WS_WRLO);
    unsigned* TK = (unsigned*)(ws + WS_TK); float* TKW = (float*)(ws + WS_TKW); unsigned* WGB = (unsigned*)(ws + WS_WGBASE);
    LAS unsigned* HIST = (LAS unsigned*)(lds + RT_HIST);
    if (tid < 64) HIST[tid] = 0u;
    const float rb = in[19][lane];
    f32x4 gv[4], bv[4];
#pragma unroll
    for (int j = 0; j < 4; ++j) { gv[j] = ((const f32x4*)in[16])[lane + 64 * j]; bv[j] = ((const f32x4*)in[17])[lane + 64 * j]; }
    bf16x8 bh[4][4], bl[4][4];
#pragma unroll
    for (int kk = 0; kk < 4; ++kk)
#pragma unroll
        for (int nt = 0; nt < 4; ++nt) { const size_t o = (size_t)(16 * nt + r) * D + 128 * w + 32 * kk + 8 * q; bh[kk][nt] = *(const bf16x8*)(WRH + o); bl[kk][nt] = *(const bf16x8*)(WRL + o); }
    u32x2 va[4], vb[4];
    { const int tl0 = F.vcu; if (tl0 < T / 16) {
#pragma unroll
        for (int j = 0; j < 4; ++j) { va[j] = ((const u32x2*)(Y2 + ((size_t)16 * tl0 + 2 * w) * D))[lane + 64 * j]; vb[j] = ((const u32x2*)(Y2 + ((size_t)16 * tl0 + 2 * w + 1) * D))[lane + 64 * j]; } } }
    __syncthreads();
    for (int tl = F.vcu; tl < T / 16; tl += F.G) {
#pragma unroll
        for (int rr = 0; rr < 2; ++rr) { const int lr = 2 * w + rr; const size_t m = (size_t)16 * tl + lr;
            f32x4 v[4]; float s = 0.f;
#pragma unroll
            for (int j = 0; j < 4; ++j) { const u32x2 x = rr ? vb[j] : va[j]; v[j] = (f32x4){bflo(x.x), bfhi(x.x), bflo(x.y), bfhi(x.y)}; s += (v[j][0] + v[j][1]) + (v[j][2] + v[j][3]); }
            const float mean = wave_sum(s) * (1.f / D); float s2 = 0.f;
#pragma unroll
            for (int j = 0; j < 4; ++j) { const f32x4 d = v[j] - mean; s2 += (d[0] * d[0] + d[1] * d[1]) + (d[2] * d[2] + d[3] * d[3]); }
            const float rstd = 1.f / sqrtf(wave_sum(s2) * (1.f / D) + LN_EPS);
            u32x2* ob = (u32x2*)(X2b + m * D) + lane;
#pragma unroll
            for (int j = 0; j < 4; ++j) { const f32x4 y = (v[j] - mean) * rstd * gv[j] + bv[j];
                const u32x2 hi = (u32x2){pg8::pk2(y[0], y[1]), pg8::pk2(y[2], y[3])}; ob[64 * j] = hi;
                const f32x4 rs = (f32x4){y[0] - bflo(hi.x), y[1] - bfhi(hi.x), y[2] - bflo(hi.y), y[3] - bfhi(hi.y)};
                *(LAS u32x2*)(lds + RT_XH + lr * RT_XRS + (4 * lane + 256 * j) * 2) = hi;
                *(LAS u32x2*)(lds + RT_XL + lr * RT_XRS + (4 * lane + 256 * j) * 2) = (u32x2){pg8::pk2(rs[0], rs[1]), pg8::pk2(rs[2], rs[3])}; } }
        { const int tn = tl + F.G; if (tn < T / 16) {
#pragma unroll
            for (int j = 0; j < 4; ++j) { va[j] = ((const u32x2*)(Y2 + ((size_t)16 * tn + 2 * w) * D))[lane + 64 * j]; vb[j] = ((const u32x2*)(Y2 + ((size_t)16 * tn + 2 * w + 1) * D))[lane + 64 * j]; } } }
        __syncthreads();
        { f32x4 acc[4];
#pragma unroll
          for (int nt = 0; nt < 4; ++nt) acc[nt] = (f32x4){0.f, 0.f, 0.f, 0.f};
#pragma unroll
          for (int kk = 0; kk < 4; ++kk) { const int k0 = 128 * w + 32 * kk + 8 * q;
              const bf16x8 ah = *(const LAS bf16x8*)(lds + RT_XH + r * RT_XRS + k0 * 2), al = *(const LAS bf16x8*)(lds + RT_XL + r * RT_XRS + k0 * 2);
#pragma unroll
              for (int nt = 0; nt < 4; ++nt) {
                  acc[nt] = __builtin_amdgcn_mfma_f32_16x16x32_bf16(ah, bh[kk][nt], acc[nt], 0, 0, 0);
                  acc[nt] = __builtin_amdgcn_mfma_f32_16x16x32_bf16(al, bh[kk][nt], acc[nt], 0, 0, 0);
                  acc[nt] = __builtin_amdgcn_mfma_f32_16x16x32_bf16(ah, bl[kk][nt], acc[nt], 0, 0, 0); } }
#pragma unroll
          for (int nt = 0; nt < 4; ++nt)
#pragma unroll
              for (int e = 0; e < 4; ++e) *(LAS float*)(lds + RT_PART + ((w * 16 + 4 * q + e) * 64 + 16 * nt + r) * 4) = acc[nt][e]; }
        __syncthreads();
#pragma unroll
        for (int rr = 0; rr < 2; ++rr) { const int lt = 2 * w + rr; const size_t tok = (size_t)16 * tl + lt;
            float lg = 0.f;
#pragma unroll
            for (int k = 0; k < 8; ++k) lg += *(const LAS float*)(lds + RT_PART + ((k * 16 + lt) * 64 + lane) * 4);
            const float sc = 1.0f / (1.0f + __expf(-lg)); const float sel = sc + rb;
            const int g = lane >> 3;
            const float m1 = grp8_max(sel);
            const unsigned long long bal = __ballot(sel == m1);
            const unsigned gb = (unsigned)(bal >> (8 * g)) & 0xffu; const int first = 8 * g + __builtin_ctz(gb);
            const float m2 = grp8_max(lane == first ? -1e30f : sel);
            const float gs = m1 + m2;
            int grank = 0;
#pragma unroll
            for (int g2 = 0; g2 < 8; ++g2) { const float v = rdlane(gs, 8 * g2); grank += ((v > gs) || (v == gs && g2 < g)) ? 1 : 0; }
            const float val = (grank < 4) ? sel : -1e30f;
            float cur = val; bool chosen = false;
#pragma unroll
            for (int it = 0; it < 8; ++it) { const float mxv = wave_max_dpp(cur); const unsigned long long hit = __ballot(cur == mxv);
                const int win = __builtin_ctzll(hit); const bool me = (lane == win); chosen = chosen || me; cur = me ? -3.0e38f : cur; }
            const unsigned long long cm = __ballot(chosen);
            const float wsum = wave_sum(chosen ? sc : 0.f);
            if (chosen) { const int kidx = __builtin_popcountll(cm & ((1ull << lane) - 1ull));
                const unsigned lrk = __hip_atomic_fetch_add(&HIST[lane], 1u, __ATOMIC_RELAXED, __HIP_MEMORY_SCOPE_WORKGROUP);
                TK[tok * 8 + kidx] = (unsigned)lane | (lrk << 8); TKW[tok * 8 + kidx] = sc * (ROUTED_SCALE / wsum); }
        }
        __syncthreads();
    }
    if (tid < 64) { const unsigned cnt = HIST[tid]; const unsigned base = __hip_atomic_fetch_add(gcount + tid, cnt, RLX_AGENT); WGB[F.vcu * 64 + tid] = base; }
}

DI void slots_phase(Frame& F) {
    LAS unsigned char* lds = F.lds; unsigned char* ws = F.ws; const int tid = F.tid;
    LAS unsigned* CNT = (LAS unsigned*)lds; LAS unsigned* PS = CNT + 64;
    int* ROWTOK = (int*)(ws + WS_ROWTOK); float* ROWW = (float*)(ws + WS_ROWW); unsigned* SLOT = (unsigned*)(ws + WS_SLOT);
    const unsigned* TK = (const unsigned*)(ws + WS_TK); const float* TKW = (const float*)(ws + WS_TKW); const unsigned* WGB = (const unsigned*)(ws + WS_WGBASE);
    if (tid < 64) CNT[tid] = __hip_atomic_load(F.ctl + CW_GCOUNT + tid, RLX_AGENT);
    __syncthreads();
    if (tid == 0) { unsigned run = 0u; for (int e = 0; e < 64; ++e) { PS[e] = run; run += (CNT[e] + 255u) & ~255u; } PS[64] = run; }
    __syncthreads();
    const unsigned nblk = PS[64] >> 8;
    if (F.vcu == 0) {
        if (tid == 0) { __hip_atomic_store(F.ctl + CW_HDR, nblk, RLX_AGENT); __hip_atomic_store(F.ctl + CW_HDR + 1, (nblk + 1u) >> 1, RLX_AGENT); }
        for (unsigned bl = tid; bl < nblk; bl += NTHREADS) { unsigned e = 0; for (int k = 1; k < 64; ++k) e += (PS[k] <= bl * 256u) ? 1u : 0u; __hip_atomic_store(F.ctl + CW_BLKE + bl, e, RLX_AGENT); }
    }
    for (int e = F.vcu; e < 64; e += F.G) { const unsigned lo = PS[e] + CNT[e], hi = PS[e + 1]; for (unsigned s = lo + tid; s < hi; s += NTHREADS) { ROWTOK[s] = 0; ROWW[s] = 0.f; } }
    for (int tl = F.vcu; tl < T / 16; tl += F.G) {
        if (tid < 128) { const size_t a = (size_t)16 * 8 * tl + tid; const unsigned pk = TK[a], e = pk & 0xffu, lrk = pk >> 8;
            const unsigned slot = PS[e] + WGB[F.vcu * 64 + e] + lrk; ROWTOK[slot] = (int)(a >> 3); ROWW[slot] = TKW[a]; SLOT[a] = slot; }
    }
}

DI void dec8(unsigned w, float (&o)[4]) { const f32x2 a = __builtin_amdgcn_cvt_pk_f32_fp8((int)w, false), b = __builtin_amdgcn_cvt_pk_f32_fp8((int)w, true); o[0] = a[0]; o[1] = a[1]; o[2] = b[0]; o[3] = b[1]; }
DI void combine_phase(Frame& F, const float* const* in) {
    const int gw = F.vcu * NWAVES + F.wave, NGW = F.G * NWAVES, lane = F.lane;
    const unsigned* SLOT = (const unsigned*)(F.ws + WS_SLOT); const unsigned char* Y8 = (const unsigned char*)(F.ws + WS_YH); const bf16* base = (const bf16*)(F.ws + WS_X2B); float* out = F.out;
    f32x4 gv[4], bv[4];
#pragma unroll
    for (int j = 0; j < 4; ++j) { gv[j] = *(const f32x4*)(in[26] + 16 * lane + 4 * j); bv[j] = *(const f32x4*)(in[27] + 16 * lane + 4 * j); }
    for (int m0 = gw; m0 < T; m0 += 2 * NGW) {
        u32x4 yr[2][8]; u32x4 bs[2][2];
#pragma unroll
        for (int t2 = 0; t2 < 2; ++t2) { const int m = m0 + t2 * NGW; const int mm = (m < T) ? m : m0;
            unsigned sl[8];
#pragma unroll
            for (int k = 0; k < 8; ++k) sl[k] = __builtin_amdgcn_readfirstlane(__hip_atomic_load(SLOT + (size_t)mm * 8 + k, RLX_AGENT));
            bs[t2][0] = *(const u32x4*)(base + (size_t)mm * D + 16 * lane); bs[t2][1] = *(const u32x4*)(base + (size_t)mm * D + 16 * lane + 8);
#pragma unroll
            for (int k = 0; k < 8; ++k) yr[t2][k] = *(const u32x4*)(Y8 + (size_t)sl[k] * D + 16 * lane);
        }
#pragma unroll
        for (int t2 = 0; t2 < 2; ++t2) { const int m = m0 + t2 * NGW; if (m >= T) continue;
            float a[16];
#pragma unroll
            for (int c = 0; c < 16; ++c) a[c] = 0.f;
#pragma unroll
            for (int k = 0; k < 8; ++k) { const u32x4 y = yr[t2][k]; float d[4];
                dec8(y.x, d); a[0] += d[0]; a[1] += d[1]; a[2] += d[2]; a[3] += d[3];
                dec8(y.y, d); a[4] += d[0]; a[5] += d[1]; a[6] += d[2]; a[7] += d[3];
                dec8(y.z, d); a[8] += d[0]; a[9] += d[1]; a[10] += d[2]; a[11] += d[3];
                dec8(y.w, d); a[12] += d[0]; a[13] += d[1]; a[14] += d[2]; a[15] += d[3]; }
            f32x4 v[4];
#pragma unroll
            for (int h = 0; h < 2; ++h) { const u32x4 x = bs[t2][h];
                v[2 * h] = (f32x4){bflo(x.x), bfhi(x.x), bflo(x.y), bfhi(x.y)} + (f32x4){a[8 * h], a[8 * h + 1], a[8 * h + 2], a[8 * h + 3]} * (1.0f / pg8::Y8_SCALE);
                v[2 * h + 1] = (f32x4){bflo(x.z), bfhi(x.z), bflo(x.w), bfhi(x.w)} + (f32x4){a[8 * h + 4], a[8 * h + 5], a[8 * h + 6], a[8 * h + 7]} * (1.0f / pg8::Y8_SCALE); }
            float s = 0.f;
#pragma unroll
            for (int j = 0; j < 4; ++j) s += (v[j][0] + v[j][1]) + (v[j][2] + v[j][3]);
            const float mean = wave_sum(s) * (1.f / D); float s2 = 0.f;
#pragma unroll
            for (int j = 0; j < 4; ++j) { const f32x4 d = v[j] - mean; s2 += (d[0] * d[0] + d[1] * d[1]) + (d[2] * d[2] + d[3] * d[3]); }
            const float rstd = 1.f / sqrtf(wave_sum(s2) * (1.f / D) + LN_EPS);
#pragma unroll
            for (int j = 0; j < 4; ++j) *(f32x4*)(out + (size_t)m * D + 16 * lane + 4 * j) = (v[j] - mean) * rstd * gv[j] + bv[j];
        }
    }
}

DI void stagger(const Frame& F, unsigned ticks) {
    if (F.vcu & 1) { const unsigned long long t0 = __builtin_amdgcn_s_memrealtime(); while (__builtin_amdgcn_s_memrealtime() - t0 < ticks) __builtin_amdgcn_s_sleep(8); }
}
#ifndef STAG_DOWN
#define STAG_DOWN 350
#endif
constexpr int NPHASE = 13;
constexpr int CVT_A = 12288;
constexpr int N_LAUNCHES = MK_N_LAUNCHES;
static_assert(N_LAUNCHES == 1 || N_LAUNCHES == NPHASE, "MK_N_LAUNCHES: 1 (one dispatch) or 13 (one dispatch per phase)");
struct Args { const float* in[28]; float* out; unsigned char* ws; int ph_lo, ph_hi; };
static_assert(sizeof(Args) == 28 * 8 + 8 + 8 + 8, "Args has no padding");

__global__ void __launch_bounds__(NTHREADS, 2) fwd_kernel(Args args) {
    extern __shared__ __attribute__((aligned(16))) unsigned char lds_raw[];
    Frame F;
    F.lds = (LAS unsigned char*)lds_raw;
    volatile LAS unsigned* MISC = (volatile LAS unsigned*)(F.lds + MISC_OFF);
    F.tid = threadIdx.x; F.lane = F.tid & 63; F.wave = __builtin_amdgcn_readfirstlane(F.tid >> 6);
    F.G = gridDim.x; { const int bx = blockIdx.x; F.vcu = (F.G % 8 == 0) ? (bx % 8) * (F.G / 8) + bx / 8 : bx; }
    F.ws = args.ws; F.ctl = (unsigned*)(args.ws + WS_CTL); F.out = args.out;
    unsigned char* ws = args.ws;
    for (int u = F.tid; u < (LDS_BYTES - MISC_OFF) / 4; u += NTHREADS) ((LAS unsigned*)(F.lds + MISC_OFF))[u] = 0u;
    __syncthreads();
    XcdBarrier bar; bar.bar = F.ctl + CW_BAR; bar.x = 0; bar.st = nullptr;
    if (N_LAUNCHES == 1) bar = xcd_barrier_post(F.ctl + CW_BAR, MISC + 8);
#define GRID_BAR() do { if (N_LAUNCHES == 1) xcd_barrier(bar); } while (0)
    const int lo = args.ph_lo, hi = args.ph_hi;
#ifndef PHASE_MASK
#define PHASE_MASK 0x1fff
#endif
#define IN(k) (((PHASE_MASK >> (k)) & 1) && lo <= (k) && (k) < hi)
#ifndef REPEAT_MASK
#define REPEAT_MASK 0
#endif
#ifndef DOWN_PROBE
#define DOWN_PROBE 0
#endif
#define REP(k) (((REPEAT_MASK >> (k)) & 1) ? 2 : 1)
#define SEAM(k) do { if (IN(k) && IN((k) + 1)) GRID_BAR(); } while (0)
    const float* const* in = args.in;

    for (int rep_ = 0; rep_ < (IN(0) ? REP(0) : 0); ++rep_) { if (rep_) GRID_BAR(); p0_prologue(F, in); SEAM(0); }
    for (int rep_ = 0; rep_ < (IN(1) ? REP(1) : 0); ++rep_) { if (rep_) GRID_BAR();
        pg8::DenseOrder S; S.init((const bf16*)F.out, (const bf16*)(ws + WS_WIN), T, INW, D, F.G, (int)blockIdx.x);
        pg8::EpiInProj E{(bf16*)(ws + WS_P1), (float*)(ws + WS_VSTAT), (const float*)(ws + WS_BPERM)};
        pg8::gemm_phase<pg8::EpiInProj, pg8::DenseOrder, true>(F.lds, D, S, E);
        SEAM(1);
    }
    for (int rep_ = 0; rep_ < (IN(2) ? REP(2) : 0); ++rep_) { if (rep_) GRID_BAR(); mix_phase(F, in); SEAM(2); }
    for (int rep_ = 0; rep_ < (IN(3) ? REP(3) : 0); ++rep_) { if (rep_) GRID_BAR();
        pg8::DenseOrder S; S.init((const bf16*)(ws + WS_MERGED), (const bf16*)(ws + WS_WOUT), T, D, D, F.G, (int)blockIdx.x);
        pg8::EpiResB16<true> E{(bf16*)(ws + WS_Y1), in[0], nullptr, (const float*)(ws + WS_XSTAT), in[2], in[3]};
        pg8::gemm_phase<pg8::EpiResB16<true>, pg8::DenseOrder, false>(F.lds, D, S, E);
        SEAM(3);
    }
    for (int rep_ = 0; rep_ < (IN(4) ? REP(4) : 0); ++rep_) { if (rep_) GRID_BAR(); ln1_phase(F, in); SEAM(4); }
    for (int rep_ = 0; rep_ < (IN(5) ? REP(5) : 0); ++rep_) { if (rep_) GRID_BAR();
        if (F.G == 256) { if ((int)blockIdx.x >= 160) expert_convert(F, in, (int)blockIdx.x - 160, 96, 0, CVT_A); }
        else expert_convert(F, in, F.vcu, F.G, 0, NEXP * 384);
        __syncthreads();
        { pg8::DenseOrder S; S.init((const bf16*)(ws + WS_X1B), (const bf16*)(ws + WS_WQ), T, MEMW, D, F.G, (int)blockIdx.x);
          pg8::EpiBf16S E{(bf16*)(ws + WS_QM), MEMW, QSCALE};
          pg8::gemm_phase<pg8::EpiBf16S, pg8::DenseOrder, false>(F.lds, D, S, E); }
        { const int c2 = ((int)blockIdx.x + F.G - 128 % F.G) % F.G;
          pg8::DenseOrder S; S.init((const bf16*)(ws + WS_MEMB), (const bf16*)(ws + WS_WKV), NBATCH * MEMLEN, 2 * MEMW, D, F.G, c2);
          pg8::EpiBf16S E{(bf16*)(ws + WS_KVM), 2 * MEMW, 1.0f};
          pg8::gemm_phase<pg8::EpiBf16S, pg8::DenseOrder, false>(F.lds, D, S, E); }
        SEAM(5);
    }
    for (int rep_ = 0; rep_ < (IN(6) ? REP(6) : 0); ++rep_) { if (rep_) GRID_BAR();
        if (F.G == 256) { if (F.vcu & 1) expert_convert(F, in, F.vcu >> 1, 128, CVT_A, NEXP * 384); else memattn_phase(F, F.vcu >> 1, 128); }
        else memattn_phase(F, F.vcu, F.G);
        SEAM(6); }
    for (int rep_ = 0; rep_ < (IN(7) ? REP(7) : 0); ++rep_) { if (rep_) GRID_BAR();
        pg8::DenseOrder S; S.init((const bf16*)(ws + WS_OM), (const bf16*)(ws + WS_WO), T, D, MEMW, F.G, (int)blockIdx.x);
        pg8::EpiResB16<false> E{(bf16*)F.out, nullptr, (const bf16*)(ws + WS_X1B), nullptr, nullptr, nullptr};
        pg8::gemm_phase<pg8::EpiResB16<false>, pg8::DenseOrder, false>(F.lds, MEMW, S, E);
        SEAM(7);
    }
    for (int rep_ = 0; rep_ < (IN(8) ? REP(8) : 0); ++rep_) { if (rep_) GRID_BAR(); route_phase(F, in, F.ctl + ((rep_ + 1 < REP(8)) ? 2048 : CW_GCOUNT)); SEAM(8); }
    for (int rep_ = 0; rep_ < (IN(9) ? REP(9) : 0); ++rep_) { if (rep_) GRID_BAR(); slots_phase(F); SEAM(9); }
    for (int rep_ = 0; rep_ < (IN(10) ? REP(10) : 0); ++rep_) { if (rep_) GRID_BAR();
        const int nblk = (int)__builtin_amdgcn_readfirstlane(__hip_atomic_load(F.ctl + CW_HDR, RLX_AGENT));
        pg8::moe_tables(F.lds, F.ctl + CW_BLKE, nblk, (const int*)(ws + WS_ROWTOK), (const float*)(ws + WS_ROWW), true, F.G, F.vcu, F.tid);
        pg8::GateUpOrder S{(const char*)(ws + WS_X2B), (const char*)(ws + WS_WGU), (const char*)(ws + WS_WGUS), F.lds, nblk, F.G, F.vcu};
        pg8::EpiGateUp E{(unsigned char*)(ws + WS_H), F.lds};
        pg8::gemm_phase<pg8::EpiGateUp, pg8::GateUpOrder, true>(F.lds, D, S, E);
        SEAM(10);
    }
    for (int rep_ = 0; rep_ < (IN(11) ? REP(11) : 0); ++rep_) { if (rep_) GRID_BAR();
        const int nblk = (int)__builtin_amdgcn_readfirstlane(__hip_atomic_load(F.ctl + CW_HDR, RLX_AGENT));
        pg8::moe_tables(F.lds, F.ctl + CW_BLKE, nblk, nullptr, nullptr, false, F.G, F.vcu, F.tid);
        pg8::DownOrder S{(const char*)(ws + WS_H), (const char*)(ws + WS_WD), (const char*)(ws + WS_WDS), F.lds, 0, nblk, 64, F.G, F.vcu, 0};
        pg8::EpiDown E{(unsigned char*)(ws + WS_YH), (bf16*)(ws + WS_X2B), 0};
        int kq = EH / 2; asm volatile("" : "+s"(kq));
        pg8::gemm_phase<pg8::EpiDown, pg8::DownOrder, true, true>(F.lds, kq, S, E);
        SEAM(11);
    }
    if (IN(12)) { combine_phase(F, in); }
#undef IN
#undef SEAM
#undef GRID_BAR
}

extern "C" void kernel_launch(void* const* d_in, const int* in_sizes, int n_in, void* d_out, int out_size, void* d_ws, size_t ws_size, hipStream_t stream) {
    static int grid = 0;
    if (grid == 0) {
        if (n_in != 28 || in_sizes[0] != T * D || out_size != T * D || ws_size < WS_END) { fprintf(stderr, "kernel_launch: unexpected shapes / workspace (n_in %d, ws %zu < %zu)\n", n_in, ws_size, (size_t)WS_END); grid = -1; return; }
        int dev = 0, cus = 0, per_cu = 0;
        if (hipGetDevice(&dev) != hipSuccess || hipDeviceGetAttribute(&cus, hipDeviceAttributeMultiprocessorCount, dev) != hipSuccess) { grid = -1; return; }
        if (hipFuncSetAttribute((const void*)fwd_kernel, hipFuncAttributeMaxDynamicSharedMemorySize, LDS_BYTES) != hipSuccess) { fprintf(stderr, "kernel_launch: hipFuncSetAttribute failed\n"); grid = -1; return; }
        if (hipOccupancyMaxActiveBlocksPerMultiprocessor(&per_cu, (const void*)fwd_kernel, NTHREADS, LDS_BYTES) != hipSuccess || per_cu < 1) { fprintf(stderr, "kernel_launch: occupancy query reports %d\n", per_cu); }
        (void)hipGetLastError();
        grid = cus;
    }
    if (grid < 0) return;
    if (hipMemsetAsync((char*)d_ws + WS_CTL, 0, CTL_ZERO_BYTES, stream) != hipSuccess) return;
    Args a{};
    for (int i = 0; i < 28; ++i) a.in[i] = (const float*)d_in[i];
    a.out = (float*)d_out; a.ws = (unsigned char*)d_ws;
    for (int li = 0; li < N_LAUNCHES; ++li) {
        a.ph_lo = (N_LAUNCHES == 1) ? 0 : li; a.ph_hi = (N_LAUNCHES == 1) ? NPHASE : li + 1;
        hipLaunchKernelGGL(fwd_kernel, dim3(grid), dim3(NTHREADS), LDS_BYTES, stream, a);
        if (hipPeekAtLastError() != hipSuccess) { fprintf(stderr, "kernel_launch: launch %d failed\n", li); break; }
    }
}
```
